# Optimizing an MI355X kernel written in HIP

```python
import jax, jax.numpy as jnp
from jax import lax
import numpy as np

D_MODEL = 1024
BATCH = 8
SEQ = 2048
DEPTH = 2
DEC_BATCH = 128
DEC_SEQ = 1
PAST_LEN = 16384
PAGE_SIZE = 128

D_MIX = 2 * D_MODEL
W_A = D_MIX // 2
W_B = D_MIX - W_A
NB_A = 16
BW_A = W_A // NB_A
CONV_W = 4
LRU_C = 8.0
H_B = 4
DK = W_B // H_B
DV = W_B // H_B
CHUNK = 128
EPS = 1e-6
SPLIT_SIZES = (W_A, W_A, W_B, W_B, W_B, W_B, W_B, H_B, H_B)
D_IN = sum(SPLIT_SIZES)
SPLIT_IDX = tuple(int(v) for v in np.cumsum(SPLIT_SIZES)[:-1])

kernel_name = "hymba_rglru_mlstm_decoder_step"


def rmsnorm(x, g):
    xf = x.astype(jnp.float32)
    y = xf * lax.rsqrt(jnp.mean(xf * xf, axis=-1, keepdims=True) + EPS)
    return (y * g.astype(jnp.float32)).astype(x.dtype)


def _lin_combine(e1, e2):
    a1, b1 = e1
    a2, b2 = e2
    return a1 * a2, a2 * b1 + b2


def rglru_branch(xa, conv_buf, h0, conv_w, conv_b, w_r, b_r, w_i, b_i, lam):
    B, S, _ = xa.shape
    ext = jnp.concatenate([conv_buf.astype(xa.dtype), xa], axis=1)
    xc = conv_b.astype(jnp.float32) + sum(
        conv_w[j].astype(jnp.float32) * ext[:, j:j + S].astype(jnp.float32) for j in range(CONV_W))
    new_buf = ext[:, S:]
    blocks = xc.reshape(B, S, NB_A, BW_A)
    r = jax.nn.sigmoid(jnp.einsum('bsnc,ncd->bsnd', blocks, w_r.astype(jnp.float32)).reshape(B, S, W_A)
                       + b_r.astype(jnp.float32))
    i = jax.nn.sigmoid(jnp.einsum('bsnc,ncd->bsnd', blocks, w_i.astype(jnp.float32)).reshape(B, S, W_A)
                       + b_i.astype(jnp.float32))
    log_a = -LRU_C * r * jax.nn.softplus(-lam.astype(jnp.float32))
    a = jnp.exp(log_a)
    u = jnp.sqrt(-jnp.expm1(2.0 * log_a)) * (i * xc)
    A, Bc = lax.associative_scan(_lin_combine, (a, u), axis=1)
    h = A * h0.astype(jnp.float32)[:, None, :] + Bc
    return h, h[:, -1], new_buf


def mlstm_chunk(carry, inp):
    C, n, m = carry
    q, k, v, ig, lf = inp
    L = q.shape[1]
    b = jnp.cumsum(lf, axis=1).transpose(0, 2, 1)
    igh = ig.transpose(0, 2, 1)
    causal = jnp.tril(jnp.ones((L, L), dtype=bool))
    D = jnp.where(causal, b[:, :, :, None] - b[:, :, None, :] + igh[:, :, None, :], -jnp.inf)
    g = b + m[:, :, None]
    m_t = jnp.maximum(g, jnp.max(D, axis=-1))
    w = jnp.exp(D - m_t[..., None])
    ginter = jnp.exp(g - m_t)
    P = w * jnp.einsum('bthk,bshk->bhts', q, k)
    num = (jnp.einsum('bhts,bshv->bthv', P, v)
           + ginter.transpose(0, 2, 1)[..., None] * jnp.einsum('bthk,bhkv->bthv', q, C))
    den = jnp.sum(P, axis=-1) + ginter * jnp.einsum('bthk,bhk->bht', q, n)
    denom = jnp.maximum(jnp.abs(den), jnp.exp(-m_t)).transpose(0, 2, 1)[..., None]
    h = num / denom
    mL = m_t[:, :, -1]
    decay = jnp.exp(b[:, :, -1:] - b + igh - mL[:, :, None])
    carry_scale = jnp.exp(b[:, :, -1] + m - mL)
    C_new = carry_scale[..., None, None] * C + jnp.einsum('bhs,bshk,bshv->bhkv', decay, k, v)
    n_new = carry_scale[..., None] * n + jnp.einsum('bhs,bshk->bhk', decay, k)
    return (C_new, n_new, mL), h


def mlstm_seq(q, k, v, ig, lf, C0, n0, m0):
    B, S = q.shape[:2]
    L = CHUNK if S % CHUNK == 0 else S
    nc = S // L

    def to_chunks(t):
        return jnp.moveaxis(t.reshape((B, nc, L) + t.shape[2:]), 1, 0)

    carry0 = (C0.astype(jnp.float32), n0.astype(jnp.float32), m0.astype(jnp.float32))
    (C, n, m), hs = lax.scan(mlstm_chunk, carry0,
                             (to_chunks(q), to_chunks(k), to_chunks(v), to_chunks(ig), to_chunks(lf)))
    h = jnp.moveaxis(hs, 0, 1).reshape(B, S, H_B, DV)
    return h, C, n, m


def hybrid_layer(x, h0, conv0, C0, n0, m0, g_norm, w_in, conv_w, conv_b, w_rgate, b_rgate,
                 w_igate, b_igate, lru_lambda, b_mi, b_mf, g_mhead, w_out):
    B, S, _ = x.shape
    hn = rmsnorm(x, g_norm)
    u = hn @ w_in
    xa, za, uq, uk, uv, uo, zb, ui, uf = jnp.split(u, SPLIT_IDX, axis=-1)
    yA, hA, bufA = rglru_branch(xa, conv0, h0, conv_w, conv_b, w_rgate, b_rgate, w_igate, b_igate, lru_lambda)
    q = uq.astype(jnp.float32).reshape(B, S, H_B, DK)
    k = uk.astype(jnp.float32).reshape(B, S, H_B, DK) * (DK ** -0.5)
    v = uv.astype(jnp.float32).reshape(B, S, H_B, DV)
    ig = ui.astype(jnp.float32) + b_mi.astype(jnp.float32)
    lf = jax.nn.log_sigmoid(uf.astype(jnp.float32) + b_mf.astype(jnp.float32))
    hB, C, n, m = mlstm_seq(q, k, v, ig, lf, C0, n0, m0)
    yB = jax.nn.sigmoid(uo.astype(jnp.float32)).reshape(B, S, H_B, DV) * hB
    yB = yB * lax.rsqrt(jnp.mean(yB * yB, axis=-1, keepdims=True) + EPS)
    yB = yB.reshape(B, S, W_B) * g_mhead.astype(jnp.float32)
    merged = jnp.concatenate([yA * jax.nn.silu(za.astype(jnp.float32)),
                              yB * jax.nn.silu(zb.astype(jnp.float32))], axis=-1).astype(x.dtype)
    x = x + merged @ w_out
    return x, hA, bufA, C, n, m


def trunk(x, h_s, conv_s, C_s, n_s, m_s, g_norm, w_in, conv_w, conv_b, w_rgate, b_rgate,
          w_igate, b_igate, lru_lambda, b_mi, b_mf, g_mhead, w_out, g_final):
    hs, bufs, Cs, ns, ms = [], [], [], [], []
    for l in range(DEPTH):
        x, hA, bufA, C, n, m = hybrid_layer(
            x, h_s[l], conv_s[l], C_s[l], n_s[l], m_s[l], g_norm[l], w_in[l], conv_w[l], conv_b[l],
            w_rgate[l], b_rgate[l], w_igate[l], b_igate[l], lru_lambda[l], b_mi[l], b_mf[l],
            g_mhead[l], w_out[l])
        hs.append(hA.astype(h_s.dtype)); bufs.append(bufA.astype(conv_s.dtype))
        Cs.append(C.astype(C_s.dtype)); ns.append(n.astype(n_s.dtype)); ms.append(m.astype(m_s.dtype))
    y = rmsnorm(x, g_final)
    return y, jnp.stack(hs), jnp.stack(bufs), jnp.stack(Cs), jnp.stack(ns), jnp.stack(ms)


def setup_inputs(seed: int = 0) -> dict:
    key = jax.random.key(seed)
    ks = jax.random.split(key, 24)
    f32 = jnp.float32
    nrm = lambda k, shape, s: jax.random.normal(k, shape, f32) * s
    a_c = jax.random.uniform(ks[0], (DEPTH, W_A), f32, 0.9, 0.999)
    s = a_c ** (1.0 / LRU_C)
    lru_lambda = jnp.log(s) - jnp.log1p(-s)
    b_mf = jnp.linspace(3.0, 6.0, H_B, dtype=f32)[None, :] + nrm(ks[1], (DEPTH, H_B), 0.1)
    return {
        "x_prompt": nrm(ks[2], (BATCH, SEQ, D_MODEL), 1.0),
        "x_sample": nrm(ks[3], (DEC_BATCH, DEC_SEQ, D_MODEL), 1.0),
        "state_rglru_h": nrm(ks[4], (DEPTH, DEC_BATCH, W_A), 0.5),
        "state_rglru_conv": nrm(ks[5], (DEPTH, DEC_BATCH, CONV_W - 1, W_A), 1.0),
        "state_mlstm_C": nrm(ks[6], (DEPTH, DEC_BATCH, H_B, DK, DV), 0.1),
        "state_mlstm_n": nrm(ks[7], (DEPTH, DEC_BATCH, H_B, DK), 0.5),
        "state_mlstm_m": nrm(ks[8], (DEPTH, DEC_BATCH, H_B), 0.5),
        "g_norm": 1.0 + nrm(ks[9], (DEPTH, D_MODEL), 0.02),
        "w_in": nrm(ks[10], (DEPTH, D_MODEL, D_IN), D_MODEL ** -0.5),
        "conv_w": nrm(ks[11], (DEPTH, CONV_W, W_A), CONV_W ** -0.5),
        "conv_b": nrm(ks[12], (DEPTH, W_A), 0.05),
        "w_rgate": nrm(ks[13], (DEPTH, NB_A, BW_A, BW_A), BW_A ** -0.5),
        "b_rgate": nrm(ks[14], (DEPTH, W_A), 0.1),
        "w_igate": nrm(ks[15], (DEPTH, NB_A, BW_A, BW_A), BW_A ** -0.5),
        "b_igate": nrm(ks[16], (DEPTH, W_A), 0.1),
        "lru_lambda": lru_lambda,
        "b_mi": nrm(ks[17], (DEPTH, H_B), 0.1),
        "b_mf": b_mf,
        "g_mhead": 1.0 + nrm(ks[18], (DEPTH, W_B), 0.02),
        "w_out": nrm(ks[19], (DEPTH, W_A + W_B, D_MODEL), (W_A + W_B) ** -0.5),
        "g_final": 1.0 + nrm(ks[20], (D_MODEL,), 0.02),
    }


def reference(x_prompt, x_sample, state_rglru_h, state_rglru_conv, state_mlstm_C, state_mlstm_n,
              state_mlstm_m, g_norm, w_in, conv_w, conv_b, w_rgate, b_rgate, w_igate, b_igate,
              lru_lambda, b_mi, b_mf, g_mhead, w_out, g_final):
    Bp = x_prompt.shape[0]
    zh = jnp.zeros((DEPTH, Bp, W_A), state_rglru_h.dtype)
    zconv = jnp.zeros((DEPTH, Bp, CONV_W - 1, W_A), state_rglru_conv.dtype)
    zC = jnp.zeros((DEPTH, Bp, H_B, DK, DV), state_mlstm_C.dtype)
    zn = jnp.zeros((DEPTH, Bp, H_B, DK), state_mlstm_n.dtype)
    zm = jnp.zeros((DEPTH, Bp, H_B), state_mlstm_m.dtype)
    y_prompt, p_h, p_conv, p_C, p_n, p_m = trunk(
        x_prompt, zh, zconv, zC, zn, zm, g_norm, w_in, conv_w, conv_b, w_rgate, b_rgate,
        w_igate, b_igate, lru_lambda, b_mi, b_mf, g_mhead, w_out, g_final)
    y_sample, s_h, s_conv, s_C, s_n, s_m = trunk(
        x_sample, state_rglru_h, state_rglru_conv, state_mlstm_C, state_mlstm_n, state_mlstm_m,
        g_norm, w_in, conv_w, conv_b, w_rgate, b_rgate, w_igate, b_igate, lru_lambda, b_mi, b_mf,
        g_mhead, w_out, g_final)
    return (y_prompt, y_sample, p_h, p_conv, p_C, p_n, p_m, s_h, s_conv, s_C, s_n, s_m)
```

```cpp
#include <hip/hip_runtime.h>
#include <hip/hip_cooperative_groups.h>
#include <cstdio>
namespace cg = cooperative_groups;

#define LAS __attribute__((address_space(3)))
typedef unsigned short bf16_t;
typedef short bf16x8 __attribute__((ext_vector_type(8)));
typedef short bf16x4 __attribute__((ext_vector_type(4)));
typedef float f32x4 __attribute__((ext_vector_type(4)));
typedef unsigned u32x4 __attribute__((ext_vector_type(4)));
typedef unsigned u32x2 __attribute__((ext_vector_type(2)));

constexpr int NT = 512;
constexpr int LDS_BYTES = 147456;
constexpr int MP = 16384, MV = 16512, MR = 16640;
constexpr int DM = 1024, NU = 7168, NW1 = 7424, DIN = 7176, DMG = 2048;
constexpr float EPSF = 1e-6f;

constexpr size_t WS_XB = 0;
constexpr size_t WS_WT1 = WS_XB + (size_t)MR * DM * 2;
constexpr size_t WS_WT2 = WS_WT1 + (size_t)2 * NW1 * DM * 2;
constexpr size_t WS_WGT = WS_WT2 + (size_t)2 * DM * DMG * 2;
constexpr size_t WS_U = WS_WGT + (size_t)2 * 2 * 16 * 64 * 64 * 2;
constexpr size_t WS_G = WS_U + (size_t)MR * NU * 2;
constexpr size_t WS_MG = WS_G + (size_t)MR * 8 * 4;
constexpr size_t WS_X1 = WS_MG + (size_t)MR * DMG * 2;
constexpr size_t WS_X2 = WS_X1 + (size_t)MR * DM * 4;
constexpr size_t WS_SS = WS_X2 + (size_t)MR * DM * 4;
constexpr size_t WS_YSS = WS_SS + (size_t)MR * 16 * 4;
constexpr size_t WS_BAR = WS_YSS + (size_t)MR * 16 * 4;
constexpr size_t WS_END = WS_BAR + 16384;

struct Params {
    const float* xp; const float* xs; const float* st_h; const float* st_conv; const float* st_C; const float* st_n; const float* st_m;
    const float* g_norm; const float* w_in; const float* conv_w; const float* conv_b; const float* w_r; const float* b_r; const float* w_i; const float* b_i;
    const float* lam; const float* b_mi; const float* b_mf; const float* g_mhead; const float* w_out; const float* g_final;
    float* out; unsigned char* ws;
};

constexpr size_t O_YP = 0;
constexpr size_t O_YS = O_YP + (size_t)MP * DM;
constexpr size_t O_PH = O_YS + (size_t)128 * DM;
constexpr size_t O_PCONV = O_PH + 2 * 8 * 1024;
constexpr size_t O_PC = O_PCONV + 2 * 8 * 3 * 1024;
constexpr size_t O_PN = O_PC + (size_t)2 * 8 * 4 * 65536;
constexpr size_t O_PM = O_PN + 2 * 8 * 4 * 256;
constexpr size_t O_SH = O_PM + 2 * 8 * 4;
constexpr size_t O_SCONV = O_SH + 2 * 128 * 1024;
constexpr size_t O_SC = O_SCONV + 2 * 128 * 3 * 1024;
constexpr size_t O_SN = O_SC + (size_t)2 * 128 * 4 * 65536;
constexpr size_t O_SM = O_SN + 2 * 128 * 4 * 256;

__device__ __forceinline__ float bf2f(unsigned short v) { return __uint_as_float(((unsigned)v) << 16); }
__device__ __forceinline__ unsigned cvt_pk_bf16(float lo, float hi) { unsigned r; asm volatile("v_cvt_pk_bf16_f32 %0, %1, %2" : "=v"(r) : "v"(lo), "v"(hi)); return r; }
__device__ __forceinline__ float sigmoidf_(float x) { return __builtin_amdgcn_rcpf(1.0f + __builtin_amdgcn_exp2f(-1.44269504f * x)); }
__device__ __forceinline__ float siluf_(float x) { return x * __builtin_amdgcn_rcpf(1.0f + __builtin_amdgcn_exp2f(-1.44269504f * x)); }
__device__ __forceinline__ float softplusf_(float x) { return fmaxf(x, 0.f) + log1pf(__expf(-fabsf(x))); }
__device__ __forceinline__ int otid() { int t = threadIdx.x; asm volatile("" : "+v"(t)); return t; }
__device__ __forceinline__ int obid() { int t = blockIdx.x; asm volatile("" : "+s"(t)); return t; }
__device__ __forceinline__ f32x4 zero4() { float z = 0.f; asm volatile("" : "+v"(z)); return (f32x4){z, z, z, z}; }
__device__ __forceinline__ float lo16(unsigned w) { return __uint_as_float(w << 16); }
__device__ __forceinline__ float hi16(unsigned w) { return __uint_as_float(w & 0xffff0000u); }

namespace pg8 {
constexpr int BM = 256, BK = 64, HALF = 128, HTB = HALF * BK * 2, STAGE_BYTES = 8 * HTB, NXCD = 8, WGM = 2;
__host__ __device__ __forceinline__ int lds_byte(int r, int c) { const int st = (r >> 4) * 2 + (c >> 5), rr = r & 15, cc = c & 31, ob = rr * 64 + cc * 2; return st * 1024 + (ob ^ (((ob >> 9) & 1) << 5)); }
__host__ __device__ __forceinline__ void stage_rc(int b, int& R, int& C) { const int st = b / 1024, sb = b % 1024, swz = sb ^ (((sb >> 9) & 1) << 5); R = (st >> 1) * 16 + swz / 64; C = (st & 1) * 32 + (swz % 64) / 2; }
__host__ __device__ __forceinline__ int perm32(int rho) { const int n = rho >> 4, i = rho & 15; return 8 * (i >> 2) + 4 * n + (i & 3); }
struct Unit { int pm, pn; };
struct Gemm { const bf16_t* A; const bf16_t* Bt; int M, N, K; };
template <int NM_, int NN_>
struct StaticOrder {
    static constexpr int nM = NM_, nN = NN_, nwg = NM_ * NN_;
    int G, c;
    __device__ void init(int G_, int c_) { G = G_; c = c_; }
    __device__ static void map(int L, Unit& u) {
        int wgid = L; { constexpr int q = nwg / NXCD, r = nwg % NXCD; const int xcd = wgid % NXCD, off = wgid / NXCD; wgid = (xcd < r ? xcd * (q + 1) : r * (q + 1) + (xcd - r) * q) + off; }
        constexpr int nig = WGM * nN; const int gid = wgid / nig, fm = gid * WGM, gsz = (nM - fm) < WGM ? (nM - fm) : WGM;
        u.pm = fm + ((wgid % nig) % gsz); u.pn = (wgid % nig) / gsz;
    }
    __device__ bool next(int i, Unit& u) const { const int L = i * G + c; if (L >= nwg) return false; map(L, u); return true; }
    __device__ __forceinline__ void done(const Unit&, int) const {}
};

struct OutOrder {
    int G, c, mode;
    __device__ bool next(int i, Unit& u) const {
        const int L = i * G + c;
        if (mode == 0) { if (L >= 4) return false; u.pm = 64; u.pn = L; return true; }
        if (L >= 256) return false; StaticOrder<64, 4>::map(L, u); return true;
    }
    __device__ __forceinline__ void done(const Unit&, int) const {}
};

constexpr int IN_UNITS = 65 * 29, IN_DEC_UNITS = 29;
struct InOrder {
    int G, c; unsigned* done_ctr;
    __device__ bool next(int i, Unit& u) const {
        const int L = i * G + c; if (L >= IN_UNITS) return false;
        if (L < IN_DEC_UNITS) { u.pm = 64; u.pn = L; return true; }
        StaticOrder<64, 29>::map(L - IN_DEC_UNITS, u); return true;
    }
    __device__ __forceinline__ void done(const Unit& u, int lane) const {
        if (u.pm == 64) {
            asm volatile("s_waitcnt vmcnt(0)" ::: "memory");
            __builtin_amdgcn_fence(__ATOMIC_RELEASE, "agent");
            asm volatile("s_waitcnt vmcnt(0)" ::: "memory");
            if (lane == 0) __hip_atomic_fetch_add(done_ctr, 1u, __ATOMIC_RELAXED, __HIP_MEMORY_SCOPE_AGENT);
        }
    }
};

template <class Epi, class Sched, int KK>
__device__ __forceinline__ void gemm_phase(LAS unsigned char* lds, const Gemm g, const Sched& S, const Epi& E) {
    const int tid = otid(), wid = __builtin_amdgcn_readfirstlane(tid >> 6), lane = tid & 63, wr = wid >> 2, wc = wid & 3, fr = lane & 15, fq = lane >> 4;
    constexpr int K = KK, nt = K / BK;
    unsigned voffA[2], voffB[2];
#pragma unroll
    for (int i = 0; i < 2; ++i) { int R, C; stage_rc(tid * 16 + i * 8192, R, C); const int Rb = Epi::PERM ? ((R & ~31) + perm32(R & 31)) : R;
        voffA[i] = (unsigned)(R * K + C) * 2u; voffB[i] = (unsigned)(Rb * K + C) * 2u; }
    const size_t kstep = (size_t)(BK * 2);
    const size_t hstep = (size_t)HALF * K * 2;
    const size_t tstep = 2 * hstep;
    const unsigned ldsw = (unsigned)wid * 1024u;
    const int aoff = lds_byte(wr * 64 + fr, fq * 8), boff = lds_byte(wc * 32 + fr, fq * 8);
#define PG8_SA(b, h) (((b) * 2 + (h)) * HTB)
#define PG8_SB(b, h) ((4 + (b) * 2 + (h)) * HTB)
#define PG8_STAGE(bufoff, gbase, voff) do { _Pragma("unroll") for (int _i = 0; _i < 2; ++_i) \
        __builtin_amdgcn_global_load_lds((const unsigned*)((const char*)(gbase) + (voff)[_i]), (LAS unsigned*)(lds + (bufoff) + ldsw + _i * 8192), 16, 0, 0); } while (0)
#define PG8_LDA(dst, b, h) do { _Pragma("unroll") for (int m = 0; m < 4; ++m) _Pragma("unroll") for (int k = 0; k < 2; ++k) dst[m][k] = *(const LAS bf16x8*)(lds + PG8_SA(b, h) + aoff + m * 2048 + k * 1024); } while (0)
#define PG8_LDB(dst, b, h) do { _Pragma("unroll") for (int n = 0; n < 2; ++n) _Pragma("unroll") for (int k = 0; k < 2; ++k) dst[n][k] = *(const LAS bf16x8*)(lds + PG8_SB(b, h) + boff + n * 2048 + k * 1024); } while (0)
#define PG8_MMA(ai, bj, At, Bt) do { __builtin_amdgcn_s_setprio(1); _Pragma("unroll") for (int m = 0; m < 4; ++m) _Pragma("unroll") for (int n = 0; n < 2; ++n) _Pragma("unroll") for (int k = 0; k < 2; ++k) \
        acc[ai][bj][m][n] = __builtin_amdgcn_mfma_f32_16x16x32_bf16(Bt[n][k], At[m][k], acc[ai][bj][m][n], 0, 0, 0); __builtin_amdgcn_s_setprio(0); } while (0)
#define PG8_WAIT_V(n) asm volatile("s_waitcnt vmcnt(" #n ")" ::: "memory")
#define PG8_WAIT_L(n) asm volatile("s_waitcnt lgkmcnt(" #n ")" ::: "memory")
#define PG8_BAR __builtin_amdgcn_s_barrier()
#define PG8_SCHED __builtin_amdgcn_sched_barrier(0)
    Unit cur, nxt; int ui = 0;
    if (!S.next(0, cur)) return;
    f32x4 acc[2][2][4][2];
#pragma unroll
    for (int a = 0; a < 2; ++a)
#pragma unroll
        for (int b = 0; b < 2; ++b)
#pragma unroll
            for (int m = 0; m < 4; ++m)
#pragma unroll
                for (int n = 0; n < 2; ++n) acc[a][b][m][n] = zero4();
    bf16x8 At[4][2], B0[2][2], B1[2][2];
    const char* cA = (const char*)g.A + (size_t)cur.pm * tstep; const char* cB = (const char*)g.Bt + (size_t)cur.pn * tstep;
    PG8_STAGE(PG8_SB(0, 0), cB, voffB); PG8_STAGE(PG8_SA(0, 0), cA, voffA); PG8_STAGE(PG8_SB(0, 1), cB + hstep, voffB); PG8_STAGE(PG8_SA(0, 1), cA + hstep, voffA);
    if (wr == 1) PG8_BAR;
    PG8_WAIT_V(4); PG8_BAR;
    PG8_STAGE(PG8_SB(1, 0), cB + kstep, voffB); PG8_STAGE(PG8_SA(1, 0), cA + kstep, voffA); PG8_STAGE(PG8_SB(1, 1), cB + hstep + kstep, voffB);
    PG8_WAIT_V(6); PG8_BAR;
    for (;;) {
        const bool has_next = S.next(ui + 1, nxt);
        const char* nA = has_next ? (const char*)g.A + (size_t)nxt.pm * tstep : cA; const char* nB = has_next ? (const char*)g.Bt + (size_t)nxt.pn * tstep : cB;
        for (int t = 0; t < nt; t += 2) {
            const bool last = (t == nt - 2);
            const char* a1 = cA + (size_t)(t + 1) * kstep;
            const char* a2 = last ? nA : cA + (size_t)(t + 2) * kstep; const char* b2 = last ? nB : cB + (size_t)(t + 2) * kstep;
            const char* a3 = a2 + kstep; const char* b3 = b2 + kstep;
            PG8_LDB(B0, 0, 0); PG8_SCHED; PG8_LDA(At, 0, 0); PG8_STAGE(PG8_SA(1, 1), a1 + hstep, voffA);
            PG8_WAIT_L(8); PG8_BAR; PG8_WAIT_L(0); PG8_MMA(0, 0, At, B0); PG8_BAR; PG8_SCHED;
            PG8_LDB(B1, 0, 1); PG8_STAGE(PG8_SB(0, 0), b2, voffB);
            PG8_BAR; PG8_WAIT_L(0); PG8_MMA(0, 1, At, B1); PG8_BAR;
            PG8_LDA(At, 0, 1); PG8_STAGE(PG8_SA(0, 0), a2, voffA);
            PG8_BAR; PG8_WAIT_L(0); PG8_MMA(1, 0, At, B0); PG8_BAR; PG8_SCHED;
            PG8_STAGE(PG8_SB(0, 1), b2 + hstep, voffB);
            PG8_WAIT_V(6); PG8_BAR; PG8_MMA(1, 1, At, B1); PG8_BAR;
            PG8_LDB(B0, 1, 0); PG8_SCHED; PG8_LDA(At, 1, 0); PG8_STAGE(PG8_SA(0, 1), a2 + hstep, voffA);
            PG8_WAIT_L(8); PG8_BAR; PG8_WAIT_L(0); PG8_MMA(0, 0, At, B0); PG8_BAR; PG8_SCHED;
            PG8_LDB(B1, 1, 1); PG8_STAGE(PG8_SB(1, 0), b3, voffB);
            PG8_BAR; PG8_WAIT_L(0); PG8_MMA(0, 1, At, B1); PG8_BAR;
            PG8_LDA(At, 1, 1); PG8_STAGE(PG8_SA(1, 0), a3, voffA);
            PG8_BAR; PG8_WAIT_L(0); PG8_MMA(1, 0, At, B0); PG8_BAR; PG8_SCHED;
            PG8_STAGE(PG8_SB(1, 1), b3 + hstep, voffB);
            PG8_WAIT_V(6); PG8_BAR; PG8_MMA(1, 1, At, B1); PG8_BAR;
        }
        E(acc, cur, wr, wc, fr, fq);
        S.done(cur, lane);
        if (!has_next) break;
#pragma unroll
        for (int a = 0; a < 2; ++a)
#pragma unroll
            for (int b = 0; b < 2; ++b)
#pragma unroll
                for (int m = 0; m < 4; ++m)
#pragma unroll
                    for (int n = 0; n < 2; ++n) acc[a][b][m][n] = zero4();
        cur = nxt; cA = nA; cB = nB; ++ui;
    }
    PG8_WAIT_V(0);
    if (wr == 0) PG8_BAR;
    PG8_BAR;
#undef PG8_SA
#undef PG8_SB
#undef PG8_STAGE
#undef PG8_LDA
#undef PG8_LDB
#undef PG8_MMA
#undef PG8_WAIT_V
#undef PG8_WAIT_L
#undef PG8_BAR
#undef PG8_SCHED
}
}

struct EpiIn {
    static constexpr bool PERM = true;
    bf16_t* U; float* G; const float* SS; const float* bmi; const float* bmf;
    __device__ __forceinline__ void operator()(const f32x4 (&acc)[2][2][4][2], const pg8::Unit& u, int wr, int wc, int fr, int fq) const {
        const int row0 = u.pm * 256 + wr * 64 + fr;
        const int pn = u.pn;
        const int mode = ((pn >= 4 && pn < 8) || (pn >= 24 && pn < 28)) ? 1 : ((pn >= 20 && pn < 24) ? 2 : 0);
        f32x4 cur[4];
        { const f32x4* sp = (const f32x4*)(SS + (size_t)row0 * 16); cur[0] = sp[0]; cur[1] = sp[1]; cur[2] = sp[2]; cur[3] = sp[3]; }
#pragma unroll
        for (int r = 0; r < 8; ++r) {
            const int ai = r >> 2, m = r & 3;
            const int row = row0 + ai * 128 + m * 16;
            f32x4 nxt[4];
            if (r < 7) {
                const f32x4* sp = (const f32x4*)(SS + (size_t)(row0 + ((r + 1) >> 2) * 128 + ((r + 1) & 3) * 16) * 16);
                nxt[0] = sp[0]; nxt[1] = sp[1]; nxt[2] = sp[2]; nxt[3] = sp[3];
            }
            const float ss = ((cur[0][0] + cur[0][1]) + (cur[0][2] + cur[0][3])) + ((cur[1][0] + cur[1][1]) + (cur[1][2] + cur[1][3])) + ((cur[2][0] + cur[2][1]) + (cur[2][2] + cur[2][3])) + ((cur[3][0] + cur[3][1]) + (cur[3][2] + cur[3][3]));
            const float rstd = rsqrtf(ss * (1.0f / 1024.0f) + EPSF);
            if (pn < 28) {
                bf16_t* rowp = U + (size_t)row * NU + pn * 256 + wc * 32 + 8 * fq;
#pragma unroll
                for (int bj = 0; bj < 2; ++bj) {
                    f32x4 v0 = acc[ai][bj][m][0] * rstd, v1 = acc[ai][bj][m][1] * rstd;
                    if (mode == 1) {
#pragma unroll
                        for (int j = 0; j < 4; ++j) { v0[j] = siluf_(v0[j]); v1[j] = siluf_(v1[j]); }
                    } else if (mode == 2) {
#pragma unroll
                        for (int j = 0; j < 4; ++j) { v0[j] = sigmoidf_(v0[j]); v1[j] = sigmoidf_(v1[j]); }
                    }
                    u32x4 w; w.x = cvt_pk_bf16(v0[0], v0[1]); w.y = cvt_pk_bf16(v0[2], v0[3]); w.z = cvt_pk_bf16(v1[0], v1[1]); w.w = cvt_pk_bf16(v1[2], v1[3]);
                    *(u32x4*)(rowp + bj * 128) = w;
                }
            } else if (wc == 0 && fq == 0) {
                const f32x4 v0 = acc[ai][0][m][0] * rstd, v1 = acc[ai][0][m][1] * rstd;
                f32x4 gi, gf;
#pragma unroll
                for (int j = 0; j < 4; ++j) { gi[j] = v0[j] + bmi[j]; const float x = v1[j] + bmf[j]; gf[j] = fminf(x, 0.f) - log1pf(__expf(-fabsf(x))); }
                *(f32x4*)(G + (size_t)row * 8) = gi; *(f32x4*)(G + (size_t)row * 8 + 4) = gf;
            }
            if (r < 7) { cur[0] = nxt[0]; cur[1] = nxt[1]; cur[2] = nxt[2]; cur[3] = nxt[3]; }
        }
    }
};

struct EpiOut {
    static constexpr bool PERM = false;
    bf16_t* XBo; float* SSo;
    __device__ __forceinline__ void operator()(const f32x4 (&acc)[2][2][4][2], const pg8::Unit& u, int wr, int wc, int fr, int fq) const {
        const int row0 = u.pm * 256 + wr * 64 + fr, col0 = u.pn * 256 + wc * 32 + 4 * fq;
#pragma unroll
        for (int ai = 0; ai < 2; ++ai) {
            u32x2 bs[4][2][2];
#pragma unroll
            for (int m = 0; m < 4; ++m)
#pragma unroll
                for (int bj = 0; bj < 2; ++bj)
#pragma unroll
                    for (int n = 0; n < 2; ++n) bs[m][bj][n] = *(const u32x2*)(XBo + (size_t)(row0 + ai * 128 + m * 16) * DM + col0 + bj * 128 + n * 16);
#pragma unroll
            for (int m = 0; m < 4; ++m) {
                const int row = row0 + ai * 128 + m * 16;
                float ss = 0.f;
#pragma unroll
                for (int bj = 0; bj < 2; ++bj)
#pragma unroll
                    for (int n = 0; n < 2; ++n) {
                        const int c = col0 + bj * 128 + n * 16;
                        const u32x2 v = bs[m][bj][n];
                        const f32x4 o = (f32x4){lo16(v.x), hi16(v.x), lo16(v.y), hi16(v.y)} + acc[ai][bj][m][n];
                        u32x2 w; w.x = cvt_pk_bf16(o[0], o[1]); w.y = cvt_pk_bf16(o[2], o[3]); *(u32x2*)(XBo + (size_t)row * DM + c) = w;
                        ss += (o[0] * o[0] + o[1] * o[1]) + (o[2] * o[2] + o[3] * o[3]);
                    }
                ss += __shfl_xor(ss, 16); ss += __shfl_xor(ss, 32);
                if (fq == 0) SSo[(size_t)row * 16 + u.pn * 4 + wc] = ss;
            }
        }
    }
};

__device__ void transpose_tile(const float* src, int ldn, int nvalid, int k0, int n0, bf16_t* dst, int ldk, const float* sk, float sn, LAS float* T) {
    const int tid = otid();
    {
        const int r = tid >> 4, c4 = tid & 15;
#pragma unroll
        for (int i = 0; i < 2; ++i) {
            const int k = r + 32 * i; const int n = n0 + 4 * c4;
            f32x4 v = zero4();
            if (n + 3 < nvalid) v = *(const f32x4*)(src + (size_t)(k0 + k) * ldn + n);
            const float s = (sk ? sk[k0 + k] : 1.0f) * sn;
            T[k * 65 + 4 * c4 + 0] = v[0] * s; T[k * 65 + 4 * c4 + 1] = v[1] * s; T[k * 65 + 4 * c4 + 2] = v[2] * s; T[k * 65 + 4 * c4 + 3] = v[3] * s;
        }
    }
    __syncthreads();
    {
        const int n = tid >> 3, kq = tid & 7;
        float f[8];
#pragma unroll
        for (int j = 0; j < 8; ++j) f[j] = T[(kq * 8 + j) * 65 + n];
        u32x4 w; w.x = cvt_pk_bf16(f[0], f[1]); w.y = cvt_pk_bf16(f[2], f[3]); w.z = cvt_pk_bf16(f[4], f[5]); w.w = cvt_pk_bf16(f[6], f[7]);
        *(u32x4*)(dst + (size_t)(n0 + n) * ldk + k0 + kq * 8) = w;
    }
    __syncthreads();
}

__device__ void phase_prep(const Params& p, LAS unsigned char* lds) {
    LAS float* T = (LAS float*)lds;
    bf16_t* WT1 = (bf16_t*)(p.ws + WS_WT1); bf16_t* WT2 = (bf16_t*)(p.ws + WS_WT2); bf16_t* WGT = (bf16_t*)(p.ws + WS_WGT);
    bf16_t* XB = (bf16_t*)(p.ws + WS_XB); float* SS = (float*)(p.ws + WS_SS); bf16_t* MG = (bf16_t*)(p.ws + WS_MG);
    constexpr int JA = 2 * 16 * 116, JB = 2 * 32 * 16, JC = 64, JD = MR / 8;
    for (int job = blockIdx.x; job < JA + JB + JC + JD; job += gridDim.x) {
        if (job < JA) {
            const int l = job / (16 * 116), r = job % (16 * 116), ntile = r / 16, kt = r % 16;
            const int n0 = ntile * 64;
            const float sn = (n0 >= 3072 && n0 < 4096) ? 0.0625f : 1.0f;
            transpose_tile(p.w_in + (size_t)l * DM * DIN, DIN, DIN, kt * 64, n0, WT1 + (size_t)l * NW1 * DM, DM, p.g_norm + l * DM, sn, T);
        } else if (job < JA + JB) {
            const int j = job - JA, l = j / 512, r = j % 512, ntile = r / 32, kt = r % 32;
            transpose_tile(p.w_out + (size_t)l * DMG * DM, DM, DM, kt * 64, ntile * 64, WT2 + (size_t)l * DM * DMG, DMG, nullptr, 1.0f, T);
        } else if (job < JA + JB + JC) {
            const int j = job - JA - JB, l = j >> 5, gate = (j >> 4) & 1, blk = j & 15;
            const float* src = (gate ? p.w_i : p.w_r) + (size_t)(l * 16 + blk) * 4096;
            transpose_tile(src, 64, 64, 0, 0, WGT + (size_t)((l * 2 + gate) * 16 + blk) * 4096, 64, nullptr, 1.0f, T);
        } else {
            const int j = job - JA - JB - JC; const int tidp = otid(); const int wid = tidp >> 6, lane = tidp & 63;
            const int row = j * 8 + wid;
            const float* src = row < MP ? p.xp + (size_t)row * DM : (row < MV ? p.xs + (size_t)(row - MP) * DM : nullptr);
            f32x4 v[4]; float ss = 0.f;
#pragma unroll
            for (int i = 0; i < 4; ++i) { v[i] = src ? *(const f32x4*)(src + lane * 16 + i * 4) : zero4(); ss += (v[i][0] * v[i][0] + v[i][1] * v[i][1]) + (v[i][2] * v[i][2] + v[i][3] * v[i][3]); }
#pragma unroll
            for (int o = 32; o >= 1; o >>= 1) ss += __shfl_xor(ss, o);
            u32x4 w0, w1;
            w0.x = cvt_pk_bf16(v[0][0], v[0][1]); w0.y = cvt_pk_bf16(v[0][2], v[0][3]); w0.z = cvt_pk_bf16(v[1][0], v[1][1]); w0.w = cvt_pk_bf16(v[1][2], v[1][3]);
            w1.x = cvt_pk_bf16(v[2][0], v[2][1]); w1.y = cvt_pk_bf16(v[2][2], v[2][3]); w1.z = cvt_pk_bf16(v[3][0], v[3][1]); w1.w = cvt_pk_bf16(v[3][2], v[3][3]);
            *(u32x4*)(XB + (size_t)row * DM + lane * 16) = w0; *(u32x4*)(XB + (size_t)row * DM + lane * 16 + 8) = w1;
            if (lane < 16) SS[(size_t)row * 16 + lane] = lane == 0 ? ss : 0.f;
            if (row >= MV) { const u32x4 z = (u32x4){0u, 0u, 0u, 0u}; u32x4* mp = (u32x4*)(MG + (size_t)row * DMG + lane * 32); mp[0] = z; mp[1] = z; mp[2] = z; mp[3] = z; }
        }
    }
}

constexpr int M_QI = 0, M_KI = 38912, M_VI = 77824, M_CTI = 96256, M_SM = 130048;
constexpr int RS_QK = 304, RS_V = 144, RS_CT = 528;

template <int OFF0, int OFF1>
__device__ __forceinline__ bf16x8 tr_frag(unsigned base) {
    bf16x4 lo, hi;
    asm volatile("ds_read_b64_tr_b16 %0, %2 offset:%3\n\tds_read_b64_tr_b16 %1, %2 offset:%4\n\ts_waitcnt lgkmcnt(0)" : "=&v"(lo), "=&v"(hi) : "v"(base), "i"(OFF0), "i"(OFF1) : "memory");
    bf16x8 r; r[0] = lo[0]; r[1] = lo[1]; r[2] = lo[2]; r[3] = lo[3]; r[4] = hi[0]; r[5] = hi[1]; r[6] = hi[2]; r[7] = hi[3]; return r;
}

template <int KS>
__device__ __forceinline__ void mlstm_D(f32x4 (&CT)[8], unsigned bvD, unsigned bkD) {
    const bf16x8 vdf = tr_frag<KS * 32 * RS_V, KS * 32 * RS_V + 4 * RS_V>(bvD);
    const bf16x8 k0 = tr_frag<KS * 32 * RS_QK + 0, KS * 32 * RS_QK + 0 + 4 * RS_QK>(bkD);
    const bf16x8 k1 = tr_frag<KS * 32 * RS_QK + 32, KS * 32 * RS_QK + 32 + 4 * RS_QK>(bkD);
    const bf16x8 k2 = tr_frag<KS * 32 * RS_QK + 64, KS * 32 * RS_QK + 64 + 4 * RS_QK>(bkD);
    const bf16x8 k3 = tr_frag<KS * 32 * RS_QK + 96, KS * 32 * RS_QK + 96 + 4 * RS_QK>(bkD);
    CT[0] = __builtin_amdgcn_mfma_f32_16x16x32_bf16(k0, vdf, CT[0], 0, 0, 0);
    CT[1] = __builtin_amdgcn_mfma_f32_16x16x32_bf16(k1, vdf, CT[1], 0, 0, 0);
    CT[2] = __builtin_amdgcn_mfma_f32_16x16x32_bf16(k2, vdf, CT[2], 0, 0, 0);
    CT[3] = __builtin_amdgcn_mfma_f32_16x16x32_bf16(k3, vdf, CT[3], 0, 0, 0);
    const bf16x8 k4 = tr_frag<KS * 32 * RS_QK + 128, KS * 32 * RS_QK + 128 + 4 * RS_QK>(bkD);
    const bf16x8 k5 = tr_frag<KS * 32 * RS_QK + 160, KS * 32 * RS_QK + 160 + 4 * RS_QK>(bkD);
    const bf16x8 k6 = tr_frag<KS * 32 * RS_QK + 192, KS * 32 * RS_QK + 192 + 4 * RS_QK>(bkD);
    const bf16x8 k7 = tr_frag<KS * 32 * RS_QK + 224, KS * 32 * RS_QK + 224 + 4 * RS_QK>(bkD);
    CT[4] = __builtin_amdgcn_mfma_f32_16x16x32_bf16(k4, vdf, CT[4], 0, 0, 0);
    CT[5] = __builtin_amdgcn_mfma_f32_16x16x32_bf16(k5, vdf, CT[5], 0, 0, 0);
    CT[6] = __builtin_amdgcn_mfma_f32_16x16x32_bf16(k6, vdf, CT[6], 0, 0, 0);
    CT[7] = __builtin_amdgcn_mfma_f32_16x16x32_bf16(k7, vdf, CT[7], 0, 0, 0);
}
template <int KS>
__device__ __forceinline__ void mlstm_B(f32x4 (&N1)[4], LAS unsigned char* lds, unsigned bvB, int t, int fq) {
    const bf16x8 pf = *(const LAS bf16x8*)(lds + M_QI + t * RS_QK + KS * 64 + fq * 16);
    const bf16x8 v0 = tr_frag<KS * 32 * RS_V + 0, KS * 32 * RS_V + 0 + 4 * RS_V>(bvB);
    const bf16x8 v1 = tr_frag<KS * 32 * RS_V + 32, KS * 32 * RS_V + 32 + 4 * RS_V>(bvB);
    const bf16x8 v2 = tr_frag<KS * 32 * RS_V + 64, KS * 32 * RS_V + 64 + 4 * RS_V>(bvB);
    const bf16x8 v3 = tr_frag<KS * 32 * RS_V + 96, KS * 32 * RS_V + 96 + 4 * RS_V>(bvB);
    N1[0] = __builtin_amdgcn_mfma_f32_16x16x32_bf16(v0, pf, N1[0], 0, 0, 0);
    N1[1] = __builtin_amdgcn_mfma_f32_16x16x32_bf16(v1, pf, N1[1], 0, 0, 0);
    N1[2] = __builtin_amdgcn_mfma_f32_16x16x32_bf16(v2, pf, N1[2], 0, 0, 0);
    N1[3] = __builtin_amdgcn_mfma_f32_16x16x32_bf16(v3, pf, N1[3], 0, 0, 0);
}

__device__ void mlstm_prompt(const Params& p, int l, int item, LAS unsigned char* lds) {
    const int tid0 = otid();
    const int js = item & 3, h = (item >> 2) & 3, b = item >> 4;
    const unsigned ldsb = (unsigned)(size_t)lds;
    LAS float* sm = (LAS float*)(lds + M_SM);
    LAS float* nbuf = sm + 512; LAS float* npart = sm + 1040;
    const bf16_t* U = (const bf16_t*)(p.ws + WS_U); const float* G = (const float*)(p.ws + WS_G);
    bf16_t* MG = (bf16_t*)(p.ws + WS_MG);
    const size_t grow_base = (size_t)b * 2048;
    const int qcol = 2048 + h * 256, kcol = 3072 + h * 256, vcol = 4096 + h * 256 + js * 64;

    __syncthreads();
    for (int i = tid0; i < RS_CT * 64 / 16; i += NT) *(LAS u32x4*)(lds + M_CTI + i * 16) = (u32x4){0u, 0u, 0u, 0u};
    nbuf[tid0] = 0.f;
    f32x4 CTacc[8];
#pragma unroll
    for (int i = 0; i < 8; ++i) CTacc[i] = zero4();
    float m_prev = 0.f;
    u32x4 qreg[4], kreg[4], vreg[2]; float igr[2] = {0.f, 0.f}, lfr[2] = {0.f, 0.f};

#define ML_LOAD_QK(row0_, hd_) do { _Pragma("unroll") for (int i_ = 0; i_ < 4; ++i_) { const int id_ = tid + NT * i_, r_ = id_ >> 4, cq_ = id_ & 15; \
        const bf16_t* rp_ = U + (grow_base + (row0_) + r_) * NU + (hd_) * 128 + cq_ * 8; qreg[i_] = *(const u32x4*)(rp_ + qcol); kreg[i_] = *(const u32x4*)(rp_ + kcol); } } while (0)
#define ML_STORE_QK() do { _Pragma("unroll") for (int i_ = 0; i_ < 4; ++i_) { const int id_ = tid + NT * i_, r_ = id_ >> 4, cq_ = id_ & 15; \
        *(LAS u32x4*)(lds + M_QI + r_ * RS_QK + cq_ * 16) = qreg[i_]; *(LAS u32x4*)(lds + M_KI + r_ * RS_QK + cq_ * 16) = kreg[i_]; } } while (0)
#define ML_LOAD_VG(row0_) do { _Pragma("unroll") for (int i_ = 0; i_ < 2; ++i_) { const int id_ = tid + NT * i_, s_ = id_ >> 3, cq_ = id_ & 7; \
        vreg[i_] = *(const u32x4*)(U + (grow_base + (row0_) + s_) * NU + vcol + cq_ * 8); } \
        if (w == 0) { const float* gp_ = G + (grow_base + (row0_) + 2 * lane) * 8 + h; igr[0] = gp_[0]; lfr[0] = gp_[4]; igr[1] = gp_[8]; lfr[1] = gp_[12]; } } while (0)

#define ML_PREPASS(buf_) do { if (w == 0) { LAS float* dec_ = sm + 128 * (buf_); LAS float* expnm_ = sm + 256 + 128 * (buf_); LAS float* scal_ = sm + 1024 + 8 * (buf_); \
            const float s2 = lfr[0] + lfr[1]; float incl = s2; \
            _Pragma("unroll") for (int o = 1; o < 64; o <<= 1) { const float t_ = __shfl_up(incl, o); if (lane >= o) incl += t_; } \
            const float b0 = incl - s2 + lfr[0], b1 = incl; \
            const float a0 = igr[0] - b0, a1 = igr[1] - b1; float im = fmaxf(a0, a1); \
            _Pragma("unroll") for (int o = 1; o < 64; o <<= 1) { const float t_ = __shfl_up(im, o); if (lane >= o) im = fmaxf(im, t_); } \
            float ex = __shfl_up(im, 1); if (lane == 0) ex = -INFINITY; \
            const float M0 = fmaxf(ex, a0), M1 = fmaxf(M0, a1); \
            const float mt1 = b1 + fmaxf(m_prev, M1); \
            const float bL = __shfl(b1, 63), mL = __shfl(mt1, 63); \
            expnm_[2 * lane] = __expf(bL - mL - b0); expnm_[2 * lane + 1] = __expf(bL - mL - b1); \
            dec_[2 * lane] = __expf(bL - b0 + igr[0] - mL); dec_[2 * lane + 1] = __expf(bL - b1 + igr[1] - mL); \
            if (lane == 0) { scal_[0] = __expf(bL + m_prev - mL); scal_[1] = mL; } \
            m_prev = mL; } } while (0)
    { const int tid = tid0, w = tid >> 6, lane = tid & 63; ML_LOAD_QK(0, 0); ML_LOAD_VG(0); ML_PREPASS(0); }
#pragma unroll 1
    for (int c = 0; c < 16; ++c) {
        int tid = tid0; asm volatile("" : "+v"(tid));
        const int w = __builtin_amdgcn_readfirstlane(tid >> 6), lane = tid & 63, fr = lane & 15, fq = lane >> 4;
        const int cD = w & 3, gD = w >> 2, qq = (lane & 15) >> 2, pp = lane & 3;
        const unsigned bvB = ldsb + M_VI + (8 * fq + qq) * RS_V + 8 * pp;
        const unsigned bvD = bvB + cD * 32;
        const int row0 = c * 128;
        LAS float* nC = nbuf + (c & 1) * 256; LAS float* nN = nbuf + ((c + 1) & 1) * 256;
        __syncthreads();
        ML_STORE_QK();
        LAS float* dec = sm + 128 * (c & 1); LAS float* expnm = sm + 256 + 128 * (c & 1); LAS float* scal = sm + 1024 + 8 * (c & 1);
        const float cs = scal[0];
#pragma unroll
        for (int i = 0; i < 2; ++i) {
            const int id = tid + NT * i, s = id >> 3, cq = id & 7; const float d = dec[s];
            u32x4 v = vreg[i], o;
            o.x = cvt_pk_bf16(lo16(v.x) * d, hi16(v.x) * d); o.y = cvt_pk_bf16(lo16(v.y) * d, hi16(v.y) * d);
            o.z = cvt_pk_bf16(lo16(v.z) * d, hi16(v.z) * d); o.w = cvt_pk_bf16(lo16(v.w) * d, hi16(v.w) * d);
            *(LAS u32x4*)(lds + M_VI + s * RS_V + cq * 16) = o;
        }
        if (tid < 256) nN[tid] = cs * nC[tid];
        ML_LOAD_QK(row0, 1);
        f32x4 Sacc[8], N2[4];
#pragma unroll
        for (int i = 0; i < 8; ++i) Sacc[i] = zero4();
#pragma unroll
        for (int i = 0; i < 4; ++i) N2[i] = zero4();
        float qnp = 0.f;
#pragma unroll 1
        for (int hd = 0; hd < 2; ++hd) {
            __syncthreads();
#pragma unroll
            for (int ks = 0; ks < 4; ++ks) {
                const bf16x8 qf = *(const LAS bf16x8*)(lds + M_QI + (16 * w + fr) * RS_QK + ks * 64 + fq * 16);
#pragma unroll
                for (int i = 0; i < 8; ++i) if (i <= w) {
                    const bf16x8 kf = *(const LAS bf16x8*)(lds + M_KI + (16 * i + fr) * RS_QK + ks * 64 + fq * 16);
                    Sacc[i] = __builtin_amdgcn_mfma_f32_16x16x32_bf16(kf, qf, Sacc[i], 0, 0, 0);
                }
#pragma unroll
                for (int c4 = 0; c4 < 4; ++c4) {
                    const bf16x8 ctf = *(const LAS bf16x8*)(lds + M_CTI + (16 * c4 + fr) * RS_CT + hd * 256 + ks * 64 + fq * 16);
                    N2[c4] = __builtin_amdgcn_mfma_f32_16x16x32_bf16(ctf, qf, N2[c4], 0, 0, 0);
                }
                const LAS float* np = nC + hd * 128 + ks * 32 + fq * 8;
#pragma unroll
                for (int j = 0; j < 8; ++j) qnp += bf2f((unsigned short)qf[j]) * np[j];
                __builtin_amdgcn_sched_barrier(0);
            }
            if (gD == hd) {
                const unsigned bkD = ldsb + M_KI + (8 * fq + qq) * RS_QK + 8 * pp;
#pragma unroll
                for (int i = 0; i < 8; ++i) CTacc[i] *= cs;
                mlstm_D<0>(CTacc, bvD, bkD); __builtin_amdgcn_sched_barrier(0); mlstm_D<1>(CTacc, bvD, bkD); __builtin_amdgcn_sched_barrier(0); mlstm_D<2>(CTacc, bvD, bkD); __builtin_amdgcn_sched_barrier(0); mlstm_D<3>(CTacc, bvD, bkD); __builtin_amdgcn_sched_barrier(0);
            }
            if (gD != hd) {
                const int lidx = (w & 3) * 64 + lane, dkl = lidx & 127, part = lidx >> 7; float a = 0.f;
#pragma unroll 8
                for (int s = 64 * part; s < 64 * part + 64; ++s) a += dec[s] * bf2f(*(const LAS unsigned short*)(lds + M_KI + s * RS_QK + dkl * 2));
                npart[part * 128 + dkl] = a;
            }
            __syncthreads();
            if (tid < 128) nN[hd * 128 + tid] += npart[tid] + npart[128 + tid];
            if (gD == hd) {
#pragma unroll
                for (int i = 0; i < 8; ++i) {
                    u32x2 wv; wv.x = cvt_pk_bf16(CTacc[i][0], CTacc[i][1]); wv.y = cvt_pk_bf16(CTacc[i][2], CTacc[i][3]);
                    *(LAS u32x2*)(lds + M_CTI + (16 * cD + fr) * RS_CT + (hd * 128 + 16 * i + 4 * fq) * 2) = wv;
                }
            }
            if (hd == 0) {
                ML_STORE_QK();
                if (c < 15) { ML_LOAD_QK(row0 + 128, 0); }
            }
        }
        if (c < 15) { ML_LOAD_VG(row0 + 128); }
        const int t = 16 * w + fr;
        float den1 = 0.f;
#pragma unroll
        for (int i = 0; i < 8; ++i) if (i <= (w | 1)) {
            f32x4 sv = Sacc[i];
            const f32x4 dv = *(const LAS f32x4*)(dec + 16 * i + 4 * fq);
#pragma unroll
            for (int j = 0; j < 4; ++j) { const int s = 16 * i + 4 * fq + j; if (s > t || i > w) sv[j] = 0.f; den1 += sv[j] * dv[j]; }
            u32x2 wv; wv.x = cvt_pk_bf16(sv[0], sv[1]); wv.y = cvt_pk_bf16(sv[2], sv[3]);
            *(LAS u32x2*)(lds + M_QI + t * RS_QK + (16 * i + 4 * fq) * 2) = wv;
        }
        den1 += __shfl_xor(den1, 16); den1 += __shfl_xor(den1, 32);
        qnp += __shfl_xor(qnp, 16); qnp += __shfl_xor(qnp, 32);
#pragma unroll
        for (int i = 0; i < 4; ++i) N2[i] *= cs;
        if (0 <= (w >> 1)) mlstm_B<0>(N2, lds, bvB, t, fq);
        if (1 <= (w >> 1)) mlstm_B<1>(N2, lds, bvB, t, fq);
        if (2 <= (w >> 1)) mlstm_B<2>(N2, lds, bvB, t, fq);
        if (3 <= (w >> 1)) mlstm_B<3>(N2, lds, bvB, t, fq);
        {
            const float den = den1 + cs * qnp;
            const float inv = 1.0f / fmaxf(fabsf(den), expnm[t]);
            const size_t grow = grow_base + row0 + t;
#pragma unroll
            for (int c4 = 0; c4 < 4; ++c4) {
                const float y0 = N2[c4][0] * inv, y1 = N2[c4][1] * inv, y2 = N2[c4][2] * inv, y3 = N2[c4][3] * inv;
                u32x2 wv; wv.x = cvt_pk_bf16(y0, y1); wv.y = cvt_pk_bf16(y2, y3);
                *(u32x2*)(MG + grow * DMG + 1024 + h * 256 + js * 64 + 16 * c4 + 4 * fq) = wv;
            }
        }
        if (c < 15) ML_PREPASS((c + 1) & 1);
    }
    __syncthreads();
    {
        const int tid = tid0, w = tid >> 6, lane = tid & 63, fr = lane & 15, fq = lane >> 4, cD = w & 3, gD = w >> 2;
        float* pC = p.out + O_PC + ((size_t)((l * 8 + b) * 4 + h)) * 65536;
#pragma unroll
        for (int i = 0; i < 8; ++i)
#pragma unroll
            for (int j = 0; j < 4; ++j) pC[(size_t)(gD * 128 + 16 * i + 4 * fq + j) * 256 + js * 64 + 16 * cD + fr] = CTacc[i][j];
        if (js == 0) {
            if (tid < 256) p.out[O_PN + ((size_t)((l * 8 + b) * 4 + h)) * 256 + tid] = nbuf[tid];
            if (tid == 0) p.out[O_PM + (l * 8 + b) * 4 + h] = sm[1024 + 8 + 1];
        }
    }
    __syncthreads();
#undef ML_LOAD_QK
#undef ML_STORE_QK
#undef ML_LOAD_VG
#undef ML_PREPASS
}

constexpr int R_XAI = 0, R_XCF = 16768, R_XCB = 49536, R_AA = 67968, R_UU = 100736, R_PT = 133504, R_HC = 137600, R_CW = 138112, R_CH = 139392;
__device__ void rglru_item(const Params& p, int l, int b, int cb, bool decm, LAS unsigned char* lds) {
    const int tid = otid(), w = __builtin_amdgcn_readfirstlane(tid >> 6), lane = tid & 63, fr = lane & 15, fq = lane >> 4;
    const bf16_t* U = (const bf16_t*)(p.ws + WS_U); bf16_t* MG = (bf16_t*)(p.ws + WS_MG);
    const bf16_t* WGT = (const bf16_t*)(p.ws + WS_WGT);
    LAS float* XCF = (LAS float*)(lds + R_XCF); LAS float* AA = (LAS float*)(lds + R_AA); LAS float* UU = (LAS float*)(lds + R_UU);
    LAS float* PT = (LAS float*)(lds + R_PT); LAS float* HC = (LAS float*)(lds + R_HC); LAS float* CW = (LAS float*)(lds + R_CW); LAS float* CH = (LAS float*)(lds + R_CH);
    const int ch0 = cb * 64;
    const size_t grow_base = decm ? (size_t)MP : (size_t)b * 2048;
    const int nchunk = decm ? 1 : 16;
    __syncthreads();
    if (tid < 64) {
        const int ch = ch0 + tid;
#pragma unroll
        for (int j = 0; j < 4; ++j) CW[j * 64 + tid] = p.conv_w[(size_t)(l * 4 + j) * 1024 + ch];
        CW[256 + tid] = p.conv_b[l * 1024 + ch];
        CH[tid] = p.b_r[l * 1024 + ch]; CH[64 + tid] = p.b_i[l * 1024 + ch]; CH[128 + tid] = 8.0f * softplusf_(-p.lam[l * 1024 + ch]);
        HC[tid] = 0.f; HC[64 + tid] = 0.f;
    }
    if (tid < 24) *(LAS u32x4*)(lds + R_XAI + tid * 16) = (u32x4){0u, 0u, 0u, 0u};
    u32x4 xreg[2], zreg[2];
#pragma unroll
    for (int i = 0; i < 2; ++i) { const int id = tid + NT * i, r = id >> 3, cq = id & 7; const bf16_t* rp = U + (grow_base + r) * NU + ch0 + cq * 8; xreg[i] = *(const u32x4*)rp; zreg[i] = *(const u32x4*)(rp + 1024); }
    for (int c = 0; c < nchunk; ++c) {
        const int row0 = c * 128;
        __syncthreads();
        if (c > 0) {
#pragma unroll
            for (int i = 0; i < 2; ++i) { const int id = tid + NT * i, r = id >> 3, cq = id & 7; *(u32x4*)(MG + (grow_base + row0 - 128 + r) * DMG + ch0 + cq * 8) = *(const LAS u32x4*)(lds + R_XCF + r * 128 + cq * 16); }
        }
        u32x4 zcur[2];
#pragma unroll
        for (int i = 0; i < 2; ++i) { const int id = tid + NT * i, r = id >> 3, cq = id & 7; *(LAS u32x4*)(lds + R_XAI + (3 + r) * 128 + cq * 16) = xreg[i]; zcur[i] = zreg[i]; }
        if (c + 1 < nchunk) {
#pragma unroll
            for (int i = 0; i < 2; ++i) { const int id = tid + NT * i, r = id >> 3, cq = id & 7; const bf16_t* rp = U + (grow_base + row0 + 128 + r) * NU + ch0 + cq * 8; xreg[i] = *(const u32x4*)rp; zreg[i] = *(const u32x4*)(rp + 1024); }
        }
        __syncthreads();
        {
            const int t = tid >> 2, c0 = (tid & 3) * 16;
            float xc[16];
#pragma unroll
            for (int k = 0; k < 16; ++k) xc[k] = CW[256 + c0 + k];
            if (!decm) {
#pragma unroll
                for (int j = 0; j < 4; ++j) {
                    const u32x4 a = *(const LAS u32x4*)(lds + R_XAI + (t + j) * 128 + c0 * 2), bq = *(const LAS u32x4*)(lds + R_XAI + (t + j) * 128 + c0 * 2 + 16);
                    const unsigned wv[8] = {a.x, a.y, a.z, a.w, bq.x, bq.y, bq.z, bq.w};
#pragma unroll
                    for (int k = 0; k < 8; ++k) { xc[2 * k] += CW[j * 64 + c0 + 2 * k] * lo16(wv[k]); xc[2 * k + 1] += CW[j * 64 + c0 + 2 * k + 1] * hi16(wv[k]); }
                }
            } else {
                const float* stp = p.st_conv + ((size_t)(l * 128 + t) * 3) * 1024 + ch0 + c0;
                float* so = p.out + O_SCONV + ((size_t)(l * 128 + t) * 3) * 1024 + ch0 + c0;
#pragma unroll
                for (int j = 0; j < 3; ++j)
#pragma unroll
                    for (int k4 = 0; k4 < 4; ++k4) {
                        const f32x4 sv = *(const f32x4*)(stp + (size_t)j * 1024 + k4 * 4);
#pragma unroll
                        for (int e = 0; e < 4; ++e) xc[k4 * 4 + e] += CW[j * 64 + c0 + k4 * 4 + e] * sv[e];
                        if (j >= 1) *(f32x4*)(so + (size_t)(j - 1) * 1024 + k4 * 4) = sv;
                    }
                const u32x4 a = *(const LAS u32x4*)(lds + R_XAI + (t + 3) * 128 + c0 * 2), bq = *(const LAS u32x4*)(lds + R_XAI + (t + 3) * 128 + c0 * 2 + 16);
                const unsigned wv[8] = {a.x, a.y, a.z, a.w, bq.x, bq.y, bq.z, bq.w};
#pragma unroll
                for (int k = 0; k < 8; ++k) {
                    const float x0 = lo16(wv[k]), x1 = hi16(wv[k]);
                    xc[2 * k] += CW[3 * 64 + c0 + 2 * k] * x0; xc[2 * k + 1] += CW[3 * 64 + c0 + 2 * k + 1] * x1;
                    so[2 * 1024 + 2 * k] = x0; so[2 * 1024 + 2 * k + 1] = x1;
                }
            }
#pragma unroll
            for (int k4 = 0; k4 < 4; ++k4) *(LAS f32x4*)(XCF + t * 64 + c0 + k4 * 4) = (f32x4){xc[k4 * 4], xc[k4 * 4 + 1], xc[k4 * 4 + 2], xc[k4 * 4 + 3]};
            u32x4 o0, o1;
            o0.x = cvt_pk_bf16(xc[0], xc[1]); o0.y = cvt_pk_bf16(xc[2], xc[3]); o0.z = cvt_pk_bf16(xc[4], xc[5]); o0.w = cvt_pk_bf16(xc[6], xc[7]);
            o1.x = cvt_pk_bf16(xc[8], xc[9]); o1.y = cvt_pk_bf16(xc[10], xc[11]); o1.z = cvt_pk_bf16(xc[12], xc[13]); o1.w = cvt_pk_bf16(xc[14], xc[15]);
            *(LAS u32x4*)(lds + R_XCB + t * 144 + c0 * 2) = o0; *(LAS u32x4*)(lds + R_XCB + t * 144 + c0 * 2 + 16) = o1;
        }
        __syncthreads();
        if (!decm && tid < 24) { const u32x4 v = *(const LAS u32x4*)(lds + R_XAI + 128 * 128 + tid * 16); *(LAS u32x4*)(lds + R_XAI + tid * 16) = v; }
        {
            bf16x8 xf[2];
#pragma unroll
            for (int ks = 0; ks < 2; ++ks) xf[ks] = *(const LAS bf16x8*)(lds + R_XCB + (16 * w + fr) * 144 + ks * 64 + fq * 16);
            const int t = 16 * w + fr;
#pragma unroll
            for (int c4 = 0; c4 < 4; ++c4) {
                f32x4 ar = zero4(), ai = ar;
#pragma unroll
                for (int ks = 0; ks < 2; ++ks) {
                    const bf16x8 wfr = *(const bf16x8*)(WGT + (size_t)((l * 2 + 0) * 16 + cb) * 4096 + (16 * c4 + fr) * 64 + ks * 32 + fq * 8);
                    const bf16x8 wfi = *(const bf16x8*)(WGT + (size_t)((l * 2 + 1) * 16 + cb) * 4096 + (16 * c4 + fr) * 64 + ks * 32 + fq * 8);
                    ar = __builtin_amdgcn_mfma_f32_16x16x32_bf16(wfr, xf[ks], ar, 0, 0, 0); ai = __builtin_amdgcn_mfma_f32_16x16x32_bf16(wfi, xf[ks], ai, 0, 0, 0); }
                const int d = 16 * c4 + 4 * fq;
                const f32x4 xcv = *(const LAS f32x4*)(XCF + t * 64 + d);
                f32x4 av, uv;
#pragma unroll
                for (int j = 0; j < 4; ++j) {
                    const float r = sigmoidf_(ar[j] + CH[d + j]), ig = sigmoidf_(ai[j] + CH[64 + d + j]);
                    const float la = -r * CH[128 + d + j];
                    const float x2 = 2.0f * la;
                    const float ser = -x2 * (1.0f + x2 * (0.5f + x2 * (0.16666667f + x2 * (0.041666668f + x2 * (0.0083333338f + x2 * 0.0013888889f)))));
                    const float om = x2 > -0.3f ? ser : 1.0f - __expf(x2);
                    av[j] = __expf(la); uv[j] = __builtin_amdgcn_sqrtf(om) * (ig * xcv[j]);
                }
                if (!decm) { *(LAS f32x4*)(AA + t * 64 + d) = av; *(LAS f32x4*)(UU + t * 64 + d) = uv; }
                else {
                    const f32x4 h0 = *(const f32x4*)(p.st_h + (size_t)(l * 128 + t) * 1024 + ch0 + d);
                    const f32x4 hn = av * h0 + uv;
                    *(f32x4*)(p.out + O_SH + (size_t)(l * 128 + t) * 1024 + ch0 + d) = hn;
                    const u32x2 zv = *(const u32x2*)(U + (grow_base + t) * NU + 1024 + ch0 + d);
                    u32x2 wv; wv.x = cvt_pk_bf16(hn[0] * lo16(zv.x), hn[1] * hi16(zv.x)); wv.y = cvt_pk_bf16(hn[2] * lo16(zv.y), hn[3] * hi16(zv.y));
                    *(u32x2*)(MG + (grow_base + t) * DMG + ch0 + d) = wv;
                }
            }
        }
        if (decm) break;
        __syncthreads();
#pragma unroll
        for (int i = 0; i < 2; ++i) { const int id = tid + NT * i, r = id >> 3, cq = id & 7; *(LAS u32x4*)(lds + R_XCB + r * 144 + cq * 16) = zcur[i]; }
        const int ch = tid & 63, part = tid >> 6;
        {
            float hh = 0.f, Ac = 1.f;
#pragma unroll 4
            for (int k = 0; k < 16; ++k) { const int t = part * 16 + k; const float a = AA[t * 64 + ch], u = UU[t * 64 + ch]; hh = a * hh + u; Ac *= a; UU[t * 64 + ch] = hh; AA[t * 64 + ch] = Ac; }
            PT[(part * 64 + ch) * 2] = Ac; PT[(part * 64 + ch) * 2 + 1] = hh;
        }
        __syncthreads();
        {
            float hin = HC[(c & 1) * 64 + ch];
            for (int q = 0; q < part; ++q) hin = PT[(q * 64 + ch) * 2] * hin + PT[(q * 64 + ch) * 2 + 1];
            float hf = hin;
#pragma unroll 4
            for (int k = 0; k < 16; ++k) {
                const int t = part * 16 + k; hf = AA[t * 64 + ch] * hin + UU[t * 64 + ch];
                const float z = bf2f(*(const LAS unsigned short*)(lds + R_XCB + t * 144 + ch * 2));
                const float y = hf * z;
                *(LAS unsigned short*)(lds + R_XCF + t * 128 + ch * 2) = (unsigned short)(cvt_pk_bf16(y, y) & 0xffffu);
            }
            if (part == 7) {
                HC[((c + 1) & 1) * 64 + ch] = hf;
                if (c == 15) p.out[O_PH + (size_t)(l * 8 + b) * 1024 + ch0 + ch] = hf;
            }
        }
        if (c == 15 && tid < 192) {
            const int j = tid >> 6, cc = tid & 63;
            p.out[O_PCONV + ((size_t)(l * 8 + b) * 3 + j) * 1024 + ch0 + cc] = bf2f(*(const LAS unsigned short*)(lds + R_XAI + j * 128 + cc * 2));
        }
    }
    __syncthreads();
    if (!decm) {
#pragma unroll
        for (int i = 0; i < 2; ++i) { const int id = tid + NT * i, r = id >> 3, cq = id & 7; *(u32x4*)(MG + (grow_base + 15 * 128 + r) * DMG + ch0 + cq * 8) = *(const LAS u32x4*)(lds + R_XCF + r * 128 + cq * 16); }
    }
    __syncthreads();
}

__device__ void mlstm_decode(const Params& p, int l, int b, int h, LAS unsigned char* lds) {
    const int tid = otid(), lane = tid & 63;
    const bf16_t* U = (const bf16_t*)(p.ws + WS_U); const float* G = (const float*)(p.ws + WS_G);
    bf16_t* MG = (bf16_t*)(p.ws + WS_MG);
    LAS float* qs = (LAS float*)lds; LAS float* ks = qs + 256; LAS float* vs = qs + 512; LAS float* ns = qs + 768; LAS float* red = qs + 1024; LAS float* red2 = qs + 1024 + 2048;
    const size_t row = (size_t)MP + b;
    const size_t sidx = (size_t)((l * 128 + b) * 4 + h);
    __syncthreads();
    if (tid < 256) {
        qs[tid] = bf2f(U[row * NU + 2048 + h * 256 + tid]); ks[tid] = bf2f(U[row * NU + 3072 + h * 256 + tid]); vs[tid] = bf2f(U[row * NU + 4096 + h * 256 + tid]);
        ns[tid] = p.st_n[sidx * 256 + tid];
    }
    const float ig = G[row * 8 + h], lf = G[row * 8 + 4 + h], m0 = p.st_m[sidx];
    __syncthreads();
    float qk = 0.f, qn = 0.f;
#pragma unroll
    for (int j = 0; j < 4; ++j) { const float qv = qs[lane * 4 + j]; qk += qv * ks[lane * 4 + j]; qn += qv * ns[lane * 4 + j]; }
#pragma unroll
    for (int o = 32; o >= 1; o >>= 1) { qk += __shfl_xor(qk, o); qn += __shfl_xor(qn, o); }
    const float mt = fmaxf(lf + m0, ig), wg = __expf(ig - mt), gi = __expf(lf + m0 - mt);
    const int dvq = tid & 63, dkg = tid >> 6;
    float o_pre = 0.f, zg_pre = 0.f;
    if (tid < 256) { o_pre = bf2f(U[row * NU + 5120 + h * 256 + tid]); zg_pre = p.g_mhead[l * 1024 + h * 256 + tid] * bf2f(U[row * NU + 6144 + h * 256 + tid]); }
    const float* C0 = p.st_C + sidx * 65536; float* C1 = p.out + O_SC + sidx * 65536;
    const f32x4 v4 = *(const LAS f32x4*)(vs + dvq * 4);
    f32x4 qc = zero4();
#pragma unroll 16
    for (int i = 0; i < 32; ++i) {
        const int dk = dkg * 32 + i;
        const f32x4 c4 = __builtin_nontemporal_load((const f32x4*)(C0 + (size_t)dk * 256 + dvq * 4));
        const float qv = qs[dk], kv = wg * ks[dk];
        qc += qv * c4;
        const f32x4 cn = gi * c4 + kv * v4;
        __builtin_nontemporal_store(cn, (f32x4*)(C1 + (size_t)dk * 256 + dvq * 4));
    }
    *(LAS f32x4*)(red + dkg * 256 + dvq * 4) = qc;
    __syncthreads();
    float yv = 0.f;
    if (tid < 256) {
        float qcv = 0.f;
#pragma unroll
        for (int g = 0; g < 8; ++g) qcv += red[g * 256 + tid];
        const float num = wg * qk * vs[tid] + gi * qcv, den = wg * qk + gi * qn;
        const float hh = num / fmaxf(fabsf(den), __expf(-mt));
        yv = hh * o_pre;
        float ss = yv * yv;
#pragma unroll
        for (int o = 32; o >= 1; o >>= 1) ss += __shfl_xor(ss, o);
        if (lane == 0) red2[tid >> 6] = ss;
        p.out[O_SN + sidx * 256 + tid] = gi * ns[tid] + wg * ks[tid];
    }
    __syncthreads();
    if (tid < 256) {
        const float rstd = rsqrtf(((red2[0] + red2[1]) + (red2[2] + red2[3])) * (1.0f / 256.0f) + EPSF);
        const float ov = yv * rstd * zg_pre;
        MG[row * DMG + 1024 + h * 256 + tid] = (bf16_t)(cvt_pk_bf16(ov, ov) & 0xffffu);
    }
    if (tid == 0) p.out[O_SM + sidx] = mt;
}

__device__ void decode_items(const Params& p, int l, LAS unsigned char* lds, int max_items) {
    unsigned* ctr = (unsigned*)(p.ws + WS_BAR) + 3584 + 64 * l;
    volatile LAS unsigned* slot = (volatile LAS unsigned*)(lds + LDS_BYTES - 32);
    for (int n = 0; n < max_items; ++n) {
        __syncthreads();
        if (threadIdx.x == 0) *slot = __hip_atomic_fetch_add(ctr, 1u, __ATOMIC_RELAXED, __HIP_MEMORY_SCOPE_AGENT);
        __syncthreads();
        const int item = (int)*slot;
        if (item >= 512) break;
        mlstm_decode(p, l, item >> 2, item & 3, lds);
    }
}

__device__ void phase_mixers(const Params& p, int l, LAS unsigned char* lds) {
    const int G = gridDim.x, bid = obid();
    const bool split = G >= 256;
    const int r = split ? bid - 128 : bid, R = split ? G - 128 : G;
    if (!split || bid < 128) { for (int item = bid; item < 128; item += (split ? 128 : G)) mlstm_prompt(p, l, item, lds); }
    if (r >= 0) {
        for (int item = r; item < 128; item += R) rglru_item(p, l, item >> 4, item & 15, false, lds);
        for (int item = r; item < 16; item += R) rglru_item(p, l, 0, item, true, lds);
    }
    decode_items(p, l, lds, 1 << 30);
}

__device__ void phase_headnorm(const Params& p, int l) {
    const bf16_t* U = (const bf16_t*)(p.ws + WS_U); bf16_t* MG = (bf16_t*)(p.ws + WS_MG);
    const float* gm = p.g_mhead + l * 1024;
    const int G = gridDim.x, bid = obid();
    const int b0 = G > 8 ? bid - 4 : bid, GG = G > 8 ? G - 4 : G;
    if (b0 < 0) return;
    for (size_t idx = (size_t)b0 * NT + otid(); idx < (size_t)MP * 128; idx += (size_t)GG * NT) {
        const size_t row = idx >> 7; const int col = (int)(idx & 127) * 8;
        const u32x4 hv = *(const u32x4*)(MG + row * DMG + 1024 + col);
        const u32x4 ov = *(const u32x4*)(U + row * NU + 5120 + col);
        const u32x4 zv = *(const u32x4*)(U + row * NU + 6144 + col);
        float y[8];
        y[0] = lo16(hv.x) * lo16(ov.x); y[1] = hi16(hv.x) * hi16(ov.x); y[2] = lo16(hv.y) * lo16(ov.y); y[3] = hi16(hv.y) * hi16(ov.y);
        y[4] = lo16(hv.z) * lo16(ov.z); y[5] = hi16(hv.z) * hi16(ov.z); y[6] = lo16(hv.w) * lo16(ov.w); y[7] = hi16(hv.w) * hi16(ov.w);
        float ss = ((y[0] * y[0] + y[1] * y[1]) + (y[2] * y[2] + y[3] * y[3])) + ((y[4] * y[4] + y[5] * y[5]) + (y[6] * y[6] + y[7] * y[7]));
#pragma unroll
        for (int o = 1; o < 32; o <<= 1) ss += __shfl_xor(ss, o);
        const float rstd = rsqrtf(ss * (1.0f / 256.0f) + EPSF);
        const f32x4 g0 = *(const f32x4*)(gm + col), g1 = *(const f32x4*)(gm + col + 4);
        u32x4 o;
        o.x = cvt_pk_bf16(y[0] * rstd * g0[0] * lo16(zv.x), y[1] * rstd * g0[1] * hi16(zv.x));
        o.y = cvt_pk_bf16(y[2] * rstd * g0[2] * lo16(zv.y), y[3] * rstd * g0[3] * hi16(zv.y));
        o.z = cvt_pk_bf16(y[4] * rstd * g1[0] * lo16(zv.z), y[5] * rstd * g1[1] * hi16(zv.z));
        o.w = cvt_pk_bf16(y[6] * rstd * g1[2] * lo16(zv.w), y[7] * rstd * g1[3] * hi16(zv.w));
        *(u32x4*)(MG + row * DMG + 1024 + col) = o;
    }
}

__device__ void phase_final(const Params& p) {
    const bf16_t* XB = (const bf16_t*)(p.ws + WS_XB); const float* SS = (const float*)(p.ws + WS_SS);
    const int tidf = otid(); const int wid = tidf >> 6, lane = tidf & 63;
    for (int row = blockIdx.x * 8 + wid; row < MV; row += gridDim.x * 8) {
        const f32x4* sp = (const f32x4*)(SS + (size_t)row * 16);
        const f32x4 s0 = sp[0], s1 = sp[1], s2 = sp[2], s3 = sp[3];
        const float ss = ((s0[0] + s0[1]) + (s0[2] + s0[3])) + ((s1[0] + s1[1]) + (s1[2] + s1[3])) + ((s2[0] + s2[1]) + (s2[2] + s2[3])) + ((s3[0] + s3[1]) + (s3[2] + s3[3]));
        const float rstd = rsqrtf(ss * (1.0f / 1024.0f) + EPSF);
        float* op = row < MP ? p.out + O_YP + (size_t)row * DM : p.out + O_YS + (size_t)(row - MP) * DM;
#pragma unroll
        for (int i = 0; i < 2; ++i) {
            const int c = i * 512 + lane * 8;
            const u32x4 xv = *(const u32x4*)(XB + (size_t)row * DM + c);
            const f32x4 g0 = *(const f32x4*)(p.g_final + c), g1 = *(const f32x4*)(p.g_final + c + 4);
            *(f32x4*)(op + c) = (f32x4){lo16(xv.x) * rstd * g0[0], hi16(xv.x) * rstd * g0[1], lo16(xv.y) * rstd * g0[2], hi16(xv.y) * rstd * g0[3]};
            *(f32x4*)(op + c + 4) = (f32x4){lo16(xv.z) * rstd * g1[0], hi16(xv.z) * rstd * g1[1], lo16(xv.w) * rstd * g1[2], hi16(xv.w) * rstd * g1[3]};
        }
    }
}

#define XB_XCNT(j) (64 * (j))
#define XB_XSUB(j) (1024 + 64 * (j))
#define XB_XGEN(j) (2048 + 64 * (j))
#define XB_TOP 3072
#define XB_TOPGEN 3136
__device__ __forceinline__ unsigned xb_ld(unsigned* p) { return __hip_atomic_load(p, __ATOMIC_RELAXED, __HIP_MEMORY_SCOPE_AGENT); }
__device__ __forceinline__ unsigned xb_add(unsigned* p, unsigned v) { return __hip_atomic_fetch_add(p, v, __ATOMIC_RELAXED, __HIP_MEMORY_SCOPE_AGENT); }
__device__ __forceinline__ unsigned xb_xcc_id() { return (unsigned)__builtin_amdgcn_s_getreg((3 << 11) | 20) & 0xFu; }
#define XB_SPIN(cond) do { unsigned sp_ = 0; while (cond) { __builtin_amdgcn_s_sleep(1); if (++sp_ > (1u << 24)) break; } } while (0)
__device__ __forceinline__ void gbar(unsigned* bar, volatile LAS unsigned* st) {
    asm volatile("s_waitcnt vmcnt(0) lgkmcnt(0)" ::: "memory");
    __syncthreads();
    if (threadIdx.x == 0) {
        const unsigned x = xb_xcc_id(), nloc = st[0], nx = st[1];
        const unsigned old = xb_add(&bar[XB_XSUB(x)], 1u);
        const unsigned gen = old / nloc;
        if (old + 1u == (gen + 1u) * nloc) {
            __builtin_amdgcn_fence(__ATOMIC_RELEASE, "agent");
            asm volatile("s_waitcnt vmcnt(0)" ::: "memory");
            const unsigned og = xb_add(&bar[XB_TOP], 1u);
            const unsigned tg = og / nx;
            if (og + 1u == (tg + 1u) * nx) xb_add(&bar[XB_TOPGEN], 1u);
            else XB_SPIN(xb_ld(&bar[XB_TOPGEN]) == tg);
            __builtin_amdgcn_fence(__ATOMIC_ACQUIRE, "agent");
            xb_add(&bar[XB_XGEN(x)], 1u);
            asm volatile("s_waitcnt vmcnt(0)" ::: "memory");
        } else {
            XB_SPIN(xb_ld(&bar[XB_XGEN(x)]) == gen);
            __builtin_amdgcn_fence(__ATOMIC_ACQUIRE, "agent");
            asm volatile("s_waitcnt vmcnt(0)" ::: "memory");
        }
    }
    __syncthreads();
}

__global__ void __launch_bounds__(NT, 2) hymba_fwd(Params p) {
    extern __shared__ __attribute__((aligned(16))) unsigned char lds_raw[];
    LAS unsigned char* lds = (LAS unsigned char*)lds_raw;
    cg::grid_group grid = cg::this_grid();
    bf16_t* XB = (bf16_t*)(p.ws + WS_XB); bf16_t* U = (bf16_t*)(p.ws + WS_U); float* G = (float*)(p.ws + WS_G); bf16_t* MG = (bf16_t*)(p.ws + WS_MG);
    float* SS = (float*)(p.ws + WS_SS);
    unsigned* bar = (unsigned*)(p.ws + WS_BAR);
    volatile LAS unsigned* st = (volatile LAS unsigned*)(lds + LDS_BYTES - 16);
    if (threadIdx.x == 0) (void)xb_add(&bar[XB_XCNT(xb_xcc_id())], 1u);
    if (p.out == nullptr) grid.sync();
    phase_prep(p, lds);
    if (threadIdx.x == 0) {
        const unsigned x = xb_xcc_id(), Gn = gridDim.x; unsigned mine = 1u, cnt = 1u, sp = 0u;
        for (;;) {
            unsigned sum = 0u; cnt = 0u;
            for (unsigned j = 0; j < 16; ++j) { const unsigned c = xb_ld(&bar[XB_XCNT(j)]); sum += c; cnt += c > 0u ? 1u : 0u; if (j == x) mine = c; }
            if (sum == Gn || ++sp > (1u << 22)) break;
            __builtin_amdgcn_s_sleep(1);
        }
        st[0] = mine > 0u ? mine : 1u; st[1] = cnt > 0u ? cnt : 1u;
    }
    __syncthreads();
    gbar(bar, st);
    for (int l = 0; l < 2; ++l) {
        {
            pg8::Gemm g; g.A = XB; g.Bt = (const bf16_t*)(p.ws + WS_WT1) + (size_t)l * NW1 * DM; g.M = MR; g.N = NW1; g.K = DM;
            unsigned* dctr = bar + 3712 + 64 * l;
            pg8::InOrder so; so.G = gridDim.x; so.c = obid(); so.done_ctr = dctr;
            EpiIn e; e.U = U; e.G = G; e.SS = SS; e.bmi = p.b_mi + l * 4; e.bmf = p.b_mf + l * 4;
            pg8::gemm_phase<EpiIn, pg8::InOrder, DM>(lds, g, so, e);
            const int Gn = gridDim.x, maxu = (pg8::IN_UNITS + Gn - 1) / Gn, mine = (pg8::IN_UNITS - so.c + Gn - 1) / Gn;
            if (mine < maxu) {
                if (threadIdx.x == 0) {
                    unsigned sp = 0u;
                    while (__hip_atomic_load(dctr, __ATOMIC_RELAXED, __HIP_MEMORY_SCOPE_AGENT) < 8u * pg8::IN_DEC_UNITS) { __builtin_amdgcn_s_sleep(2); if (++sp > (1u << 24)) break; }
                    __builtin_amdgcn_fence(__ATOMIC_ACQUIRE, "agent");
                    asm volatile("s_waitcnt vmcnt(0)" ::: "memory");
                }
                __syncthreads();
                decode_items(p, l, lds, 1);
            }
        }
        gbar(bar, st);
        phase_mixers(p, l, lds);
        gbar(bar, st);
        for (int pass = 0; pass < 2; ++pass) {
            if (pass == 0) phase_headnorm(p, l);
            pg8::Gemm g; g.A = MG; g.Bt = (const bf16_t*)(p.ws + WS_WT2) + (size_t)l * DM * DMG; g.M = MR; g.N = DM; g.K = DMG;
            pg8::OutOrder so; so.G = gridDim.x; so.c = obid(); so.mode = pass;
            EpiOut e; e.XBo = XB; e.SSo = SS;
            pg8::gemm_phase<EpiOut, pg8::OutOrder, DMG>(lds, g, so, e);
            gbar(bar, st);
        }
    }
    phase_final(p);
}

extern "C" void kernel_launch(void* const* d_in, const int* in_sizes, int n_in, void* d_out, int out_size, void* d_ws, size_t ws_size, hipStream_t stream) {
    static int grid_blocks = 0;
    if (!grid_blocks) {
        int dev = 0, cus = 0, per_cu = 0;
        hipGetDevice(&dev);
        hipDeviceGetAttribute(&cus, hipDeviceAttributeMultiprocessorCount, dev);
        hipFuncSetAttribute((const void*)hymba_fwd, hipFuncAttributeMaxDynamicSharedMemorySize, LDS_BYTES);
        hipOccupancyMaxActiveBlocksPerMultiprocessor(&per_cu, (const void*)hymba_fwd, NT, LDS_BYTES);
        if (per_cu < 1) per_cu = 1;
        grid_blocks = cus * per_cu;
        (void)hipGetLastError();
    }
    if (ws_size < WS_END) { fprintf(stderr, "workspace too small: %zu < %zu\n", ws_size, (size_t)WS_END); return; }
    Params p{};
    p.xp = (const float*)d_in[0]; p.xs = (const float*)d_in[1]; p.st_h = (const float*)d_in[2]; p.st_conv = (const float*)d_in[3];
    p.st_C = (const float*)d_in[4]; p.st_n = (const float*)d_in[5]; p.st_m = (const float*)d_in[6]; p.g_norm = (const float*)d_in[7];
    p.w_in = (const float*)d_in[8]; p.conv_w = (const float*)d_in[9]; p.conv_b = (const float*)d_in[10]; p.w_r = (const float*)d_in[11];
    p.b_r = (const float*)d_in[12]; p.w_i = (const float*)d_in[13]; p.b_i = (const float*)d_in[14]; p.lam = (const float*)d_in[15];
    p.b_mi = (const float*)d_in[16]; p.b_mf = (const float*)d_in[17]; p.g_mhead = (const float*)d_in[18]; p.w_out = (const float*)d_in[19];
    p.g_final = (const float*)d_in[20];
    p.out = (float*)d_out; p.ws = (unsigned char*)d_ws;
    (void)hipMemsetAsync((unsigned char*)d_ws + WS_BAR, 0, 16384, stream);
    void* args[] = {&p};
    hipError_t e = hipLaunchCooperativeKernel((const void*)hymba_fwd, dim3(grid_blocks), dim3(NT), args, LDS_BYTES, stream);
    if (e != hipSuccess) fprintf(stderr, "cooperative launch failed: %s (grid %d)\n", hipGetErrorString(e), grid_blocks);
}
```

```cpp
#include <hip/hip_runtime.h>
#include <hip/hip_cooperative_groups.h>
#include <cstdio>
namespace cg = cooperative_groups;

#define LAS __attribute__((address_space(3)))
typedef unsigned short bf16_t;
typedef short bf16x8 __attribute__((ext_vector_type(8)));
typedef short bf16x4 __attribute__((ext_vector_type(4)));
typedef float f32x4 __attribute__((ext_vector_type(4)));
typedef unsigned u32x4 __attribute__((ext_vector_type(4)));
typedef unsigned u32x2 __attribute__((ext_vector_type(2)));

constexpr int NT = 512;
constexpr int LDS_BYTES = 147456;
constexpr int MP = 16384, MV = 16512, MR = 16640;
constexpr int DM = 1024, NU = 7168, NW1 = 7424, DIN = 7176, DMG = 2048;
constexpr float EPSF = 1e-6f;

constexpr size_t WS_XB = 0;
constexpr size_t WS_WT1 = WS_XB + (size_t)MR * DM * 2;
constexpr size_t WS_WT2 = WS_WT1 + (size_t)2 * NW1 * DM * 2;
constexpr size_t WS_WGT = WS_WT2 + (size_t)2 * DM * DMG * 2;
constexpr size_t WS_U = WS_WGT + (size_t)2 * 2 * 16 * 64 * 64 * 2;
constexpr size_t WS_G = WS_U + (size_t)MR * NU * 2;
constexpr size_t WS_MG = WS_G + (size_t)MR * 8 * 4;
constexpr size_t WS_X1 = WS_MG + (size_t)MR * DMG * 2;
constexpr size_t WS_X2 = WS_X1 + (size_t)MR * DM * 4;
constexpr size_t WS_SS = WS_X2 + (size_t)MR * DM * 4;
constexpr size_t WS_YSS = WS_SS + (size_t)MR * 16 * 4;
constexpr size_t WS_BAR = WS_YSS + (size_t)MR * 16 * 4;
constexpr size_t WS_END = WS_BAR + 16384;

struct Params {
    const float* xp; const float* xs; const float* st_h; const float* st_conv; const float* st_C; const float* st_n; const float* st_m;
    const float* g_norm; const float* w_in; const float* conv_w; const float* conv_b; const float* w_r; const float* b_r; const float* w_i; const float* b_i;
    const float* lam; const float* b_mi; const float* b_mf; const float* g_mhead; const float* w_out; const float* g_final;
    float* out; unsigned char* ws;
};

constexpr size_t O_YP = 0;
constexpr size_t O_YS = O_YP + (size_t)MP * DM;
constexpr size_t O_PH = O_YS + (size_t)128 * DM;
constexpr size_t O_PCONV = O_PH + 2 * 8 * 1024;
constexpr size_t O_PC = O_PCONV + 2 * 8 * 3 * 1024;
constexpr size_t O_PN = O_PC + (size_t)2 * 8 * 4 * 65536;
constexpr size_t O_PM = O_PN + 2 * 8 * 4 * 256;
constexpr size_t O_SH = O_PM + 2 * 8 * 4;
constexpr size_t O_SCONV = O_SH + 2 * 128 * 1024;
constexpr size_t O_SC = O_SCONV + 2 * 128 * 3 * 1024;
constexpr size_t O_SN = O_SC + (size_t)2 * 128 * 4 * 65536;
constexpr size_t O_SM = O_SN + 2 * 128 * 4 * 256;

__device__ __forceinline__ float bf2f(unsigned short v) { return __uint_as_float(((unsigned)v) << 16); }
__device__ __forceinline__ unsigned cvt_pk_bf16(float lo, float hi) { unsigned r; asm volatile("v_cvt_pk_bf16_f32 %0, %1, %2" : "=v"(r) : "v"(lo), "v"(hi)); return r; }
__device__ __forceinline__ float sigmoidf_(float x) { return __builtin_amdgcn_rcpf(1.0f + __builtin_amdgcn_exp2f(-1.44269504f * x)); }
__device__ __forceinline__ float siluf_(float x) { return x * __builtin_amdgcn_rcpf(1.0f + __builtin_amdgcn_exp2f(-1.44269504f * x)); }
__device__ __forceinline__ float softplusf_(float x) { return fmaxf(x, 0.f) + log1pf(__expf(-fabsf(x))); }
__device__ __forceinline__ int otid() { int t = threadIdx.x; asm volatile("" : "+v"(t)); return t; }
__device__ __forceinline__ int obid() { int t = blockIdx.x; asm volatile("" : "+s"(t)); return t; }
__device__ __forceinline__ f32x4 zero4() { float z = 0.f; asm volatile("" : "+v"(z)); return (f32x4){z, z, z, z}; }
__device__ __forceinline__ float lo16(unsigned w) { return __uint_as_float(w << 16); }
__device__ __forceinline__ float hi16(unsigned w) { return __uint_as_float(w & 0xffff0000u); }

namespace pg8 {
constexpr int BM = 256, BK = 64, HALF = 128, HTB = HALF * BK * 2, STAGE_BYTES = 8 * HTB, NXCD = 8, WGM = 2;
__host__ __device__ __forceinline__ int lds_byte(int r, int c) { const int st = (r >> 4) * 2 + (c >> 5), rr = r & 15, cc = c & 31, ob = rr * 64 + cc * 2; return st * 1024 + (ob ^ (((ob >> 9) & 1) << 5)); }
__host__ __device__ __forceinline__ void stage_rc(int b, int& R, int& C) { const int st = b / 1024, sb = b % 1024, swz = sb ^ (((sb >> 9) & 1) << 5); R = (st >> 1) * 16 + swz / 64; C = (st & 1) * 32 + (swz % 64) / 2; }
__host__ __device__ __forceinline__ int perm32(int rho) { const int n = rho >> 4, i = rho & 15; return 8 * (i >> 2) + 4 * n + (i & 3); }
struct Unit { int pm, pn; };
struct Gemm { const bf16_t* A; const bf16_t* Bt; int M, N, K; };
template <int NM_, int NN_>
struct StaticOrder {
    static constexpr int nM = NM_, nN = NN_, nwg = NM_ * NN_;
    int G, c;
    __device__ void init(int G_, int c_) { G = G_; c = c_; }
    __device__ static void map(int L, Unit& u) {
        int wgid = L; { constexpr int q = nwg / NXCD, r = nwg % NXCD; const int xcd = wgid % NXCD, off = wgid / NXCD; wgid = (xcd < r ? xcd * (q + 1) : r * (q + 1) + (xcd - r) * q) + off; }
        constexpr int nig = WGM * nN; const int gid = wgid / nig, fm = gid * WGM, gsz = (nM - fm) < WGM ? (nM - fm) : WGM;
        u.pm = fm + ((wgid % nig) % gsz); u.pn = (wgid % nig) / gsz;
    }
    __device__ bool next(int i, Unit& u) const { const int L = i * G + c; if (L >= nwg) return false; map(L, u); return true; }
    __device__ __forceinline__ void done(const Unit&, int) const {}
};

struct OutOrder {
    int G, c, mode;
    __device__ bool next(int i, Unit& u) const {
        const int L = i * G + c;
        if (mode == 0) { if (L >= 4) return false; u.pm = 64; u.pn = L; return true; }
        if (L >= 256) return false; StaticOrder<64, 4>::map(L, u); return true;
    }
    __device__ __forceinline__ void done(const Unit&, int) const {}
};

constexpr int IN_UNITS = 65 * 29, IN_DEC_UNITS = 29;
struct InOrder {
    int G, c; unsigned* done_ctr;
    __device__ bool next(int i, Unit& u) const {
        const int L = i * G + c; if (L >= IN_UNITS) return false;
        if (L < IN_DEC_UNITS) { u.pm = 64; u.pn = L; return true; }
        StaticOrder<64, 29>::map(L - IN_DEC_UNITS, u); return true;
    }
    __device__ __forceinline__ void done(const Unit& u, int lane) const {
        if (u.pm == 64) {
            asm volatile("s_waitcnt vmcnt(0)" ::: "memory");
            __builtin_amdgcn_fence(__ATOMIC_RELEASE, "agent");
            asm volatile("s_waitcnt vmcnt(0)" ::: "memory");
            if (lane == 0) __hip_atomic_fetch_add(done_ctr, 1u, __ATOMIC_RELAXED, __HIP_MEMORY_SCOPE_AGENT);
        }
    }
};

template <class Epi, class Sched, int KK>
__device__ __forceinline__ void gemm_phase(LAS unsigned char* lds, const Gemm g, const Sched& S, const Epi& E) {
    const int tid = otid(), wid = __builtin_amdgcn_readfirstlane(tid >> 6), lane = tid & 63, wr = wid >> 2, wc = wid & 3, fr = lane & 15, fq = lane >> 4;
    constexpr int K = KK, nt = K / BK;
    unsigned voffA[2], voffB[2];
#pragma unroll
    for (int i = 0; i < 2; ++i) { int R, C; stage_rc(tid * 16 + i * 8192, R, C); const int Rb = Epi::PERM ? ((R & ~31) + perm32(R & 31)) : R;
        voffA[i] = (unsigned)(R * K + C) * 2u; voffB[i] = (unsigned)(Rb * K + C) * 2u; }
    const size_t kstep = (size_t)(BK * 2);
    const size_t hstep = (size_t)HALF * K * 2;
    const size_t tstep = 2 * hstep;
    const unsigned ldsw = (unsigned)wid * 1024u;
    const int aoff = lds_byte(wr * 64 + fr, fq * 8), boff = lds_byte(wc * 32 + fr, fq * 8);
#define PG8_SA(b, h) (((b) * 2 + (h)) * HTB)
#define PG8_SB(b, h) ((4 + (b) * 2 + (h)) * HTB)
#define PG8_STAGE(bufoff, gbase, voff) do { _Pragma("unroll") for (int _i = 0; _i < 2; ++_i) \
        __builtin_amdgcn_global_load_lds((const unsigned*)((const char*)(gbase) + (voff)[_i]), (LAS unsigned*)(lds + (bufoff) + ldsw + _i * 8192), 16, 0, 0); } while (0)
#define PG8_LDA(dst, b, h) do { _Pragma("unroll") for (int m = 0; m < 4; ++m) _Pragma("unroll") for (int k = 0; k < 2; ++k) dst[m][k] = *(const LAS bf16x8*)(lds + PG8_SA(b, h) + aoff + m * 2048 + k * 1024); } while (0)
#define PG8_LDB(dst, b, h) do { _Pragma("unroll") for (int n = 0; n < 2; ++n) _Pragma("unroll") for (int k = 0; k < 2; ++k) dst[n][k] = *(const LAS bf16x8*)(lds + PG8_SB(b, h) + boff + n * 2048 + k * 1024); } while (0)
#define PG8_MMA(ai, bj, At, Bt) do { __builtin_amdgcn_s_setprio(1); _Pragma("unroll") for (int m = 0; m < 4; ++m) _Pragma("unroll") for (int n = 0; n < 2; ++n) _Pragma("unroll") for (int k = 0; k < 2; ++k) \
        acc[ai][bj][m][n] = __builtin_amdgcn_mfma_f32_16x16x32_bf16(Bt[n][k], At[m][k], acc[ai][bj][m][n], 0, 0, 0); __builtin_amdgcn_s_setprio(0); } while (0)
#define PG8_WAIT_V(n) asm volatile("s_waitcnt vmcnt(" #n ")" ::: "memory")
#define PG8_WAIT_L(n) asm volatile("s_waitcnt lgkmcnt(" #n ")" ::: "memory")
#define PG8_BAR __builtin_amdgcn_s_barrier()
#define PG8_SCHED __builtin_amdgcn_sched_barrier(0)
    Unit cur, nxt; int ui = 0;
    if (!S.next(0, cur)) return;
    f32x4 acc[2][2][4][2];
#pragma unroll
    for (int a = 0; a < 2; ++a)
#pragma unroll
        for (int b = 0; b < 2; ++b)
#pragma unroll
            for (int m = 0; m < 4; ++m)
#pragma unroll
                for (int n = 0; n < 2; ++n) acc[a][b][m][n] = zero4();
    bf16x8 At[4][2], B0[2][2], B1[2][2];
    const char* cA = (const char*)g.A + (size_t)cur.pm * tstep; const char* cB = (const char*)g.Bt + (size_t)cur.pn * tstep;
    PG8_STAGE(PG8_SB(0, 0), cB, voffB); PG8_STAGE(PG8_SA(0, 0), cA, voffA); PG8_STAGE(PG8_SB(0, 1), cB + hstep, voffB); PG8_STAGE(PG8_SA(0, 1), cA + hstep, voffA);
    if (wr == 1) PG8_BAR;
    PG8_WAIT_V(4); PG8_BAR;
    PG8_STAGE(PG8_SB(1, 0), cB + kstep, voffB); PG8_STAGE(PG8_SA(1, 0), cA + kstep, voffA); PG8_STAGE(PG8_SB(1, 1), cB + hstep + kstep, voffB);
    PG8_WAIT_V(6); PG8_BAR;
    for (;;) {
        const bool has_next = S.next(ui + 1, nxt);
        const char* nA = has_next ? (const char*)g.A + (size_t)nxt.pm * tstep : cA; const char* nB = has_next ? (const char*)g.Bt + (size_t)nxt.pn * tstep : cB;
        for (int t = 0; t < nt; t += 2) {
            const bool last = (t == nt - 2);
            const char* a1 = cA + (size_t)(t + 1) * kstep;
            const char* a2 = last ? nA : cA + (size_t)(t + 2) * kstep; const char* b2 = last ? nB : cB + (size_t)(t + 2) * kstep;
            const char* a3 = a2 + kstep; const char* b3 = b2 + kstep;
            PG8_LDB(B0, 0, 0); PG8_SCHED; PG8_LDA(At, 0, 0); PG8_STAGE(PG8_SA(1, 1), a1 + hstep, voffA);
            PG8_WAIT_L(8); PG8_BAR; PG8_WAIT_L(0); PG8_MMA(0, 0, At, B0); PG8_BAR; PG8_SCHED;
            PG8_LDB(B1, 0, 1); PG8_STAGE(PG8_SB(0, 0), b2, voffB);
            PG8_BAR; PG8_WAIT_L(0); PG8_MMA(0, 1, At, B1); PG8_BAR;
            PG8_LDA(At, 0, 1); PG8_STAGE(PG8_SA(0, 0), a2, voffA);
            PG8_BAR; PG8_WAIT_L(0); PG8_MMA(1, 0, At, B0); PG8_BAR; PG8_SCHED;
            PG8_STAGE(PG8_SB(0, 1), b2 + hstep, voffB);
            PG8_WAIT_V(6); PG8_BAR; PG8_MMA(1, 1, At, B1); PG8_BAR;
            PG8_LDB(B0, 1, 0); PG8_SCHED; PG8_LDA(At, 1, 0); PG8_STAGE(PG8_SA(0, 1), a2 + hstep, voffA);
            PG8_WAIT_L(8); PG8_BAR; PG8_WAIT_L(0); PG8_MMA(0, 0, At, B0); PG8_BAR; PG8_SCHED;
            PG8_LDB(B1, 1, 1); PG8_STAGE(PG8_SB(1, 0), b3, voffB);
            PG8_BAR; PG8_WAIT_L(0); PG8_MMA(0, 1, At, B1); PG8_BAR;
            PG8_LDA(At, 1, 1); PG8_STAGE(PG8_SA(1, 0), a3, voffA);
            PG8_BAR; PG8_WAIT_L(0); PG8_MMA(1, 0, At, B0); PG8_BAR; PG8_SCHED;
            PG8_STAGE(PG8_SB(1, 1), b3 + hstep, voffB);
            PG8_WAIT_V(6); PG8_BAR; PG8_MMA(1, 1, At, B1); PG8_BAR;
        }
        E(acc, cur, wr, wc, fr, fq);
        S.done(cur, lane);
        if (!has_next) break;
#pragma unroll
        for (int a = 0; a < 2; ++a)
#pragma unroll
            for (int b = 0; b < 2; ++b)
#pragma unroll
                for (int m = 0; m < 4; ++m)
#pragma unroll
                    for (int n = 0; n < 2; ++n) acc[a][b][m][n] = zero4();
        cur = nxt; cA = nA; cB = nB; ++ui;
    }
    PG8_WAIT_V(0);
    if (wr == 0) PG8_BAR;
    PG8_BAR;
#undef PG8_SA
#undef PG8_SB
#undef PG8_STAGE
#undef PG8_LDA
#undef PG8_LDB
#undef PG8_MMA
#undef PG8_WAIT_V
#undef PG8_WAIT_L
#undef PG8_BAR
#undef PG8_SCHED
}
}

struct EpiIn {
    static constexpr bool PERM = true;
    bf16_t* U; float* G; const float* SS; const float* bmi; const float* bmf;
    __device__ __forceinline__ void operator()(const f32x4 (&acc)[2][2][4][2], const pg8::Unit& u, int wr, int wc, int fr, int fq) const {
        const int row0 = u.pm * 256 + wr * 64 + fr;
        const int pn = u.pn;
        const int mode = ((pn >= 4 && pn < 8) || (pn >= 24 && pn < 28)) ? 1 : ((pn >= 20 && pn < 24) ? 2 : 0);
        f32x4 cur[4];
        { const f32x4* sp = (const f32x4*)(SS + (size_t)row0 * 16); cur[0] = sp[0]; cur[1] = sp[1]; cur[2] = sp[2]; cur[3] = sp[3]; }
#pragma unroll
        for (int r = 0; r < 8; ++r) {
            const int ai = r >> 2, m = r & 3;
            const int row = row0 + ai * 128 + m * 16;
            f32x4 nxt[4];
            if (r < 7) {
                const f32x4* sp = (const f32x4*)(SS + (size_t)(row0 + ((r + 1) >> 2) * 128 + ((r + 1) & 3) * 16) * 16);
                nxt[0] = sp[0]; nxt[1] = sp[1]; nxt[2] = sp[2]; nxt[3] = sp[3];
            }
            const float ss = ((cur[0][0] + cur[0][1]) + (cur[0][2] + cur[0][3])) + ((cur[1][0] + cur[1][1]) + (cur[1][2] + cur[1][3])) + ((cur[2][0] + cur[2][1]) + (cur[2][2] + cur[2][3])) + ((cur[3][0] + cur[3][1]) + (cur[3][2] + cur[3][3]));
            const float rstd = rsqrtf(ss * (1.0f / 1024.0f) + EPSF);
            if (pn < 28) {
                bf16_t* rowp = U + (size_t)row * NU + pn * 256 + wc * 32 + 8 * fq;
#pragma unroll
                for (int bj = 0; bj < 2; ++bj) {
                    f32x4 v0 = acc[ai][bj][m][0] * rstd, v1 = acc[ai][bj][m][1] * rstd;
                    if (mode == 1) {
#pragma unroll
                        for (int j = 0; j < 4; ++j) { v0[j] = siluf_(v0[j]); v1[j] = siluf_(v1[j]); }
                    } else if (mode == 2) {
#pragma unroll
                        for (int j = 0; j < 4; ++j) { v0[j] = sigmoidf_(v0[j]); v1[j] = sigmoidf_(v1[j]); }
                    }
                    u32x4 w; w.x = cvt_pk_bf16(v0[0], v0[1]); w.y = cvt_pk_bf16(v0[2], v0[3]); w.z = cvt_pk_bf16(v1[0], v1[1]); w.w = cvt_pk_bf16(v1[2], v1[3]);
                    *(u32x4*)(rowp + bj * 128) = w;
                }
            } else if (wc == 0 && fq == 0) {
                const f32x4 v0 = acc[ai][0][m][0] * rstd, v1 = acc[ai][0][m][1] * rstd;
                f32x4 gi, gf;
#pragma unroll
                for (int j = 0; j < 4; ++j) { gi[j] = v0[j] + bmi[j]; const float x = v1[j] + bmf[j]; gf[j] = fminf(x, 0.f) - log1pf(__expf(-fabsf(x))); }
                *(f32x4*)(G + (size_t)row * 8) = gi; *(f32x4*)(G + (size_t)row * 8 + 4) = gf;
            }
            if (r < 7) { cur[0] = nxt[0]; cur[1] = nxt[1]; cur[2] = nxt[2]; cur[3] = nxt[3]; }
        }
    }
};

struct EpiOut {
    static constexpr bool PERM = false;
    const float* basep; const float* bases; int split;
    bf16_t* XBo; float* SSo;
    __device__ __forceinline__ void operator()(const f32x4 (&acc)[2][2][4][2], const pg8::Unit& u, int wr, int wc, int fr, int fq) const {
        const int row0 = u.pm * 256 + wr * 64 + fr, col0 = u.pn * 256 + wc * 32 + 4 * fq;
#pragma unroll
        for (int g2 = 0; g2 < 4; ++g2) {
            const int ai = g2 >> 1;
            f32x4 bs[2][2][2];
#pragma unroll
            for (int mm = 0; mm < 2; ++mm) {
                const int m = (g2 & 1) * 2 + mm;
                const int row = row0 + ai * 128 + m * 16;
                if (split) {
                    const float* bp = basep + (size_t)row * DM;
                    bool have = true;
                    if (row >= MV) have = false; else if (row >= MP) bp = bases + (size_t)(row - MP) * DM;
#pragma unroll
                    for (int bj = 0; bj < 2; ++bj)
#pragma unroll
                        for (int n = 0; n < 2; ++n) { bs[mm][bj][n] = zero4(); if (have) bs[mm][bj][n] = *(const f32x4*)(bp + col0 + bj * 128 + n * 16); }
                } else {
#pragma unroll
                    for (int bj = 0; bj < 2; ++bj)
#pragma unroll
                        for (int n = 0; n < 2; ++n) { const u32x2 v = *(const u32x2*)(XBo + (size_t)row * DM + col0 + bj * 128 + n * 16); bs[mm][bj][n] = (f32x4){lo16(v.x), hi16(v.x), lo16(v.y), hi16(v.y)}; }
                }
            }
#pragma unroll
            for (int mm = 0; mm < 2; ++mm) {
                const int m = (g2 & 1) * 2 + mm;
                const int row = row0 + ai * 128 + m * 16;
                float ss = 0.f;
#pragma unroll
                for (int bj = 0; bj < 2; ++bj)
#pragma unroll
                    for (int n = 0; n < 2; ++n) {
                        const int c = col0 + bj * 128 + n * 16;
                        const f32x4 o = bs[mm][bj][n] + acc[ai][bj][m][n];
                        u32x2 w; w.x = cvt_pk_bf16(o[0], o[1]); w.y = cvt_pk_bf16(o[2], o[3]); *(u32x2*)(XBo + (size_t)row * DM + c) = w;
                        ss += (o[0] * o[0] + o[1] * o[1]) + (o[2] * o[2] + o[3] * o[3]);
                    }
                ss += __shfl_xor(ss, 16); ss += __shfl_xor(ss, 32);
                if (fq == 0) SSo[(size_t)row * 16 + u.pn * 4 + wc] = ss;
            }
        }
    }
};

__device__ void transpose_tile(const float* src, int ldn, int nvalid, int k0, int n0, bf16_t* dst, int ldk, const float* sk, float sn, LAS float* T) {
    const int tid = otid();
    {
        const int r = tid >> 4, c4 = tid & 15;
#pragma unroll
        for (int i = 0; i < 2; ++i) {
            const int k = r + 32 * i; const int n = n0 + 4 * c4;
            f32x4 v = zero4();
            if (n + 3 < nvalid) v = *(const f32x4*)(src + (size_t)(k0 + k) * ldn + n);
            const float s = (sk ? sk[k0 + k] : 1.0f) * sn;
            T[k * 65 + 4 * c4 + 0] = v[0] * s; T[k * 65 + 4 * c4 + 1] = v[1] * s; T[k * 65 + 4 * c4 + 2] = v[2] * s; T[k * 65 + 4 * c4 + 3] = v[3] * s;
        }
    }
    __syncthreads();
    {
        const int n = tid >> 3, kq = tid & 7;
        float f[8];
#pragma unroll
        for (int j = 0; j < 8; ++j) f[j] = T[(kq * 8 + j) * 65 + n];
        u32x4 w; w.x = cvt_pk_bf16(f[0], f[1]); w.y = cvt_pk_bf16(f[2], f[3]); w.z = cvt_pk_bf16(f[4], f[5]); w.w = cvt_pk_bf16(f[6], f[7]);
        *(u32x4*)(dst + (size_t)(n0 + n) * ldk + k0 + kq * 8) = w;
    }
    __syncthreads();
}

__device__ void phase_prep(const Params& p, LAS unsigned char* lds) {
    LAS float* T = (LAS float*)lds;
    bf16_t* WT1 = (bf16_t*)(p.ws + WS_WT1); bf16_t* WT2 = (bf16_t*)(p.ws + WS_WT2); bf16_t* WGT = (bf16_t*)(p.ws + WS_WGT);
    bf16_t* XB = (bf16_t*)(p.ws + WS_XB); float* SS = (float*)(p.ws + WS_SS); bf16_t* MG = (bf16_t*)(p.ws + WS_MG);
    constexpr int JA = 2 * 16 * 116, JB = 2 * 32 * 16, JC = 64, JD = MR / 8;
    for (int job = blockIdx.x; job < JA + JB + JC + JD; job += gridDim.x) {
        if (job < JA) {
            const int l = job / (16 * 116), r = job % (16 * 116), ntile = r / 16, kt = r % 16;
            const int n0 = ntile * 64;
            const float sn = (n0 >= 3072 && n0 < 4096) ? 0.0625f : 1.0f;
            transpose_tile(p.w_in + (size_t)l * DM * DIN, DIN, DIN, kt * 64, n0, WT1 + (size_t)l * NW1 * DM, DM, p.g_norm + l * DM, sn, T);
        } else if (job < JA + JB) {
            const int j = job - JA, l = j / 512, r = j % 512, ntile = r / 32, kt = r % 32;
            transpose_tile(p.w_out + (size_t)l * DMG * DM, DM, DM, kt * 64, ntile * 64, WT2 + (size_t)l * DM * DMG, DMG, nullptr, 1.0f, T);
        } else if (job < JA + JB + JC) {
            const int j = job - JA - JB, l = j >> 5, gate = (j >> 4) & 1, blk = j & 15;
            const float* src = (gate ? p.w_i : p.w_r) + (size_t)(l * 16 + blk) * 4096;
            transpose_tile(src, 64, 64, 0, 0, WGT + (size_t)((l * 2 + gate) * 16 + blk) * 4096, 64, nullptr, 1.0f, T);
        } else {
            const int j = job - JA - JB - JC; const int tidp = otid(); const int wid = tidp >> 6, lane = tidp & 63;
            const int row = j * 8 + wid;
            const float* src = row < MP ? p.xp + (size_t)row * DM : (row < MV ? p.xs + (size_t)(row - MP) * DM : nullptr);
            f32x4 v[4]; float ss = 0.f;
#pragma unroll
            for (int i = 0; i < 4; ++i) { v[i] = src ? *(const f32x4*)(src + lane * 16 + i * 4) : zero4(); ss += (v[i][0] * v[i][0] + v[i][1] * v[i][1]) + (v[i][2] * v[i][2] + v[i][3] * v[i][3]); }
#pragma unroll
            for (int o = 32; o >= 1; o >>= 1) ss += __shfl_xor(ss, o);
            u32x4 w0, w1;
            w0.x = cvt_pk_bf16(v[0][0], v[0][1]); w0.y = cvt_pk_bf16(v[0][2], v[0][3]); w0.z = cvt_pk_bf16(v[1][0], v[1][1]); w0.w = cvt_pk_bf16(v[1][2], v[1][3]);
            w1.x = cvt_pk_bf16(v[2][0], v[2][1]); w1.y = cvt_pk_bf16(v[2][2], v[2][3]); w1.z = cvt_pk_bf16(v[3][0], v[3][1]); w1.w = cvt_pk_bf16(v[3][2], v[3][3]);
            *(u32x4*)(XB + (size_t)row * DM + lane * 16) = w0; *(u32x4*)(XB + (size_t)row * DM + lane * 16 + 8) = w1;
            if (lane < 16) SS[(size_t)row * 16 + lane] = lane == 0 ? ss : 0.f;
            if (row >= MV) { const u32x4 z = (u32x4){0u, 0u, 0u, 0u}; u32x4* mp = (u32x4*)(MG + (size_t)row * DMG + lane * 32); mp[0] = z; mp[1] = z; mp[2] = z; mp[3] = z; }
        }
    }
}

constexpr int M_QI = 0, M_KI = 38912, M_VI = 77824, M_CTI = 96256, M_SM = 130048;
constexpr int RS_QK = 304, RS_V = 144, RS_CT = 528;

template <int OFF0, int OFF1>
__device__ __forceinline__ bf16x8 tr_frag(unsigned base) {
    bf16x4 lo, hi;
    asm volatile("ds_read_b64_tr_b16 %0, %2 offset:%3\n\tds_read_b64_tr_b16 %1, %2 offset:%4\n\ts_waitcnt lgkmcnt(0)" : "=&v"(lo), "=&v"(hi) : "v"(base), "i"(OFF0), "i"(OFF1) : "memory");
    bf16x8 r; r[0] = lo[0]; r[1] = lo[1]; r[2] = lo[2]; r[3] = lo[3]; r[4] = hi[0]; r[5] = hi[1]; r[6] = hi[2]; r[7] = hi[3]; return r;
}

template <int KS>
__device__ __forceinline__ void mlstm_D(f32x4 (&CT)[8], unsigned bvD, unsigned bkD) {
    const bf16x8 vdf = tr_frag<KS * 32 * RS_V, KS * 32 * RS_V + 4 * RS_V>(bvD);
    const bf16x8 k0 = tr_frag<KS * 32 * RS_QK + 0, KS * 32 * RS_QK + 0 + 4 * RS_QK>(bkD);
    const bf16x8 k1 = tr_frag<KS * 32 * RS_QK + 32, KS * 32 * RS_QK + 32 + 4 * RS_QK>(bkD);
    const bf16x8 k2 = tr_frag<KS * 32 * RS_QK + 64, KS * 32 * RS_QK + 64 + 4 * RS_QK>(bkD);
    const bf16x8 k3 = tr_frag<KS * 32 * RS_QK + 96, KS * 32 * RS_QK + 96 + 4 * RS_QK>(bkD);
    CT[0] = __builtin_amdgcn_mfma_f32_16x16x32_bf16(k0, vdf, CT[0], 0, 0, 0);
    CT[1] = __builtin_amdgcn_mfma_f32_16x16x32_bf16(k1, vdf, CT[1], 0, 0, 0);
    CT[2] = __builtin_amdgcn_mfma_f32_16x16x32_bf16(k2, vdf, CT[2], 0, 0, 0);
    CT[3] = __builtin_amdgcn_mfma_f32_16x16x32_bf16(k3, vdf, CT[3], 0, 0, 0);
    const bf16x8 k4 = tr_frag<KS * 32 * RS_QK + 128, KS * 32 * RS_QK + 128 + 4 * RS_QK>(bkD);
    const bf16x8 k5 = tr_frag<KS * 32 * RS_QK + 160, KS * 32 * RS_QK + 160 + 4 * RS_QK>(bkD);
    const bf16x8 k6 = tr_frag<KS * 32 * RS_QK + 192, KS * 32 * RS_QK + 192 + 4 * RS_QK>(bkD);
    const bf16x8 k7 = tr_frag<KS * 32 * RS_QK + 224, KS * 32 * RS_QK + 224 + 4 * RS_QK>(bkD);
    CT[4] = __builtin_amdgcn_mfma_f32_16x16x32_bf16(k4, vdf, CT[4], 0, 0, 0);
    CT[5] = __builtin_amdgcn_mfma_f32_16x16x32_bf16(k5, vdf, CT[5], 0, 0, 0);
    CT[6] = __builtin_amdgcn_mfma_f32_16x16x32_bf16(k6, vdf, CT[6], 0, 0, 0);
    CT[7] = __builtin_amdgcn_mfma_f32_16x16x32_bf16(k7, vdf, CT[7], 0, 0, 0);
}
template <int KS>
__device__ __forceinline__ void mlstm_B(f32x4 (&N1)[4], LAS unsigned char* lds, unsigned bvB, int t, int fq) {
    const bf16x8 pf = *(const LAS bf16x8*)(lds + M_QI + t * RS_QK + KS * 64 + fq * 16);
    const bf16x8 v0 = tr_frag<KS * 32 * RS_V + 0, KS * 32 * RS_V + 0 + 4 * RS_V>(bvB);
    const bf16x8 v1 = tr_frag<KS * 32 * RS_V + 32, KS * 32 * RS_V + 32 + 4 * RS_V>(bvB);
    const bf16x8 v2 = tr_frag<KS * 32 * RS_V + 64, KS * 32 * RS_V + 64 + 4 * RS_V>(bvB);
    const bf16x8 v3 = tr_frag<KS * 32 * RS_V + 96, KS * 32 * RS_V + 96 + 4 * RS_V>(bvB);
    N1[0] = __builtin_amdgcn_mfma_f32_16x16x32_bf16(v0, pf, N1[0], 0, 0, 0);
    N1[1] = __builtin_amdgcn_mfma_f32_16x16x32_bf16(v1, pf, N1[1], 0, 0, 0);
    N1[2] = __builtin_amdgcn_mfma_f32_16x16x32_bf16(v2, pf, N1[2], 0, 0, 0);
    N1[3] = __builtin_amdgcn_mfma_f32_16x16x32_bf16(v3, pf, N1[3], 0, 0, 0);
}

__device__ void mlstm_prompt(const Params& p, int l, int item, LAS unsigned char* lds) {
    const int tid0 = otid();
    const int js = item & 3, h = (item >> 2) & 3, b = item >> 4;
    const unsigned ldsb = (unsigned)(size_t)lds;
    LAS float* sm = (LAS float*)(lds + M_SM);
    LAS float* nbuf = sm + 512; LAS float* npart = sm + 1040;
    const bf16_t* U = (const bf16_t*)(p.ws + WS_U); const float* G = (const float*)(p.ws + WS_G);
    bf16_t* MG = (bf16_t*)(p.ws + WS_MG);
    const size_t grow_base = (size_t)b * 2048;
    const int qcol = 2048 + h * 256, kcol = 3072 + h * 256, vcol = 4096 + h * 256 + js * 64;

    __syncthreads();
    for (int i = tid0; i < RS_CT * 64 / 16; i += NT) *(LAS u32x4*)(lds + M_CTI + i * 16) = (u32x4){0u, 0u, 0u, 0u};
    nbuf[tid0] = 0.f;
    f32x4 CTacc[8];
#pragma unroll
    for (int i = 0; i < 8; ++i) CTacc[i] = zero4();
    float m_prev = 0.f;
    u32x4 qreg[4], kreg[4], vreg[2]; float igr[2] = {0.f, 0.f}, lfr[2] = {0.f, 0.f};

#define ML_LOAD_QK(row0_, hd_) do { _Pragma("unroll") for (int i_ = 0; i_ < 4; ++i_) { const int id_ = tid + NT * i_, r_ = id_ >> 4, cq_ = id_ & 15; \
        const bf16_t* rp_ = U + (grow_base + (row0_) + r_) * NU + (hd_) * 128 + cq_ * 8; qreg[i_] = *(const u32x4*)(rp_ + qcol); kreg[i_] = *(const u32x4*)(rp_ + kcol); } } while (0)
#define ML_STORE_QK() do { _Pragma("unroll") for (int i_ = 0; i_ < 4; ++i_) { const int id_ = tid + NT * i_, r_ = id_ >> 4, cq_ = id_ & 15; \
        *(LAS u32x4*)(lds + M_QI + r_ * RS_QK + cq_ * 16) = qreg[i_]; *(LAS u32x4*)(lds + M_KI + r_ * RS_QK + cq_ * 16) = kreg[i_]; } } while (0)
#define ML_LOAD_VG(row0_) do { _Pragma("unroll") for (int i_ = 0; i_ < 2; ++i_) { const int id_ = tid + NT * i_, s_ = id_ >> 3, cq_ = id_ & 7; \
        vreg[i_] = *(const u32x4*)(U + (grow_base + (row0_) + s_) * NU + vcol + cq_ * 8); } \
        if (w == 0) { const float* gp_ = G + (grow_base + (row0_) + 2 * lane) * 8 + h; igr[0] = gp_[0]; lfr[0] = gp_[4]; igr[1] = gp_[8]; lfr[1] = gp_[12]; } } while (0)

#define ML_PREPASS(buf_) do { if (w == 0) { LAS float* dec_ = sm + 128 * (buf_); LAS float* expnm_ = sm + 256 + 128 * (buf_); LAS float* scal_ = sm + 1024 + 8 * (buf_); \
            const float s2 = lfr[0] + lfr[1]; float incl = s2; \
            _Pragma("unroll") for (int o = 1; o < 64; o <<= 1) { const float t_ = __shfl_up(incl, o); if (lane >= o) incl += t_; } \
            const float b0 = incl - s2 + lfr[0], b1 = incl; \
            const float a0 = igr[0] - b0, a1 = igr[1] - b1; float im = fmaxf(a0, a1); \
            _Pragma("unroll") for (int o = 1; o < 64; o <<= 1) { const float t_ = __shfl_up(im, o); if (lane >= o) im = fmaxf(im, t_); } \
            float ex = __shfl_up(im, 1); if (lane == 0) ex = -INFINITY; \
            const float M0 = fmaxf(ex, a0), M1 = fmaxf(M0, a1); \
            const float mt1 = b1 + fmaxf(m_prev, M1); \
            const float bL = __shfl(b1, 63), mL = __shfl(mt1, 63); \
            expnm_[2 * lane] = __expf(bL - mL - b0); expnm_[2 * lane + 1] = __expf(bL - mL - b1); \
            dec_[2 * lane] = __expf(bL - b0 + igr[0] - mL); dec_[2 * lane + 1] = __expf(bL - b1 + igr[1] - mL); \
            if (lane == 0) { scal_[0] = __expf(bL + m_prev - mL); scal_[1] = mL; } \
            m_prev = mL; } } while (0)
    { const int tid = tid0, w = tid >> 6, lane = tid & 63; ML_LOAD_QK(0, 0); ML_LOAD_VG(0); ML_PREPASS(0); }
#pragma unroll 1
    for (int c = 0; c < 16; ++c) {
        int tid = tid0; asm volatile("" : "+v"(tid));
        const int w = __builtin_amdgcn_readfirstlane(tid >> 6), lane = tid & 63, fr = lane & 15, fq = lane >> 4;
        const int cD = w & 3, gD = w >> 2, qq = (lane & 15) >> 2, pp = lane & 3;
        const unsigned bvB = ldsb + M_VI + (8 * fq + qq) * RS_V + 8 * pp;
        const unsigned bvD = bvB + cD * 32;
        const int row0 = c * 128;
        LAS float* nC = nbuf + (c & 1) * 256; LAS float* nN = nbuf + ((c + 1) & 1) * 256;
        __syncthreads();
        ML_STORE_QK();
        LAS float* dec = sm + 128 * (c & 1); LAS float* expnm = sm + 256 + 128 * (c & 1); LAS float* scal = sm + 1024 + 8 * (c & 1);
        const float cs = scal[0];
#pragma unroll
        for (int i = 0; i < 2; ++i) {
            const int id = tid + NT * i, s = id >> 3, cq = id & 7; const float d = dec[s];
            u32x4 v = vreg[i], o;
            o.x = cvt_pk_bf16(lo16(v.x) * d, hi16(v.x) * d); o.y = cvt_pk_bf16(lo16(v.y) * d, hi16(v.y) * d);
            o.z = cvt_pk_bf16(lo16(v.z) * d, hi16(v.z) * d); o.w = cvt_pk_bf16(lo16(v.w) * d, hi16(v.w) * d);
            *(LAS u32x4*)(lds + M_VI + s * RS_V + cq * 16) = o;
        }
        if (tid < 256) nN[tid] = cs * nC[tid];
        ML_LOAD_QK(row0, 1);
        f32x4 Sacc[8], N2[4];
#pragma unroll
        for (int i = 0; i < 8; ++i) Sacc[i] = zero4();
#pragma unroll
        for (int i = 0; i < 4; ++i) N2[i] = zero4();
        float qnp = 0.f;
#pragma unroll 1
        for (int hd = 0; hd < 2; ++hd) {
            __syncthreads();
#pragma unroll
            for (int ks = 0; ks < 4; ++ks) {
                const bf16x8 qf = *(const LAS bf16x8*)(lds + M_QI + (16 * w + fr) * RS_QK + ks * 64 + fq * 16);
#pragma unroll
                for (int i = 0; i < 8; ++i) if (i <= w) {
                    const bf16x8 kf = *(const LAS bf16x8*)(lds + M_KI + (16 * i + fr) * RS_QK + ks * 64 + fq * 16);
                    Sacc[i] = __builtin_amdgcn_mfma_f32_16x16x32_bf16(kf, qf, Sacc[i], 0, 0, 0);
                }
#pragma unroll
                for (int c4 = 0; c4 < 4; ++c4) {
                    const bf16x8 ctf = *(const LAS bf16x8*)(lds + M_CTI + (16 * c4 + fr) * RS_CT + hd * 256 + ks * 64 + fq * 16);
                    N2[c4] = __builtin_amdgcn_mfma_f32_16x16x32_bf16(ctf, qf, N2[c4], 0, 0, 0);
                }
                const LAS float* np = nC + hd * 128 + ks * 32 + fq * 8;
#pragma unroll
                for (int j = 0; j < 8; ++j) qnp += bf2f((unsigned short)qf[j]) * np[j];
                __builtin_amdgcn_sched_barrier(0);
            }
            if (gD == hd) {
                const unsigned bkD = ldsb + M_KI + (8 * fq + qq) * RS_QK + 8 * pp;
#pragma unroll
                for (int i = 0; i < 8; ++i) CTacc[i] *= cs;
                mlstm_D<0>(CTacc, bvD, bkD); __builtin_amdgcn_sched_barrier(0); mlstm_D<1>(CTacc, bvD, bkD); __builtin_amdgcn_sched_barrier(0); mlstm_D<2>(CTacc, bvD, bkD); __builtin_amdgcn_sched_barrier(0); mlstm_D<3>(CTacc, bvD, bkD); __builtin_amdgcn_sched_barrier(0);
            }
            if (gD != hd) {
                const int lidx = (w & 3) * 64 + lane, dk2 = lidx & 63, part = lidx >> 6; float a0 = 0.f, a1 = 0.f;
#pragma unroll 8
                for (int s = 32 * part; s < 32 * part + 32; ++s) { const unsigned kv = *(const LAS unsigned*)(lds + M_KI + s * RS_QK + dk2 * 4); const float d = dec[s]; a0 += d * lo16(kv); a1 += d * hi16(kv); }
                npart[part * 128 + 2 * dk2] = a0; npart[part * 128 + 2 * dk2 + 1] = a1;
            }
            __syncthreads();
            if (tid < 128) nN[hd * 128 + tid] += (npart[tid] + npart[128 + tid]) + (npart[256 + tid] + npart[384 + tid]);
            if (gD == hd) {
#pragma unroll
                for (int i = 0; i < 8; ++i) {
                    u32x2 wv; wv.x = cvt_pk_bf16(CTacc[i][0], CTacc[i][1]); wv.y = cvt_pk_bf16(CTacc[i][2], CTacc[i][3]);
                    *(LAS u32x2*)(lds + M_CTI + (16 * cD + fr) * RS_CT + (hd * 128 + 16 * i + 4 * fq) * 2) = wv;
                }
            }
            if (hd == 0) {
                ML_STORE_QK();
                if (c < 15) { ML_LOAD_QK(row0 + 128, 0); }
            }
        }
        if (c < 15) { ML_LOAD_VG(row0 + 128); }
        const int t = 16 * w + fr;
        float den1 = 0.f;
#pragma unroll
        for (int i = 0; i < 8; ++i) if (i <= (w | 1)) {
            f32x4 sv = Sacc[i];
            const f32x4 dv = *(const LAS f32x4*)(dec + 16 * i + 4 * fq);
#pragma unroll
            for (int j = 0; j < 4; ++j) { const int s = 16 * i + 4 * fq + j; if (s > t || i > w) sv[j] = 0.f; den1 += sv[j] * dv[j]; }
            u32x2 wv; wv.x = cvt_pk_bf16(sv[0], sv[1]); wv.y = cvt_pk_bf16(sv[2], sv[3]);
            *(LAS u32x2*)(lds + M_QI + t * RS_QK + (16 * i + 4 * fq) * 2) = wv;
        }
        den1 += __shfl_xor(den1, 16); den1 += __shfl_xor(den1, 32);
        qnp += __shfl_xor(qnp, 16); qnp += __shfl_xor(qnp, 32);
#pragma unroll
        for (int i = 0; i < 4; ++i) N2[i] *= cs;
        if (0 <= (w >> 1)) mlstm_B<0>(N2, lds, bvB, t, fq);
        if (1 <= (w >> 1)) mlstm_B<1>(N2, lds, bvB, t, fq);
        if (2 <= (w >> 1)) mlstm_B<2>(N2, lds, bvB, t, fq);
        if (3 <= (w >> 1)) mlstm_B<3>(N2, lds, bvB, t, fq);
        {
            const float den = den1 + cs * qnp;
            const float inv = 1.0f / fmaxf(fabsf(den), expnm[t]);
            const size_t grow = grow_base + row0 + t;
#pragma unroll
            for (int c4 = 0; c4 < 4; ++c4) {
                const float y0 = N2[c4][0] * inv, y1 = N2[c4][1] * inv, y2 = N2[c4][2] * inv, y3 = N2[c4][3] * inv;
                u32x2 wv; wv.x = cvt_pk_bf16(y0, y1); wv.y = cvt_pk_bf16(y2, y3);
                *(u32x2*)(MG + grow * DMG + 1024 + h * 256 + js * 64 + 16 * c4 + 4 * fq) = wv;
            }
        }
        if (c < 15) ML_PREPASS((c + 1) & 1);
    }
    __syncthreads();
    {
        const int tid = tid0, w = tid >> 6, lane = tid & 63, fr = lane & 15, fq = lane >> 4, cD = w & 3, gD = w >> 2;
        float* pC = p.out + O_PC + ((size_t)((l * 8 + b) * 4 + h)) * 65536;
#pragma unroll
        for (int i = 0; i < 8; ++i)
#pragma unroll
            for (int j = 0; j < 4; ++j) pC[(size_t)(gD * 128 + 16 * i + 4 * fq + j) * 256 + js * 64 + 16 * cD + fr] = CTacc[i][j];
        if (js == 0) {
            if (tid < 256) p.out[O_PN + ((size_t)((l * 8 + b) * 4 + h)) * 256 + tid] = nbuf[tid];
            if (tid == 0) p.out[O_PM + (l * 8 + b) * 4 + h] = sm[1024 + 8 + 1];
        }
    }
    __syncthreads();
#undef ML_LOAD_QK
#undef ML_STORE_QK
#undef ML_LOAD_VG
#undef ML_PREPASS
}

constexpr int R_XAI = 0, R_XCF = 16768, R_XCB = 49536, R_AA = 67968, R_UU = 100736, R_PT = 133504, R_HC = 137600, R_CW = 138112, R_CH = 139392;
__device__ void rglru_item(const Params& p, int l, int b, int cb, bool decm, LAS unsigned char* lds) {
    const int tid = otid(), w = __builtin_amdgcn_readfirstlane(tid >> 6), lane = tid & 63, fr = lane & 15, fq = lane >> 4;
    const bf16_t* U = (const bf16_t*)(p.ws + WS_U); bf16_t* MG = (bf16_t*)(p.ws + WS_MG);
    const bf16_t* WGT = (const bf16_t*)(p.ws + WS_WGT);
    LAS float* XCF = (LAS float*)(lds + R_XCF); LAS float* AA = (LAS float*)(lds + R_AA); LAS float* UU = (LAS float*)(lds + R_UU);
    LAS float* PT = (LAS float*)(lds + R_PT); LAS float* HC = (LAS float*)(lds + R_HC); LAS float* CW = (LAS float*)(lds + R_CW); LAS float* CH = (LAS float*)(lds + R_CH);
    const int ch0 = cb * 64;
    const size_t grow_base = decm ? (size_t)MP : (size_t)b * 2048;
    const int nchunk = decm ? 1 : 16;
    __syncthreads();
    if (tid < 64) {
        const int ch = ch0 + tid;
#pragma unroll
        for (int j = 0; j < 4; ++j) CW[j * 64 + tid] = p.conv_w[(size_t)(l * 4 + j) * 1024 + ch];
        CW[256 + tid] = p.conv_b[l * 1024 + ch];
        CH[tid] = p.b_r[l * 1024 + ch]; CH[64 + tid] = p.b_i[l * 1024 + ch]; CH[128 + tid] = 8.0f * softplusf_(-p.lam[l * 1024 + ch]);
        HC[tid] = 0.f; HC[64 + tid] = 0.f;
    }
    if (tid < 24) *(LAS u32x4*)(lds + R_XAI + tid * 16) = (u32x4){0u, 0u, 0u, 0u};
    u32x4 xreg[2], zreg[2];
#pragma unroll
    for (int i = 0; i < 2; ++i) { const int id = tid + NT * i, r = id >> 3, cq = id & 7; const bf16_t* rp = U + (grow_base + r) * NU + ch0 + cq * 8; xreg[i] = *(const u32x4*)rp; zreg[i] = *(const u32x4*)(rp + 1024); }
    for (int c = 0; c < nchunk; ++c) {
        const int row0 = c * 128;
        __syncthreads();
        if (c > 0) {
#pragma unroll
            for (int i = 0; i < 2; ++i) { const int id = tid + NT * i, r = id >> 3, cq = id & 7; *(u32x4*)(MG + (grow_base + row0 - 128 + r) * DMG + ch0 + cq * 8) = *(const LAS u32x4*)(lds + R_XCF + r * 128 + cq * 16); }
        }
        u32x4 zcur[2];
#pragma unroll
        for (int i = 0; i < 2; ++i) { const int id = tid + NT * i, r = id >> 3, cq = id & 7; *(LAS u32x4*)(lds + R_XAI + (3 + r) * 128 + cq * 16) = xreg[i]; zcur[i] = zreg[i]; }
        if (c + 1 < nchunk) {
#pragma unroll
            for (int i = 0; i < 2; ++i) { const int id = tid + NT * i, r = id >> 3, cq = id & 7; const bf16_t* rp = U + (grow_base + row0 + 128 + r) * NU + ch0 + cq * 8; xreg[i] = *(const u32x4*)rp; zreg[i] = *(const u32x4*)(rp + 1024); }
        }
        __syncthreads();
        {
            const int t = tid >> 2, c0 = (tid & 3) * 16;
            float xc[16];
#pragma unroll
            for (int k = 0; k < 16; ++k) xc[k] = CW[256 + c0 + k];
            if (!decm) {
#pragma unroll
                for (int j = 0; j < 4; ++j) {
                    const u32x4 a = *(const LAS u32x4*)(lds + R_XAI + (t + j) * 128 + c0 * 2), bq = *(const LAS u32x4*)(lds + R_XAI + (t + j) * 128 + c0 * 2 + 16);
                    const unsigned wv[8] = {a.x, a.y, a.z, a.w, bq.x, bq.y, bq.z, bq.w};
#pragma unroll
                    for (int k = 0; k < 8; ++k) { xc[2 * k] += CW[j * 64 + c0 + 2 * k] * lo16(wv[k]); xc[2 * k + 1] += CW[j * 64 + c0 + 2 * k + 1] * hi16(wv[k]); }
                }
            } else {
                const float* stp = p.st_conv + ((size_t)(l * 128 + t) * 3) * 1024 + ch0 + c0;
                float* so = p.out + O_SCONV + ((size_t)(l * 128 + t) * 3) * 1024 + ch0 + c0;
#pragma unroll
                for (int j = 0; j < 3; ++j)
#pragma unroll
                    for (int k4 = 0; k4 < 4; ++k4) {
                        const f32x4 sv = *(const f32x4*)(stp + (size_t)j * 1024 + k4 * 4);
#pragma unroll
                        for (int e = 0; e < 4; ++e) xc[k4 * 4 + e] += CW[j * 64 + c0 + k4 * 4 + e] * sv[e];
                        if (j >= 1) *(f32x4*)(so + (size_t)(j - 1) * 1024 + k4 * 4) = sv;
                    }
                const u32x4 a = *(const LAS u32x4*)(lds + R_XAI + (t + 3) * 128 + c0 * 2), bq = *(const LAS u32x4*)(lds + R_XAI + (t + 3) * 128 + c0 * 2 + 16);
                const unsigned wv[8] = {a.x, a.y, a.z, a.w, bq.x, bq.y, bq.z, bq.w};
#pragma unroll
                for (int k = 0; k < 8; ++k) {
                    const float x0 = lo16(wv[k]), x1 = hi16(wv[k]);
                    xc[2 * k] += CW[3 * 64 + c0 + 2 * k] * x0; xc[2 * k + 1] += CW[3 * 64 + c0 + 2 * k + 1] * x1;
                    so[2 * 1024 + 2 * k] = x0; so[2 * 1024 + 2 * k + 1] = x1;
                }
            }
#pragma unroll
            for (int k4 = 0; k4 < 4; ++k4) *(LAS f32x4*)(XCF + t * 64 + c0 + k4 * 4) = (f32x4){xc[k4 * 4], xc[k4 * 4 + 1], xc[k4 * 4 + 2], xc[k4 * 4 + 3]};
            u32x4 o0, o1;
            o0.x = cvt_pk_bf16(xc[0], xc[1]); o0.y = cvt_pk_bf16(xc[2], xc[3]); o0.z = cvt_pk_bf16(xc[4], xc[5]); o0.w = cvt_pk_bf16(xc[6], xc[7]);
            o1.x = cvt_pk_bf16(xc[8], xc[9]); o1.y = cvt_pk_bf16(xc[10], xc[11]); o1.z = cvt_pk_bf16(xc[12], xc[13]); o1.w = cvt_pk_bf16(xc[14], xc[15]);
            *(LAS u32x4*)(lds + R_XCB + t * 144 + c0 * 2) = o0; *(LAS u32x4*)(lds + R_XCB + t * 144 + c0 * 2 + 16) = o1;
        }
        __syncthreads();
        if (!decm && tid < 24) { const u32x4 v = *(const LAS u32x4*)(lds + R_XAI + 128 * 128 + tid * 16); *(LAS u32x4*)(lds + R_XAI + tid * 16) = v; }
        {
            bf16x8 xf[2];
#pragma unroll
            for (int ks = 0; ks < 2; ++ks) xf[ks] = *(const LAS bf16x8*)(lds + R_XCB + (16 * w + fr) * 144 + ks * 64 + fq * 16);
            const int t = 16 * w + fr;
#pragma unroll
            for (int c4 = 0; c4 < 4; ++c4) {
                f32x4 ar = zero4(), ai = ar;
#pragma unroll
                for (int ks = 0; ks < 2; ++ks) {
                    const bf16x8 wfr = *(const bf16x8*)(WGT + (size_t)((l * 2 + 0) * 16 + cb) * 4096 + (16 * c4 + fr) * 64 + ks * 32 + fq * 8);
                    const bf16x8 wfi = *(const bf16x8*)(WGT + (size_t)((l * 2 + 1) * 16 + cb) * 4096 + (16 * c4 + fr) * 64 + ks * 32 + fq * 8);
                    ar = __builtin_amdgcn_mfma_f32_16x16x32_bf16(wfr, xf[ks], ar, 0, 0, 0); ai = __builtin_amdgcn_mfma_f32_16x16x32_bf16(wfi, xf[ks], ai, 0, 0, 0); }
                const int d = 16 * c4 + 4 * fq;
                const f32x4 xcv = *(const LAS f32x4*)(XCF + t * 64 + d);
                f32x4 av, uv;
#pragma unroll
                for (int j = 0; j < 4; ++j) {
                    const float r = sigmoidf_(ar[j] + CH[d + j]), ig = sigmoidf_(ai[j] + CH[64 + d + j]);
                    const float la = -r * CH[128 + d + j];
                    const float x2 = 2.0f * la;
                    const float ser = -x2 * (1.0f + x2 * (0.5f + x2 * (0.16666667f + x2 * (0.041666668f + x2 * (0.0083333338f + x2 * 0.0013888889f)))));
                    const float om = x2 > -0.3f ? ser : 1.0f - __expf(x2);
                    av[j] = __expf(la); uv[j] = __builtin_amdgcn_sqrtf(om) * (ig * xcv[j]);
                }
                if (!decm) { *(LAS f32x4*)(AA + t * 64 + d) = av; *(LAS f32x4*)(UU + t * 64 + d) = uv; }
                else {
                    const f32x4 h0 = *(const f32x4*)(p.st_h + (size_t)(l * 128 + t) * 1024 + ch0 + d);
                    const f32x4 hn = av * h0 + uv;
                    *(f32x4*)(p.out + O_SH + (size_t)(l * 128 + t) * 1024 + ch0 + d) = hn;
                    const u32x2 zv = *(const u32x2*)(U + (grow_base + t) * NU + 1024 + ch0 + d);
                    u32x2 wv; wv.x = cvt_pk_bf16(hn[0] * lo16(zv.x), hn[1] * hi16(zv.x)); wv.y = cvt_pk_bf16(hn[2] * lo16(zv.y), hn[3] * hi16(zv.y));
                    *(u32x2*)(MG + (grow_base + t) * DMG + ch0 + d) = wv;
                }
            }
        }
        if (decm) break;
        __syncthreads();
#pragma unroll
        for (int i = 0; i < 2; ++i) { const int id = tid + NT * i, r = id >> 3, cq = id & 7; *(LAS u32x4*)(lds + R_XCB + r * 144 + cq * 16) = zcur[i]; }
        const int ch = tid & 63, part = tid >> 6;
        {
            float hh = 0.f, Ac = 1.f;
#pragma unroll 4
            for (int k = 0; k < 16; ++k) { const int t = part * 16 + k; const float a = AA[t * 64 + ch], u = UU[t * 64 + ch]; hh = a * hh + u; Ac *= a; UU[t * 64 + ch] = hh; AA[t * 64 + ch] = Ac; }
            PT[(part * 64 + ch) * 2] = Ac; PT[(part * 64 + ch) * 2 + 1] = hh;
        }
        __syncthreads();
        {
            float hin = HC[(c & 1) * 64 + ch];
            for (int q = 0; q < part; ++q) hin = PT[(q * 64 + ch) * 2] * hin + PT[(q * 64 + ch) * 2 + 1];
            float hf = hin;
#pragma unroll 4
            for (int k = 0; k < 16; ++k) {
                const int t = part * 16 + k; hf = AA[t * 64 + ch] * hin + UU[t * 64 + ch];
                const float z = bf2f(*(const LAS unsigned short*)(lds + R_XCB + t * 144 + ch * 2));
                const float y = hf * z;
                *(LAS unsigned short*)(lds + R_XCF + t * 128 + ch * 2) = (unsigned short)(cvt_pk_bf16(y, y) & 0xffffu);
            }
            if (part == 7) {
                HC[((c + 1) & 1) * 64 + ch] = hf;
                if (c == 15) p.out[O_PH + (size_t)(l * 8 + b) * 1024 + ch0 + ch] = hf;
            }
        }
        if (c == 15 && tid < 192) {
            const int j = tid >> 6, cc = tid & 63;
            p.out[O_PCONV + ((size_t)(l * 8 + b) * 3 + j) * 1024 + ch0 + cc] = bf2f(*(const LAS unsigned short*)(lds + R_XAI + j * 128 + cc * 2));
        }
    }
    __syncthreads();
    if (!decm) {
#pragma unroll
        for (int i = 0; i < 2; ++i) { const int id = tid + NT * i, r = id >> 3, cq = id & 7; *(u32x4*)(MG + (grow_base + 15 * 128 + r) * DMG + ch0 + cq * 8) = *(const LAS u32x4*)(lds + R_XCF + r * 128 + cq * 16); }
    }
    __syncthreads();
}

__device__ void mlstm_decode(const Params& p, int l, int b, int h, LAS unsigned char* lds) {
    const int tid = otid(), lane = tid & 63;
    const bf16_t* U = (const bf16_t*)(p.ws + WS_U); const float* G = (const float*)(p.ws + WS_G);
    bf16_t* MG = (bf16_t*)(p.ws + WS_MG);
    LAS float* qs = (LAS float*)lds; LAS float* ks = qs + 256; LAS float* vs = qs + 512; LAS float* ns = qs + 768; LAS float* red = qs + 1024; LAS float* red2 = qs + 1024 + 2048;
    const size_t row = (size_t)MP + b;
    const size_t sidx = (size_t)((l * 128 + b) * 4 + h);
    __syncthreads();
    if (tid < 256) {
        qs[tid] = bf2f(U[row * NU + 2048 + h * 256 + tid]); ks[tid] = bf2f(U[row * NU + 3072 + h * 256 + tid]); vs[tid] = bf2f(U[row * NU + 4096 + h * 256 + tid]);
        ns[tid] = p.st_n[sidx * 256 + tid];
    }
    const float ig = G[row * 8 + h], lf = G[row * 8 + 4 + h], m0 = p.st_m[sidx];
    __syncthreads();
    float qk = 0.f, qn = 0.f;
#pragma unroll
    for (int j = 0; j < 4; ++j) { const float qv = qs[lane * 4 + j]; qk += qv * ks[lane * 4 + j]; qn += qv * ns[lane * 4 + j]; }
#pragma unroll
    for (int o = 32; o >= 1; o >>= 1) { qk += __shfl_xor(qk, o); qn += __shfl_xor(qn, o); }
    const float mt = fmaxf(lf + m0, ig), wg = __expf(ig - mt), gi = __expf(lf + m0 - mt);
    const int dvq = tid & 63, dkg = tid >> 6;
    float o_pre = 0.f, zg_pre = 0.f;
    if (tid < 256) { o_pre = bf2f(U[row * NU + 5120 + h * 256 + tid]); zg_pre = p.g_mhead[l * 1024 + h * 256 + tid] * bf2f(U[row * NU + 6144 + h * 256 + tid]); }
    const float* C0 = p.st_C + sidx * 65536; float* C1 = p.out + O_SC + sidx * 65536;
    const f32x4 v4 = *(const LAS f32x4*)(vs + dvq * 4);
    f32x4 qc = zero4();
#pragma unroll 16
    for (int i = 0; i < 32; ++i) {
        const int dk = dkg * 32 + i;
        const f32x4 c4 = __builtin_nontemporal_load((const f32x4*)(C0 + (size_t)dk * 256 + dvq * 4));
        const float qv = qs[dk], kv = wg * ks[dk];
        qc += qv * c4;
        const f32x4 cn = gi * c4 + kv * v4;
        __builtin_nontemporal_store(cn, (f32x4*)(C1 + (size_t)dk * 256 + dvq * 4));
    }
    *(LAS f32x4*)(red + dkg * 256 + dvq * 4) = qc;
    __syncthreads();
    float yv = 0.f;
    if (tid < 256) {
        float qcv = 0.f;
#pragma unroll
        for (int g = 0; g < 8; ++g) qcv += red[g * 256 + tid];
        const float num = wg * qk * vs[tid] + gi * qcv, den = wg * qk + gi * qn;
        const float hh = num / fmaxf(fabsf(den), __expf(-mt));
        yv = hh * o_pre;
        float ss = yv * yv;
#pragma unroll
        for (int o = 32; o >= 1; o >>= 1) ss += __shfl_xor(ss, o);
        if (lane == 0) red2[tid >> 6] = ss;
        p.out[O_SN + sidx * 256 + tid] = gi * ns[tid] + wg * ks[tid];
    }
    __syncthreads();
    if (tid < 256) {
        const float rstd = rsqrtf(((red2[0] + red2[1]) + (red2[2] + red2[3])) * (1.0f / 256.0f) + EPSF);
        const float ov = yv * rstd * zg_pre;
        MG[row * DMG + 1024 + h * 256 + tid] = (bf16_t)(cvt_pk_bf16(ov, ov) & 0xffffu);
    }
    if (tid == 0) p.out[O_SM + sidx] = mt;
}

__device__ void decode_items(const Params& p, int l, LAS unsigned char* lds, int max_items) {
    unsigned* ctr = (unsigned*)(p.ws + WS_BAR) + 3584 + 64 * l;
    volatile LAS unsigned* slot = (volatile LAS unsigned*)(lds + LDS_BYTES - 32);
    for (int n = 0; n < max_items; ++n) {
        __syncthreads();
        if (threadIdx.x == 0) *slot = __hip_atomic_fetch_add(ctr, 1u, __ATOMIC_RELAXED, __HIP_MEMORY_SCOPE_AGENT);
        __syncthreads();
        const int item = (int)*slot;
        if (item >= 512) break;
        mlstm_decode(p, l, item >> 2, item & 3, lds);
    }
}

__device__ void phase_mixers(const Params& p, int l, LAS unsigned char* lds) {
    const int G = gridDim.x, bid = obid();
    const bool split = G >= 256;
    const int r = split ? bid - 128 : bid, R = split ? G - 128 : G;
    if (!split || bid < 128) { for (int item = bid; item < 128; item += (split ? 128 : G)) mlstm_prompt(p, l, item, lds); }
    if (r >= 0) {
        for (int item = r; item < 128; item += R) rglru_item(p, l, item >> 4, item & 15, false, lds);
        for (int item = r; item < 16; item += R) rglru_item(p, l, 0, item, true, lds);
    }
    decode_items(p, l, lds, 1 << 30);
}

__device__ void phase_headnorm(const Params& p, int l) {
    const bf16_t* U = (const bf16_t*)(p.ws + WS_U); bf16_t* MG = (bf16_t*)(p.ws + WS_MG);
    const float* gm = p.g_mhead + l * 1024;
    const int G = gridDim.x, bid = obid();
    const int b0 = G > 8 ? bid - 4 : bid, GG = G > 8 ? G - 4 : G;
    if (b0 < 0) return;
    for (size_t idx = (size_t)b0 * NT + otid(); idx < (size_t)MP * 128; idx += (size_t)GG * NT) {
        const size_t row = idx >> 7; const int col = (int)(idx & 127) * 8;
        const u32x4 hv = *(const u32x4*)(MG + row * DMG + 1024 + col);
        const u32x4 ov = *(const u32x4*)(U + row * NU + 5120 + col);
        const u32x4 zv = *(const u32x4*)(U + row * NU + 6144 + col);
        float y[8];
        y[0] = lo16(hv.x) * lo16(ov.x); y[1] = hi16(hv.x) * hi16(ov.x); y[2] = lo16(hv.y) * lo16(ov.y); y[3] = hi16(hv.y) * hi16(ov.y);
        y[4] = lo16(hv.z) * lo16(ov.z); y[5] = hi16(hv.z) * hi16(ov.z); y[6] = lo16(hv.w) * lo16(ov.w); y[7] = hi16(hv.w) * hi16(ov.w);
        float ss = ((y[0] * y[0] + y[1] * y[1]) + (y[2] * y[2] + y[3] * y[3])) + ((y[4] * y[4] + y[5] * y[5]) + (y[6] * y[6] + y[7] * y[7]));
#pragma unroll
        for (int o = 1; o < 32; o <<= 1) ss += __shfl_xor(ss, o);
        const float rstd = rsqrtf(ss * (1.0f / 256.0f) + EPSF);
        const f32x4 g0 = *(const f32x4*)(gm + col), g1 = *(const f32x4*)(gm + col + 4);
        u32x4 o;
        o.x = cvt_pk_bf16(y[0] * rstd * g0[0] * lo16(zv.x), y[1] * rstd * g0[1] * hi16(zv.x));
        o.y = cvt_pk_bf16(y[2] * rstd * g0[2] * lo16(zv.y), y[3] * rstd * g0[3] * hi16(zv.y));
        o.z = cvt_pk_bf16(y[4] * rstd * g1[0] * lo16(zv.z), y[5] * rstd * g1[1] * hi16(zv.z));
        o.w = cvt_pk_bf16(y[6] * rstd * g1[2] * lo16(zv.w), y[7] * rstd * g1[3] * hi16(zv.w));
        *(u32x4*)(MG + row * DMG + 1024 + col) = o;
    }
}

__device__ void phase_final(const Params& p) {
    const bf16_t* XB = (const bf16_t*)(p.ws + WS_XB); const float* SS = (const float*)(p.ws + WS_SS);
    const int tidf = otid(); const int wid = tidf >> 6, lane = tidf & 63;
    for (int row = blockIdx.x * 8 + wid; row < MV; row += gridDim.x * 8) {
        const f32x4* sp = (const f32x4*)(SS + (size_t)row * 16);
        const f32x4 s0 = sp[0], s1 = sp[1], s2 = sp[2], s3 = sp[3];
        const float ss = ((s0[0] + s0[1]) + (s0[2] + s0[3])) + ((s1[0] + s1[1]) + (s1[2] + s1[3])) + ((s2[0] + s2[1]) + (s2[2] + s2[3])) + ((s3[0] + s3[1]) + (s3[2] + s3[3]));
        const float rstd = rsqrtf(ss * (1.0f / 1024.0f) + EPSF);
        float* op = row < MP ? p.out + O_YP + (size_t)row * DM : p.out + O_YS + (size_t)(row - MP) * DM;
#pragma unroll
        for (int i = 0; i < 2; ++i) {
            const int c = i * 512 + lane * 8;
            const u32x4 xv = *(const u32x4*)(XB + (size_t)row * DM + c);
            const f32x4 g0 = *(const f32x4*)(p.g_final + c), g1 = *(const f32x4*)(p.g_final + c + 4);
            *(f32x4*)(op + c) = (f32x4){lo16(xv.x) * rstd * g0[0], hi16(xv.x) * rstd * g0[1], lo16(xv.y) * rstd * g0[2], hi16(xv.y) * rstd * g0[3]};
            *(f32x4*)(op + c + 4) = (f32x4){lo16(xv.z) * rstd * g1[0], hi16(xv.z) * rstd * g1[1], lo16(xv.w) * rstd * g1[2], hi16(xv.w) * rstd * g1[3]};
        }
    }
}

#define XB_XCNT(j) (64 * (j))
#define XB_XSUB(j) (1024 + 64 * (j))
#define XB_XGEN(j) (2048 + 64 * (j))
#define XB_TOP 3072
#define XB_TOPGEN 3136
__device__ __forceinline__ unsigned xb_ld(unsigned* p) { return __hip_atomic_load(p, __ATOMIC_RELAXED, __HIP_MEMORY_SCOPE_AGENT); }
__device__ __forceinline__ unsigned xb_add(unsigned* p, unsigned v) { return __hip_atomic_fetch_add(p, v, __ATOMIC_RELAXED, __HIP_MEMORY_SCOPE_AGENT); }
__device__ __forceinline__ unsigned xb_xcc_id() { return (unsigned)__builtin_amdgcn_s_getreg((3 << 11) | 20) & 0xFu; }
#define XB_SPIN(cond) do { unsigned sp_ = 0; while (cond) { __builtin_amdgcn_s_sleep(1); if (++sp_ > (1u << 24)) break; } } while (0)
__device__ __forceinline__ void gbar(unsigned* bar, volatile LAS unsigned* st) {
    asm volatile("s_waitcnt vmcnt(0) lgkmcnt(0)" ::: "memory");
    __syncthreads();
    if (threadIdx.x == 0) {
        const unsigned x = xb_xcc_id(), nloc = st[0], nx = st[1];
        const unsigned old = xb_add(&bar[XB_XSUB(x)], 1u);
        const unsigned gen = old / nloc;
        if (old + 1u == (gen + 1u) * nloc) {
            __builtin_amdgcn_fence(__ATOMIC_RELEASE, "agent");
            asm volatile("s_waitcnt vmcnt(0)" ::: "memory");
            const unsigned og = xb_add(&bar[XB_TOP], 1u);
            const unsigned tg = og / nx;
            if (og + 1u == (tg + 1u) * nx) xb_add(&bar[XB_TOPGEN], 1u);
            else XB_SPIN(xb_ld(&bar[XB_TOPGEN]) == tg);
            __builtin_amdgcn_fence(__ATOMIC_ACQUIRE, "agent");
            xb_add(&bar[XB_XGEN(x)], 1u);
            asm volatile("s_waitcnt vmcnt(0)" ::: "memory");
        } else {
            XB_SPIN(xb_ld(&bar[XB_XGEN(x)]) == gen);
            __builtin_amdgcn_fence(__ATOMIC_ACQUIRE, "agent");
            asm volatile("s_waitcnt vmcnt(0)" ::: "memory");
        }
    }
    __syncthreads();
}

__global__ void __launch_bounds__(NT, 2) hymba_fwd(Params p) {
    extern __shared__ __attribute__((aligned(16))) unsigned char lds_raw[];
    LAS unsigned char* lds = (LAS unsigned char*)lds_raw;
    cg::grid_group grid = cg::this_grid();
    bf16_t* XB = (bf16_t*)(p.ws + WS_XB); bf16_t* U = (bf16_t*)(p.ws + WS_U); float* G = (float*)(p.ws + WS_G); bf16_t* MG = (bf16_t*)(p.ws + WS_MG);
    float* SS = (float*)(p.ws + WS_SS);
    unsigned* bar = (unsigned*)(p.ws + WS_BAR);
    volatile LAS unsigned* st = (volatile LAS unsigned*)(lds + LDS_BYTES - 16);
    if (threadIdx.x == 0) (void)xb_add(&bar[XB_XCNT(xb_xcc_id())], 1u);
    if (p.out == nullptr) grid.sync();
    phase_prep(p, lds);
    if (threadIdx.x == 0) {
        const unsigned x = xb_xcc_id(), Gn = gridDim.x; unsigned mine = 1u, cnt = 1u, sp = 0u;
        for (;;) {
            unsigned sum = 0u; cnt = 0u;
            for (unsigned j = 0; j < 16; ++j) { const unsigned c = xb_ld(&bar[XB_XCNT(j)]); sum += c; cnt += c > 0u ? 1u : 0u; if (j == x) mine = c; }
            if (sum == Gn || ++sp > (1u << 22)) break;
            __builtin_amdgcn_s_sleep(1);
        }
        st[0] = mine > 0u ? mine : 1u; st[1] = cnt > 0u ? cnt : 1u;
    }
    __syncthreads();
    gbar(bar, st);
    for (int l = 0; l < 2; ++l) {
        {
            pg8::Gemm g; g.A = XB; g.Bt = (const bf16_t*)(p.ws + WS_WT1) + (size_t)l * NW1 * DM; g.M = MR; g.N = NW1; g.K = DM;
            unsigned* dctr = bar + 3712 + 64 * l;
            pg8::InOrder so; so.G = gridDim.x; so.c = obid(); so.done_ctr = dctr;
            EpiIn e; e.U = U; e.G = G; e.SS = SS; e.bmi = p.b_mi + l * 4; e.bmf = p.b_mf + l * 4;
            pg8::gemm_phase<EpiIn, pg8::InOrder, DM>(lds, g, so, e);
            const int Gn = gridDim.x, maxu = (pg8::IN_UNITS + Gn - 1) / Gn, mine = (pg8::IN_UNITS - so.c + Gn - 1) / Gn;
            if (mine < maxu) {
                if (threadIdx.x == 0) {
                    unsigned sp = 0u;
                    while (__hip_atomic_load(dctr, __ATOMIC_RELAXED, __HIP_MEMORY_SCOPE_AGENT) < 8u * pg8::IN_DEC_UNITS) { __builtin_amdgcn_s_sleep(2); if (++sp > (1u << 24)) break; }
                    __builtin_amdgcn_fence(__ATOMIC_ACQUIRE, "agent");
                    asm volatile("s_waitcnt vmcnt(0)" ::: "memory");
                }
                __syncthreads();
                decode_items(p, l, lds, 1);
            }
        }
        gbar(bar, st);
        phase_mixers(p, l, lds);
        gbar(bar, st);
        for (int pass = 0; pass < 2; ++pass) {
            if (pass == 0) phase_headnorm(p, l);
            pg8::Gemm g; g.A = MG; g.Bt = (const bf16_t*)(p.ws + WS_WT2) + (size_t)l * DM * DMG; g.M = MR; g.N = DM; g.K = DMG;
            pg8::OutOrder so; so.G = gridDim.x; so.c = obid(); so.mode = pass;
            EpiOut e; e.basep = p.xp; e.bases = p.xs; e.split = l == 0 ? 1 : 0; e.XBo = XB; e.SSo = SS;
            pg8::gemm_phase<EpiOut, pg8::OutOrder, DMG>(lds, g, so, e);
            gbar(bar, st);
        }
    }
    phase_final(p);
}

extern "C" void kernel_launch(void* const* d_in, const int* in_sizes, int n_in, void* d_out, int out_size, void* d_ws, size_t ws_size, hipStream_t stream) {
    static int grid_blocks = 0;
    if (!grid_blocks) {
        int dev = 0, cus = 0, per_cu = 0;
        hipGetDevice(&dev);
        hipDeviceGetAttribute(&cus, hipDeviceAttributeMultiprocessorCount, dev);
        hipFuncSetAttribute((const void*)hymba_fwd, hipFuncAttributeMaxDynamicSharedMemorySize, LDS_BYTES);
        hipOccupancyMaxActiveBlocksPerMultiprocessor(&per_cu, (const void*)hymba_fwd, NT, LDS_BYTES);
        if (per_cu < 1) per_cu = 1;
        grid_blocks = cus * per_cu;
        (void)hipGetLastError();
    }
    if (ws_size < WS_END) { fprintf(stderr, "workspace too small: %zu < %zu\n", ws_size, (size_t)WS_END); return; }
    Params p{};
    p.xp = (const float*)d_in[0]; p.xs = (const float*)d_in[1]; p.st_h = (const float*)d_in[2]; p.st_conv = (const float*)d_in[3];
    p.st_C = (const float*)d_in[4]; p.st_n = (const float*)d_in[5]; p.st_m = (const float*)d_in[6]; p.g_norm = (const float*)d_in[7];
    p.w_in = (const float*)d_in[8]; p.conv_w = (const float*)d_in[9]; p.conv_b = (const float*)d_in[10]; p.w_r = (const float*)d_in[11];
    p.b_r = (const float*)d_in[12]; p.w_i = (const float*)d_in[13]; p.b_i = (const float*)d_in[14]; p.lam = (const float*)d_in[15];
    p.b_mi = (const float*)d_in[16]; p.b_mf = (const float*)d_in[17]; p.g_mhead = (const float*)d_in[18]; p.w_out = (const float*)d_in[19];
    p.g_final = (const float*)d_in[20];
    p.out = (float*)d_out; p.ws = (unsigned char*)d_ws;
    (void)hipMemsetAsync((unsigned char*)d_ws + WS_BAR, 0, 16384, stream);
    void* args[] = {&p};
    hipError_t e = hipLaunchCooperativeKernel((const void*)hymba_fwd, dim3(grid_blocks), dim3(NT), args, LDS_BYTES, stream);
    if (e != hipSuccess) fprintf(stderr, "cooperative launch failed: %s (grid %d)\n", hipGetErrorString(e), grid_blocks);
}
```

```cpp
#include <hip/hip_runtime.h>
#include <hip/hip_cooperative_groups.h>
#include <cstdio>
namespace cg = cooperative_groups;

#define LAS __attribute__((address_space(3)))
typedef unsigned short bf16_t;
typedef short bf16x8 __attribute__((ext_vector_type(8)));
typedef short bf16x4 __attribute__((ext_vector_type(4)));
typedef float f32x4 __attribute__((ext_vector_type(4)));
typedef unsigned u32x4 __attribute__((ext_vector_type(4)));
typedef unsigned u32x2 __attribute__((ext_vector_type(2)));

constexpr int NT = 512;
constexpr int LDS_BYTES = 147456;
constexpr int MP = 16384, MV = 16512, MR = 16640;
constexpr int DM = 1024, NU = 7168, NW1 = 7424, DIN = 7176, DMG = 2048;
constexpr float EPSF = 1e-6f;

constexpr size_t WS_XB = 0;
constexpr size_t WS_WT1 = WS_XB + (size_t)MR * DM * 2;
constexpr size_t WS_WT2 = WS_WT1 + (size_t)2 * NW1 * DM * 2;
constexpr size_t WS_WGT = WS_WT2 + (size_t)2 * DM * DMG * 2;
constexpr size_t WS_U = WS_WGT + (size_t)2 * 2 * 16 * 64 * 64 * 2;
constexpr size_t WS_G = WS_U + (size_t)MR * NU * 2;
constexpr size_t WS_MG = WS_G + (size_t)MR * 8 * 4;
constexpr size_t WS_X1 = WS_MG + (size_t)MR * DMG * 2;
constexpr size_t WS_X2 = WS_X1 + (size_t)MR * DM * 4;
constexpr size_t WS_SS = WS_X2 + (size_t)MR * DM * 4;
constexpr size_t WS_YSS = WS_SS + (size_t)MR * 16 * 4;
constexpr size_t WS_BAR = WS_YSS + (size_t)MR * 16 * 4;
constexpr size_t WS_END = WS_BAR + 16384;

struct Params {
    const float* xp; const float* xs; const float* st_h; const float* st_conv; const float* st_C; const float* st_n; const float* st_m;
    const float* g_norm; const float* w_in; const float* conv_w; const float* conv_b; const float* w_r; const float* b_r; const float* w_i; const float* b_i;
    const float* lam; const float* b_mi; const float* b_mf; const float* g_mhead; const float* w_out; const float* g_final;
    float* out; unsigned char* ws;
};

constexpr size_t O_YP = 0;
constexpr size_t O_YS = O_YP + (size_t)MP * DM;
constexpr size_t O_PH = O_YS + (size_t)128 * DM;
constexpr size_t O_PCONV = O_PH + 2 * 8 * 1024;
constexpr size_t O_PC = O_PCONV + 2 * 8 * 3 * 1024;
constexpr size_t O_PN = O_PC + (size_t)2 * 8 * 4 * 65536;
constexpr size_t O_PM = O_PN + 2 * 8 * 4 * 256;
constexpr size_t O_SH = O_PM + 2 * 8 * 4;
constexpr size_t O_SCONV = O_SH + 2 * 128 * 1024;
constexpr size_t O_SC = O_SCONV + 2 * 128 * 3 * 1024;
constexpr size_t O_SN = O_SC + (size_t)2 * 128 * 4 * 65536;
constexpr size_t O_SM = O_SN + 2 * 128 * 4 * 256;

__device__ __forceinline__ float bf2f(unsigned short v) { return __uint_as_float(((unsigned)v) << 16); }
__device__ __forceinline__ unsigned cvt_pk_bf16(float lo, float hi) { unsigned r; asm volatile("v_cvt_pk_bf16_f32 %0, %1, %2" : "=v"(r) : "v"(lo), "v"(hi)); return r; }
__device__ __forceinline__ float sigmoidf_(float x) { return __builtin_amdgcn_rcpf(1.0f + __builtin_amdgcn_exp2f(-1.44269504f * x)); }
__device__ __forceinline__ float siluf_(float x) { return x * __builtin_amdgcn_rcpf(1.0f + __builtin_amdgcn_exp2f(-1.44269504f * x)); }
__device__ __forceinline__ float softplusf_(float x) { return fmaxf(x, 0.f) + log1pf(__expf(-fabsf(x))); }
__device__ __forceinline__ int otid() { int t = threadIdx.x; asm volatile("" : "+v"(t)); return t; }
__device__ __forceinline__ int obid() { int t = blockIdx.x; asm volatile("" : "+s"(t)); return t; }
__device__ __forceinline__ f32x4 zero4() { float z = 0.f; asm volatile("" : "+v"(z)); return (f32x4){z, z, z, z}; }
__device__ __forceinline__ float lo16(unsigned w) { return __uint_as_float(w << 16); }
__device__ __forceinline__ float hi16(unsigned w) { return __uint_as_float(w & 0xffff0000u); }

namespace pg8 {
constexpr int BM = 256, BK = 64, HALF = 128, HTB = HALF * BK * 2, STAGE_BYTES = 8 * HTB, NXCD = 8, WGM = 2;
__host__ __device__ __forceinline__ int lds_byte(int r, int c) { const int st = (r >> 4) * 2 + (c >> 5), rr = r & 15, cc = c & 31, ob = rr * 64 + cc * 2; return st * 1024 + (ob ^ (((ob >> 9) & 1) << 5)); }
__host__ __device__ __forceinline__ void stage_rc(int b, int& R, int& C) { const int st = b / 1024, sb = b % 1024, swz = sb ^ (((sb >> 9) & 1) << 5); R = (st >> 1) * 16 + swz / 64; C = (st & 1) * 32 + (swz % 64) / 2; }
__host__ __device__ __forceinline__ int perm32(int rho) { const int n = rho >> 4, i = rho & 15; return 8 * (i >> 2) + 4 * n + (i & 3); }
struct Unit { int pm, pn; };
struct Gemm { const bf16_t* A; const bf16_t* Bt; int M, N, K; };
template <int NM_, int NN_>
struct StaticOrder {
    static constexpr int nM = NM_, nN = NN_, nwg = NM_ * NN_;
    int G, c;
    __device__ void init(int G_, int c_) { G = G_; c = c_; }
    __device__ static void map(int L, Unit& u) {
        int wgid = L; { constexpr int q = nwg / NXCD, r = nwg % NXCD; const int xcd = wgid % NXCD, off = wgid / NXCD; wgid = (xcd < r ? xcd * (q + 1) : r * (q + 1) + (xcd - r) * q) + off; }
        constexpr int nig = WGM * nN; const int gid = wgid / nig, fm = gid * WGM, gsz = (nM - fm) < WGM ? (nM - fm) : WGM;
        u.pm = fm + ((wgid % nig) % gsz); u.pn = (wgid % nig) / gsz;
    }
    __device__ bool next(int i, Unit& u) const { const int L = i * G + c; if (L >= nwg) return false; map(L, u); return true; }
    __device__ __forceinline__ void done(const Unit&, int) const {}
};

struct OutOrder {
    int G, c, mode;
    __device__ bool next(int i, Unit& u) const {
        const int L = i * G + c;
        if (mode == 0) { if (L >= 4) return false; u.pm = 64; u.pn = L; return true; }
        if (L >= 256) return false; StaticOrder<64, 4>::map(L, u); return true;
    }
    __device__ __forceinline__ void done(const Unit&, int) const {}
};

constexpr int IN_UNITS = 65 * 29, IN_DEC_UNITS = 29;
struct InOrder {
    int G, c; unsigned* done_ctr;
    __device__ bool next(int i, Unit& u) const {
        const int L = i * G + c; if (L >= IN_UNITS) return false;
        if (L < IN_DEC_UNITS) { u.pm = 64; u.pn = L; return true; }
        StaticOrder<64, 29>::map(L - IN_DEC_UNITS, u); return true;
    }
    __device__ __forceinline__ void done(const Unit& u, int lane) const {
        if (u.pm == 64) {
            asm volatile("s_waitcnt vmcnt(0)" ::: "memory");
            __builtin_amdgcn_fence(__ATOMIC_RELEASE, "agent");
            asm volatile("s_waitcnt vmcnt(0)" ::: "memory");
            if (lane == 0) __hip_atomic_fetch_add(done_ctr, 1u, __ATOMIC_RELAXED, __HIP_MEMORY_SCOPE_AGENT);
        }
    }
};

template <class Epi, class Sched, int KK>
__device__ __forceinline__ void gemm_phase(LAS unsigned char* lds, const Gemm g, const Sched& S, const Epi& E) {
    const int tid = otid(), wid = __builtin_amdgcn_readfirstlane(tid >> 6), lane = tid & 63, wr = wid >> 2, wc = wid & 3, fr = lane & 15, fq = lane >> 4;
    constexpr int K = KK, nt = K / BK;
    unsigned voffA[2], voffB[2];
#pragma unroll
    for (int i = 0; i < 2; ++i) { int R, C; stage_rc(tid * 16 + i * 8192, R, C); const int Rb = Epi::PERM ? ((R & ~31) + perm32(R & 31)) : R;
        voffA[i] = (unsigned)(R * K + C) * 2u; voffB[i] = (unsigned)(Rb * K + C) * 2u; }
    const size_t kstep = (size_t)(BK * 2);
    const size_t hstep = (size_t)HALF * K * 2;
    const size_t tstep = 2 * hstep;
    const unsigned ldsw = (unsigned)wid * 1024u;
    const int aoff = lds_byte(wr * 64 + fr, fq * 8), boff = lds_byte(wc * 32 + fr, fq * 8);
#define PG8_SA(b, h) (((b) * 2 + (h)) * HTB)
#define PG8_SB(b, h) ((4 + (b) * 2 + (h)) * HTB)
#define PG8_STAGE(bufoff, gbase, voff) do { _Pragma("unroll") for (int _i = 0; _i < 2; ++_i) \
        __builtin_amdgcn_global_load_lds((const unsigned*)((const char*)(gbase) + (voff)[_i]), (LAS unsigned*)(lds + (bufoff) + ldsw + _i * 8192), 16, 0, 0); } while (0)
#define PG8_LDA(dst, b, h) do { _Pragma("unroll") for (int m = 0; m < 4; ++m) _Pragma("unroll") for (int k = 0; k < 2; ++k) dst[m][k] = *(const LAS bf16x8*)(lds + PG8_SA(b, h) + aoff + m * 2048 + k * 1024); } while (0)
#define PG8_LDB(dst, b, h) do { _Pragma("unroll") for (int n = 0; n < 2; ++n) _Pragma("unroll") for (int k = 0; k < 2; ++k) dst[n][k] = *(const LAS bf16x8*)(lds + PG8_SB(b, h) + boff + n * 2048 + k * 1024); } while (0)
#define PG8_MMA(ai, bj, At, Bt) do { __builtin_amdgcn_s_setprio(1); _Pragma("unroll") for (int m = 0; m < 4; ++m) _Pragma("unroll") for (int n = 0; n < 2; ++n) _Pragma("unroll") for (int k = 0; k < 2; ++k) \
        acc[ai][bj][m][n] = __builtin_amdgcn_mfma_f32_16x16x32_bf16(Bt[n][k], At[m][k], acc[ai][bj][m][n], 0, 0, 0); __builtin_amdgcn_s_setprio(0); } while (0)
#define PG8_WAIT_V(n) asm volatile("s_waitcnt vmcnt(" #n ")" ::: "memory")
#define PG8_WAIT_L(n) asm volatile("s_waitcnt lgkmcnt(" #n ")" ::: "memory")
#define PG8_BAR __builtin_amdgcn_s_barrier()
#define PG8_SCHED __builtin_amdgcn_sched_barrier(0)
    Unit cur, nxt; int ui = 0;
    if (!S.next(0, cur)) return;
    f32x4 acc[2][2][4][2];
#pragma unroll
    for (int a = 0; a < 2; ++a)
#pragma unroll
        for (int b = 0; b < 2; ++b)
#pragma unroll
            for (int m = 0; m < 4; ++m)
#pragma unroll
                for (int n = 0; n < 2; ++n) acc[a][b][m][n] = zero4();
    bf16x8 At[4][2], B0[2][2], B1[2][2];
    const char* cA = (const char*)g.A + (size_t)cur.pm * tstep; const char* cB = (const char*)g.Bt + (size_t)cur.pn * tstep;
    PG8_STAGE(PG8_SB(0, 0), cB, voffB); PG8_STAGE(PG8_SA(0, 0), cA, voffA); PG8_STAGE(PG8_SB(0, 1), cB + hstep, voffB); PG8_STAGE(PG8_SA(0, 1), cA + hstep, voffA);
    if (wr == 1) PG8_BAR;
    PG8_WAIT_V(4); PG8_BAR;
    PG8_STAGE(PG8_SB(1, 0), cB + kstep, voffB); PG8_STAGE(PG8_SA(1, 0), cA + kstep, voffA); PG8_STAGE(PG8_SB(1, 1), cB + hstep + kstep, voffB);
    PG8_WAIT_V(6); PG8_BAR;
    for (;;) {
        const bool has_next = S.next(ui + 1, nxt);
        const char* nA = has_next ? (const char*)g.A + (size_t)nxt.pm * tstep : cA; const char* nB = has_next ? (const char*)g.Bt + (size_t)nxt.pn * tstep : cB;
        for (int t = 0; t < nt; t += 2) {
            const bool last = (t == nt - 2);
            const char* a1 = cA + (size_t)(t + 1) * kstep;
            const char* a2 = last ? nA : cA + (size_t)(t + 2) * kstep; const char* b2 = last ? nB : cB + (size_t)(t + 2) * kstep;
            const char* a3 = a2 + kstep; const char* b3 = b2 + kstep;
            PG8_LDB(B0, 0, 0); PG8_SCHED; PG8_LDA(At, 0, 0); PG8_STAGE(PG8_SA(1, 1), a1 + hstep, voffA);
            PG8_WAIT_L(8); PG8_BAR; PG8_WAIT_L(0); PG8_MMA(0, 0, At, B0); PG8_BAR; PG8_SCHED;
            PG8_LDB(B1, 0, 1); PG8_STAGE(PG8_SB(0, 0), b2, voffB);
            PG8_BAR; PG8_WAIT_L(0); PG8_MMA(0, 1, At, B1); PG8_BAR;
            PG8_LDA(At, 0, 1); PG8_STAGE(PG8_SA(0, 0), a2, voffA);
            PG8_BAR; PG8_WAIT_L(0); PG8_MMA(1, 0, At, B0); PG8_BAR; PG8_SCHED;
            PG8_STAGE(PG8_SB(0, 1), b2 + hstep, voffB);
            PG8_WAIT_V(6); PG8_BAR; PG8_MMA(1, 1, At, B1); PG8_BAR;
            PG8_LDB(B0, 1, 0); PG8_SCHED; PG8_LDA(At, 1, 0); PG8_STAGE(PG8_SA(0, 1), a2 + hstep, voffA);
            PG8_WAIT_L(8); PG8_BAR; PG8_WAIT_L(0); PG8_MMA(0, 0, At, B0); PG8_BAR; PG8_SCHED;
            PG8_LDB(B1, 1, 1); PG8_STAGE(PG8_SB(1, 0), b3, voffB);
            PG8_BAR; PG8_WAIT_L(0); PG8_MMA(0, 1, At, B1); PG8_BAR;
            PG8_LDA(At, 1, 1); PG8_STAGE(PG8_SA(1, 0), a3, voffA);
            PG8_BAR; PG8_WAIT_L(0); PG8_MMA(1, 0, At, B0); PG8_BAR; PG8_SCHED;
            PG8_STAGE(PG8_SB(1, 1), b3 + hstep, voffB);
            PG8_WAIT_V(6); PG8_BAR; PG8_MMA(1, 1, At, B1); PG8_BAR;
        }
        E(acc, cur, wr, wc, fr, fq);
        S.done(cur, lane);
        if (!has_next) break;
#pragma unroll
        for (int a = 0; a < 2; ++a)
#pragma unroll
            for (int b = 0; b < 2; ++b)
#pragma unroll
                for (int m = 0; m < 4; ++m)
#pragma unroll
                    for (int n = 0; n < 2; ++n) acc[a][b][m][n] = zero4();
        cur = nxt; cA = nA; cB = nB; ++ui;
    }
    PG8_WAIT_V(0);
    if (wr == 0) PG8_BAR;
    PG8_BAR;
#undef PG8_SA
#undef PG8_SB
#undef PG8_STAGE
#undef PG8_LDA
#undef PG8_LDB
#undef PG8_MMA
#undef PG8_WAIT_V
#undef PG8_WAIT_L
#undef PG8_BAR
#undef PG8_SCHED
}
}

struct EpiIn {
    static constexpr bool PERM = true;
    bf16_t* U; float* G; const float* SS; const float* bmi; const float* bmf;
    __device__ __forceinline__ void operator()(const f32x4 (&acc)[2][2][4][2], const pg8::Unit& u, int wr, int wc, int fr, int fq) const {
        const int row0 = u.pm * 256 + wr * 64 + fr;
        const int pn = u.pn;
        const int mode = ((pn >= 4 && pn < 8) || (pn >= 24 && pn < 28)) ? 1 : ((pn >= 20 && pn < 24) ? 2 : 0);
        f32x4 cur[4];
        { const f32x4* sp = (const f32x4*)(SS + (size_t)row0 * 16); cur[0] = sp[0]; cur[1] = sp[1]; cur[2] = sp[2]; cur[3] = sp[3]; }
#pragma unroll
        for (int r = 0; r < 8; ++r) {
            const int ai = r >> 2, m = r & 3;
            const int row = row0 + ai * 128 + m * 16;
            f32x4 nxt[4];
            if (r < 7) {
                const f32x4* sp = (const f32x4*)(SS + (size_t)(row0 + ((r + 1) >> 2) * 128 + ((r + 1) & 3) * 16) * 16);
                nxt[0] = sp[0]; nxt[1] = sp[1]; nxt[2] = sp[2]; nxt[3] = sp[3];
            }
            const float ss = ((cur[0][0] + cur[0][1]) + (cur[0][2] + cur[0][3])) + ((cur[1][0] + cur[1][1]) + (cur[1][2] + cur[1][3])) + ((cur[2][0] + cur[2][1]) + (cur[2][2] + cur[2][3])) + ((cur[3][0] + cur[3][1]) + (cur[3][2] + cur[3][3]));
            const float rstd = rsqrtf(ss * (1.0f / 1024.0f) + EPSF);
            if (pn < 28) {
                bf16_t* rowp = U + (size_t)row * NU + pn * 256 + wc * 32 + 8 * fq;
#pragma unroll
                for (int bj = 0; bj < 2; ++bj) {
                    f32x4 v0 = acc[ai][bj][m][0] * rstd, v1 = acc[ai][bj][m][1] * rstd;
                    if (mode == 1) {
#pragma unroll
                        for (int j = 0; j < 4; ++j) { v0[j] = siluf_(v0[j]); v1[j] = siluf_(v1[j]); }
                    } else if (mode == 2) {
#pragma unroll
                        for (int j = 0; j < 4; ++j) { v0[j] = sigmoidf_(v0[j]); v1[j] = sigmoidf_(v1[j]); }
                    }
                    u32x4 w; w.x = cvt_pk_bf16(v0[0], v0[1]); w.y = cvt_pk_bf16(v0[2], v0[3]); w.z = cvt_pk_bf16(v1[0], v1[1]); w.w = cvt_pk_bf16(v1[2], v1[3]);
                    *(u32x4*)(rowp + bj * 128) = w;
                }
            } else if (wc == 0 && fq == 0) {
                const f32x4 v0 = acc[ai][0][m][0] * rstd, v1 = acc[ai][0][m][1] * rstd;
                f32x4 gi, gf;
#pragma unroll
                for (int j = 0; j < 4; ++j) { gi[j] = v0[j] + bmi[j]; const float x = v1[j] + bmf[j]; gf[j] = fminf(x, 0.f) - log1pf(__expf(-fabsf(x))); }
                *(f32x4*)(G + (size_t)row * 8) = gi; *(f32x4*)(G + (size_t)row * 8 + 4) = gf;
            }
            if (r < 7) { cur[0] = nxt[0]; cur[1] = nxt[1]; cur[2] = nxt[2]; cur[3] = nxt[3]; }
        }
    }
};

struct EpiOut {
    static constexpr bool PERM = false;
    const float* basep; const float* bases; int split;
    bf16_t* XBo; float* SSo;
    __device__ __forceinline__ void operator()(const f32x4 (&acc)[2][2][4][2], const pg8::Unit& u, int wr, int wc, int fr, int fq) const {
        const int row0 = u.pm * 256 + wr * 64 + fr, col0 = u.pn * 256 + wc * 32 + 4 * fq;
#pragma unroll
        for (int g2 = 0; g2 < 4; ++g2) {
            const int ai = g2 >> 1;
            f32x4 bs[2][2][2];
#pragma unroll
            for (int mm = 0; mm < 2; ++mm) {
                const int m = (g2 & 1) * 2 + mm;
                const int row = row0 + ai * 128 + m * 16;
                if (split) {
                    const float* bp = basep + (size_t)row * DM;
                    bool have = true;
                    if (row >= MV) have = false; else if (row >= MP) bp = bases + (size_t)(row - MP) * DM;
#pragma unroll
                    for (int bj = 0; bj < 2; ++bj)
#pragma unroll
                        for (int n = 0; n < 2; ++n) { bs[mm][bj][n] = zero4(); if (have) bs[mm][bj][n] = *(const f32x4*)(bp + col0 + bj * 128 + n * 16); }
                } else {
#pragma unroll
                    for (int bj = 0; bj < 2; ++bj)
#pragma unroll
                        for (int n = 0; n < 2; ++n) { const u32x2 v = *(const u32x2*)(XBo + (size_t)row * DM + col0 + bj * 128 + n * 16); bs[mm][bj][n] = (f32x4){lo16(v.x), hi16(v.x), lo16(v.y), hi16(v.y)}; }
                }
            }
#pragma unroll
            for (int mm = 0; mm < 2; ++mm) {
                const int m = (g2 & 1) * 2 + mm;
                const int row = row0 + ai * 128 + m * 16;
                float ss = 0.f;
#pragma unroll
                for (int bj = 0; bj < 2; ++bj)
#pragma unroll
                    for (int n = 0; n < 2; ++n) {
                        const int c = col0 + bj * 128 + n * 16;
                        const f32x4 o = bs[mm][bj][n] + acc[ai][bj][m][n];
                        u32x2 w; w.x = cvt_pk_bf16(o[0], o[1]); w.y = cvt_pk_bf16(o[2], o[3]); *(u32x2*)(XBo + (size_t)row * DM + c) = w;
                        ss += (o[0] * o[0] + o[1] * o[1]) + (o[2] * o[2] + o[3] * o[3]);
                    }
                ss += __shfl_xor(ss, 16); ss += __shfl_xor(ss, 32);
                if (fq == 0) SSo[(size_t)row * 16 + u.pn * 4 + wc] = ss;
            }
        }
    }
};

__device__ void transpose_tile(const float* src, int ldn, int nvalid, int k0, int n0, bf16_t* dst, int ldk, const float* sk, float sn, LAS float* T) {
    const int tid = otid();
    {
        const int r = tid >> 4, c4 = tid & 15;
#pragma unroll
        for (int i = 0; i < 2; ++i) {
            const int k = r + 32 * i; const int n = n0 + 4 * c4;
            f32x4 v = zero4();
            if (n + 3 < nvalid) v = *(const f32x4*)(src + (size_t)(k0 + k) * ldn + n);
            const float s = (sk ? sk[k0 + k] : 1.0f) * sn;
            T[k * 65 + 4 * c4 + 0] = v[0] * s; T[k * 65 + 4 * c4 + 1] = v[1] * s; T[k * 65 + 4 * c4 + 2] = v[2] * s; T[k * 65 + 4 * c4 + 3] = v[3] * s;
        }
    }
    __syncthreads();
    {
        const int n = tid >> 3, kq = tid & 7;
        float f[8];
#pragma unroll
        for (int j = 0; j < 8; ++j) f[j] = T[(kq * 8 + j) * 65 + n];
        u32x4 w; w.x = cvt_pk_bf16(f[0], f[1]); w.y = cvt_pk_bf16(f[2], f[3]); w.z = cvt_pk_bf16(f[4], f[5]); w.w = cvt_pk_bf16(f[6], f[7]);
        *(u32x4*)(dst + (size_t)(n0 + n) * ldk + k0 + kq * 8) = w;
    }
    __syncthreads();
}

__device__ void phase_prep(const Params& p, LAS unsigned char* lds) {
    LAS float* T = (LAS float*)lds;
    bf16_t* WT1 = (bf16_t*)(p.ws + WS_WT1); bf16_t* WT2 = (bf16_t*)(p.ws + WS_WT2); bf16_t* WGT = (bf16_t*)(p.ws + WS_WGT);
    bf16_t* XB = (bf16_t*)(p.ws + WS_XB); float* SS = (float*)(p.ws + WS_SS); bf16_t* MG = (bf16_t*)(p.ws + WS_MG);
    constexpr int JA = 2 * 16 * 116, JB = 2 * 32 * 16, JC = 64, JD = MR / 8;
    for (int job = blockIdx.x; job < JA + JB + JC + JD; job += gridDim.x) {
        if (job < JA) {
            const int l = job / (16 * 116), r = job % (16 * 116), ntile = r / 16, kt = r % 16;
            const int n0 = ntile * 64;
            const float sn = (n0 >= 3072 && n0 < 4096) ? 0.0625f : 1.0f;
            transpose_tile(p.w_in + (size_t)l * DM * DIN, DIN, DIN, kt * 64, n0, WT1 + (size_t)l * NW1 * DM, DM, p.g_norm + l * DM, sn, T);
        } else if (job < JA + JB) {
            const int j = job - JA, l = j / 512, r = j % 512, ntile = r / 32, kt = r % 32;
            transpose_tile(p.w_out + (size_t)l * DMG * DM, DM, DM, kt * 64, ntile * 64, WT2 + (size_t)l * DM * DMG, DMG, nullptr, 1.0f, T);
        } else if (job < JA + JB + JC) {
            const int j = job - JA - JB, l = j >> 5, gate = (j >> 4) & 1, blk = j & 15;
            const float* src = (gate ? p.w_i : p.w_r) + (size_t)(l * 16 + blk) * 4096;
            transpose_tile(src, 64, 64, 0, 0, WGT + (size_t)((l * 2 + gate) * 16 + blk) * 4096, 64, nullptr, 1.0f, T);
        } else {
            const int j = job - JA - JB - JC; const int tidp = otid(); const int wid = tidp >> 6, lane = tidp & 63;
            const int row = j * 8 + wid;
            const float* src = row < MP ? p.xp + (size_t)row * DM : (row < MV ? p.xs + (size_t)(row - MP) * DM : nullptr);
            f32x4 v[4]; float ss = 0.f;
#pragma unroll
            for (int i = 0; i < 4; ++i) { v[i] = src ? *(const f32x4*)(src + lane * 16 + i * 4) : zero4(); ss += (v[i][0] * v[i][0] + v[i][1] * v[i][1]) + (v[i][2] * v[i][2] + v[i][3] * v[i][3]); }
#pragma unroll
            for (int o = 32; o >= 1; o >>= 1) ss += __shfl_xor(ss, o);
            u32x4 w0, w1;
            w0.x = cvt_pk_bf16(v[0][0], v[0][1]); w0.y = cvt_pk_bf16(v[0][2], v[0][3]); w0.z = cvt_pk_bf16(v[1][0], v[1][1]); w0.w = cvt_pk_bf16(v[1][2], v[1][3]);
            w1.x = cvt_pk_bf16(v[2][0], v[2][1]); w1.y = cvt_pk_bf16(v[2][2], v[2][3]); w1.z = cvt_pk_bf16(v[3][0], v[3][1]); w1.w = cvt_pk_bf16(v[3][2], v[3][3]);
            *(u32x4*)(XB + (size_t)row * DM + lane * 16) = w0; *(u32x4*)(XB + (size_t)row * DM + lane * 16 + 8) = w1;
            if (lane < 16) SS[(size_t)row * 16 + lane] = lane == 0 ? ss : 0.f;
            if (row >= MV) { const u32x4 z = (u32x4){0u, 0u, 0u, 0u}; u32x4* mp = (u32x4*)(MG + (size_t)row * DMG + lane * 32); mp[0] = z; mp[1] = z; mp[2] = z; mp[3] = z; }
        }
    }
}

constexpr int M_QI = 0, M_KI = 38912, M_VI = 77824, M_CTI = 96256, M_SM = 130048;
constexpr int RS_QK = 304, RS_V = 144, RS_CT = 528;

template <int OFF0, int OFF1>
__device__ __forceinline__ bf16x8 tr_frag(unsigned base) {
    bf16x4 lo, hi;
    asm volatile("ds_read_b64_tr_b16 %0, %2 offset:%3\n\tds_read_b64_tr_b16 %1, %2 offset:%4\n\ts_waitcnt lgkmcnt(0)" : "=&v"(lo), "=&v"(hi) : "v"(base), "i"(OFF0), "i"(OFF1) : "memory");
    bf16x8 r; r[0] = lo[0]; r[1] = lo[1]; r[2] = lo[2]; r[3] = lo[3]; r[4] = hi[0]; r[5] = hi[1]; r[6] = hi[2]; r[7] = hi[3]; return r;
}

template <int O0, int O1, int HI>
__device__ __forceinline__ void tr_frag2(unsigned base, bf16x8& f0, bf16x8& f1) {
    bf16x4 a0, a1, b0, b1;
    asm volatile("ds_read_b64_tr_b16 %0, %4 offset:%5\n\tds_read_b64_tr_b16 %1, %4 offset:%6\n\tds_read_b64_tr_b16 %2, %4 offset:%7\n\tds_read_b64_tr_b16 %3, %4 offset:%8\n\ts_waitcnt lgkmcnt(0)"
                 : "=&v"(a0), "=&v"(a1), "=&v"(b0), "=&v"(b1) : "v"(base), "i"(O0), "i"(O0 + HI), "i"(O1), "i"(O1 + HI) : "memory");
    f0 = __builtin_shufflevector(a0, a1, 0, 1, 2, 3, 4, 5, 6, 7); f1 = __builtin_shufflevector(b0, b1, 0, 1, 2, 3, 4, 5, 6, 7);
}
template <int KS>
__device__ __forceinline__ void mlstm_D(f32x4 (&CT)[8], unsigned bvD, unsigned bkD) {
    const bf16x8 vdf = tr_frag<KS * 32 * RS_V, KS * 32 * RS_V + 4 * RS_V>(bvD);
    bf16x8 k0, k1;
    tr_frag2<KS * 32 * RS_QK + 0, KS * 32 * RS_QK + 32, 4 * RS_QK>(bkD, k0, k1);
    CT[0] = __builtin_amdgcn_mfma_f32_16x16x32_bf16(k0, vdf, CT[0], 0, 0, 0);
    CT[1] = __builtin_amdgcn_mfma_f32_16x16x32_bf16(k1, vdf, CT[1], 0, 0, 0);
    tr_frag2<KS * 32 * RS_QK + 64, KS * 32 * RS_QK + 96, 4 * RS_QK>(bkD, k0, k1);
    CT[2] = __builtin_amdgcn_mfma_f32_16x16x32_bf16(k0, vdf, CT[2], 0, 0, 0);
    CT[3] = __builtin_amdgcn_mfma_f32_16x16x32_bf16(k1, vdf, CT[3], 0, 0, 0);
    tr_frag2<KS * 32 * RS_QK + 128, KS * 32 * RS_QK + 160, 4 * RS_QK>(bkD, k0, k1);
    CT[4] = __builtin_amdgcn_mfma_f32_16x16x32_bf16(k0, vdf, CT[4], 0, 0, 0);
    CT[5] = __builtin_amdgcn_mfma_f32_16x16x32_bf16(k1, vdf, CT[5], 0, 0, 0);
    tr_frag2<KS * 32 * RS_QK + 192, KS * 32 * RS_QK + 224, 4 * RS_QK>(bkD, k0, k1);
    CT[6] = __builtin_amdgcn_mfma_f32_16x16x32_bf16(k0, vdf, CT[6], 0, 0, 0);
    CT[7] = __builtin_amdgcn_mfma_f32_16x16x32_bf16(k1, vdf, CT[7], 0, 0, 0);
}
template <int KS>
__device__ __forceinline__ void mlstm_B(f32x4 (&N1)[4], LAS unsigned char* lds, unsigned bvB, int t, int fq) {
    const bf16x8 pf = *(const LAS bf16x8*)(lds + M_QI + t * RS_QK + KS * 64 + fq * 16);
    bf16x8 v0, v1;
    tr_frag2<KS * 32 * RS_V + 0, KS * 32 * RS_V + 32, 4 * RS_V>(bvB, v0, v1);
    N1[0] = __builtin_amdgcn_mfma_f32_16x16x32_bf16(v0, pf, N1[0], 0, 0, 0);
    N1[1] = __builtin_amdgcn_mfma_f32_16x16x32_bf16(v1, pf, N1[1], 0, 0, 0);
    tr_frag2<KS * 32 * RS_V + 64, KS * 32 * RS_V + 96, 4 * RS_V>(bvB, v0, v1);
    N1[2] = __builtin_amdgcn_mfma_f32_16x16x32_bf16(v0, pf, N1[2], 0, 0, 0);
    N1[3] = __builtin_amdgcn_mfma_f32_16x16x32_bf16(v1, pf, N1[3], 0, 0, 0);
}

__device__ void mlstm_prompt(const Params& p, int l, int item, LAS unsigned char* lds) {
    const int tid0 = otid();
    const int js = item & 3, h = (item >> 2) & 3, b = item >> 4;
    const unsigned ldsb = (unsigned)(size_t)lds;
    LAS float* sm = (LAS float*)(lds + M_SM);
    LAS float* nbuf = sm + 512; LAS float* npart = sm + 1552;
    const bf16_t* U = (const bf16_t*)(p.ws + WS_U); const float* G = (const float*)(p.ws + WS_G);
    bf16_t* MG = (bf16_t*)(p.ws + WS_MG);
    const size_t grow_base = (size_t)b * 2048;
    const int qcol = 2048 + h * 256, kcol = 3072 + h * 256, vcol = 4096 + h * 256 + js * 64;

    __syncthreads();
    for (int i = tid0; i < RS_CT * 64 / 16; i += NT) *(LAS u32x4*)(lds + M_CTI + i * 16) = (u32x4){0u, 0u, 0u, 0u};
    nbuf[tid0] = 0.f;
    f32x4 CTacc[8];
#pragma unroll
    for (int i = 0; i < 8; ++i) CTacc[i] = zero4();
    float m_prev = 0.f;
    u32x4 qreg[4], kreg[4], vreg[2]; float igr[2] = {0.f, 0.f}, lfr[2] = {0.f, 0.f};

#define ML_LOAD_QK(row0_, hd_) do { _Pragma("unroll") for (int i_ = 0; i_ < 4; ++i_) { const int id_ = tid + NT * i_, r_ = id_ >> 4, cq_ = id_ & 15; \
        const bf16_t* rp_ = U + (grow_base + (row0_) + r_) * NU + (hd_) * 128 + cq_ * 8; qreg[i_] = *(const u32x4*)(rp_ + qcol); kreg[i_] = *(const u32x4*)(rp_ + kcol); } } while (0)
#define ML_STORE_QK() do { _Pragma("unroll") for (int i_ = 0; i_ < 4; ++i_) { const int id_ = tid + NT * i_, r_ = id_ >> 4, cq_ = id_ & 15; \
        *(LAS u32x4*)(lds + M_QI + r_ * RS_QK + cq_ * 16) = qreg[i_]; *(LAS u32x4*)(lds + M_KI + r_ * RS_QK + cq_ * 16) = kreg[i_]; } } while (0)
#define ML_LOAD_VG(row0_) do { _Pragma("unroll") for (int i_ = 0; i_ < 2; ++i_) { const int id_ = tid + NT * i_, s_ = id_ >> 3, cq_ = id_ & 7; \
        vreg[i_] = *(const u32x4*)(U + (grow_base + (row0_) + s_) * NU + vcol + cq_ * 8); } \
        if (w == 0) { const float* gp_ = G + (grow_base + (row0_) + 2 * lane) * 8 + h; igr[0] = gp_[0]; lfr[0] = gp_[4]; igr[1] = gp_[8]; lfr[1] = gp_[12]; } } while (0)

#define ML_PREPASS(buf_) do { if (w == 0) { LAS float* dec_ = sm + 128 * (buf_); LAS float* expnm_ = sm + 256 + 128 * (buf_); LAS float* scal_ = sm + 1024 + 8 * (buf_); \
            const float s2 = lfr[0] + lfr[1]; float incl = s2; \
            _Pragma("unroll") for (int o = 1; o < 64; o <<= 1) { const float t_ = __shfl_up(incl, o); if (lane >= o) incl += t_; } \
            const float b0 = incl - s2 + lfr[0], b1 = incl; \
            const float a0 = igr[0] - b0, a1 = igr[1] - b1; float im = fmaxf(a0, a1); \
            _Pragma("unroll") for (int o = 1; o < 64; o <<= 1) { const float t_ = __shfl_up(im, o); if (lane >= o) im = fmaxf(im, t_); } \
            float ex = __shfl_up(im, 1); if (lane == 0) ex = -INFINITY; \
            const float M0 = fmaxf(ex, a0), M1 = fmaxf(M0, a1); \
            const float mt1 = b1 + fmaxf(m_prev, M1); \
            const float bL = __shfl(b1, 63), mL = __shfl(mt1, 63); \
            expnm_[2 * lane] = __expf(bL - mL - b0); expnm_[2 * lane + 1] = __expf(bL - mL - b1); \
            dec_[2 * lane] = __expf(bL - b0 + igr[0] - mL); dec_[2 * lane + 1] = __expf(bL - b1 + igr[1] - mL); \
            if (lane == 0) { scal_[0] = __expf(bL + m_prev - mL); scal_[1] = mL; } \
            m_prev = mL; } } while (0)
    { const int tid = tid0, w = tid >> 6, lane = tid & 63; ML_LOAD_QK(0, 0); ML_LOAD_VG(0); ML_PREPASS(0); }
#pragma unroll 1
    for (int c = 0; c < 16; ++c) {
        int tid = tid0; asm volatile("" : "+v"(tid));
        const int w = __builtin_amdgcn_readfirstlane(tid >> 6), lane = tid & 63, fr = lane & 15, fq = lane >> 4;
        const int cD = w & 3, gD = w >> 2, qq = (lane & 15) >> 2, pp = lane & 3;
        const unsigned bvB = ldsb + M_VI + (8 * fq + qq) * RS_V + 8 * pp;
        const unsigned bvD = bvB + cD * 32;
        const int row0 = c * 128;
        LAS float* nC = nbuf + (c & 1) * 256; LAS float* nN = nbuf + ((c + 1) & 1) * 256;
        __syncthreads();
        ML_STORE_QK();
        LAS float* dec = sm + 128 * (c & 1); LAS float* expnm = sm + 256 + 128 * (c & 1); LAS float* scal = sm + 1024 + 8 * (c & 1);
        const float cs = scal[0];
#pragma unroll
        for (int i = 0; i < 2; ++i) {
            const int id = tid + NT * i, s = id >> 3, cq = id & 7; const float d = dec[s];
            u32x4 v = vreg[i], o;
            o.x = cvt_pk_bf16(lo16(v.x) * d, hi16(v.x) * d); o.y = cvt_pk_bf16(lo16(v.y) * d, hi16(v.y) * d);
            o.z = cvt_pk_bf16(lo16(v.z) * d, hi16(v.z) * d); o.w = cvt_pk_bf16(lo16(v.w) * d, hi16(v.w) * d);
            *(LAS u32x4*)(lds + M_VI + s * RS_V + cq * 16) = o;
        }
        if (tid < 256) nN[tid] = cs * nC[tid];
        ML_LOAD_QK(row0, 1);
        f32x4 Sacc[8], N2[4];
#pragma unroll
        for (int i = 0; i < 8; ++i) Sacc[i] = zero4();
#pragma unroll
        for (int i = 0; i < 4; ++i) N2[i] = zero4();
        float qnp = 0.f;
#pragma unroll 1
        for (int hd = 0; hd < 2; ++hd) {
            __syncthreads();
#pragma unroll
            for (int ks = 0; ks < 4; ++ks) {
                const bf16x8 qf = *(const LAS bf16x8*)(lds + M_QI + (16 * w + fr) * RS_QK + ks * 64 + fq * 16);
#pragma unroll
                for (int i = 0; i < 8; ++i) if (i <= w) {
                    const bf16x8 kf = *(const LAS bf16x8*)(lds + M_KI + (16 * i + fr) * RS_QK + ks * 64 + fq * 16);
                    Sacc[i] = __builtin_amdgcn_mfma_f32_16x16x32_bf16(kf, qf, Sacc[i], 0, 0, 0);
                }
#pragma unroll
                for (int c4 = 0; c4 < 4; ++c4) {
                    const bf16x8 ctf = *(const LAS bf16x8*)(lds + M_CTI + (16 * c4 + fr) * RS_CT + hd * 256 + ks * 64 + fq * 16);
                    N2[c4] = __builtin_amdgcn_mfma_f32_16x16x32_bf16(ctf, qf, N2[c4], 0, 0, 0);
                }
                const LAS float* np = nC + hd * 128 + ks * 32 + fq * 8;
#pragma unroll
                for (int j = 0; j < 8; ++j) qnp += bf2f((unsigned short)qf[j]) * np[j];
                __builtin_amdgcn_sched_barrier(0);
            }
            if (gD == hd) {
                const unsigned bkD = ldsb + M_KI + (8 * fq + qq) * RS_QK + 8 * pp;
#pragma unroll
                for (int i = 0; i < 8; ++i) CTacc[i] *= cs;
                mlstm_D<0>(CTacc, bvD, bkD); __builtin_amdgcn_sched_barrier(0); mlstm_D<1>(CTacc, bvD, bkD); __builtin_amdgcn_sched_barrier(0); mlstm_D<2>(CTacc, bvD, bkD); __builtin_amdgcn_sched_barrier(0); mlstm_D<3>(CTacc, bvD, bkD); __builtin_amdgcn_sched_barrier(0);
            }
            if (gD != hd) {
                const int lidx = (w & 3) * 64 + lane, dk4 = lidx & 31, part = lidx >> 5; float a0 = 0.f, a1 = 0.f, a2 = 0.f, a3 = 0.f;
#pragma unroll 2
                for (int s = 16 * part; s < 16 * part + 16; ++s) {
                    const u32x2 kv = *(const LAS u32x2*)(lds + M_KI + s * RS_QK + dk4 * 8); const float d = dec[s];
                    a0 += d * lo16(kv.x); a1 += d * hi16(kv.x); a2 += d * lo16(kv.y); a3 += d * hi16(kv.y);
                }
                *(LAS f32x4*)(npart + part * 128 + 4 * dk4) = (f32x4){a0, a1, a2, a3};
            }
            __syncthreads();
            if (tid < 128) nN[hd * 128 + tid] += ((npart[tid] + npart[128 + tid]) + (npart[256 + tid] + npart[384 + tid])) + ((npart[512 + tid] + npart[640 + tid]) + (npart[768 + tid] + npart[896 + tid]));
            if (gD == hd) {
#pragma unroll
                for (int i = 0; i < 8; ++i) {
                    u32x2 wv; wv.x = cvt_pk_bf16(CTacc[i][0], CTacc[i][1]); wv.y = cvt_pk_bf16(CTacc[i][2], CTacc[i][3]);
                    *(LAS u32x2*)(lds + M_CTI + (16 * cD + fr) * RS_CT + (hd * 128 + 16 * i + 4 * fq) * 2) = wv;
                }
            }
            if (hd == 0) {
                ML_STORE_QK();
                if (c < 15) { ML_LOAD_QK(row0 + 128, 0); }
            }
        }
        if (c < 15) { ML_LOAD_VG(row0 + 128); }
        const int t = 16 * w + fr;
        float den1 = 0.f;
#pragma unroll
        for (int i = 0; i < 8; ++i) if (i <= (w | 1)) {
            f32x4 sv = Sacc[i];
            const f32x4 dv = *(const LAS f32x4*)(dec + 16 * i + 4 * fq);
#pragma unroll
            for (int j = 0; j < 4; ++j) { const int s = 16 * i + 4 * fq + j; if (s > t || i > w) sv[j] = 0.f; den1 += sv[j] * dv[j]; }
            u32x2 wv; wv.x = cvt_pk_bf16(sv[0], sv[1]); wv.y = cvt_pk_bf16(sv[2], sv[3]);
            *(LAS u32x2*)(lds + M_QI + t * RS_QK + (16 * i + 4 * fq) * 2) = wv;
        }
        den1 += __shfl_xor(den1, 16); den1 += __shfl_xor(den1, 32);
        qnp += __shfl_xor(qnp, 16); qnp += __shfl_xor(qnp, 32);
#pragma unroll
        for (int i = 0; i < 4; ++i) N2[i] *= cs;
        if (0 <= (w >> 1)) mlstm_B<0>(N2, lds, bvB, t, fq);
        if (1 <= (w >> 1)) mlstm_B<1>(N2, lds, bvB, t, fq);
        if (2 <= (w >> 1)) mlstm_B<2>(N2, lds, bvB, t, fq);
        if (3 <= (w >> 1)) mlstm_B<3>(N2, lds, bvB, t, fq);
        {
            const float den = den1 + cs * qnp;
            const float inv = 1.0f / fmaxf(fabsf(den), expnm[t]);
            const size_t grow = grow_base + row0 + t;
#pragma unroll
            for (int c4 = 0; c4 < 4; ++c4) {
                const float y0 = N2[c4][0] * inv, y1 = N2[c4][1] * inv, y2 = N2[c4][2] * inv, y3 = N2[c4][3] * inv;
                u32x2 wv; wv.x = cvt_pk_bf16(y0, y1); wv.y = cvt_pk_bf16(y2, y3);
                *(u32x2*)(MG + grow * DMG + 1024 + h * 256 + js * 64 + 16 * c4 + 4 * fq) = wv;
            }
        }
        if (c < 15) ML_PREPASS((c + 1) & 1);
    }
    __syncthreads();
    {
        const int tid = tid0, w = tid >> 6, lane = tid & 63, fr = lane & 15, fq = lane >> 4, cD = w & 3, gD = w >> 2;
        float* pC = p.out + O_PC + ((size_t)((l * 8 + b) * 4 + h)) * 65536;
#pragma unroll
        for (int i = 0; i < 8; ++i)
#pragma unroll
            for (int j = 0; j < 4; ++j) pC[(size_t)(gD * 128 + 16 * i + 4 * fq + j) * 256 + js * 64 + 16 * cD + fr] = CTacc[i][j];
        if (js == 0) {
            if (tid < 256) p.out[O_PN + ((size_t)((l * 8 + b) * 4 + h)) * 256 + tid] = nbuf[tid];
            if (tid == 0) p.out[O_PM + (l * 8 + b) * 4 + h] = sm[1024 + 8 + 1];
        }
    }
    __syncthreads();
#undef ML_LOAD_QK
#undef ML_STORE_QK
#undef ML_LOAD_VG
#undef ML_PREPASS
}

constexpr int R_XAI = 0, R_XCF = 16768, R_XCB = 49536, R_AA = 67968, R_UU = 100736, R_PT = 133504, R_HC = 137600, R_CW = 138112, R_CH = 139392;
__device__ void rglru_item(const Params& p, int l, int b, int cb, bool decm, LAS unsigned char* lds) {
    const int tid = otid(), w = __builtin_amdgcn_readfirstlane(tid >> 6), lane = tid & 63, fr = lane & 15, fq = lane >> 4;
    const bf16_t* U = (const bf16_t*)(p.ws + WS_U); bf16_t* MG = (bf16_t*)(p.ws + WS_MG);
    const bf16_t* WGT = (const bf16_t*)(p.ws + WS_WGT);
    LAS float* XCF = (LAS float*)(lds + R_XCF); LAS float* AA = (LAS float*)(lds + R_AA); LAS float* UU = (LAS float*)(lds + R_UU);
    LAS float* PT = (LAS float*)(lds + R_PT); LAS float* HC = (LAS float*)(lds + R_HC); LAS float* CW = (LAS float*)(lds + R_CW); LAS float* CH = (LAS float*)(lds + R_CH);
    const int ch0 = cb * 64;
    const size_t grow_base = decm ? (size_t)MP : (size_t)b * 2048;
    const int nchunk = decm ? 1 : 16;
    __syncthreads();
    if (tid < 64) {
        const int ch = ch0 + tid;
#pragma unroll
        for (int j = 0; j < 4; ++j) CW[j * 64 + tid] = p.conv_w[(size_t)(l * 4 + j) * 1024 + ch];
        CW[256 + tid] = p.conv_b[l * 1024 + ch];
        CH[tid] = p.b_r[l * 1024 + ch]; CH[64 + tid] = p.b_i[l * 1024 + ch]; CH[128 + tid] = 8.0f * softplusf_(-p.lam[l * 1024 + ch]);
        HC[tid] = 0.f; HC[64 + tid] = 0.f;
    }
    if (tid < 24) *(LAS u32x4*)(lds + R_XAI + tid * 16) = (u32x4){0u, 0u, 0u, 0u};
    u32x4 xreg[2], zreg[2];
#pragma unroll
    for (int i = 0; i < 2; ++i) { const int id = tid + NT * i, r = id >> 3, cq = id & 7; const bf16_t* rp = U + (grow_base + r) * NU + ch0 + cq * 8; xreg[i] = *(const u32x4*)rp; zreg[i] = *(const u32x4*)(rp + 1024); }
    for (int c = 0; c < nchunk; ++c) {
        const int row0 = c * 128;
        __syncthreads();
        if (c > 0) {
#pragma unroll
            for (int i = 0; i < 2; ++i) { const int id = tid + NT * i, r = id >> 3, cq = id & 7; *(u32x4*)(MG + (grow_base + row0 - 128 + r) * DMG + ch0 + cq * 8) = *(const LAS u32x4*)(lds + R_XCF + r * 128 + cq * 16); }
        }
        u32x4 zcur[2];
#pragma unroll
        for (int i = 0; i < 2; ++i) { const int id = tid + NT * i, r = id >> 3, cq = id & 7; *(LAS u32x4*)(lds + R_XAI + (3 + r) * 128 + cq * 16) = xreg[i]; zcur[i] = zreg[i]; }
        if (c + 1 < nchunk) {
#pragma unroll
            for (int i = 0; i < 2; ++i) { const int id = tid + NT * i, r = id >> 3, cq = id & 7; const bf16_t* rp = U + (grow_base + row0 + 128 + r) * NU + ch0 + cq * 8; xreg[i] = *(const u32x4*)rp; zreg[i] = *(const u32x4*)(rp + 1024); }
        }
        __syncthreads();
        {
            const int t = tid >> 2, c0 = (tid & 3) * 16;
            float xc[16];
#pragma unroll
            for (int k = 0; k < 16; ++k) xc[k] = CW[256 + c0 + k];
            if (!decm) {
#pragma unroll
                for (int j = 0; j < 4; ++j) {
                    const u32x4 a = *(const LAS u32x4*)(lds + R_XAI + (t + j) * 128 + c0 * 2), bq = *(const LAS u32x4*)(lds + R_XAI + (t + j) * 128 + c0 * 2 + 16);
                    const unsigned wv[8] = {a.x, a.y, a.z, a.w, bq.x, bq.y, bq.z, bq.w};
#pragma unroll
                    for (int k = 0; k < 8; ++k) { xc[2 * k] += CW[j * 64 + c0 + 2 * k] * lo16(wv[k]); xc[2 * k + 1] += CW[j * 64 + c0 + 2 * k + 1] * hi16(wv[k]); }
                }
            } else {
                const float* stp = p.st_conv + ((size_t)(l * 128 + t) * 3) * 1024 + ch0 + c0;
                float* so = p.out + O_SCONV + ((size_t)(l * 128 + t) * 3) * 1024 + ch0 + c0;
#pragma unroll
                for (int j = 0; j < 3; ++j)
#pragma unroll
                    for (int k4 = 0; k4 < 4; ++k4) {
                        const f32x4 sv = *(const f32x4*)(stp + (size_t)j * 1024 + k4 * 4);
#pragma unroll
                        for (int e = 0; e < 4; ++e) xc[k4 * 4 + e] += CW[j * 64 + c0 + k4 * 4 + e] * sv[e];
                        if (j >= 1) *(f32x4*)(so + (size_t)(j - 1) * 1024 + k4 * 4) = sv;
                    }
                const u32x4 a = *(const LAS u32x4*)(lds + R_XAI + (t + 3) * 128 + c0 * 2), bq = *(const LAS u32x4*)(lds + R_XAI + (t + 3) * 128 + c0 * 2 + 16);
                const unsigned wv[8] = {a.x, a.y, a.z, a.w, bq.x, bq.y, bq.z, bq.w};
#pragma unroll
                for (int k = 0; k < 8; ++k) {
                    const float x0 = lo16(wv[k]), x1 = hi16(wv[k]);
                    xc[2 * k] += CW[3 * 64 + c0 + 2 * k] * x0; xc[2 * k + 1] += CW[3 * 64 + c0 + 2 * k + 1] * x1;
                    so[2 * 1024 + 2 * k] = x0; so[2 * 1024 + 2 * k + 1] = x1;
                }
            }
#pragma unroll
            for (int k4 = 0; k4 < 4; ++k4) *(LAS f32x4*)(XCF + t * 64 + c0 + k4 * 4) = (f32x4){xc[k4 * 4], xc[k4 * 4 + 1], xc[k4 * 4 + 2], xc[k4 * 4 + 3]};
            u32x4 o0, o1;
            o0.x = cvt_pk_bf16(xc[0], xc[1]); o0.y = cvt_pk_bf16(xc[2], xc[3]); o0.z = cvt_pk_bf16(xc[4], xc[5]); o0.w = cvt_pk_bf16(xc[6], xc[7]);
            o1.x = cvt_pk_bf16(xc[8], xc[9]); o1.y = cvt_pk_bf16(xc[10], xc[11]); o1.z = cvt_pk_bf16(xc[12], xc[13]); o1.w = cvt_pk_bf16(xc[14], xc[15]);
            *(LAS u32x4*)(lds + R_XCB + t * 144 + c0 * 2) = o0; *(LAS u32x4*)(lds + R_XCB + t * 144 + c0 * 2 + 16) = o1;
        }
        __syncthreads();
        if (!decm && tid < 24) { const u32x4 v = *(const LAS u32x4*)(lds + R_XAI + 128 * 128 + tid * 16); *(LAS u32x4*)(lds + R_XAI + tid * 16) = v; }
        {
            bf16x8 xf[2];
#pragma unroll
            for (int ks = 0; ks < 2; ++ks) xf[ks] = *(const LAS bf16x8*)(lds + R_XCB + (16 * w + fr) * 144 + ks * 64 + fq * 16);
            const int t = 16 * w + fr;
#pragma unroll
            for (int c4 = 0; c4 < 4; ++c4) {
                f32x4 ar = zero4(), ai = ar;
#pragma unroll
                for (int ks = 0; ks < 2; ++ks) {
                    const bf16x8 wfr = *(const bf16x8*)(WGT + (size_t)((l * 2 + 0) * 16 + cb) * 4096 + (16 * c4 + fr) * 64 + ks * 32 + fq * 8);
                    const bf16x8 wfi = *(const bf16x8*)(WGT + (size_t)((l * 2 + 1) * 16 + cb) * 4096 + (16 * c4 + fr) * 64 + ks * 32 + fq * 8);
                    ar = __builtin_amdgcn_mfma_f32_16x16x32_bf16(wfr, xf[ks], ar, 0, 0, 0); ai = __builtin_amdgcn_mfma_f32_16x16x32_bf16(wfi, xf[ks], ai, 0, 0, 0); }
                const int d = 16 * c4 + 4 * fq;
                const f32x4 xcv = *(const LAS f32x4*)(XCF + t * 64 + d);
                f32x4 av, uv;
#pragma unroll
                for (int j = 0; j < 4; ++j) {
                    const float r = sigmoidf_(ar[j] + CH[d + j]), ig = sigmoidf_(ai[j] + CH[64 + d + j]);
                    const float la = -r * CH[128 + d + j];
                    const float x2 = 2.0f * la;
                    const float ser = -x2 * (1.0f + x2 * (0.5f + x2 * (0.16666667f + x2 * (0.041666668f + x2 * (0.0083333338f + x2 * 0.0013888889f)))));
                    const float om = x2 > -0.3f ? ser : 1.0f - __expf(x2);
                    av[j] = __expf(la); uv[j] = __builtin_amdgcn_sqrtf(om) * (ig * xcv[j]);
                }
                if (!decm) { *(LAS f32x4*)(AA + t * 64 + d) = av; *(LAS f32x4*)(UU + t * 64 + d) = uv; }
                else {
                    const f32x4 h0 = *(const f32x4*)(p.st_h + (size_t)(l * 128 + t) * 1024 + ch0 + d);
                    const f32x4 hn = av * h0 + uv;
                    *(f32x4*)(p.out + O_SH + (size_t)(l * 128 + t) * 1024 + ch0 + d) = hn;
                    const u32x2 zv = *(const u32x2*)(U + (grow_base + t) * NU + 1024 + ch0 + d);
                    u32x2 wv; wv.x = cvt_pk_bf16(hn[0] * lo16(zv.x), hn[1] * hi16(zv.x)); wv.y = cvt_pk_bf16(hn[2] * lo16(zv.y), hn[3] * hi16(zv.y));
                    *(u32x2*)(MG + (grow_base + t) * DMG + ch0 + d) = wv;
                }
            }
        }
        if (decm) break;
        __syncthreads();
#pragma unroll
        for (int i = 0; i < 2; ++i) { const int id = tid + NT * i, r = id >> 3, cq = id & 7; *(LAS u32x4*)(lds + R_XCB + r * 144 + cq * 16) = zcur[i]; }
        const int ch = tid & 63, part = tid >> 6;
        {
            float hh = 0.f, Ac = 1.f;
#pragma unroll 4
            for (int k = 0; k < 16; ++k) { const int t = part * 16 + k; const float a = AA[t * 64 + ch], u = UU[t * 64 + ch]; hh = a * hh + u; Ac *= a; UU[t * 64 + ch] = hh; AA[t * 64 + ch] = Ac; }
            PT[(part * 64 + ch) * 2] = Ac; PT[(part * 64 + ch) * 2 + 1] = hh;
        }
        __syncthreads();
        {
            float hin = HC[(c & 1) * 64 + ch];
            for (int q = 0; q < part; ++q) hin = PT[(q * 64 + ch) * 2] * hin + PT[(q * 64 + ch) * 2 + 1];
            float hf = hin;
#pragma unroll 4
            for (int k = 0; k < 16; ++k) {
                const int t = part * 16 + k; hf = AA[t * 64 + ch] * hin + UU[t * 64 + ch];
                const float z = bf2f(*(const LAS unsigned short*)(lds + R_XCB + t * 144 + ch * 2));
                const float y = hf * z;
                *(LAS unsigned short*)(lds + R_XCF + t * 128 + ch * 2) = (unsigned short)(cvt_pk_bf16(y, y) & 0xffffu);
            }
            if (part == 7) {
                HC[((c + 1) & 1) * 64 + ch] = hf;
                if (c == 15) p.out[O_PH + (size_t)(l * 8 + b) * 1024 + ch0 + ch] = hf;
            }
        }
        if (c == 15 && tid < 192) {
            const int j = tid >> 6, cc = tid & 63;
            p.out[O_PCONV + ((size_t)(l * 8 + b) * 3 + j) * 1024 + ch0 + cc] = bf2f(*(const LAS unsigned short*)(lds + R_XAI + j * 128 + cc * 2));
        }
    }
    __syncthreads();
    if (!decm) {
#pragma unroll
        for (int i = 0; i < 2; ++i) { const int id = tid + NT * i, r = id >> 3, cq = id & 7; *(u32x4*)(MG + (grow_base + 15 * 128 + r) * DMG + ch0 + cq * 8) = *(const LAS u32x4*)(lds + R_XCF + r * 128 + cq * 16); }
    }
    __syncthreads();
}

__device__ void mlstm_decode(const Params& p, int l, int b, int h, LAS unsigned char* lds) {
    const int tid = otid(), lane = tid & 63;
    const bf16_t* U = (const bf16_t*)(p.ws + WS_U); const float* G = (const float*)(p.ws + WS_G);
    bf16_t* MG = (bf16_t*)(p.ws + WS_MG);
    LAS float* qs = (LAS float*)lds; LAS float* ks = qs + 256; LAS float* vs = qs + 512; LAS float* ns = qs + 768; LAS float* red = qs + 1024; LAS float* red2 = qs + 1024 + 2048;
    const size_t row = (size_t)MP + b;
    const size_t sidx = (size_t)((l * 128 + b) * 4 + h);
    __syncthreads();
    if (tid < 256) {
        qs[tid] = bf2f(U[row * NU + 2048 + h * 256 + tid]); ks[tid] = bf2f(U[row * NU + 3072 + h * 256 + tid]); vs[tid] = bf2f(U[row * NU + 4096 + h * 256 + tid]);
        ns[tid] = p.st_n[sidx * 256 + tid];
    }
    const float ig = G[row * 8 + h], lf = G[row * 8 + 4 + h], m0 = p.st_m[sidx];
    __syncthreads();
    float qk = 0.f, qn = 0.f;
#pragma unroll
    for (int j = 0; j < 4; ++j) { const float qv = qs[lane * 4 + j]; qk += qv * ks[lane * 4 + j]; qn += qv * ns[lane * 4 + j]; }
#pragma unroll
    for (int o = 32; o >= 1; o >>= 1) { qk += __shfl_xor(qk, o); qn += __shfl_xor(qn, o); }
    const float mt = fmaxf(lf + m0, ig), wg = __expf(ig - mt), gi = __expf(lf + m0 - mt);
    const int dvq = tid & 63, dkg = tid >> 6;
    float o_pre = 0.f, zg_pre = 0.f;
    if (tid < 256) { o_pre = bf2f(U[row * NU + 5120 + h * 256 + tid]); zg_pre = p.g_mhead[l * 1024 + h * 256 + tid] * bf2f(U[row * NU + 6144 + h * 256 + tid]); }
    const float* C0 = p.st_C + sidx * 65536; float* C1 = p.out + O_SC + sidx * 65536;
    const f32x4 v4 = *(const LAS f32x4*)(vs + dvq * 4);
    f32x4 qc = zero4();
#pragma unroll 16
    for (int i = 0; i < 32; ++i) {
        const int dk = dkg * 32 + i;
        const f32x4 c4 = __builtin_nontemporal_load((const f32x4*)(C0 + (size_t)dk * 256 + dvq * 4));
        const float qv = qs[dk], kv = wg * ks[dk];
        qc += qv * c4;
        const f32x4 cn = gi * c4 + kv * v4;
        __builtin_nontemporal_store(cn, (f32x4*)(C1 + (size_t)dk * 256 + dvq * 4));
    }
    *(LAS f32x4*)(red + dkg * 256 + dvq * 4) = qc;
    __syncthreads();
    float yv = 0.f;
    if (tid < 256) {
        float qcv = 0.f;
#pragma unroll
        for (int g = 0; g < 8; ++g) qcv += red[g * 256 + tid];
        const float num = wg * qk * vs[tid] + gi * qcv, den = wg * qk + gi * qn;
        const float hh = num / fmaxf(fabsf(den), __expf(-mt));
        yv = hh * o_pre;
        float ss = yv * yv;
#pragma unroll
        for (int o = 32; o >= 1; o >>= 1) ss += __shfl_xor(ss, o);
        if (lane == 0) red2[tid >> 6] = ss;
        p.out[O_SN + sidx * 256 + tid] = gi * ns[tid] + wg * ks[tid];
    }
    __syncthreads();
    if (tid < 256) {
        const float rstd = rsqrtf(((red2[0] + red2[1]) + (red2[2] + red2[3])) * (1.0f / 256.0f) + EPSF);
        const float ov = yv * rstd * zg_pre;
        MG[row * DMG + 1024 + h * 256 + tid] = (bf16_t)(cvt_pk_bf16(ov, ov) & 0xffffu);
    }
    if (tid == 0) p.out[O_SM + sidx] = mt;
}

__device__ void decode_items(const Params& p, int l, LAS unsigned char* lds, int max_items) {
    unsigned* ctr = (unsigned*)(p.ws + WS_BAR) + 3584 + 64 * l;
    volatile LAS unsigned* slot = (volatile LAS unsigned*)(lds + LDS_BYTES - 32);
    for (int n = 0; n < max_items; ++n) {
        __syncthreads();
        if (threadIdx.x == 0) *slot = __hip_atomic_fetch_add(ctr, 1u, __ATOMIC_RELAXED, __HIP_MEMORY_SCOPE_AGENT);
        __syncthreads();
        const int item = (int)*slot;
        if (item >= 512) break;
        mlstm_decode(p, l, item >> 2, item & 3, lds);
    }
}

__device__ void phase_mixers(const Params& p, int l, LAS unsigned char* lds) {
    const int G = gridDim.x, bid = obid();
    const bool split = G >= 256;
    const int r = split ? bid - 128 : bid, R = split ? G - 128 : G;
    if (!split || bid < 128) { for (int item = bid; item < 128; item += (split ? 128 : G)) mlstm_prompt(p, l, item, lds); }
    if (r >= 0) {
        for (int item = r; item < 128; item += R) rglru_item(p, l, item >> 4, item & 15, false, lds);
        for (int item = r; item < 16; item += R) rglru_item(p, l, 0, item, true, lds);
    }
    decode_items(p, l, lds, 1 << 30);
}

__device__ void phase_headnorm(const Params& p, int l) {
    const bf16_t* U = (const bf16_t*)(p.ws + WS_U); bf16_t* MG = (bf16_t*)(p.ws + WS_MG);
    const float* gm = p.g_mhead + l * 1024;
    const int G = gridDim.x, bid = obid();
    const int b0 = G > 8 ? bid - 4 : bid, GG = G > 8 ? G - 4 : G;
    if (b0 < 0) return;
    for (size_t idx = (size_t)b0 * NT + otid(); idx < (size_t)MP * 128; idx += (size_t)GG * NT) {
        const size_t row = idx >> 7; const int col = (int)(idx & 127) * 8;
        const u32x4 hv = *(const u32x4*)(MG + row * DMG + 1024 + col);
        const u32x4 ov = *(const u32x4*)(U + row * NU + 5120 + col);
        const u32x4 zv = *(const u32x4*)(U + row * NU + 6144 + col);
        float y[8];
        y[0] = lo16(hv.x) * lo16(ov.x); y[1] = hi16(hv.x) * hi16(ov.x); y[2] = lo16(hv.y) * lo16(ov.y); y[3] = hi16(hv.y) * hi16(ov.y);
        y[4] = lo16(hv.z) * lo16(ov.z); y[5] = hi16(hv.z) * hi16(ov.z); y[6] = lo16(hv.w) * lo16(ov.w); y[7] = hi16(hv.w) * hi16(ov.w);
        float ss = ((y[0] * y[0] + y[1] * y[1]) + (y[2] * y[2] + y[3] * y[3])) + ((y[4] * y[4] + y[5] * y[5]) + (y[6] * y[6] + y[7] * y[7]));
#pragma unroll
        for (int o = 1; o < 32; o <<= 1) ss += __shfl_xor(ss, o);
        const float rstd = rsqrtf(ss * (1.0f / 256.0f) + EPSF);
        const f32x4 g0 = *(const f32x4*)(gm + col), g1 = *(const f32x4*)(gm + col + 4);
        u32x4 o;
        o.x = cvt_pk_bf16(y[0] * rstd * g0[0] * lo16(zv.x), y[1] * rstd * g0[1] * hi16(zv.x));
        o.y = cvt_pk_bf16(y[2] * rstd * g0[2] * lo16(zv.y), y[3] * rstd * g0[3] * hi16(zv.y));
        o.z = cvt_pk_bf16(y[4] * rstd * g1[0] * lo16(zv.z), y[5] * rstd * g1[1] * hi16(zv.z));
        o.w = cvt_pk_bf16(y[6] * rstd * g1[2] * lo16(zv.w), y[7] * rstd * g1[3] * hi16(zv.w));
        *(u32x4*)(MG + row * DMG + 1024 + col) = o;
    }
}

__device__ void phase_final(const Params& p) {
    const bf16_t* XB = (const bf16_t*)(p.ws + WS_XB); const float* SS = (const float*)(p.ws + WS_SS);
    const int tidf = otid(); const int wid = tidf >> 6, lane = tidf & 63;
    for (int row = blockIdx.x * 8 + wid; row < MV; row += gridDim.x * 8) {
        const f32x4* sp = (const f32x4*)(SS + (size_t)row * 16);
        const f32x4 s0 = sp[0], s1 = sp[1], s2 = sp[2], s3 = sp[3];
        const float ss = ((s0[0] + s0[1]) + (s0[2] + s0[3])) + ((s1[0] + s1[1]) + (s1[2] + s1[3])) + ((s2[0] + s2[1]) + (s2[2] + s2[3])) + ((s3[0] + s3[1]) + (s3[2] + s3[3]));
        const float rstd = rsqrtf(ss * (1.0f / 1024.0f) + EPSF);
        float* op = row < MP ? p.out + O_YP + (size_t)row * DM : p.out + O_YS + (size_t)(row - MP) * DM;
#pragma unroll
        for (int i = 0; i < 2; ++i) {
            const int c = i * 512 + lane * 8;
            const u32x4 xv = *(const u32x4*)(XB + (size_t)row * DM + c);
            const f32x4 g0 = *(const f32x4*)(p.g_final + c), g1 = *(const f32x4*)(p.g_final + c + 4);
            *(f32x4*)(op + c) = (f32x4){lo16(xv.x) * rstd * g0[0], hi16(xv.x) * rstd * g0[1], lo16(xv.y) * rstd * g0[2], hi16(xv.y) * rstd * g0[3]};
            *(f32x4*)(op + c + 4) = (f32x4){lo16(xv.z) * rstd * g1[0], hi16(xv.z) * rstd * g1[1], lo16(xv.w) * rstd * g1[2], hi16(xv.w) * rstd * g1[3]};
        }
    }
}

#define XB_XCNT(j) (64 * (j))
#define XB_XSUB(j) (1024 + 64 * (j))
#define XB_XGEN(j) (2048 + 64 * (j))
#define XB_TOP 3072
#define XB_TOPGEN 3136
__device__ __forceinline__ unsigned xb_ld(unsigned* p) { return __hip_atomic_load(p, __ATOMIC_RELAXED, __HIP_MEMORY_SCOPE_AGENT); }
__device__ __forceinline__ unsigned xb_add(unsigned* p, unsigned v) { return __hip_atomic_fetch_add(p, v, __ATOMIC_RELAXED, __HIP_MEMORY_SCOPE_AGENT); }
__device__ __forceinline__ unsigned xb_xcc_id() { return (unsigned)__builtin_amdgcn_s_getreg((3 << 11) | 20) & 0xFu; }
#define XB_SPIN(cond) do { unsigned sp_ = 0; while (cond) { __builtin_amdgcn_s_sleep(1); if (++sp_ > (1u << 24)) break; } } while (0)
__device__ __forceinline__ void gbar(unsigned* bar, volatile LAS unsigned* st) {
    asm volatile("s_waitcnt vmcnt(0) lgkmcnt(0)" ::: "memory");
    __syncthreads();
    if (threadIdx.x == 0) {
        const unsigned x = xb_xcc_id(), nloc = st[0], nx = st[1];
        const unsigned old = xb_add(&bar[XB_XSUB(x)], 1u);
        const unsigned gen = old / nloc;
        if (old + 1u == (gen + 1u) * nloc) {
            __builtin_amdgcn_fence(__ATOMIC_RELEASE, "agent");
            asm volatile("s_waitcnt vmcnt(0)" ::: "memory");
            const unsigned og = xb_add(&bar[XB_TOP], 1u);
            const unsigned tg = og / nx;
            if (og + 1u == (tg + 1u) * nx) xb_add(&bar[XB_TOPGEN], 1u);
            else XB_SPIN(xb_ld(&bar[XB_TOPGEN]) == tg);
            __builtin_amdgcn_fence(__ATOMIC_ACQUIRE, "agent");
            xb_add(&bar[XB_XGEN(x)], 1u);
            asm volatile("s_waitcnt vmcnt(0)" ::: "memory");
        } else {
            XB_SPIN(xb_ld(&bar[XB_XGEN(x)]) == gen);
            __builtin_amdgcn_fence(__ATOMIC_ACQUIRE, "agent");
            asm volatile("s_waitcnt vmcnt(0)" ::: "memory");
        }
    }
    __syncthreads();
}

__global__ void __launch_bounds__(NT, 2) hymba_fwd(Params p) {
    extern __shared__ __attribute__((aligned(16))) unsigned char lds_raw[];
    LAS unsigned char* lds = (LAS unsigned char*)lds_raw;
    cg::grid_group grid = cg::this_grid();
    bf16_t* XB = (bf16_t*)(p.ws + WS_XB); bf16_t* U = (bf16_t*)(p.ws + WS_U); float* G = (float*)(p.ws + WS_G); bf16_t* MG = (bf16_t*)(p.ws + WS_MG);
    float* SS = (float*)(p.ws + WS_SS);
    unsigned* bar = (unsigned*)(p.ws + WS_BAR);
    volatile LAS unsigned* st = (volatile LAS unsigned*)(lds + LDS_BYTES - 16);
    if (threadIdx.x == 0) (void)xb_add(&bar[XB_XCNT(xb_xcc_id())], 1u);
    if (p.out == nullptr) grid.sync();
    phase_prep(p, lds);
    if (threadIdx.x == 0) {
        const unsigned x = xb_xcc_id(), Gn = gridDim.x; unsigned mine = 1u, cnt = 1u, sp = 0u;
        for (;;) {
            unsigned sum = 0u; cnt = 0u;
            for (unsigned j = 0; j < 16; ++j) { const unsigned c = xb_ld(&bar[XB_XCNT(j)]); sum += c; cnt += c > 0u ? 1u : 0u; if (j == x) mine = c; }
            if (sum == Gn || ++sp > (1u << 22)) break;
            __builtin_amdgcn_s_sleep(1);
        }
        st[0] = mine > 0u ? mine : 1u; st[1] = cnt > 0u ? cnt : 1u;
    }
    __syncthreads();
    gbar(bar, st);
    for (int l = 0; l < 2; ++l) {
        {
            pg8::Gemm g; g.A = XB; g.Bt = (const bf16_t*)(p.ws + WS_WT1) + (size_t)l * NW1 * DM; g.M = MR; g.N = NW1; g.K = DM;
            unsigned* dctr = bar + 3712 + 64 * l;
            pg8::InOrder so; so.G = gridDim.x; so.c = obid(); so.done_ctr = dctr;
            EpiIn e; e.U = U; e.G = G; e.SS = SS; e.bmi = p.b_mi + l * 4; e.bmf = p.b_mf + l * 4;
            pg8::gemm_phase<EpiIn, pg8::InOrder, DM>(lds, g, so, e);
            const int Gn = gridDim.x, maxu = (pg8::IN_UNITS + Gn - 1) / Gn, mine = (pg8::IN_UNITS - so.c + Gn - 1) / Gn;
            if (mine < maxu) {
                if (threadIdx.x == 0) {
                    unsigned sp = 0u;
                    while (__hip_atomic_load(dctr, __ATOMIC_RELAXED, __HIP_MEMORY_SCOPE_AGENT) < 8u * pg8::IN_DEC_UNITS) { __builtin_amdgcn_s_sleep(2); if (++sp > (1u << 24)) break; }
                    __builtin_amdgcn_fence(__ATOMIC_ACQUIRE, "agent");
                    asm volatile("s_waitcnt vmcnt(0)" ::: "memory");
                }
                __syncthreads();
                decode_items(p, l, lds, 1);
            }
        }
        gbar(bar, st);
        phase_mixers(p, l, lds);
        gbar(bar, st);
        for (int pass = 0; pass < 2; ++pass) {
            if (pass == 0) phase_headnorm(p, l);
            pg8::Gemm g; g.A = MG; g.Bt = (const bf16_t*)(p.ws + WS_WT2) + (size_t)l * DM * DMG; g.M = MR; g.N = DM; g.K = DMG;
            pg8::OutOrder so; so.G = gridDim.x; so.c = obid(); so.mode = pass;
            EpiOut e; e.basep = p.xp; e.bases = p.xs; e.split = l == 0 ? 1 : 0; e.XBo = XB; e.SSo = SS;
            pg8::gemm_phase<EpiOut, pg8::OutOrder, DMG>(lds, g, so, e);
            gbar(bar, st);
        }
    }
    phase_final(p);
}

extern "C" void kernel_launch(void* const* d_in, const int* in_sizes, int n_in, void* d_out, int out_size, void* d_ws, size_t ws_size, hipStream_t stream) {
    static int grid_blocks = 0;
    if (!grid_blocks) {
        int dev = 0, cus = 0, per_cu = 0;
        hipGetDevice(&dev);
        hipDeviceGetAttribute(&cus, hipDeviceAttributeMultiprocessorCount, dev);
        hipFuncSetAttribute((const void*)hymba_fwd, hipFuncAttributeMaxDynamicSharedMemorySize, LDS_BYTES);
        hipOccupancyMaxActiveBlocksPerMultiprocessor(&per_cu, (const void*)hymba_fwd, NT, LDS_BYTES);
        if (per_cu < 1) per_cu = 1;
        grid_blocks = cus * per_cu;
        (void)hipGetLastError();
    }
    if (ws_size < WS_END) { fprintf(stderr, "workspace too small: %zu < %zu\n", ws_size, (size_t)WS_END); return; }
    Params p{};
    p.xp = (const float*)d_in[0]; p.xs = (const float*)d_in[1]; p.st_h = (const float*)d_in[2]; p.st_conv = (const float*)d_in[3];
    p.st_C = (const float*)d_in[4]; p.st_n = (const float*)d_in[5]; p.st_m = (const float*)d_in[6]; p.g_norm = (const float*)d_in[7];
    p.w_in = (const float*)d_in[8]; p.conv_w = (const float*)d_in[9]; p.conv_b = (const float*)d_in[10]; p.w_r = (const float*)d_in[11];
    p.b_r = (const float*)d_in[12]; p.w_i = (const float*)d_in[13]; p.b_i = (const float*)d_in[14]; p.lam = (const float*)d_in[15];
    p.b_mi = (const float*)d_in[16]; p.b_mf = (const float*)d_in[17]; p.g_mhead = (const float*)d_in[18]; p.w_out = (const float*)d_in[19];
    p.g_final = (const float*)d_in[20];
    p.out = (float*)d_out; p.ws = (unsigned char*)d_ws;
    (void)hipMemsetAsync((unsigned char*)d_ws + WS_BAR, 0, 16384, stream);
    void* args[] = {&p};
    hipError_t e = hipLaunchCooperativeKernel((const void*)hymba_fwd, dim3(grid_blocks), dim3(NT), args, LDS_BYTES, stream);
    if (e != hipSuccess) fprintf(stderr, "cooperative launch failed: %s (grid %d)\n", hipGetErrorString(e), grid_blocks);
}
```

```cpp
#include <hip/hip_runtime.h>
#include <hip/hip_cooperative_groups.h>
#include <cstdio>
namespace cg = cooperative_groups;

#define LAS __attribute__((address_space(3)))
typedef unsigned short bf16_t;
typedef short bf16x8 __attribute__((ext_vector_type(8)));
typedef short bf16x4 __attribute__((ext_vector_type(4)));
typedef float f32x4 __attribute__((ext_vector_type(4)));
typedef unsigned u32x4 __attribute__((ext_vector_type(4)));
typedef unsigned u32x2 __attribute__((ext_vector_type(2)));

constexpr int NT = 512;
constexpr int LDS_BYTES = 147456;
constexpr int MP = 16384, MV = 16512, MR = 16640;
constexpr int DM = 1024, NU = 7168, NW1 = 7424, DIN = 7176, DMG = 2048;
constexpr float EPSF = 1e-6f;

constexpr size_t WS_XB = 0;
constexpr size_t WS_WT1 = WS_XB + (size_t)MR * DM * 2;
constexpr size_t WS_WT2 = WS_WT1 + (size_t)2 * NW1 * DM * 2;
constexpr size_t WS_WGT = WS_WT2 + (size_t)2 * DM * DMG * 2;
constexpr size_t WS_U = WS_WGT + (size_t)2 * 2 * 16 * 64 * 64 * 2;
constexpr size_t WS_G = WS_U + (size_t)MR * NU * 2;
constexpr size_t WS_MG = WS_G + (size_t)MR * 8 * 4;
constexpr size_t WS_X1 = WS_MG + (size_t)MR * DMG * 2;
constexpr size_t WS_X2 = WS_X1 + (size_t)MR * DM * 4;
constexpr size_t WS_SS = WS_X2 + (size_t)MR * DM * 4;
constexpr size_t WS_YSS = WS_SS + (size_t)MR * 16 * 4;
constexpr size_t WS_BAR = WS_YSS + (size_t)MR * 16 * 4;
constexpr size_t WS_END = WS_BAR + 16384;

struct Params {
    const float* xp; const float* xs; const float* st_h; const float* st_conv; const float* st_C; const float* st_n; const float* st_m;
    const float* g_norm; const float* w_in; const float* conv_w; const float* conv_b; const float* w_r; const float* b_r; const float* w_i; const float* b_i;
    const float* lam; const float* b_mi; const float* b_mf; const float* g_mhead; const float* w_out; const float* g_final;
    float* out; unsigned char* ws;
};

constexpr size_t O_YP = 0;
constexpr size_t O_YS = O_YP + (size_t)MP * DM;
constexpr size_t O_PH = O_YS + (size_t)128 * DM;
constexpr size_t O_PCONV = O_PH + 2 * 8 * 1024;
constexpr size_t O_PC = O_PCONV + 2 * 8 * 3 * 1024;
constexpr size_t O_PN = O_PC + (size_t)2 * 8 * 4 * 65536;
constexpr size_t O_PM = O_PN + 2 * 8 * 4 * 256;
constexpr size_t O_SH = O_PM + 2 * 8 * 4;
constexpr size_t O_SCONV = O_SH + 2 * 128 * 1024;
constexpr size_t O_SC = O_SCONV + 2 * 128 * 3 * 1024;
constexpr size_t O_SN = O_SC + (size_t)2 * 128 * 4 * 65536;
constexpr size_t O_SM = O_SN + 2 * 128 * 4 * 256;

__device__ __forceinline__ float bf2f(unsigned short v) { return __uint_as_float(((unsigned)v) << 16); }
__device__ __forceinline__ unsigned cvt_pk_bf16(float lo, float hi) { unsigned r; asm volatile("v_cvt_pk_bf16_f32 %0, %1, %2" : "=v"(r) : "v"(lo), "v"(hi)); return r; }
__device__ __forceinline__ float sigmoidf_(float x) { return __builtin_amdgcn_rcpf(1.0f + __builtin_amdgcn_exp2f(-1.44269504f * x)); }
__device__ __forceinline__ float siluf_(float x) { return x * __builtin_amdgcn_rcpf(1.0f + __builtin_amdgcn_exp2f(-1.44269504f * x)); }
__device__ __forceinline__ float softplusf_(float x) { return fmaxf(x, 0.f) + log1pf(__expf(-fabsf(x))); }
__device__ __forceinline__ int otid() { int t = threadIdx.x; asm volatile("" : "+v"(t)); return t; }
__device__ __forceinline__ int obid() { int t = blockIdx.x; asm volatile("" : "+s"(t)); return t; }
__device__ __forceinline__ f32x4 zero4() { float z = 0.f; asm volatile("" : "+v"(z)); return (f32x4){z, z, z, z}; }
__device__ __forceinline__ float lo16(unsigned w) { return __uint_as_float(w << 16); }
__device__ __forceinline__ float hi16(unsigned w) { return __uint_as_float(w & 0xffff0000u); }

namespace pg8 {
constexpr int BM = 256, BK = 64, HALF = 128, HTB = HALF * BK * 2, STAGE_BYTES = 8 * HTB, NXCD = 8, WGM = 2;
__host__ __device__ __forceinline__ int lds_byte(int r, int c) { const int st = (r >> 4) * 2 + (c >> 5), rr = r & 15, cc = c & 31, ob = rr * 64 + cc * 2; return st * 1024 + (ob ^ (((ob >> 9) & 1) << 5)); }
__host__ __device__ __forceinline__ void stage_rc(int b, int& R, int& C) { const int st = b / 1024, sb = b % 1024, swz = sb ^ (((sb >> 9) & 1) << 5); R = (st >> 1) * 16 + swz / 64; C = (st & 1) * 32 + (swz % 64) / 2; }
__host__ __device__ __forceinline__ int perm32(int rho) { const int n = rho >> 4, i = rho & 15; return 8 * (i >> 2) + 4 * n + (i & 3); }
struct Unit { int pm, pn; };
struct Gemm { const bf16_t* A; const bf16_t* Bt; int M, N, K; };
template <int NM_, int NN_>
struct StaticOrder {
    static constexpr int nM = NM_, nN = NN_, nwg = NM_ * NN_;
    int G, c;
    __device__ void init(int G_, int c_) { G = G_; c = c_; }
    __device__ static void map(int L, Unit& u) {
        int wgid = L; { constexpr int q = nwg / NXCD, r = nwg % NXCD; const int xcd = wgid % NXCD, off = wgid / NXCD; wgid = (xcd < r ? xcd * (q + 1) : r * (q + 1) + (xcd - r) * q) + off; }
        constexpr int nig = WGM * nN; const int gid = wgid / nig, fm = gid * WGM, gsz = (nM - fm) < WGM ? (nM - fm) : WGM;
        u.pm = fm + ((wgid % nig) % gsz); u.pn = (wgid % nig) / gsz;
    }
    __device__ bool next(int i, Unit& u) const { const int L = i * G + c; if (L >= nwg) return false; map(L, u); return true; }
    __device__ __forceinline__ void done(const Unit&, int) const {}
};

struct OutOrder {
    int G, c, mode;
    __device__ bool next(int i, Unit& u) const {
        const int L = i * G + c;
        if (mode == 0) { if (L >= 4) return false; u.pm = 64; u.pn = L; return true; }
        if (L >= 256) return false; StaticOrder<64, 4>::map(L, u); return true;
    }
    __device__ __forceinline__ void done(const Unit&, int) const {}
};

constexpr int IN_UNITS = 65 * 29, IN_DEC_UNITS = 29;
struct InOrder {
    int G, c; unsigned* done_ctr;
    __device__ bool next(int i, Unit& u) const {
        const int L = i * G + c; if (L >= IN_UNITS) return false;
        if (L < IN_DEC_UNITS) { u.pm = 64; u.pn = L; return true; }
        StaticOrder<64, 29>::map(L - IN_DEC_UNITS, u); return true;
    }
    __device__ __forceinline__ void done(const Unit& u, int lane) const {
        if (u.pm == 64) {
            asm volatile("s_waitcnt vmcnt(0)" ::: "memory");
            __builtin_amdgcn_fence(__ATOMIC_RELEASE, "agent");
            asm volatile("s_waitcnt vmcnt(0)" ::: "memory");
            if (lane == 0) __hip_atomic_fetch_add(done_ctr, 1u, __ATOMIC_RELAXED, __HIP_MEMORY_SCOPE_AGENT);
        }
    }
};

template <class Epi, class Sched, int KK>
__device__ __forceinline__ void gemm_phase(LAS unsigned char* lds, const Gemm g, const Sched& S, const Epi& E) {
    const int tid = otid(), wid = __builtin_amdgcn_readfirstlane(tid >> 6), lane = tid & 63, wr = wid >> 2, wc = wid & 3, fr = lane & 15, fq = lane >> 4;
    constexpr int K = KK, nt = K / BK;
    unsigned voffA[2], voffB[2];
#pragma unroll
    for (int i = 0; i < 2; ++i) { int R, C; stage_rc(tid * 16 + i * 8192, R, C); const int Rb = Epi::PERM ? ((R & ~31) + perm32(R & 31)) : R;
        voffA[i] = (unsigned)(R * K + C) * 2u; voffB[i] = (unsigned)(Rb * K + C) * 2u; }
    const size_t kstep = (size_t)(BK * 2);
    const size_t hstep = (size_t)HALF * K * 2;
    const size_t tstep = 2 * hstep;
    const unsigned ldsw = (unsigned)wid * 1024u;
    const int aoff = lds_byte(wr * 64 + fr, fq * 8), boff = lds_byte(wc * 32 + fr, fq * 8);
#define PG8_SA(b, h) (((b) * 2 + (h)) * HTB)
#define PG8_SB(b, h) ((4 + (b) * 2 + (h)) * HTB)
#define PG8_STAGE(bufoff, gbase, voff) do { _Pragma("unroll") for (int _i = 0; _i < 2; ++_i) \
        __builtin_amdgcn_global_load_lds((const unsigned*)((const char*)(gbase) + (voff)[_i]), (LAS unsigned*)(lds + (bufoff) + ldsw + _i * 8192), 16, 0, 0); } while (0)
#define PG8_LDA(dst, b, h) do { _Pragma("unroll") for (int m = 0; m < 4; ++m) _Pragma("unroll") for (int k = 0; k < 2; ++k) dst[m][k] = *(const LAS bf16x8*)(lds + PG8_SA(b, h) + aoff + m * 2048 + k * 1024); } while (0)
#define PG8_LDB(dst, b, h) do { _Pragma("unroll") for (int n = 0; n < 2; ++n) _Pragma("unroll") for (int k = 0; k < 2; ++k) dst[n][k] = *(const LAS bf16x8*)(lds + PG8_SB(b, h) + boff + n * 2048 + k * 1024); } while (0)
#define PG8_MMA(ai, bj, At, Bt) do { __builtin_amdgcn_s_setprio(1); _Pragma("unroll") for (int m = 0; m < 4; ++m) _Pragma("unroll") for (int n = 0; n < 2; ++n) _Pragma("unroll") for (int k = 0; k < 2; ++k) \
        acc[ai][bj][m][n] = __builtin_amdgcn_mfma_f32_16x16x32_bf16(Bt[n][k], At[m][k], acc[ai][bj][m][n], 0, 0, 0); __builtin_amdgcn_s_setprio(0); } while (0)
#define PG8_WAIT_V(n) asm volatile("s_waitcnt vmcnt(" #n ")" ::: "memory")
#define PG8_WAIT_L(n) asm volatile("s_waitcnt lgkmcnt(" #n ")" ::: "memory")
#define PG8_BAR __builtin_amdgcn_s_barrier()
#define PG8_SCHED __builtin_amdgcn_sched_barrier(0)
    Unit cur, nxt; int ui = 0;
    if (!S.next(0, cur)) return;
    f32x4 acc[2][2][4][2];
#pragma unroll
    for (int a = 0; a < 2; ++a)
#pragma unroll
        for (int b = 0; b < 2; ++b)
#pragma unroll
            for (int m = 0; m < 4; ++m)
#pragma unroll
                for (int n = 0; n < 2; ++n) acc[a][b][m][n] = zero4();
    bf16x8 At[4][2], B0[2][2], B1[2][2];
    const char* cA = (const char*)g.A + (size_t)cur.pm * tstep; const char* cB = (const char*)g.Bt + (size_t)cur.pn * tstep;
    PG8_STAGE(PG8_SB(0, 0), cB, voffB); PG8_STAGE(PG8_SA(0, 0), cA, voffA); PG8_STAGE(PG8_SB(0, 1), cB + hstep, voffB); PG8_STAGE(PG8_SA(0, 1), cA + hstep, voffA);
    if (wr == 1) PG8_BAR;
    PG8_WAIT_V(4); PG8_BAR;
    PG8_STAGE(PG8_SB(1, 0), cB + kstep, voffB); PG8_STAGE(PG8_SA(1, 0), cA + kstep, voffA); PG8_STAGE(PG8_SB(1, 1), cB + hstep + kstep, voffB);
    PG8_WAIT_V(6); PG8_BAR;
    for (;;) {
        const bool has_next = S.next(ui + 1, nxt);
        const char* nA = has_next ? (const char*)g.A + (size_t)nxt.pm * tstep : cA; const char* nB = has_next ? (const char*)g.Bt + (size_t)nxt.pn * tstep : cB;
        for (int t = 0; t < nt; t += 2) {
            const bool last = (t == nt - 2);
            const char* a1 = cA + (size_t)(t + 1) * kstep;
            const char* a2 = last ? nA : cA + (size_t)(t + 2) * kstep; const char* b2 = last ? nB : cB + (size_t)(t + 2) * kstep;
            const char* a3 = a2 + kstep; const char* b3 = b2 + kstep;
            PG8_LDB(B0, 0, 0); PG8_SCHED; PG8_LDA(At, 0, 0); PG8_STAGE(PG8_SA(1, 1), a1 + hstep, voffA);
            PG8_WAIT_L(8); PG8_BAR; PG8_WAIT_L(0); PG8_MMA(0, 0, At, B0); PG8_BAR; PG8_SCHED;
            PG8_LDB(B1, 0, 1); PG8_STAGE(PG8_SB(0, 0), b2, voffB);
            PG8_BAR; PG8_WAIT_L(0); PG8_MMA(0, 1, At, B1); PG8_BAR;
            PG8_LDA(At, 0, 1); PG8_STAGE(PG8_SA(0, 0), a2, voffA);
            PG8_BAR; PG8_WAIT_L(0); PG8_MMA(1, 0, At, B0); PG8_BAR; PG8_SCHED;
            PG8_STAGE(PG8_SB(0, 1), b2 + hstep, voffB);
            PG8_WAIT_V(6); PG8_BAR; PG8_MMA(1, 1, At, B1); PG8_BAR;
            PG8_LDB(B0, 1, 0); PG8_SCHED; PG8_LDA(At, 1, 0); PG8_STAGE(PG8_SA(0, 1), a2 + hstep, voffA);
            PG8_WAIT_L(8); PG8_BAR; PG8_WAIT_L(0); PG8_MMA(0, 0, At, B0); PG8_BAR; PG8_SCHED;
            PG8_LDB(B1, 1, 1); PG8_STAGE(PG8_SB(1, 0), b3, voffB);
            PG8_BAR; PG8_WAIT_L(0); PG8_MMA(0, 1, At, B1); PG8_BAR;
            PG8_LDA(At, 1, 1); PG8_STAGE(PG8_SA(1, 0), a3, voffA);
            PG8_BAR; PG8_WAIT_L(0); PG8_MMA(1, 0, At, B0); PG8_BAR; PG8_SCHED;
            PG8_STAGE(PG8_SB(1, 1), b3 + hstep, voffB);
            PG8_WAIT_V(6); PG8_BAR; PG8_MMA(1, 1, At, B1); PG8_BAR;
        }
        E(acc, cur, wr, wc, fr, fq);
        S.done(cur, lane);
        if (!has_next) break;
#pragma unroll
        for (int a = 0; a < 2; ++a)
#pragma unroll
            for (int b = 0; b < 2; ++b)
#pragma unroll
                for (int m = 0; m < 4; ++m)
#pragma unroll
                    for (int n = 0; n < 2; ++n) acc[a][b][m][n] = zero4();
        cur = nxt; cA = nA; cB = nB; ++ui;
    }
    PG8_WAIT_V(0);
    if (wr == 0) PG8_BAR;
    PG8_BAR;
#undef PG8_SA
#undef PG8_SB
#undef PG8_STAGE
#undef PG8_LDA
#undef PG8_LDB
#undef PG8_MMA
#undef PG8_WAIT_V
#undef PG8_WAIT_L
#undef PG8_BAR
#undef PG8_SCHED
}
}

struct EpiIn {
    static constexpr bool PERM = true;
    bf16_t* U; float* G; const float* SS; const float* bmi; const float* bmf;
    __device__ __forceinline__ void operator()(const f32x4 (&acc)[2][2][4][2], const pg8::Unit& u, int wr, int wc, int fr, int fq) const {
        const int row0 = u.pm * 256 + wr * 64 + fr;
        const int pn = u.pn;
        const int mode = ((pn >= 4 && pn < 8) || (pn >= 24 && pn < 28)) ? 1 : ((pn >= 20 && pn < 24) ? 2 : 0);
        f32x4 cur[4];
        { const f32x4* sp = (const f32x4*)(SS + (size_t)row0 * 16); cur[0] = sp[0]; cur[1] = sp[1]; cur[2] = sp[2]; cur[3] = sp[3]; }
#pragma unroll
        for (int r = 0; r < 8; ++r) {
            const int ai = r >> 2, m = r & 3;
            const int row = row0 + ai * 128 + m * 16;
            f32x4 nxt[4];
            if (r < 7) {
                const f32x4* sp = (const f32x4*)(SS + (size_t)(row0 + ((r + 1) >> 2) * 128 + ((r + 1) & 3) * 16) * 16);
                nxt[0] = sp[0]; nxt[1] = sp[1]; nxt[2] = sp[2]; nxt[3] = sp[3];
            }
            const float ss = ((cur[0][0] + cur[0][1]) + (cur[0][2] + cur[0][3])) + ((cur[1][0] + cur[1][1]) + (cur[1][2] + cur[1][3])) + ((cur[2][0] + cur[2][1]) + (cur[2][2] + cur[2][3])) + ((cur[3][0] + cur[3][1]) + (cur[3][2] + cur[3][3]));
            const float rstd = rsqrtf(ss * (1.0f / 1024.0f) + EPSF);
            if (pn < 28) {
                bf16_t* rowp = U + (size_t)row * NU + pn * 256 + wc * 32 + 8 * fq;
#pragma unroll
                for (int bj = 0; bj < 2; ++bj) {
                    f32x4 v0 = acc[ai][bj][m][0] * rstd, v1 = acc[ai][bj][m][1] * rstd;
                    if (mode == 1) {
#pragma unroll
                        for (int j = 0; j < 4; ++j) { v0[j] = siluf_(v0[j]); v1[j] = siluf_(v1[j]); }
                    } else if (mode == 2) {
#pragma unroll
                        for (int j = 0; j < 4; ++j) { v0[j] = sigmoidf_(v0[j]); v1[j] = sigmoidf_(v1[j]); }
                    }
                    u32x4 w; w.x = cvt_pk_bf16(v0[0], v0[1]); w.y = cvt_pk_bf16(v0[2], v0[3]); w.z = cvt_pk_bf16(v1[0], v1[1]); w.w = cvt_pk_bf16(v1[2], v1[3]);
                    *(u32x4*)(rowp + bj * 128) = w;
                }
            } else if (wc == 0 && fq == 0) {
                const f32x4 v0 = acc[ai][0][m][0] * rstd, v1 = acc[ai][0][m][1] * rstd;
                f32x4 gi, gf;
#pragma unroll
                for (int j = 0; j < 4; ++j) { gi[j] = v0[j] + bmi[j]; const float x = v1[j] + bmf[j]; gf[j] = fminf(x, 0.f) - log1pf(__expf(-fabsf(x))); }
                *(f32x4*)(G + (size_t)row * 8) = gi; *(f32x4*)(G + (size_t)row * 8 + 4) = gf;
            }
            if (r < 7) { cur[0] = nxt[0]; cur[1] = nxt[1]; cur[2] = nxt[2]; cur[3] = nxt[3]; }
        }
    }
};

struct EpiOut {
    static constexpr bool PERM = false;
    const float* basep; const float* bases; int split;
    bf16_t* XBo; float* SSo;
    __device__ __forceinline__ void operator()(const f32x4 (&acc)[2][2][4][2], const pg8::Unit& u, int wr, int wc, int fr, int fq) const {
        const int row0 = u.pm * 256 + wr * 64 + fr, col0 = u.pn * 256 + wc * 32 + 4 * fq;
#pragma unroll
        for (int g2 = 0; g2 < 4; ++g2) {
            const int ai = g2 >> 1;
            f32x4 bs[2][2][2];
#pragma unroll
            for (int mm = 0; mm < 2; ++mm) {
                const int m = (g2 & 1) * 2 + mm;
                const int row = row0 + ai * 128 + m * 16;
                if (split) {
                    const float* bp = basep + (size_t)row * DM;
                    bool have = true;
                    if (row >= MV) have = false; else if (row >= MP) bp = bases + (size_t)(row - MP) * DM;
#pragma unroll
                    for (int bj = 0; bj < 2; ++bj)
#pragma unroll
                        for (int n = 0; n < 2; ++n) { bs[mm][bj][n] = zero4(); if (have) bs[mm][bj][n] = *(const f32x4*)(bp + col0 + bj * 128 + n * 16); }
                } else {
#pragma unroll
                    for (int bj = 0; bj < 2; ++bj)
#pragma unroll
                        for (int n = 0; n < 2; ++n) { const u32x2 v = *(const u32x2*)(XBo + (size_t)row * DM + col0 + bj * 128 + n * 16); bs[mm][bj][n] = (f32x4){lo16(v.x), hi16(v.x), lo16(v.y), hi16(v.y)}; }
                }
            }
#pragma unroll
            for (int mm = 0; mm < 2; ++mm) {
                const int m = (g2 & 1) * 2 + mm;
                const int row = row0 + ai * 128 + m * 16;
                float ss = 0.f;
#pragma unroll
                for (int bj = 0; bj < 2; ++bj)
#pragma unroll
                    for (int n = 0; n < 2; ++n) {
                        const int c = col0 + bj * 128 + n * 16;
                        const f32x4 o = bs[mm][bj][n] + acc[ai][bj][m][n];
                        u32x2 w; w.x = cvt_pk_bf16(o[0], o[1]); w.y = cvt_pk_bf16(o[2], o[3]); *(u32x2*)(XBo + (size_t)row * DM + c) = w;
                        ss += (o[0] * o[0] + o[1] * o[1]) + (o[2] * o[2] + o[3] * o[3]);
                    }
                ss += __shfl_xor(ss, 16); ss += __shfl_xor(ss, 32);
                if (fq == 0) SSo[(size_t)row * 16 + u.pn * 4 + wc] = ss;
            }
        }
    }
};

__device__ void transpose_tile(const float* src, int ldn, int nvalid, int k0, int n0, bf16_t* dst, int ldk, const float* sk, float sn, LAS float* T) {
    const int tid = otid();
    {
        const int r = tid >> 4, c4 = tid & 15;
#pragma unroll
        for (int i = 0; i < 2; ++i) {
            const int k = r + 32 * i; const int n = n0 + 4 * c4;
            f32x4 v = zero4();
            if (n + 3 < nvalid) v = *(const f32x4*)(src + (size_t)(k0 + k) * ldn + n);
            const float s = (sk ? sk[k0 + k] : 1.0f) * sn;
            T[k * 65 + 4 * c4 + 0] = v[0] * s; T[k * 65 + 4 * c4 + 1] = v[1] * s; T[k * 65 + 4 * c4 + 2] = v[2] * s; T[k * 65 + 4 * c4 + 3] = v[3] * s;
        }
    }
    __syncthreads();
    {
        const int n = tid >> 3, kq = tid & 7;
        float f[8];
#pragma unroll
        for (int j = 0; j < 8; ++j) f[j] = T[(kq * 8 + j) * 65 + n];
        u32x4 w; w.x = cvt_pk_bf16(f[0], f[1]); w.y = cvt_pk_bf16(f[2], f[3]); w.z = cvt_pk_bf16(f[4], f[5]); w.w = cvt_pk_bf16(f[6], f[7]);
        *(u32x4*)(dst + (size_t)(n0 + n) * ldk + k0 + kq * 8) = w;
    }
    __syncthreads();
}

__device__ void phase_prep(const Params& p, LAS unsigned char* lds) {
    LAS float* T = (LAS float*)lds;
    bf16_t* WT1 = (bf16_t*)(p.ws + WS_WT1); bf16_t* WT2 = (bf16_t*)(p.ws + WS_WT2); bf16_t* WGT = (bf16_t*)(p.ws + WS_WGT);
    bf16_t* XB = (bf16_t*)(p.ws + WS_XB); float* SS = (float*)(p.ws + WS_SS); bf16_t* MG = (bf16_t*)(p.ws + WS_MG);
    constexpr int JA = 2 * 16 * 116, JB = 2 * 32 * 16, JC = 64, JD = MR / 8;
    for (int job = blockIdx.x; job < JA + JB + JC + JD; job += gridDim.x) {
        if (job < JA) {
            const int l = job / (16 * 116), r = job % (16 * 116), ntile = r / 16, kt = r % 16;
            const int n0 = ntile * 64;
            const float sn = (n0 >= 3072 && n0 < 4096) ? 0.0625f : 1.0f;
            transpose_tile(p.w_in + (size_t)l * DM * DIN, DIN, DIN, kt * 64, n0, WT1 + (size_t)l * NW1 * DM, DM, p.g_norm + l * DM, sn, T);
        } else if (job < JA + JB) {
            const int j = job - JA, l = j / 512, r = j % 512, ntile = r / 32, kt = r % 32;
            transpose_tile(p.w_out + (size_t)l * DMG * DM, DM, DM, kt * 64, ntile * 64, WT2 + (size_t)l * DM * DMG, DMG, nullptr, 1.0f, T);
        } else if (job < JA + JB + JC) {
            const int j = job - JA - JB, l = j >> 5, gate = (j >> 4) & 1, blk = j & 15;
            const float* src = (gate ? p.w_i : p.w_r) + (size_t)(l * 16 + blk) * 4096;
            transpose_tile(src, 64, 64, 0, 0, WGT + (size_t)((l * 2 + gate) * 16 + blk) * 4096, 64, nullptr, 1.0f, T);
        } else {
            const int j = job - JA - JB - JC; const int tidp = otid(); const int wid = tidp >> 6, lane = tidp & 63;
            const int row = j * 8 + wid;
            const float* src = row < MP ? p.xp + (size_t)row * DM : (row < MV ? p.xs + (size_t)(row - MP) * DM : nullptr);
            f32x4 v[4]; float ss = 0.f;
#pragma unroll
            for (int i = 0; i < 4; ++i) { v[i] = src ? *(const f32x4*)(src + lane * 16 + i * 4) : zero4(); ss += (v[i][0] * v[i][0] + v[i][1] * v[i][1]) + (v[i][2] * v[i][2] + v[i][3] * v[i][3]); }
#pragma unroll
            for (int o = 32; o >= 1; o >>= 1) ss += __shfl_xor(ss, o);
            u32x4 w0, w1;
            w0.x = cvt_pk_bf16(v[0][0], v[0][1]); w0.y = cvt_pk_bf16(v[0][2], v[0][3]); w0.z = cvt_pk_bf16(v[1][0], v[1][1]); w0.w = cvt_pk_bf16(v[1][2], v[1][3]);
            w1.x = cvt_pk_bf16(v[2][0], v[2][1]); w1.y = cvt_pk_bf16(v[2][2], v[2][3]); w1.z = cvt_pk_bf16(v[3][0], v[3][1]); w1.w = cvt_pk_bf16(v[3][2], v[3][3]);
            *(u32x4*)(XB + (size_t)row * DM + lane * 16) = w0; *(u32x4*)(XB + (size_t)row * DM + lane * 16 + 8) = w1;
            if (lane < 16) SS[(size_t)row * 16 + lane] = lane == 0 ? ss : 0.f;
            if (row >= MV) { const u32x4 z = (u32x4){0u, 0u, 0u, 0u}; u32x4* mp = (u32x4*)(MG + (size_t)row * DMG + lane * 32); mp[0] = z; mp[1] = z; mp[2] = z; mp[3] = z; }
        }
    }
}

constexpr int M_QI = 0, M_KI = 38912, M_VI = 77824, M_CTI = 96256, M_SM = 130048;
constexpr int RS_QK = 304, RS_V = 144, RS_CT = 528;

template <int OFF0, int OFF1>
__device__ __forceinline__ bf16x8 tr_frag(unsigned base) {
    bf16x4 lo, hi;
    asm volatile("ds_read_b64_tr_b16 %0, %2 offset:%3\n\tds_read_b64_tr_b16 %1, %2 offset:%4\n\ts_waitcnt lgkmcnt(0)" : "=&v"(lo), "=&v"(hi) : "v"(base), "i"(OFF0), "i"(OFF1) : "memory");
    bf16x8 r; r[0] = lo[0]; r[1] = lo[1]; r[2] = lo[2]; r[3] = lo[3]; r[4] = hi[0]; r[5] = hi[1]; r[6] = hi[2]; r[7] = hi[3]; return r;
}

template <int O0, int O1, int HI>
__device__ __forceinline__ void tr_frag2(unsigned base, bf16x8& f0, bf16x8& f1) {
    bf16x4 a0, a1, b0, b1;
    asm volatile("ds_read_b64_tr_b16 %0, %4 offset:%5\n\tds_read_b64_tr_b16 %1, %4 offset:%6\n\tds_read_b64_tr_b16 %2, %4 offset:%7\n\tds_read_b64_tr_b16 %3, %4 offset:%8\n\ts_waitcnt lgkmcnt(0)"
                 : "=&v"(a0), "=&v"(a1), "=&v"(b0), "=&v"(b1) : "v"(base), "i"(O0), "i"(O0 + HI), "i"(O1), "i"(O1 + HI) : "memory");
    f0 = __builtin_shufflevector(a0, a1, 0, 1, 2, 3, 4, 5, 6, 7); f1 = __builtin_shufflevector(b0, b1, 0, 1, 2, 3, 4, 5, 6, 7);
}
template <int KS>
__device__ __forceinline__ void mlstm_D(f32x4 (&CT)[8], unsigned bvD, unsigned bkD) {
    const bf16x8 vdf = tr_frag<KS * 32 * RS_V, KS * 32 * RS_V + 4 * RS_V>(bvD);
    bf16x8 k0, k1;
    tr_frag2<KS * 32 * RS_QK + 0, KS * 32 * RS_QK + 32, 4 * RS_QK>(bkD, k0, k1);
    CT[0] = __builtin_amdgcn_mfma_f32_16x16x32_bf16(k0, vdf, CT[0], 0, 0, 0);
    CT[1] = __builtin_amdgcn_mfma_f32_16x16x32_bf16(k1, vdf, CT[1], 0, 0, 0);
    tr_frag2<KS * 32 * RS_QK + 64, KS * 32 * RS_QK + 96, 4 * RS_QK>(bkD, k0, k1);
    CT[2] = __builtin_amdgcn_mfma_f32_16x16x32_bf16(k0, vdf, CT[2], 0, 0, 0);
    CT[3] = __builtin_amdgcn_mfma_f32_16x16x32_bf16(k1, vdf, CT[3], 0, 0, 0);
    tr_frag2<KS * 32 * RS_QK + 128, KS * 32 * RS_QK + 160, 4 * RS_QK>(bkD, k0, k1);
    CT[4] = __builtin_amdgcn_mfma_f32_16x16x32_bf16(k0, vdf, CT[4], 0, 0, 0);
    CT[5] = __builtin_amdgcn_mfma_f32_16x16x32_bf16(k1, vdf, CT[5], 0, 0, 0);
    tr_frag2<KS * 32 * RS_QK + 192, KS * 32 * RS_QK + 224, 4 * RS_QK>(bkD, k0, k1);
    CT[6] = __builtin_amdgcn_mfma_f32_16x16x32_bf16(k0, vdf, CT[6], 0, 0, 0);
    CT[7] = __builtin_amdgcn_mfma_f32_16x16x32_bf16(k1, vdf, CT[7], 0, 0, 0);
}
template <int KS>
__device__ __forceinline__ void mlstm_B(f32x4 (&N1)[4], LAS unsigned char* lds, unsigned bvB, int t, int fq) {
    const bf16x8 pf = *(const LAS bf16x8*)(lds + M_QI + t * RS_QK + KS * 64 + fq * 16);
    bf16x8 v0, v1;
    tr_frag2<KS * 32 * RS_V + 0, KS * 32 * RS_V + 32, 4 * RS_V>(bvB, v0, v1);
    N1[0] = __builtin_amdgcn_mfma_f32_16x16x32_bf16(v0, pf, N1[0], 0, 0, 0);
    N1[1] = __builtin_amdgcn_mfma_f32_16x16x32_bf16(v1, pf, N1[1], 0, 0, 0);
    tr_frag2<KS * 32 * RS_V + 64, KS * 32 * RS_V + 96, 4 * RS_V>(bvB, v0, v1);
    N1[2] = __builtin_amdgcn_mfma_f32_16x16x32_bf16(v0, pf, N1[2], 0, 0, 0);
    N1[3] = __builtin_amdgcn_mfma_f32_16x16x32_bf16(v1, pf, N1[3], 0, 0, 0);
}

__device__ void mlstm_prompt(const Params& p, int l, int item, LAS unsigned char* lds) {
    const int tid0 = otid();
    const int js = item & 3, h = (item >> 2) & 3, b = item >> 4;
    const unsigned ldsb = (unsigned)(size_t)lds;
    LAS float* sm = (LAS float*)(lds + M_SM);
    LAS float* nbuf = sm + 512; LAS float* npart = sm + 1552;
    const bf16_t* U = (const bf16_t*)(p.ws + WS_U); const float* G = (const float*)(p.ws + WS_G);
    bf16_t* MG = (bf16_t*)(p.ws + WS_MG);
    const size_t grow_base = (size_t)b * 2048;
    const int qcol = 2048 + h * 256, kcol = 3072 + h * 256, vcol = 4096 + h * 256 + js * 64;

    __syncthreads();
    for (int i = tid0; i < RS_CT * 64 / 16; i += NT) *(LAS u32x4*)(lds + M_CTI + i * 16) = (u32x4){0u, 0u, 0u, 0u};
    nbuf[tid0] = 0.f;
    f32x4 CTacc[8];
#pragma unroll
    for (int i = 0; i < 8; ++i) CTacc[i] = zero4();
    float m_prev = 0.f;
    u32x4 qreg[4], kreg[4], vreg[2]; float igr[2] = {0.f, 0.f}, lfr[2] = {0.f, 0.f};

#define ML_LOAD_QK(row0_, hd_) do { _Pragma("unroll") for (int i_ = 0; i_ < 4; ++i_) { const int id_ = tid + NT * i_, r_ = id_ >> 4, cq_ = id_ & 15; \
        const bf16_t* rp_ = U + (grow_base + (row0_) + r_) * NU + (hd_) * 128 + cq_ * 8; qreg[i_] = *(const u32x4*)(rp_ + qcol); kreg[i_] = *(const u32x4*)(rp_ + kcol); } } while (0)
#define ML_STORE_QK() do { _Pragma("unroll") for (int i_ = 0; i_ < 4; ++i_) { const int id_ = tid + NT * i_, r_ = id_ >> 4, cq_ = id_ & 15; \
        *(LAS u32x4*)(lds + M_QI + r_ * RS_QK + cq_ * 16) = qreg[i_]; *(LAS u32x4*)(lds + M_KI + r_ * RS_QK + cq_ * 16) = kreg[i_]; } } while (0)
#define ML_LOAD_VG(row0_) do { _Pragma("unroll") for (int i_ = 0; i_ < 2; ++i_) { const int id_ = tid + NT * i_, s_ = id_ >> 3, cq_ = id_ & 7; \
        vreg[i_] = *(const u32x4*)(U + (grow_base + (row0_) + s_) * NU + vcol + cq_ * 8); } \
        if (w == 0) { const float* gp_ = G + (grow_base + (row0_) + 2 * lane) * 8 + h; igr[0] = gp_[0]; lfr[0] = gp_[4]; igr[1] = gp_[8]; lfr[1] = gp_[12]; } } while (0)

#define ML_PREPASS(buf_) do { if (w == 0) { LAS float* dec_ = sm + 128 * (buf_); LAS float* expnm_ = sm + 256 + 128 * (buf_); LAS float* scal_ = sm + 1024 + 8 * (buf_); \
            const float s2 = lfr[0] + lfr[1]; float incl = s2; \
            _Pragma("unroll") for (int o = 1; o < 64; o <<= 1) { const float t_ = __shfl_up(incl, o); if (lane >= o) incl += t_; } \
            const float b0 = incl - s2 + lfr[0], b1 = incl; \
            const float a0 = igr[0] - b0, a1 = igr[1] - b1; float im = fmaxf(a0, a1); \
            _Pragma("unroll") for (int o = 1; o < 64; o <<= 1) { const float t_ = __shfl_up(im, o); if (lane >= o) im = fmaxf(im, t_); } \
            float ex = __shfl_up(im, 1); if (lane == 0) ex = -INFINITY; \
            const float M0 = fmaxf(ex, a0), M1 = fmaxf(M0, a1); \
            const float mt1 = b1 + fmaxf(m_prev, M1); \
            const float bL = __shfl(b1, 63), mL = __shfl(mt1, 63); \
            expnm_[2 * lane] = __expf(bL - mL - b0); expnm_[2 * lane + 1] = __expf(bL - mL - b1); \
            dec_[2 * lane] = __expf(bL - b0 + igr[0] - mL); dec_[2 * lane + 1] = __expf(bL - b1 + igr[1] - mL); \
            if (lane == 0) { scal_[0] = __expf(bL + m_prev - mL); scal_[1] = mL; } \
            m_prev = mL; } } while (0)
    { const int tid = tid0, w = tid >> 6, lane = tid & 63; ML_LOAD_QK(0, 0); ML_LOAD_VG(0); ML_PREPASS(0); }
#pragma unroll 1
    for (int c = 0; c < 16; ++c) {
        int tid = tid0; asm volatile("" : "+v"(tid));
        const int w = __builtin_amdgcn_readfirstlane(tid >> 6), lane = tid & 63, fr = lane & 15, fq = lane >> 4;
        const int cD = w & 3, gD = w >> 2, qq = (lane & 15) >> 2, pp = lane & 3;
        const unsigned bvB = ldsb + M_VI + (8 * fq + qq) * RS_V + 8 * pp;
        const unsigned bvD = bvB + cD * 32;
        const int row0 = c * 128;
        LAS float* nC = nbuf + (c & 1) * 256; LAS float* nN = nbuf + ((c + 1) & 1) * 256;
        __syncthreads();
        ML_STORE_QK();
        LAS float* dec = sm + 128 * (c & 1); LAS float* expnm = sm + 256 + 128 * (c & 1); LAS float* scal = sm + 1024 + 8 * (c & 1);
        const float cs = scal[0];
#pragma unroll
        for (int i = 0; i < 2; ++i) {
            const int id = tid + NT * i, s = id >> 3, cq = id & 7; const float d = dec[s];
            u32x4 v = vreg[i], o;
            o.x = cvt_pk_bf16(lo16(v.x) * d, hi16(v.x) * d); o.y = cvt_pk_bf16(lo16(v.y) * d, hi16(v.y) * d);
            o.z = cvt_pk_bf16(lo16(v.z) * d, hi16(v.z) * d); o.w = cvt_pk_bf16(lo16(v.w) * d, hi16(v.w) * d);
            *(LAS u32x4*)(lds + M_VI + s * RS_V + cq * 16) = o;
        }
        if (tid < 256) nN[tid] = cs * nC[tid];
        ML_LOAD_QK(row0, 1);
        f32x4 Sacc[8], N2[4];
#pragma unroll
        for (int i = 0; i < 8; ++i) Sacc[i] = zero4();
#pragma unroll
        for (int i = 0; i < 4; ++i) N2[i] = zero4();
        float qnp = 0.f;
#pragma unroll 1
        for (int hd = 0; hd < 2; ++hd) {
            __syncthreads();
#pragma unroll
            for (int ks = 0; ks < 4; ++ks) {
                const bf16x8 qf = *(const LAS bf16x8*)(lds + M_QI + (16 * w + fr) * RS_QK + ks * 64 + fq * 16);
#pragma unroll
                for (int g = 0; g < 2; ++g) if (4 * g <= w) {
                    bf16x8 kf[4];
#pragma unroll
                    for (int e = 0; e < 4; ++e) kf[e] = *(const LAS bf16x8*)(lds + M_KI + (64 * g + 16 * e + fr) * RS_QK + ks * 64 + fq * 16);
#pragma unroll
                    for (int e = 0; e < 4; ++e) Sacc[4 * g + e] = __builtin_amdgcn_mfma_f32_16x16x32_bf16(kf[e], qf, Sacc[4 * g + e], 0, 0, 0);
                }
#pragma unroll
                for (int c4 = 0; c4 < 4; ++c4) {
                    const bf16x8 ctf = *(const LAS bf16x8*)(lds + M_CTI + (16 * c4 + fr) * RS_CT + hd * 256 + ks * 64 + fq * 16);
                    N2[c4] = __builtin_amdgcn_mfma_f32_16x16x32_bf16(ctf, qf, N2[c4], 0, 0, 0);
                }
                const LAS float* np = nC + hd * 128 + ks * 32 + fq * 8;
#pragma unroll
                for (int j = 0; j < 8; ++j) qnp += bf2f((unsigned short)qf[j]) * np[j];
                __builtin_amdgcn_sched_barrier(0);
            }
            if (gD == hd) {
                const unsigned bkD = ldsb + M_KI + (8 * fq + qq) * RS_QK + 8 * pp;
#pragma unroll
                for (int i = 0; i < 8; ++i) CTacc[i] *= cs;
                mlstm_D<0>(CTacc, bvD, bkD); __builtin_amdgcn_sched_barrier(0); mlstm_D<1>(CTacc, bvD, bkD); __builtin_amdgcn_sched_barrier(0); mlstm_D<2>(CTacc, bvD, bkD); __builtin_amdgcn_sched_barrier(0); mlstm_D<3>(CTacc, bvD, bkD); __builtin_amdgcn_sched_barrier(0);
            }
            if (gD != hd) {
                const int lidx = (w & 3) * 64 + lane, dk4 = lidx & 31, part = lidx >> 5; float a0 = 0.f, a1 = 0.f, a2 = 0.f, a3 = 0.f;
#pragma unroll 2
                for (int s = 16 * part; s < 16 * part + 16; ++s) {
                    const u32x2 kv = *(const LAS u32x2*)(lds + M_KI + s * RS_QK + dk4 * 8); const float d = dec[s];
                    a0 += d * lo16(kv.x); a1 += d * hi16(kv.x); a2 += d * lo16(kv.y); a3 += d * hi16(kv.y);
                }
                *(LAS f32x4*)(npart + part * 128 + 4 * dk4) = (f32x4){a0, a1, a2, a3};
            }
            __syncthreads();
            if (tid < 128) nN[hd * 128 + tid] += ((npart[tid] + npart[128 + tid]) + (npart[256 + tid] + npart[384 + tid])) + ((npart[512 + tid] + npart[640 + tid]) + (npart[768 + tid] + npart[896 + tid]));
            if (gD == hd) {
#pragma unroll
                for (int i = 0; i < 8; ++i) {
                    u32x2 wv; wv.x = cvt_pk_bf16(CTacc[i][0], CTacc[i][1]); wv.y = cvt_pk_bf16(CTacc[i][2], CTacc[i][3]);
                    *(LAS u32x2*)(lds + M_CTI + (16 * cD + fr) * RS_CT + (hd * 128 + 16 * i + 4 * fq) * 2) = wv;
                }
            }
            if (hd == 0) {
                ML_STORE_QK();
                if (c < 15) { ML_LOAD_QK(row0 + 128, 0); }
            }
        }
        if (c < 15) { ML_LOAD_VG(row0 + 128); }
        const int t = 16 * w + fr;
        float den1 = 0.f;
#pragma unroll
        for (int i = 0; i < 8; ++i) if (i <= (w | 1)) {
            f32x4 sv = Sacc[i];
            const f32x4 dv = *(const LAS f32x4*)(dec + 16 * i + 4 * fq);
#pragma unroll
            for (int j = 0; j < 4; ++j) { const int s = 16 * i + 4 * fq + j; if (s > t || i > w) sv[j] = 0.f; den1 += sv[j] * dv[j]; }
            u32x2 wv; wv.x = cvt_pk_bf16(sv[0], sv[1]); wv.y = cvt_pk_bf16(sv[2], sv[3]);
            *(LAS u32x2*)(lds + M_QI + t * RS_QK + (16 * i + 4 * fq) * 2) = wv;
        }
        den1 += __shfl_xor(den1, 16); den1 += __shfl_xor(den1, 32);
        qnp += __shfl_xor(qnp, 16); qnp += __shfl_xor(qnp, 32);
#pragma unroll
        for (int i = 0; i < 4; ++i) N2[i] *= cs;
        if (0 <= (w >> 1)) mlstm_B<0>(N2, lds, bvB, t, fq);
        if (1 <= (w >> 1)) mlstm_B<1>(N2, lds, bvB, t, fq);
        if (2 <= (w >> 1)) mlstm_B<2>(N2, lds, bvB, t, fq);
        if (3 <= (w >> 1)) mlstm_B<3>(N2, lds, bvB, t, fq);
        {
            const float den = den1 + cs * qnp;
            const float inv = 1.0f / fmaxf(fabsf(den), expnm[t]);
            const size_t grow = grow_base + row0 + t;
#pragma unroll
            for (int c4 = 0; c4 < 4; ++c4) {
                const float y0 = N2[c4][0] * inv, y1 = N2[c4][1] * inv, y2 = N2[c4][2] * inv, y3 = N2[c4][3] * inv;
                u32x2 wv; wv.x = cvt_pk_bf16(y0, y1); wv.y = cvt_pk_bf16(y2, y3);
                *(u32x2*)(MG + grow * DMG + 1024 + h * 256 + js * 64 + 16 * c4 + 4 * fq) = wv;
            }
        }
        if (c < 15) ML_PREPASS((c + 1) & 1);
    }
    __syncthreads();
    {
        const int tid = tid0, w = tid >> 6, lane = tid & 63, fr = lane & 15, fq = lane >> 4, cD = w & 3, gD = w >> 2;
        float* pC = p.out + O_PC + ((size_t)((l * 8 + b) * 4 + h)) * 65536;
#pragma unroll
        for (int i = 0; i < 8; ++i)
#pragma unroll
            for (int j = 0; j < 4; ++j) pC[(size_t)(gD * 128 + 16 * i + 4 * fq + j) * 256 + js * 64 + 16 * cD + fr] = CTacc[i][j];
        if (js == 0) {
            if (tid < 256) p.out[O_PN + ((size_t)((l * 8 + b) * 4 + h)) * 256 + tid] = nbuf[tid];
            if (tid == 0) p.out[O_PM + (l * 8 + b) * 4 + h] = sm[1024 + 8 + 1];
        }
    }
    __syncthreads();
#undef ML_LOAD_QK
#undef ML_STORE_QK
#undef ML_LOAD_VG
#undef ML_PREPASS
}

constexpr int R_XAI = 0, R_XCF = 16768, R_XCB = 49536, R_AA = 67968, R_UU = 100736, R_PT = 133504, R_HC = 137600, R_CW = 138112, R_CH = 139392;
__device__ void rglru_item(const Params& p, int l, int b, int cb, bool decm, LAS unsigned char* lds) {
    const int tid = otid(), w = __builtin_amdgcn_readfirstlane(tid >> 6), lane = tid & 63, fr = lane & 15, fq = lane >> 4;
    const bf16_t* U = (const bf16_t*)(p.ws + WS_U); bf16_t* MG = (bf16_t*)(p.ws + WS_MG);
    const bf16_t* WGT = (const bf16_t*)(p.ws + WS_WGT);
    LAS float* XCF = (LAS float*)(lds + R_XCF); LAS float* AA = (LAS float*)(lds + R_AA); LAS float* UU = (LAS float*)(lds + R_UU);
    LAS float* PT = (LAS float*)(lds + R_PT); LAS float* HC = (LAS float*)(lds + R_HC); LAS float* CW = (LAS float*)(lds + R_CW); LAS float* CH = (LAS float*)(lds + R_CH);
    const int ch0 = cb * 64;
    const size_t grow_base = decm ? (size_t)MP : (size_t)b * 2048;
    const int nchunk = decm ? 1 : 16;
    __syncthreads();
    if (tid < 64) {
        const int ch = ch0 + tid;
#pragma unroll
        for (int j = 0; j < 4; ++j) CW[j * 64 + tid] = p.conv_w[(size_t)(l * 4 + j) * 1024 + ch];
        CW[256 + tid] = p.conv_b[l * 1024 + ch];
        CH[tid] = p.b_r[l * 1024 + ch]; CH[64 + tid] = p.b_i[l * 1024 + ch]; CH[128 + tid] = 8.0f * softplusf_(-p.lam[l * 1024 + ch]);
        HC[tid] = 0.f; HC[64 + tid] = 0.f;
    }
    if (tid < 24) *(LAS u32x4*)(lds + R_XAI + tid * 16) = (u32x4){0u, 0u, 0u, 0u};
    u32x4 xreg[2], zreg[2];
#pragma unroll
    for (int i = 0; i < 2; ++i) { const int id = tid + NT * i, r = id >> 3, cq = id & 7; const bf16_t* rp = U + (grow_base + r) * NU + ch0 + cq * 8; xreg[i] = *(const u32x4*)rp; zreg[i] = *(const u32x4*)(rp + 1024); }
    for (int c = 0; c < nchunk; ++c) {
        const int row0 = c * 128;
        __syncthreads();
        if (c > 0) {
#pragma unroll
            for (int i = 0; i < 2; ++i) { const int id = tid + NT * i, r = id >> 3, cq = id & 7; *(u32x4*)(MG + (grow_base + row0 - 128 + r) * DMG + ch0 + cq * 8) = *(const LAS u32x4*)(lds + R_XCF + r * 128 + cq * 16); }
        }
        u32x4 zcur[2];
#pragma unroll
        for (int i = 0; i < 2; ++i) { const int id = tid + NT * i, r = id >> 3, cq = id & 7; *(LAS u32x4*)(lds + R_XAI + (3 + r) * 128 + cq * 16) = xreg[i]; zcur[i] = zreg[i]; }
        if (c + 1 < nchunk) {
#pragma unroll
            for (int i = 0; i < 2; ++i) { const int id = tid + NT * i, r = id >> 3, cq = id & 7; const bf16_t* rp = U + (grow_base + row0 + 128 + r) * NU + ch0 + cq * 8; xreg[i] = *(const u32x4*)rp; zreg[i] = *(const u32x4*)(rp + 1024); }
        }
        __syncthreads();
        {
            const int t = tid >> 2, c0 = (tid & 3) * 16;
            float xc[16];
#pragma unroll
            for (int k = 0; k < 16; ++k) xc[k] = CW[256 + c0 + k];
            if (!decm) {
#pragma unroll
                for (int j = 0; j < 4; ++j) {
                    const u32x4 a = *(const LAS u32x4*)(lds + R_XAI + (t + j) * 128 + c0 * 2), bq = *(const LAS u32x4*)(lds + R_XAI + (t + j) * 128 + c0 * 2 + 16);
                    const unsigned wv[8] = {a.x, a.y, a.z, a.w, bq.x, bq.y, bq.z, bq.w};
#pragma unroll
                    for (int k = 0; k < 8; ++k) { xc[2 * k] += CW[j * 64 + c0 + 2 * k] * lo16(wv[k]); xc[2 * k + 1] += CW[j * 64 + c0 + 2 * k + 1] * hi16(wv[k]); }
                }
            } else {
                const float* stp = p.st_conv + ((size_t)(l * 128 + t) * 3) * 1024 + ch0 + c0;
                float* so = p.out + O_SCONV + ((size_t)(l * 128 + t) * 3) * 1024 + ch0 + c0;
#pragma unroll
                for (int j = 0; j < 3; ++j)
#pragma unroll
                    for (int k4 = 0; k4 < 4; ++k4) {
                        const f32x4 sv = *(const f32x4*)(stp + (size_t)j * 1024 + k4 * 4);
#pragma unroll
                        for (int e = 0; e < 4; ++e) xc[k4 * 4 + e] += CW[j * 64 + c0 + k4 * 4 + e] * sv[e];
                        if (j >= 1) *(f32x4*)(so + (size_t)(j - 1) * 1024 + k4 * 4) = sv;
                    }
                const u32x4 a = *(const LAS u32x4*)(lds + R_XAI + (t + 3) * 128 + c0 * 2), bq = *(const LAS u32x4*)(lds + R_XAI + (t + 3) * 128 + c0 * 2 + 16);
                const unsigned wv[8] = {a.x, a.y, a.z, a.w, bq.x, bq.y, bq.z, bq.w};
#pragma unroll
                for (int k = 0; k < 8; ++k) {
                    const float x0 = lo16(wv[k]), x1 = hi16(wv[k]);
                    xc[2 * k] += CW[3 * 64 + c0 + 2 * k] * x0; xc[2 * k + 1] += CW[3 * 64 + c0 + 2 * k + 1] * x1;
                    so[2 * 1024 + 2 * k] = x0; so[2 * 1024 + 2 * k + 1] = x1;
                }
            }
#pragma unroll
            for (int k4 = 0; k4 < 4; ++k4) *(LAS f32x4*)(XCF + t * 64 + c0 + k4 * 4) = (f32x4){xc[k4 * 4], xc[k4 * 4 + 1], xc[k4 * 4 + 2], xc[k4 * 4 + 3]};
            u32x4 o0, o1;
            o0.x = cvt_pk_bf16(xc[0], xc[1]); o0.y = cvt_pk_bf16(xc[2], xc[3]); o0.z = cvt_pk_bf16(xc[4], xc[5]); o0.w = cvt_pk_bf16(xc[6], xc[7]);
            o1.x = cvt_pk_bf16(xc[8], xc[9]); o1.y = cvt_pk_bf16(xc[10], xc[11]); o1.z = cvt_pk_bf16(xc[12], xc[13]); o1.w = cvt_pk_bf16(xc[14], xc[15]);
            *(LAS u32x4*)(lds + R_XCB + t * 144 + c0 * 2) = o0; *(LAS u32x4*)(lds + R_XCB + t * 144 + c0 * 2 + 16) = o1;
        }
        __syncthreads();
        if (!decm && tid < 24) { const u32x4 v = *(const LAS u32x4*)(lds + R_XAI + 128 * 128 + tid * 16); *(LAS u32x4*)(lds + R_XAI + tid * 16) = v; }
        {
            bf16x8 xf[2];
#pragma unroll
            for (int ks = 0; ks < 2; ++ks) xf[ks] = *(const LAS bf16x8*)(lds + R_XCB + (16 * w + fr) * 144 + ks * 64 + fq * 16);
            const int t = 16 * w + fr;
#pragma unroll
            for (int c4 = 0; c4 < 4; ++c4) {
                f32x4 ar = zero4(), ai = ar;
#pragma unroll
                for (int ks = 0; ks < 2; ++ks) {
                    const bf16x8 wfr = *(const bf16x8*)(WGT + (size_t)((l * 2 + 0) * 16 + cb) * 4096 + (16 * c4 + fr) * 64 + ks * 32 + fq * 8);
                    const bf16x8 wfi = *(const bf16x8*)(WGT + (size_t)((l * 2 + 1) * 16 + cb) * 4096 + (16 * c4 + fr) * 64 + ks * 32 + fq * 8);
                    ar = __builtin_amdgcn_mfma_f32_16x16x32_bf16(wfr, xf[ks], ar, 0, 0, 0); ai = __builtin_amdgcn_mfma_f32_16x16x32_bf16(wfi, xf[ks], ai, 0, 0, 0); }
                const int d = 16 * c4 + 4 * fq;
                const f32x4 xcv = *(const LAS f32x4*)(XCF + t * 64 + d);
                f32x4 av, uv;
#pragma unroll
                for (int j = 0; j < 4; ++j) {
                    const float r = sigmoidf_(ar[j] + CH[d + j]), ig = sigmoidf_(ai[j] + CH[64 + d + j]);
                    const float la = -r * CH[128 + d + j];
                    const float x2 = 2.0f * la;
                    const float ser = -x2 * (1.0f + x2 * (0.5f + x2 * (0.16666667f + x2 * (0.041666668f + x2 * (0.0083333338f + x2 * 0.0013888889f)))));
                    const float om = x2 > -0.3f ? ser : 1.0f - __expf(x2);
                    av[j] = __expf(la); uv[j] = __builtin_amdgcn_sqrtf(om) * (ig * xcv[j]);
                }
                if (!decm) { *(LAS f32x4*)(AA + t * 64 + d) = av; *(LAS f32x4*)(UU + t * 64 + d) = uv; }
                else {
                    const f32x4 h0 = *(const f32x4*)(p.st_h + (size_t)(l * 128 + t) * 1024 + ch0 + d);
                    const f32x4 hn = av * h0 + uv;
                    *(f32x4*)(p.out + O_SH + (size_t)(l * 128 + t) * 1024 + ch0 + d) = hn;
                    const u32x2 zv = *(const u32x2*)(U + (grow_base + t) * NU + 1024 + ch0 + d);
                    u32x2 wv; wv.x = cvt_pk_bf16(hn[0] * lo16(zv.x), hn[1] * hi16(zv.x)); wv.y = cvt_pk_bf16(hn[2] * lo16(zv.y), hn[3] * hi16(zv.y));
                    *(u32x2*)(MG + (grow_base + t) * DMG + ch0 + d) = wv;
                }
            }
        }
        if (decm) break;
        __syncthreads();
#pragma unroll
        for (int i = 0; i < 2; ++i) { const int id = tid + NT * i, r = id >> 3, cq = id & 7; *(LAS u32x4*)(lds + R_XCB + r * 144 + cq * 16) = zcur[i]; }
        const int ch = tid & 63, part = tid >> 6;
        {
            float hh = 0.f, Ac = 1.f;
#pragma unroll 4
            for (int k = 0; k < 16; ++k) { const int t = part * 16 + k; const float a = AA[t * 64 + ch], u = UU[t * 64 + ch]; hh = a * hh + u; Ac *= a; UU[t * 64 + ch] = hh; AA[t * 64 + ch] = Ac; }
            PT[(part * 64 + ch) * 2] = Ac; PT[(part * 64 + ch) * 2 + 1] = hh;
        }
        __syncthreads();
        {
            float hin = HC[(c & 1) * 64 + ch];
            for (int q = 0; q < part; ++q) hin = PT[(q * 64 + ch) * 2] * hin + PT[(q * 64 + ch) * 2 + 1];
            float hf = hin;
#pragma unroll 4
            for (int k = 0; k < 16; ++k) {
                const int t = part * 16 + k; hf = AA[t * 64 + ch] * hin + UU[t * 64 + ch];
                const float z = bf2f(*(const LAS unsigned short*)(lds + R_XCB + t * 144 + ch * 2));
                const float y = hf * z;
                *(LAS unsigned short*)(lds + R_XCF + t * 128 + ch * 2) = (unsigned short)(cvt_pk_bf16(y, y) & 0xffffu);
            }
            if (part == 7) {
                HC[((c + 1) & 1) * 64 + ch] = hf;
                if (c == 15) p.out[O_PH + (size_t)(l * 8 + b) * 1024 + ch0 + ch] = hf;
            }
        }
        if (c == 15 && tid < 192) {
            const int j = tid >> 6, cc = tid & 63;
            p.out[O_PCONV + ((size_t)(l * 8 + b) * 3 + j) * 1024 + ch0 + cc] = bf2f(*(const LAS unsigned short*)(lds + R_XAI + j * 128 + cc * 2));
        }
    }
    __syncthreads();
    if (!decm) {
#pragma unroll
        for (int i = 0; i < 2; ++i) { const int id = tid + NT * i, r = id >> 3, cq = id & 7; *(u32x4*)(MG + (grow_base + 15 * 128 + r) * DMG + ch0 + cq * 8) = *(const LAS u32x4*)(lds + R_XCF + r * 128 + cq * 16); }
    }
    __syncthreads();
}

__device__ void mlstm_decode(const Params& p, int l, int b, int h, LAS unsigned char* lds) {
    const int tid = otid(), lane = tid & 63;
    const bf16_t* U = (const bf16_t*)(p.ws + WS_U); const float* G = (const float*)(p.ws + WS_G);
    bf16_t* MG = (bf16_t*)(p.ws + WS_MG);
    LAS float* qs = (LAS float*)lds; LAS float* ks = qs + 256; LAS float* vs = qs + 512; LAS float* ns = qs + 768; LAS float* red = qs + 1024; LAS float* red2 = qs + 1024 + 2048;
    const size_t row = (size_t)MP + b;
    const size_t sidx = (size_t)((l * 128 + b) * 4 + h);
    __syncthreads();
    if (tid < 256) {
        qs[tid] = bf2f(U[row * NU + 2048 + h * 256 + tid]); ks[tid] = bf2f(U[row * NU + 3072 + h * 256 + tid]); vs[tid] = bf2f(U[row * NU + 4096 + h * 256 + tid]);
        ns[tid] = p.st_n[sidx * 256 + tid];
    }
    const float ig = G[row * 8 + h], lf = G[row * 8 + 4 + h], m0 = p.st_m[sidx];
    __syncthreads();
    float qk = 0.f, qn = 0.f;
#pragma unroll
    for (int j = 0; j < 4; ++j) { const float qv = qs[lane * 4 + j]; qk += qv * ks[lane * 4 + j]; qn += qv * ns[lane * 4 + j]; }
#pragma unroll
    for (int o = 32; o >= 1; o >>= 1) { qk += __shfl_xor(qk, o); qn += __shfl_xor(qn, o); }
    const float mt = fmaxf(lf + m0, ig), wg = __expf(ig - mt), gi = __expf(lf + m0 - mt);
    const int dvq = tid & 63, dkg = tid >> 6;
    float o_pre = 0.f, zg_pre = 0.f;
    if (tid < 256) { o_pre = bf2f(U[row * NU + 5120 + h * 256 + tid]); zg_pre = p.g_mhead[l * 1024 + h * 256 + tid] * bf2f(U[row * NU + 6144 + h * 256 + tid]); }
    const float* C0 = p.st_C + sidx * 65536; float* C1 = p.out + O_SC + sidx * 65536;
    const f32x4 v4 = *(const LAS f32x4*)(vs + dvq * 4);
    f32x4 qc = zero4();
#pragma unroll 16
    for (int i = 0; i < 32; ++i) {
        const int dk = dkg * 32 + i;
        const f32x4 c4 = __builtin_nontemporal_load((const f32x4*)(C0 + (size_t)dk * 256 + dvq * 4));
        const float qv = qs[dk], kv = wg * ks[dk];
        qc += qv * c4;
        const f32x4 cn = gi * c4 + kv * v4;
        __builtin_nontemporal_store(cn, (f32x4*)(C1 + (size_t)dk * 256 + dvq * 4));
    }
    *(LAS f32x4*)(red + dkg * 256 + dvq * 4) = qc;
    __syncthreads();
    float yv = 0.f;
    if (tid < 256) {
        float qcv = 0.f;
#pragma unroll
        for (int g = 0; g < 8; ++g) qcv += red[g * 256 + tid];
        const float num = wg * qk * vs[tid] + gi * qcv, den = wg * qk + gi * qn;
        const float hh = num / fmaxf(fabsf(den), __expf(-mt));
        yv = hh * o_pre;
        float ss = yv * yv;
#pragma unroll
        for (int o = 32; o >= 1; o >>= 1) ss += __shfl_xor(ss, o);
        if (lane == 0) red2[tid >> 6] = ss;
        p.out[O_SN + sidx * 256 + tid] = gi * ns[tid] + wg * ks[tid];
    }
    __syncthreads();
    if (tid < 256) {
        const float rstd = rsqrtf(((red2[0] + red2[1]) + (red2[2] + red2[3])) * (1.0f / 256.0f) + EPSF);
        const float ov = yv * rstd * zg_pre;
        MG[row * DMG + 1024 + h * 256 + tid] = (bf16_t)(cvt_pk_bf16(ov, ov) & 0xffffu);
    }
    if (tid == 0) p.out[O_SM + sidx] = mt;
}

__device__ void decode_items(const Params& p, int l, LAS unsigned char* lds, int max_items) {
    unsigned* ctr = (unsigned*)(p.ws + WS_BAR) + 3584 + 64 * l;
    volatile LAS unsigned* slot = (volatile LAS unsigned*)(lds + LDS_BYTES - 32);
    for (int n = 0; n < max_items; ++n) {
        __syncthreads();
        if (threadIdx.x == 0) *slot = __hip_atomic_fetch_add(ctr, 1u, __ATOMIC_RELAXED, __HIP_MEMORY_SCOPE_AGENT);
        __syncthreads();
        const int item = (int)*slot;
        if (item >= 512) break;
        mlstm_decode(p, l, item >> 2, item & 3, lds);
    }
}

__device__ void phase_mixers(const Params& p, int l, LAS unsigned char* lds) {
    const int G = gridDim.x, bid = obid();
    const bool split = G >= 256;
    const int r = split ? bid - 128 : bid, R = split ? G - 128 : G;
    if (!split || bid < 128) { for (int item = bid; item < 128; item += (split ? 128 : G)) mlstm_prompt(p, l, item, lds); }
    if (r >= 0) {
        for (int item = r; item < 128; item += R) rglru_item(p, l, item >> 4, item & 15, false, lds);
        for (int item = r; item < 16; item += R) rglru_item(p, l, 0, item, true, lds);
    }
    decode_items(p, l, lds, 1 << 30);
}

__device__ void phase_headnorm(const Params& p, int l) {
    const bf16_t* U = (const bf16_t*)(p.ws + WS_U); bf16_t* MG = (bf16_t*)(p.ws + WS_MG);
    const float* gm = p.g_mhead + l * 1024;
    const int G = gridDim.x, bid = obid();
    const int b0 = G > 8 ? bid - 4 : bid, GG = G > 8 ? G - 4 : G;
    if (b0 < 0) return;
    for (size_t idx = (size_t)b0 * NT + otid(); idx < (size_t)MP * 128; idx += (size_t)GG * NT) {
        const size_t row = idx >> 7; const int col = (int)(idx & 127) * 8;
        const u32x4 hv = *(const u32x4*)(MG + row * DMG + 1024 + col);
        const u32x4 ov = *(const u32x4*)(U + row * NU + 5120 + col);
        const u32x4 zv = *(const u32x4*)(U + row * NU + 6144 + col);
        float y[8];
        y[0] = lo16(hv.x) * lo16(ov.x); y[1] = hi16(hv.x) * hi16(ov.x); y[2] = lo16(hv.y) * lo16(ov.y); y[3] = hi16(hv.y) * hi16(ov.y);
        y[4] = lo16(hv.z) * lo16(ov.z); y[5] = hi16(hv.z) * hi16(ov.z); y[6] = lo16(hv.w) * lo16(ov.w); y[7] = hi16(hv.w) * hi16(ov.w);
        float ss = ((y[0] * y[0] + y[1] * y[1]) + (y[2] * y[2] + y[3] * y[3])) + ((y[4] * y[4] + y[5] * y[5]) + (y[6] * y[6] + y[7] * y[7]));
#pragma unroll
        for (int o = 1; o < 32; o <<= 1) ss += __shfl_xor(ss, o);
        const float rstd = rsqrtf(ss * (1.0f / 256.0f) + EPSF);
        const f32x4 g0 = *(const f32x4*)(gm + col), g1 = *(const f32x4*)(gm + col + 4);
        u32x4 o;
        o.x = cvt_pk_bf16(y[0] * rstd * g0[0] * lo16(zv.x), y[1] * rstd * g0[1] * hi16(zv.x));
        o.y = cvt_pk_bf16(y[2] * rstd * g0[2] * lo16(zv.y), y[3] * rstd * g0[3] * hi16(zv.y));
        o.z = cvt_pk_bf16(y[4] * rstd * g1[0] * lo16(zv.z), y[5] * rstd * g1[1] * hi16(zv.z));
        o.w = cvt_pk_bf16(y[6] * rstd * g1[2] * lo16(zv.w), y[7] * rstd * g1[3] * hi16(zv.w));
        *(u32x4*)(MG + row * DMG + 1024 + col) = o;
    }
}

__device__ void phase_final(const Params& p) {
    const bf16_t* XB = (const bf16_t*)(p.ws + WS_XB); const float* SS = (const float*)(p.ws + WS_SS);
    const int tidf = otid(); const int wid = tidf >> 6, lane = tidf & 63;
    for (int row = blockIdx.x * 8 + wid; row < MV; row += gridDim.x * 8) {
        const f32x4* sp = (const f32x4*)(SS + (size_t)row * 16);
        const f32x4 s0 = sp[0], s1 = sp[1], s2 = sp[2], s3 = sp[3];
        const float ss = ((s0[0] + s0[1]) + (s0[2] + s0[3])) + ((s1[0] + s1[1]) + (s1[2] + s1[3])) + ((s2[0] + s2[1]) + (s2[2] + s2[3])) + ((s3[0] + s3[1]) + (s3[2] + s3[3]));
        const float rstd = rsqrtf(ss * (1.0f / 1024.0f) + EPSF);
        float* op = row < MP ? p.out + O_YP + (size_t)row * DM : p.out + O_YS + (size_t)(row - MP) * DM;
#pragma unroll
        for (int i = 0; i < 2; ++i) {
            const int c = i * 512 + lane * 8;
            const u32x4 xv = *(const u32x4*)(XB + (size_t)row * DM + c);
            const f32x4 g0 = *(const f32x4*)(p.g_final + c), g1 = *(const f32x4*)(p.g_final + c + 4);
            *(f32x4*)(op + c) = (f32x4){lo16(xv.x) * rstd * g0[0], hi16(xv.x) * rstd * g0[1], lo16(xv.y) * rstd * g0[2], hi16(xv.y) * rstd * g0[3]};
            *(f32x4*)(op + c + 4) = (f32x4){lo16(xv.z) * rstd * g1[0], hi16(xv.z) * rstd * g1[1], lo16(xv.w) * rstd * g1[2], hi16(xv.w) * rstd * g1[3]};
        }
    }
}

#define XB_XCNT(j) (64 * (j))
#define XB_XSUB(j) (1024 + 64 * (j))
#define XB_XGEN(j) (2048 + 64 * (j))
#define XB_TOP 3072
#define XB_TOPGEN 3136
__device__ __forceinline__ unsigned xb_ld(unsigned* p) { return __hip_atomic_load(p, __ATOMIC_RELAXED, __HIP_MEMORY_SCOPE_AGENT); }
__device__ __forceinline__ unsigned xb_add(unsigned* p, unsigned v) { return __hip_atomic_fetch_add(p, v, __ATOMIC_RELAXED, __HIP_MEMORY_SCOPE_AGENT); }
__device__ __forceinline__ unsigned xb_xcc_id() { return (unsigned)__builtin_amdgcn_s_getreg((3 << 11) | 20) & 0xFu; }
#define XB_SPIN(cond) do { unsigned sp_ = 0; while (cond) { __builtin_amdgcn_s_sleep(1); if (++sp_ > (1u << 24)) break; } } while (0)
__device__ __forceinline__ void gbar(unsigned* bar, volatile LAS unsigned* st) {
    asm volatile("s_waitcnt vmcnt(0) lgkmcnt(0)" ::: "memory");
    __syncthreads();
    if (threadIdx.x == 0) {
        const unsigned x = xb_xcc_id(), nloc = st[0], nx = st[1];
        const unsigned old = xb_add(&bar[XB_XSUB(x)], 1u);
        const unsigned gen = old / nloc;
        if (old + 1u == (gen + 1u) * nloc) {
            __builtin_amdgcn_fence(__ATOMIC_RELEASE, "agent");
            asm volatile("s_waitcnt vmcnt(0)" ::: "memory");
            const unsigned og = xb_add(&bar[XB_TOP], 1u);
            const unsigned tg = og / nx;
            if (og + 1u == (tg + 1u) * nx) xb_add(&bar[XB_TOPGEN], 1u);
            else XB_SPIN(xb_ld(&bar[XB_TOPGEN]) == tg);
            __builtin_amdgcn_fence(__ATOMIC_ACQUIRE, "agent");
            xb_add(&bar[XB_XGEN(x)], 1u);
            asm volatile("s_waitcnt vmcnt(0)" ::: "memory");
        } else {
            XB_SPIN(xb_ld(&bar[XB_XGEN(x)]) == gen);
            __builtin_amdgcn_fence(__ATOMIC_ACQUIRE, "agent");
            asm volatile("s_waitcnt vmcnt(0)" ::: "memory");
        }
    }
    __syncthreads();
}

__global__ void __launch_bounds__(NT, 2) hymba_fwd(Params p) {
    extern __shared__ __attribute__((aligned(16))) unsigned char lds_raw[];
    LAS unsigned char* lds = (LAS unsigned char*)lds_raw;
    cg::grid_group grid = cg::this_grid();
    bf16_t* XB = (bf16_t*)(p.ws + WS_XB); bf16_t* U = (bf16_t*)(p.ws + WS_U); float* G = (float*)(p.ws + WS_G); bf16_t* MG = (bf16_t*)(p.ws + WS_MG);
    float* SS = (float*)(p.ws + WS_SS);
    unsigned* bar = (unsigned*)(p.ws + WS_BAR);
    volatile LAS unsigned* st = (volatile LAS unsigned*)(lds + LDS_BYTES - 16);
    if (threadIdx.x == 0) (void)xb_add(&bar[XB_XCNT(xb_xcc_id())], 1u);
    if (p.out == nullptr) grid.sync();
    phase_prep(p, lds);
    if (threadIdx.x == 0) {
        const unsigned x = xb_xcc_id(), Gn = gridDim.x; unsigned mine = 1u, cnt = 1u, sp = 0u;
        for (;;) {
            unsigned sum = 0u; cnt = 0u;
            for (unsigned j = 0; j < 16; ++j) { const unsigned c = xb_ld(&bar[XB_XCNT(j)]); sum += c; cnt += c > 0u ? 1u : 0u; if (j == x) mine = c; }
            if (sum == Gn || ++sp > (1u << 22)) break;
            __builtin_amdgcn_s_sleep(1);
        }
        st[0] = mine > 0u ? mine : 1u; st[1] = cnt > 0u ? cnt : 1u;
    }
    __syncthreads();
    gbar(bar, st);
    for (int l = 0; l < 2; ++l) {
        {
            pg8::Gemm g; g.A = XB; g.Bt = (const bf16_t*)(p.ws + WS_WT1) + (size_t)l * NW1 * DM; g.M = MR; g.N = NW1; g.K = DM;
            unsigned* dctr = bar + 3712 + 64 * l;
            pg8::InOrder so; so.G = gridDim.x; so.c = obid(); so.done_ctr = dctr;
            EpiIn e; e.U = U; e.G = G; e.SS = SS; e.bmi = p.b_mi + l * 4; e.bmf = p.b_mf + l * 4;
            pg8::gemm_phase<EpiIn, pg8::InOrder, DM>(lds, g, so, e);
            const int Gn = gridDim.x, maxu = (pg8::IN_UNITS + Gn - 1) / Gn, mine = (pg8::IN_UNITS - so.c + Gn - 1) / Gn;
            if (mine < maxu) {
                if (threadIdx.x == 0) {
                    unsigned sp = 0u;
                    while (__hip_atomic_load(dctr, __ATOMIC_RELAXED, __HIP_MEMORY_SCOPE_AGENT) < 8u * pg8::IN_DEC_UNITS) { __builtin_amdgcn_s_sleep(2); if (++sp > (1u << 24)) break; }
                    __builtin_amdgcn_fence(__ATOMIC_ACQUIRE, "agent");
                    asm volatile("s_waitcnt vmcnt(0)" ::: "memory");
                }
                __syncthreads();
                decode_items(p, l, lds, 1);
            }
        }
        gbar(bar, st);
        phase_mixers(p, l, lds);
        gbar(bar, st);
        for (int pass = 0; pass < 2; ++pass) {
            if (pass == 0) phase_headnorm(p, l);
            pg8::Gemm g; g.A = MG; g.Bt = (const bf16_t*)(p.ws + WS_WT2) + (size_t)l * DM * DMG; g.M = MR; g.N = DM; g.K = DMG;
            pg8::OutOrder so; so.G = gridDim.x; so.c = obid(); so.mode = pass;
            EpiOut e; e.basep = p.xp; e.bases = p.xs; e.split = l == 0 ? 1 : 0; e.XBo = XB; e.SSo = SS;
            pg8::gemm_phase<EpiOut, pg8::OutOrder, DMG>(lds, g, so, e);
            gbar(bar, st);
        }
    }
    phase_final(p);
}

extern "C" void kernel_launch(void* const* d_in, const int* in_sizes, int n_in, void* d_out, int out_size, void* d_ws, size_t ws_size, hipStream_t stream) {
    static int grid_blocks = 0;
    if (!grid_blocks) {
        int dev = 0, cus = 0, per_cu = 0;
        hipGetDevice(&dev);
        hipDeviceGetAttribute(&cus, hipDeviceAttributeMultiprocessorCount, dev);
        hipFuncSetAttribute((const void*)hymba_fwd, hipFuncAttributeMaxDynamicSharedMemorySize, LDS_BYTES);
        hipOccupancyMaxActiveBlocksPerMultiprocessor(&per_cu, (const void*)hymba_fwd, NT, LDS_BYTES);
        if (per_cu < 1) per_cu = 1;
        grid_blocks = cus * per_cu;
        (void)hipGetLastError();
    }
    if (ws_size < WS_END) { fprintf(stderr, "workspace too small: %zu < %zu\n", ws_size, (size_t)WS_END); return; }
    Params p{};
    p.xp = (const float*)d_in[0]; p.xs = (const float*)d_in[1]; p.st_h = (const float*)d_in[2]; p.st_conv = (const float*)d_in[3];
    p.st_C = (const float*)d_in[4]; p.st_n = (const float*)d_in[5]; p.st_m = (const float*)d_in[6]; p.g_norm = (const float*)d_in[7];
    p.w_in = (const float*)d_in[8]; p.conv_w = (const float*)d_in[9]; p.conv_b = (const float*)d_in[10]; p.w_r = (const float*)d_in[11];
    p.b_r = (const float*)d_in[12]; p.w_i = (const float*)d_in[13]; p.b_i = (const float*)d_in[14]; p.lam = (const float*)d_in[15];
    p.b_mi = (const float*)d_in[16]; p.b_mf = (const float*)d_in[17]; p.g_mhead = (const float*)d_in[18]; p.w_out = (const float*)d_in[19];
    p.g_final = (const float*)d_in[20];
    p.out = (float*)d_out; p.ws = (unsigned char*)d_ws;
    (void)hipMemsetAsync((unsigned char*)d_ws + WS_BAR, 0, 16384, stream);
    void* args[] = {&p};
    hipError_t e = hipLaunchCooperativeKernel((const void*)hymba_fwd, dim3(grid_blocks), dim3(NT), args, LDS_BYTES, stream);
    if (e != hipSuccess) fprintf(stderr, "cooperative launch failed: %s (grid %d)\n", hipGetErrorString(e), grid_blocks);
}
```

```cpp
#include <hip/hip_runtime.h>
#include <hip/hip_cooperative_groups.h>
#include <cstdio>
namespace cg = cooperative_groups;

#define LAS __attribute__((address_space(3)))
typedef unsigned short bf16_t;
typedef short bf16x8 __attribute__((ext_vector_type(8)));
typedef short bf16x4 __attribute__((ext_vector_type(4)));
typedef float f32x4 __attribute__((ext_vector_type(4)));
typedef unsigned u32x4 __attribute__((ext_vector_type(4)));
typedef unsigned u32x2 __attribute__((ext_vector_type(2)));

constexpr int NT = 512;
constexpr int LDS_BYTES = 163840;
constexpr int MP = 16384, MV = 16512, MR = 16640;
constexpr int DM = 1024, NU = 7168, NW1 = 7424, DIN = 7176, DMG = 2048;
constexpr float EPSF = 1e-6f;

constexpr size_t WS_XB = 0;
constexpr size_t WS_WT1 = WS_XB + (size_t)MR * DM * 2;
constexpr size_t WS_WT2 = WS_WT1 + (size_t)2 * NW1 * DM * 2;
constexpr size_t WS_WGT = WS_WT2 + (size_t)2 * DM * DMG * 2;
constexpr size_t WS_U = WS_WGT + (size_t)2 * 2 * 16 * 64 * 64 * 2;
constexpr size_t WS_G = WS_U + (size_t)MR * NU * 2;
constexpr size_t WS_MG = WS_G + (size_t)MR * 8 * 4;
constexpr size_t WS_X1 = WS_MG + (size_t)MR * DMG * 2;
constexpr size_t WS_X2 = WS_X1 + (size_t)MR * DM * 4;
constexpr size_t WS_SS = WS_X2 + (size_t)MR * DM * 4;
constexpr size_t WS_YSS = WS_SS + (size_t)MR * 16 * 4;
constexpr size_t WS_BAR = WS_YSS + (size_t)MR * 16 * 4;
constexpr size_t WS_END = WS_BAR + 16384;

struct Params {
    const float* xp; const float* xs; const float* st_h; const float* st_conv; const float* st_C; const float* st_n; const float* st_m;
    const float* g_norm; const float* w_in; const float* conv_w; const float* conv_b; const float* w_r; const float* b_r; const float* w_i; const float* b_i;
    const float* lam; const float* b_mi; const float* b_mf; const float* g_mhead; const float* w_out; const float* g_final;
    float* out; unsigned char* ws;
};

constexpr size_t O_YP = 0;
constexpr size_t O_YS = O_YP + (size_t)MP * DM;
constexpr size_t O_PH = O_YS + (size_t)128 * DM;
constexpr size_t O_PCONV = O_PH + 2 * 8 * 1024;
constexpr size_t O_PC = O_PCONV + 2 * 8 * 3 * 1024;
constexpr size_t O_PN = O_PC + (size_t)2 * 8 * 4 * 65536;
constexpr size_t O_PM = O_PN + 2 * 8 * 4 * 256;
constexpr size_t O_SH = O_PM + 2 * 8 * 4;
constexpr size_t O_SCONV = O_SH + 2 * 128 * 1024;
constexpr size_t O_SC = O_SCONV + 2 * 128 * 3 * 1024;
constexpr size_t O_SN = O_SC + (size_t)2 * 128 * 4 * 65536;
constexpr size_t O_SM = O_SN + 2 * 128 * 4 * 256;

__device__ __forceinline__ float bf2f(unsigned short v) { return __uint_as_float(((unsigned)v) << 16); }
__device__ __forceinline__ unsigned cvt_pk_bf16(float lo, float hi) { unsigned r; asm volatile("v_cvt_pk_bf16_f32 %0, %1, %2" : "=v"(r) : "v"(lo), "v"(hi)); return r; }
__device__ __forceinline__ float sigmoidf_(float x) { return __builtin_amdgcn_rcpf(1.0f + __builtin_amdgcn_exp2f(-1.44269504f * x)); }
__device__ __forceinline__ float siluf_(float x) { return x * __builtin_amdgcn_rcpf(1.0f + __builtin_amdgcn_exp2f(-1.44269504f * x)); }
__device__ __forceinline__ float softplusf_(float x) { return fmaxf(x, 0.f) + log1pf(__expf(-fabsf(x))); }
__device__ __forceinline__ int otid() { int t = threadIdx.x; asm volatile("" : "+v"(t)); return t; }
__device__ __forceinline__ int obid() { int t = blockIdx.x; asm volatile("" : "+s"(t)); return t; }
__device__ __forceinline__ f32x4 zero4() { float z = 0.f; asm volatile("" : "+v"(z)); return (f32x4){z, z, z, z}; }
__device__ __forceinline__ float lo16(unsigned w) { return __uint_as_float(w << 16); }
__device__ __forceinline__ float hi16(unsigned w) { return __uint_as_float(w & 0xffff0000u); }

namespace pg8 {
constexpr int BM = 256, BK = 64, HALF = 128, HTB = HALF * BK * 2, STAGE_BYTES = 8 * HTB, NXCD = 8, WGM = 2;
__host__ __device__ __forceinline__ int lds_byte(int r, int c) { const int st = (r >> 4) * 2 + (c >> 5), rr = r & 15, cc = c & 31, ob = rr * 64 + cc * 2; return st * 1024 + (ob ^ (((ob >> 9) & 1) << 5)); }
__host__ __device__ __forceinline__ void stage_rc(int b, int& R, int& C) { const int st = b / 1024, sb = b % 1024, swz = sb ^ (((sb >> 9) & 1) << 5); R = (st >> 1) * 16 + swz / 64; C = (st & 1) * 32 + (swz % 64) / 2; }
__host__ __device__ __forceinline__ int perm32(int rho) { const int n = rho >> 4, i = rho & 15; return 8 * (i >> 2) + 4 * n + (i & 3); }
struct Unit { int pm, pn; };
struct Gemm { const bf16_t* A; const bf16_t* Bt; int M, N, K; };
template <int NM_, int NN_>
struct StaticOrder {
    static constexpr int nM = NM_, nN = NN_, nwg = NM_ * NN_;
    int G, c;
    __device__ void init(int G_, int c_) { G = G_; c = c_; }
    __device__ static void map(int L, Unit& u) {
        int wgid = L; { constexpr int q = nwg / NXCD, r = nwg % NXCD; const int xcd = wgid % NXCD, off = wgid / NXCD; wgid = (xcd < r ? xcd * (q + 1) : r * (q + 1) + (xcd - r) * q) + off; }
        constexpr int nig = WGM * nN; const int gid = wgid / nig, fm = gid * WGM, gsz = (nM - fm) < WGM ? (nM - fm) : WGM;
        u.pm = fm + ((wgid % nig) % gsz); u.pn = (wgid % nig) / gsz;
    }
    __device__ bool next(int i, Unit& u) const { const int L = i * G + c; if (L >= nwg) return false; map(L, u); return true; }
    __device__ __forceinline__ void done(const Unit&, int) const {}
};

struct OutOrder {
    int G, c, mode;
    __device__ bool next(int i, Unit& u) const {
        const int L = i * G + c;
        if (mode == 0) { if (L >= 4) return false; u.pm = 64; u.pn = L; return true; }
        if (L >= 256) return false; StaticOrder<64, 4>::map(L, u); return true;
    }
    __device__ __forceinline__ void done(const Unit&, int) const {}
};

constexpr int IN_UNITS = 65 * 29, IN_DEC_UNITS = 29;
struct InOrder {
    int G, c; unsigned* done_ctr;
    __device__ bool next(int i, Unit& u) const {
        const int L = i * G + c; if (L >= IN_UNITS) return false;
        if (L < IN_DEC_UNITS) { u.pm = 64; u.pn = L; return true; }
        StaticOrder<64, 29>::map(L - IN_DEC_UNITS, u); return true;
    }
    __device__ __forceinline__ void done(const Unit& u, int lane) const {
        if (u.pm == 64) {
            asm volatile("s_waitcnt vmcnt(0)" ::: "memory");
            __builtin_amdgcn_fence(__ATOMIC_RELEASE, "agent");
            asm volatile("s_waitcnt vmcnt(0)" ::: "memory");
            if (lane == 0) __hip_atomic_fetch_add(done_ctr, 1u, __ATOMIC_RELAXED, __HIP_MEMORY_SCOPE_AGENT);
        }
    }
};

template <class Epi, class Sched, int KK>
__device__ __forceinline__ void gemm_phase(LAS unsigned char* lds, const Gemm g, const Sched& S, const Epi& E) {
    const int tid = otid(), wid = __builtin_amdgcn_readfirstlane(tid >> 6), lane = tid & 63, wr = wid >> 2, wc = wid & 3, fr = lane & 15, fq = lane >> 4;
    constexpr int K = KK, nt = K / BK;
    unsigned voffA[2], voffB[2];
#pragma unroll
    for (int i = 0; i < 2; ++i) { int R, C; stage_rc(tid * 16 + i * 8192, R, C); const int Rb = Epi::PERM ? ((R & ~31) + perm32(R & 31)) : R;
        voffA[i] = (unsigned)(R * K + C) * 2u; voffB[i] = (unsigned)(Rb * K + C) * 2u; }
    const size_t kstep = (size_t)(BK * 2);
    const size_t hstep = (size_t)HALF * K * 2;
    const size_t tstep = 2 * hstep;
    const unsigned ldsw = (unsigned)wid * 1024u;
    const int aoff = lds_byte(wr * 64 + fr, fq * 8), boff = lds_byte(wc * 32 + fr, fq * 8);
#define PG8_SA(b, h) (((b) * 2 + (h)) * HTB)
#define PG8_SB(b, h) ((4 + (b) * 2 + (h)) * HTB)
#define PG8_STAGE(bufoff, gbase, voff) do { _Pragma("unroll") for (int _i = 0; _i < 2; ++_i) \
        __builtin_amdgcn_global_load_lds((const unsigned*)((const char*)(gbase) + (voff)[_i]), (LAS unsigned*)(lds + (bufoff) + ldsw + _i * 8192), 16, 0, 0); } while (0)
#define PG8_LDA(dst, b, h) do { _Pragma("unroll") for (int m = 0; m < 4; ++m) _Pragma("unroll") for (int k = 0; k < 2; ++k) dst[m][k] = *(const LAS bf16x8*)(lds + PG8_SA(b, h) + aoff + m * 2048 + k * 1024); } while (0)
#define PG8_LDB(dst, b, h) do { _Pragma("unroll") for (int n = 0; n < 2; ++n) _Pragma("unroll") for (int k = 0; k < 2; ++k) dst[n][k] = *(const LAS bf16x8*)(lds + PG8_SB(b, h) + boff + n * 2048 + k * 1024); } while (0)
#define PG8_MMA(ai, bj, At, Bt) do { __builtin_amdgcn_s_setprio(1); _Pragma("unroll") for (int m = 0; m < 4; ++m) _Pragma("unroll") for (int n = 0; n < 2; ++n) _Pragma("unroll") for (int k = 0; k < 2; ++k) \
        acc[ai][bj][m][n] = __builtin_amdgcn_mfma_f32_16x16x32_bf16(Bt[n][k], At[m][k], acc[ai][bj][m][n], 0, 0, 0); __builtin_amdgcn_s_setprio(0); } while (0)
#define PG8_WAIT_V(n) asm volatile("s_waitcnt vmcnt(" #n ")" ::: "memory")
#define PG8_WAIT_L(n) asm volatile("s_waitcnt lgkmcnt(" #n ")" ::: "memory")
#define PG8_BAR __builtin_amdgcn_s_barrier()
#define PG8_SCHED __builtin_amdgcn_sched_barrier(0)
    Unit cur, nxt; int ui = 0;
    if (!S.next(0, cur)) return;
    f32x4 acc[2][2][4][2];
#pragma unroll
    for (int a = 0; a < 2; ++a)
#pragma unroll
        for (int b = 0; b < 2; ++b)
#pragma unroll
            for (int m = 0; m < 4; ++m)
#pragma unroll
                for (int n = 0; n < 2; ++n) acc[a][b][m][n] = zero4();
    bf16x8 At[4][2], B0[2][2], B1[2][2];
    const char* cA = (const char*)g.A + (size_t)cur.pm * tstep; const char* cB = (const char*)g.Bt + (size_t)cur.pn * tstep;
    PG8_STAGE(PG8_SB(0, 0), cB, voffB); PG8_STAGE(PG8_SA(0, 0), cA, voffA); PG8_STAGE(PG8_SB(0, 1), cB + hstep, voffB); PG8_STAGE(PG8_SA(0, 1), cA + hstep, voffA);
    if (wr == 1) PG8_BAR;
    PG8_WAIT_V(4); PG8_BAR;
    PG8_STAGE(PG8_SB(1, 0), cB + kstep, voffB); PG8_STAGE(PG8_SA(1, 0), cA + kstep, voffA); PG8_STAGE(PG8_SB(1, 1), cB + hstep + kstep, voffB);
    PG8_WAIT_V(6); PG8_BAR;
    for (;;) {
        const bool has_next = S.next(ui + 1, nxt);
        const char* nA = has_next ? (const char*)g.A + (size_t)nxt.pm * tstep : cA; const char* nB = has_next ? (const char*)g.Bt + (size_t)nxt.pn * tstep : cB;
        for (int t = 0; t < nt; t += 2) {
            const bool last = (t == nt - 2);
            const char* a1 = cA + (size_t)(t + 1) * kstep;
            const char* a2 = last ? nA : cA + (size_t)(t + 2) * kstep; const char* b2 = last ? nB : cB + (size_t)(t + 2) * kstep;
            const char* a3 = a2 + kstep; const char* b3 = b2 + kstep;
            PG8_LDB(B0, 0, 0); PG8_SCHED; PG8_LDA(At, 0, 0); PG8_STAGE(PG8_SA(1, 1), a1 + hstep, voffA);
            PG8_WAIT_L(8); PG8_BAR; PG8_WAIT_L(0); PG8_MMA(0, 0, At, B0); PG8_BAR; PG8_SCHED;
            PG8_LDB(B1, 0, 1); PG8_STAGE(PG8_SB(0, 0), b2, voffB);
            PG8_BAR; PG8_WAIT_L(0); PG8_MMA(0, 1, At, B1); PG8_BAR;
            PG8_LDA(At, 0, 1); PG8_STAGE(PG8_SA(0, 0), a2, voffA);
            PG8_BAR; PG8_WAIT_L(0); PG8_MMA(1, 0, At, B0); PG8_BAR; PG8_SCHED;
            PG8_STAGE(PG8_SB(0, 1), b2 + hstep, voffB);
            PG8_WAIT_V(6); PG8_BAR; PG8_MMA(1, 1, At, B1); PG8_BAR;
            PG8_LDB(B0, 1, 0); PG8_SCHED; PG8_LDA(At, 1, 0); PG8_STAGE(PG8_SA(0, 1), a2 + hstep, voffA);
            PG8_WAIT_L(8); PG8_BAR; PG8_WAIT_L(0); PG8_MMA(0, 0, At, B0); PG8_BAR; PG8_SCHED;
            PG8_LDB(B1, 1, 1); PG8_STAGE(PG8_SB(1, 0), b3, voffB);
            PG8_BAR; PG8_WAIT_L(0); PG8_MMA(0, 1, At, B1); PG8_BAR;
            PG8_LDA(At, 1, 1); PG8_STAGE(PG8_SA(1, 0), a3, voffA);
            PG8_BAR; PG8_WAIT_L(0); PG8_MMA(1, 0, At, B0); PG8_BAR; PG8_SCHED;
            PG8_STAGE(PG8_SB(1, 1), b3 + hstep, voffB);
            PG8_WAIT_V(6); PG8_BAR; PG8_MMA(1, 1, At, B1); PG8_BAR;
        }
        E(acc, cur, wr, wc, fr, fq);
        S.done(cur, lane);
        if (!has_next) break;
#pragma unroll
        for (int a = 0; a < 2; ++a)
#pragma unroll
            for (int b = 0; b < 2; ++b)
#pragma unroll
                for (int m = 0; m < 4; ++m)
#pragma unroll
                    for (int n = 0; n < 2; ++n) acc[a][b][m][n] = zero4();
        cur = nxt; cA = nA; cB = nB; ++ui;
    }
    PG8_WAIT_V(0);
    if (wr == 0) PG8_BAR;
    PG8_BAR;
#undef PG8_SA
#undef PG8_SB
#undef PG8_STAGE
#undef PG8_LDA
#undef PG8_LDB
#undef PG8_MMA
#undef PG8_WAIT_V
#undef PG8_WAIT_L
#undef PG8_BAR
#undef PG8_SCHED
}
}

struct EpiIn {
    static constexpr bool PERM = true;
    bf16_t* U; float* G; const float* SS; const float* bmi; const float* bmf;
    __device__ __forceinline__ void operator()(const f32x4 (&acc)[2][2][4][2], const pg8::Unit& u, int wr, int wc, int fr, int fq) const {
        const int row0 = u.pm * 256 + wr * 64 + fr;
        const int pn = u.pn;
        const int mode = ((pn >= 4 && pn < 8) || (pn >= 24 && pn < 28)) ? 1 : ((pn >= 20 && pn < 24) ? 2 : 0);
        f32x4 cur[4];
        { const f32x4* sp = (const f32x4*)(SS + (size_t)row0 * 16); cur[0] = sp[0]; cur[1] = sp[1]; cur[2] = sp[2]; cur[3] = sp[3]; }
#pragma unroll
        for (int r = 0; r < 8; ++r) {
            const int ai = r >> 2, m = r & 3;
            const int row = row0 + ai * 128 + m * 16;
            f32x4 nxt[4];
            if (r < 7) {
                const f32x4* sp = (const f32x4*)(SS + (size_t)(row0 + ((r + 1) >> 2) * 128 + ((r + 1) & 3) * 16) * 16);
                nxt[0] = sp[0]; nxt[1] = sp[1]; nxt[2] = sp[2]; nxt[3] = sp[3];
            }
            const float ss = ((cur[0][0] + cur[0][1]) + (cur[0][2] + cur[0][3])) + ((cur[1][0] + cur[1][1]) + (cur[1][2] + cur[1][3])) + ((cur[2][0] + cur[2][1]) + (cur[2][2] + cur[2][3])) + ((cur[3][0] + cur[3][1]) + (cur[3][2] + cur[3][3]));
            const float rstd = rsqrtf(ss * (1.0f / 1024.0f) + EPSF);
            if (pn < 28) {
                bf16_t* rowp = U + (size_t)row * NU + pn * 256 + wc * 32 + 8 * fq;
#pragma unroll
                for (int bj = 0; bj < 2; ++bj) {
                    f32x4 v0 = acc[ai][bj][m][0] * rstd, v1 = acc[ai][bj][m][1] * rstd;
                    if (mode == 1) {
#pragma unroll
                        for (int j = 0; j < 4; ++j) { v0[j] = siluf_(v0[j]); v1[j] = siluf_(v1[j]); }
                    } else if (mode == 2) {
#pragma unroll
                        for (int j = 0; j < 4; ++j) { v0[j] = sigmoidf_(v0[j]); v1[j] = sigmoidf_(v1[j]); }
                    }
                    u32x4 w; w.x = cvt_pk_bf16(v0[0], v0[1]); w.y = cvt_pk_bf16(v0[2], v0[3]); w.z = cvt_pk_bf16(v1[0], v1[1]); w.w = cvt_pk_bf16(v1[2], v1[3]);
                    *(u32x4*)(rowp + bj * 128) = w;
                }
            } else if (wc == 0 && fq == 0) {
                const f32x4 v0 = acc[ai][0][m][0] * rstd, v1 = acc[ai][0][m][1] * rstd;
                f32x4 gi, gf;
#pragma unroll
                for (int j = 0; j < 4; ++j) { gi[j] = v0[j] + bmi[j]; const float x = v1[j] + bmf[j]; gf[j] = fminf(x, 0.f) - log1pf(__expf(-fabsf(x))); }
                *(f32x4*)(G + (size_t)row * 8) = gi; *(f32x4*)(G + (size_t)row * 8 + 4) = gf;
            }
            if (r < 7) { cur[0] = nxt[0]; cur[1] = nxt[1]; cur[2] = nxt[2]; cur[3] = nxt[3]; }
        }
    }
};

struct EpiOut {
    static constexpr bool PERM = false;
    const float* basep; const float* bases; int split;
    bf16_t* XBo; float* SSo;
    __device__ __forceinline__ void operator()(const f32x4 (&acc)[2][2][4][2], const pg8::Unit& u, int wr, int wc, int fr, int fq) const {
        const int row0 = u.pm * 256 + wr * 64 + fr, col0 = u.pn * 256 + wc * 32 + 4 * fq;
#pragma unroll
        for (int g2 = 0; g2 < 4; ++g2) {
            const int ai = g2 >> 1;
            f32x4 bs[2][2][2];
#pragma unroll
            for (int mm = 0; mm < 2; ++mm) {
                const int m = (g2 & 1) * 2 + mm;
                const int row = row0 + ai * 128 + m * 16;
                if (split) {
                    const float* bp = basep + (size_t)row * DM;
                    bool have = true;
                    if (row >= MV) have = false; else if (row >= MP) bp = bases + (size_t)(row - MP) * DM;
#pragma unroll
                    for (int bj = 0; bj < 2; ++bj)
#pragma unroll
                        for (int n = 0; n < 2; ++n) { bs[mm][bj][n] = zero4(); if (have) bs[mm][bj][n] = *(const f32x4*)(bp + col0 + bj * 128 + n * 16); }
                } else {
#pragma unroll
                    for (int bj = 0; bj < 2; ++bj)
#pragma unroll
                        for (int n = 0; n < 2; ++n) { const u32x2 v = *(const u32x2*)(XBo + (size_t)row * DM + col0 + bj * 128 + n * 16); bs[mm][bj][n] = (f32x4){lo16(v.x), hi16(v.x), lo16(v.y), hi16(v.y)}; }
                }
            }
#pragma unroll
            for (int mm = 0; mm < 2; ++mm) {
                const int m = (g2 & 1) * 2 + mm;
                const int row = row0 + ai * 128 + m * 16;
                float ss = 0.f;
#pragma unroll
                for (int bj = 0; bj < 2; ++bj)
#pragma unroll
                    for (int n = 0; n < 2; ++n) {
                        const int c = col0 + bj * 128 + n * 16;
                        const f32x4 o = bs[mm][bj][n] + acc[ai][bj][m][n];
                        u32x2 w; w.x = cvt_pk_bf16(o[0], o[1]); w.y = cvt_pk_bf16(o[2], o[3]); *(u32x2*)(XBo + (size_t)row * DM + c) = w;
                        ss += (o[0] * o[0] + o[1] * o[1]) + (o[2] * o[2] + o[3] * o[3]);
                    }
                ss += __shfl_xor(ss, 16); ss += __shfl_xor(ss, 32);
                if (fq == 0) SSo[(size_t)row * 16 + u.pn * 4 + wc] = ss;
            }
        }
    }
};

__device__ void transpose_tile(const float* src, int ldn, int nvalid, int k0, int n0, bf16_t* dst, int ldk, const float* sk, float sn, LAS float* T) {
    const int tid = otid();
    {
        const int r = tid >> 4, c4 = tid & 15;
#pragma unroll
        for (int i = 0; i < 2; ++i) {
            const int k = r + 32 * i; const int n = n0 + 4 * c4;
            f32x4 v = zero4();
            if (n + 3 < nvalid) v = *(const f32x4*)(src + (size_t)(k0 + k) * ldn + n);
            const float s = (sk ? sk[k0 + k] : 1.0f) * sn;
            T[k * 65 + 4 * c4 + 0] = v[0] * s; T[k * 65 + 4 * c4 + 1] = v[1] * s; T[k * 65 + 4 * c4 + 2] = v[2] * s; T[k * 65 + 4 * c4 + 3] = v[3] * s;
        }
    }
    __syncthreads();
    {
        const int n = tid >> 3, kq = tid & 7;
        float f[8];
#pragma unroll
        for (int j = 0; j < 8; ++j) f[j] = T[(kq * 8 + j) * 65 + n];
        u32x4 w; w.x = cvt_pk_bf16(f[0], f[1]); w.y = cvt_pk_bf16(f[2], f[3]); w.z = cvt_pk_bf16(f[4], f[5]); w.w = cvt_pk_bf16(f[6], f[7]);
        *(u32x4*)(dst + (size_t)(n0 + n) * ldk + k0 + kq * 8) = w;
    }
    __syncthreads();
}

__device__ void phase_prep(const Params& p, LAS unsigned char* lds) {
    LAS float* T = (LAS float*)lds;
    bf16_t* WT1 = (bf16_t*)(p.ws + WS_WT1); bf16_t* WT2 = (bf16_t*)(p.ws + WS_WT2); bf16_t* WGT = (bf16_t*)(p.ws + WS_WGT);
    bf16_t* XB = (bf16_t*)(p.ws + WS_XB); float* SS = (float*)(p.ws + WS_SS); bf16_t* MG = (bf16_t*)(p.ws + WS_MG);
    constexpr int JA = 2 * 16 * 116, JB = 2 * 32 * 16, JC = 64, JD = MR / 8;
    for (int job = blockIdx.x; job < JA + JB + JC + JD; job += gridDim.x) {
        if (job < JA) {
            const int l = job / (16 * 116), r = job % (16 * 116), ntile = r / 16, kt = r % 16;
            const int n0 = ntile * 64;
            const float sn = (n0 >= 3072 && n0 < 4096) ? 0.0625f : 1.0f;
            transpose_tile(p.w_in + (size_t)l * DM * DIN, DIN, DIN, kt * 64, n0, WT1 + (size_t)l * NW1 * DM, DM, p.g_norm + l * DM, sn, T);
        } else if (job < JA + JB) {
            const int j = job - JA, l = j / 512, r = j % 512, ntile = r / 32, kt = r % 32;
            transpose_tile(p.w_out + (size_t)l * DMG * DM, DM, DM, kt * 64, ntile * 64, WT2 + (size_t)l * DM * DMG, DMG, nullptr, 1.0f, T);
        } else if (job < JA + JB + JC) {
            const int j = job - JA - JB, l = j >> 5, gate = (j >> 4) & 1, blk = j & 15;
            const float* src = (gate ? p.w_i : p.w_r) + (size_t)(l * 16 + blk) * 4096;
            transpose_tile(src, 64, 64, 0, 0, WGT + (size_t)((l * 2 + gate) * 16 + blk) * 4096, 64, nullptr, 1.0f, T);
        } else {
            const int j = job - JA - JB - JC; const int tidp = otid(); const int wid = tidp >> 6, lane = tidp & 63;
            const int row = j * 8 + wid;
            const float* src = row < MP ? p.xp + (size_t)row * DM : (row < MV ? p.xs + (size_t)(row - MP) * DM : nullptr);
            f32x4 v[4]; float ss = 0.f;
#pragma unroll
            for (int i = 0; i < 4; ++i) { v[i] = src ? *(const f32x4*)(src + lane * 16 + i * 4) : zero4(); ss += (v[i][0] * v[i][0] + v[i][1] * v[i][1]) + (v[i][2] * v[i][2] + v[i][3] * v[i][3]); }
#pragma unroll
            for (int o = 32; o >= 1; o >>= 1) ss += __shfl_xor(ss, o);
            u32x4 w0, w1;
            w0.x = cvt_pk_bf16(v[0][0], v[0][1]); w0.y = cvt_pk_bf16(v[0][2], v[0][3]); w0.z = cvt_pk_bf16(v[1][0], v[1][1]); w0.w = cvt_pk_bf16(v[1][2], v[1][3]);
            w1.x = cvt_pk_bf16(v[2][0], v[2][1]); w1.y = cvt_pk_bf16(v[2][2], v[2][3]); w1.z = cvt_pk_bf16(v[3][0], v[3][1]); w1.w = cvt_pk_bf16(v[3][2], v[3][3]);
            *(u32x4*)(XB + (size_t)row * DM + lane * 16) = w0; *(u32x4*)(XB + (size_t)row * DM + lane * 16 + 8) = w1;
            if (lane < 16) SS[(size_t)row * 16 + lane] = lane == 0 ? ss : 0.f;
            if (row >= MV) { const u32x4 z = (u32x4){0u, 0u, 0u, 0u}; u32x4* mp = (u32x4*)(MG + (size_t)row * DMG + lane * 32); mp[0] = z; mp[1] = z; mp[2] = z; mp[3] = z; }
        }
    }
}

constexpr int M_QI = 0, M_KI = 38912, M_VI = 77824, M_CTI = 96256, M_SM = 130048;
constexpr int RS_QK = 304, RS_V = 144, RS_CT = 528;

template <int OFF0, int OFF1>
__device__ __forceinline__ bf16x8 tr_frag(unsigned base) {
    bf16x4 lo, hi;
    asm volatile("ds_read_b64_tr_b16 %0, %2 offset:%3\n\tds_read_b64_tr_b16 %1, %2 offset:%4\n\ts_waitcnt lgkmcnt(0)" : "=&v"(lo), "=&v"(hi) : "v"(base), "i"(OFF0), "i"(OFF1) : "memory");
    bf16x8 r; r[0] = lo[0]; r[1] = lo[1]; r[2] = lo[2]; r[3] = lo[3]; r[4] = hi[0]; r[5] = hi[1]; r[6] = hi[2]; r[7] = hi[3]; return r;
}

template <int O0, int O1, int HI>
__device__ __forceinline__ void tr_frag2(unsigned base, bf16x8& f0, bf16x8& f1) {
    bf16x4 a0, a1, b0, b1;
    asm volatile("ds_read_b64_tr_b16 %0, %4 offset:%5\n\tds_read_b64_tr_b16 %1, %4 offset:%6\n\tds_read_b64_tr_b16 %2, %4 offset:%7\n\tds_read_b64_tr_b16 %3, %4 offset:%8\n\ts_waitcnt lgkmcnt(0)"
                 : "=&v"(a0), "=&v"(a1), "=&v"(b0), "=&v"(b1) : "v"(base), "i"(O0), "i"(O0 + HI), "i"(O1), "i"(O1 + HI) : "memory");
    f0 = __builtin_shufflevector(a0, a1, 0, 1, 2, 3, 4, 5, 6, 7); f1 = __builtin_shufflevector(b0, b1, 0, 1, 2, 3, 4, 5, 6, 7);
}
template <int KS>
__device__ __forceinline__ void mlstm_D(f32x4 (&CT)[8], unsigned bvD, unsigned bkD) {
    const bf16x8 vdf = tr_frag<KS * 32 * RS_V, KS * 32 * RS_V + 4 * RS_V>(bvD);
    bf16x8 k0, k1;
    tr_frag2<KS * 32 * RS_QK + 0, KS * 32 * RS_QK + 32, 4 * RS_QK>(bkD, k0, k1);
    CT[0] = __builtin_amdgcn_mfma_f32_16x16x32_bf16(k0, vdf, CT[0], 0, 0, 0);
    CT[1] = __builtin_amdgcn_mfma_f32_16x16x32_bf16(k1, vdf, CT[1], 0, 0, 0);
    tr_frag2<KS * 32 * RS_QK + 64, KS * 32 * RS_QK + 96, 4 * RS_QK>(bkD, k0, k1);
    CT[2] = __builtin_amdgcn_mfma_f32_16x16x32_bf16(k0, vdf, CT[2], 0, 0, 0);
    CT[3] = __builtin_amdgcn_mfma_f32_16x16x32_bf16(k1, vdf, CT[3], 0, 0, 0);
    tr_frag2<KS * 32 * RS_QK + 128, KS * 32 * RS_QK + 160, 4 * RS_QK>(bkD, k0, k1);
    CT[4] = __builtin_amdgcn_mfma_f32_16x16x32_bf16(k0, vdf, CT[4], 0, 0, 0);
    CT[5] = __builtin_amdgcn_mfma_f32_16x16x32_bf16(k1, vdf, CT[5], 0, 0, 0);
    tr_frag2<KS * 32 * RS_QK + 192, KS * 32 * RS_QK + 224, 4 * RS_QK>(bkD, k0, k1);
    CT[6] = __builtin_amdgcn_mfma_f32_16x16x32_bf16(k0, vdf, CT[6], 0, 0, 0);
    CT[7] = __builtin_amdgcn_mfma_f32_16x16x32_bf16(k1, vdf, CT[7], 0, 0, 0);
}
template <int O, int STEP, int HI>
__device__ __forceinline__ void tr_frag4(unsigned base, bf16x8& f0, bf16x8& f1, bf16x8& f2, bf16x8& f3) {
    bf16x4 a0, a1, b0, b1, c0, c1, d0, d1;
    asm volatile("ds_read_b64_tr_b16 %0, %8 offset:%9\n\tds_read_b64_tr_b16 %1, %8 offset:%10\n\tds_read_b64_tr_b16 %2, %8 offset:%11\n\tds_read_b64_tr_b16 %3, %8 offset:%12\n\t"
                 "ds_read_b64_tr_b16 %4, %8 offset:%13\n\tds_read_b64_tr_b16 %5, %8 offset:%14\n\tds_read_b64_tr_b16 %6, %8 offset:%15\n\tds_read_b64_tr_b16 %7, %8 offset:%16\n\ts_waitcnt lgkmcnt(0)"
                 : "=&v"(a0), "=&v"(a1), "=&v"(b0), "=&v"(b1), "=&v"(c0), "=&v"(c1), "=&v"(d0), "=&v"(d1)
                 : "v"(base), "i"(O), "i"(O + HI), "i"(O + STEP), "i"(O + STEP + HI), "i"(O + 2 * STEP), "i"(O + 2 * STEP + HI), "i"(O + 3 * STEP), "i"(O + 3 * STEP + HI) : "memory");
    f0 = __builtin_shufflevector(a0, a1, 0, 1, 2, 3, 4, 5, 6, 7); f1 = __builtin_shufflevector(b0, b1, 0, 1, 2, 3, 4, 5, 6, 7);
    f2 = __builtin_shufflevector(c0, c1, 0, 1, 2, 3, 4, 5, 6, 7); f3 = __builtin_shufflevector(d0, d1, 0, 1, 2, 3, 4, 5, 6, 7);
}
template <int KS>
__device__ __forceinline__ void mlstm_B(f32x4 (&N1)[4], LAS unsigned char* lds, unsigned bvB, int t, int fq) {
    const bf16x8 pf = *(const LAS bf16x8*)(lds + M_QI + t * RS_QK + KS * 64 + fq * 16);
    bf16x8 v0, v1, v2, v3;
    tr_frag4<KS * 32 * RS_V, 32, 4 * RS_V>(bvB, v0, v1, v2, v3);
    N1[0] = __builtin_amdgcn_mfma_f32_16x16x32_bf16(v0, pf, N1[0], 0, 0, 0);
    N1[1] = __builtin_amdgcn_mfma_f32_16x16x32_bf16(v1, pf, N1[1], 0, 0, 0);
    N1[2] = __builtin_amdgcn_mfma_f32_16x16x32_bf16(v2, pf, N1[2], 0, 0, 0);
    N1[3] = __builtin_amdgcn_mfma_f32_16x16x32_bf16(v3, pf, N1[3], 0, 0, 0);
}

__device__ void mlstm_prompt(const Params& p, int l, int item, LAS unsigned char* lds) {
    const int tid0 = otid();
    const int js = item & 3, h = (item >> 2) & 3, b = item >> 4;
    const unsigned ldsb = (unsigned)(size_t)lds;
    LAS float* sm = (LAS float*)(lds + M_SM);
    LAS float* nbuf = sm + 512; LAS float* npart = sm + 1552;
    const bf16_t* U = (const bf16_t*)(p.ws + WS_U); const float* G = (const float*)(p.ws + WS_G);
    bf16_t* MG = (bf16_t*)(p.ws + WS_MG);
    const size_t grow_base = (size_t)b * 2048;
    const int qcol = 2048 + h * 256, kcol = 3072 + h * 256, vcol = 4096 + h * 256 + js * 64;

    __syncthreads();
    for (int i = tid0; i < RS_CT * 64 / 16; i += NT) *(LAS u32x4*)(lds + M_CTI + i * 16) = (u32x4){0u, 0u, 0u, 0u};
    nbuf[tid0] = 0.f;
    f32x4 CTacc[8];
#pragma unroll
    for (int i = 0; i < 8; ++i) CTacc[i] = zero4();
    float m_prev = 0.f;
    u32x4 qreg[4], kreg[4], vreg[2]; float igr[2] = {0.f, 0.f}, lfr[2] = {0.f, 0.f};

#define ML_LOAD_QK(row0_, hd_) do { _Pragma("unroll") for (int i_ = 0; i_ < 4; ++i_) { const int id_ = tid + NT * i_, r_ = id_ >> 4, cq_ = id_ & 15; \
        const bf16_t* rp_ = U + (grow_base + (row0_) + r_) * NU + (hd_) * 128 + cq_ * 8; qreg[i_] = *(const u32x4*)(rp_ + qcol); kreg[i_] = *(const u32x4*)(rp_ + kcol); } } while (0)
#define ML_STORE_QK() do { _Pragma("unroll") for (int i_ = 0; i_ < 4; ++i_) { const int id_ = tid + NT * i_, r_ = id_ >> 4, cq_ = id_ & 15; \
        *(LAS u32x4*)(lds + M_QI + r_ * RS_QK + cq_ * 16) = qreg[i_]; *(LAS u32x4*)(lds + M_KI + r_ * RS_QK + cq_ * 16) = kreg[i_]; } } while (0)
#define ML_LOAD_VG(row0_) do { _Pragma("unroll") for (int i_ = 0; i_ < 2; ++i_) { const int id_ = tid + NT * i_, s_ = id_ >> 3, cq_ = id_ & 7; \
        vreg[i_] = *(const u32x4*)(U + (grow_base + (row0_) + s_) * NU + vcol + cq_ * 8); } \
        if (w == 0) { const float* gp_ = G + (grow_base + (row0_) + 2 * lane) * 8 + h; igr[0] = gp_[0]; lfr[0] = gp_[4]; igr[1] = gp_[8]; lfr[1] = gp_[12]; } } while (0)

#define ML_PREPASS(buf_) do { if (w == 0) { LAS float* dec_ = sm + 128 * (buf_); LAS float* expnm_ = sm + 256 + 128 * (buf_); LAS float* scal_ = sm + 1024 + 8 * (buf_); \
            const float s2 = lfr[0] + lfr[1]; float incl = s2; \
            _Pragma("unroll") for (int o = 1; o < 64; o <<= 1) { const float t_ = __shfl_up(incl, o); if (lane >= o) incl += t_; } \
            const float b0 = incl - s2 + lfr[0], b1 = incl; \
            const float a0 = igr[0] - b0, a1 = igr[1] - b1; float im = fmaxf(a0, a1); \
            _Pragma("unroll") for (int o = 1; o < 64; o <<= 1) { const float t_ = __shfl_up(im, o); if (lane >= o) im = fmaxf(im, t_); } \
            float ex = __shfl_up(im, 1); if (lane == 0) ex = -INFINITY; \
            const float M0 = fmaxf(ex, a0), M1 = fmaxf(M0, a1); \
            const float mt1 = b1 + fmaxf(m_prev, M1); \
            const float bL = __shfl(b1, 63), mL = __shfl(mt1, 63); \
            expnm_[2 * lane] = __expf(bL - mL - b0); expnm_[2 * lane + 1] = __expf(bL - mL - b1); \
            dec_[2 * lane] = __expf(bL - b0 + igr[0] - mL); dec_[2 * lane + 1] = __expf(bL - b1 + igr[1] - mL); \
            if (lane == 0) { scal_[0] = __expf(bL + m_prev - mL); scal_[1] = mL; } \
            m_prev = mL; } } while (0)
    { const int tid = tid0, w = tid >> 6, lane = tid & 63; ML_LOAD_QK(0, 0); ML_LOAD_VG(0); ML_PREPASS(0); }
#pragma unroll 1
    for (int c = 0; c < 16; ++c) {
        int tid = tid0; asm volatile("" : "+v"(tid));
        const int w = __builtin_amdgcn_readfirstlane(tid >> 6), lane = tid & 63, fr = lane & 15, fq = lane >> 4;
        const int cD = w & 3, gD = w >> 2, qq = (lane & 15) >> 2, pp = lane & 3;
        const unsigned bvB = ldsb + M_VI + (8 * fq + qq) * RS_V + 8 * pp;
        const unsigned bvD = bvB + cD * 32;
        const int row0 = c * 128;
        LAS float* nC = nbuf + (c & 1) * 256; LAS float* nN = nbuf + ((c + 1) & 1) * 256;
        __syncthreads();
        ML_STORE_QK();
        LAS float* dec = sm + 128 * (c & 1); LAS float* expnm = sm + 256 + 128 * (c & 1); LAS float* scal = sm + 1024 + 8 * (c & 1);
        const float cs = scal[0];
#pragma unroll
        for (int i = 0; i < 2; ++i) {
            const int id = tid + NT * i, s = id >> 3, cq = id & 7; const float d = dec[s];
            u32x4 v = vreg[i], o;
            o.x = cvt_pk_bf16(lo16(v.x) * d, hi16(v.x) * d); o.y = cvt_pk_bf16(lo16(v.y) * d, hi16(v.y) * d);
            o.z = cvt_pk_bf16(lo16(v.z) * d, hi16(v.z) * d); o.w = cvt_pk_bf16(lo16(v.w) * d, hi16(v.w) * d);
            *(LAS u32x4*)(lds + M_VI + s * RS_V + cq * 16) = o;
        }
        if (tid < 256) nN[tid] = cs * nC[tid];
        ML_LOAD_QK(row0, 1);
        f32x4 Sacc[8], N2[4];
#pragma unroll
        for (int i = 0; i < 8; ++i) Sacc[i] = zero4();
#pragma unroll
        for (int i = 0; i < 4; ++i) N2[i] = zero4();
        float qnp = 0.f;
#pragma unroll 1
        for (int hd = 0; hd < 2; ++hd) {
            __syncthreads();
#pragma unroll
            for (int ks = 0; ks < 4; ++ks) {
                const bf16x8 qf = *(const LAS bf16x8*)(lds + M_QI + (16 * w + fr) * RS_QK + ks * 64 + fq * 16);
#pragma unroll
                for (int g = 0; g < 2; ++g) if (4 * g <= w) {
                    bf16x8 kf[4];
#pragma unroll
                    for (int e = 0; e < 4; ++e) kf[e] = *(const LAS bf16x8*)(lds + M_KI + (64 * g + 16 * e + fr) * RS_QK + ks * 64 + fq * 16);
#pragma unroll
                    for (int e = 0; e < 4; ++e) Sacc[4 * g + e] = __builtin_amdgcn_mfma_f32_16x16x32_bf16(kf[e], qf, Sacc[4 * g + e], 0, 0, 0);
                }
#pragma unroll
                for (int c4 = 0; c4 < 4; ++c4) {
                    const bf16x8 ctf = *(const LAS bf16x8*)(lds + M_CTI + (16 * c4 + fr) * RS_CT + hd * 256 + ks * 64 + fq * 16);
                    N2[c4] = __builtin_amdgcn_mfma_f32_16x16x32_bf16(ctf, qf, N2[c4], 0, 0, 0);
                }
                const LAS float* np = nC + hd * 128 + ks * 32 + fq * 8;
#pragma unroll
                for (int j = 0; j < 8; ++j) qnp += bf2f((unsigned short)qf[j]) * np[j];
                __builtin_amdgcn_sched_barrier(0);
            }
            if (gD == hd) {
                const unsigned bkD = ldsb + M_KI + (8 * fq + qq) * RS_QK + 8 * pp;
#pragma unroll
                for (int i = 0; i < 8; ++i) CTacc[i] *= cs;
                mlstm_D<0>(CTacc, bvD, bkD); __builtin_amdgcn_sched_barrier(0); mlstm_D<1>(CTacc, bvD, bkD); __builtin_amdgcn_sched_barrier(0); mlstm_D<2>(CTacc, bvD, bkD); __builtin_amdgcn_sched_barrier(0); mlstm_D<3>(CTacc, bvD, bkD); __builtin_amdgcn_sched_barrier(0);
            }
            if (gD != hd) {
                const int lidx = (w & 3) * 64 + lane, dk4 = lidx & 31, part = lidx >> 5; float a0 = 0.f, a1 = 0.f, a2 = 0.f, a3 = 0.f;
#pragma unroll 2
                for (int s = 16 * part; s < 16 * part + 16; ++s) {
                    const u32x2 kv = *(const LAS u32x2*)(lds + M_KI + s * RS_QK + dk4 * 8); const float d = dec[s];
                    a0 += d * lo16(kv.x); a1 += d * hi16(kv.x); a2 += d * lo16(kv.y); a3 += d * hi16(kv.y);
                }
                *(LAS f32x4*)(npart + part * 128 + 4 * dk4) = (f32x4){a0, a1, a2, a3};
            }
            __syncthreads();
            if (tid < 128) nN[hd * 128 + tid] += ((npart[tid] + npart[128 + tid]) + (npart[256 + tid] + npart[384 + tid])) + ((npart[512 + tid] + npart[640 + tid]) + (npart[768 + tid] + npart[896 + tid]));
            if (gD == hd) {
#pragma unroll
                for (int i = 0; i < 8; ++i) {
                    u32x2 wv; wv.x = cvt_pk_bf16(CTacc[i][0], CTacc[i][1]); wv.y = cvt_pk_bf16(CTacc[i][2], CTacc[i][3]);
                    *(LAS u32x2*)(lds + M_CTI + (16 * cD + fr) * RS_CT + (hd * 128 + 16 * i + 4 * fq) * 2) = wv;
                }
            }
            if (hd == 0) {
                ML_STORE_QK();
                if (c < 15) { ML_LOAD_QK(row0 + 128, 0); }
            }
        }
        if (c < 15) { ML_LOAD_VG(row0 + 128); }
        const int t = 16 * w + fr;
        float den1 = 0.f;
#pragma unroll
        for (int g = 0; g < 4; ++g) if (2 * g <= w) {
            const f32x4 dv0 = *(const LAS f32x4*)(dec + 32 * g + 4 * fq), dv1 = *(const LAS f32x4*)(dec + 32 * g + 16 + 4 * fq);
            f32x4 s0 = Sacc[2 * g], s1 = Sacc[2 * g + 1];
#pragma unroll
            for (int j = 0; j < 4; ++j) {
                const int sa = 32 * g + 4 * fq + j, sb = sa + 16;
                if (sa > t) s0[j] = 0.f;
                if (sb > t || 2 * g + 1 > w) s1[j] = 0.f;
                den1 += s0[j] * dv0[j] + s1[j] * dv1[j];
            }
            u32x2 w0, w1; w0.x = cvt_pk_bf16(s0[0], s0[1]); w0.y = cvt_pk_bf16(s0[2], s0[3]); w1.x = cvt_pk_bf16(s1[0], s1[1]); w1.y = cvt_pk_bf16(s1[2], s1[3]);
            *(LAS u32x2*)(lds + M_QI + t * RS_QK + (32 * g + 4 * fq) * 2) = w0;
            *(LAS u32x2*)(lds + M_QI + t * RS_QK + (32 * g + 16 + 4 * fq) * 2) = w1;
        }
        den1 += __shfl_xor(den1, 16); den1 += __shfl_xor(den1, 32);
        qnp += __shfl_xor(qnp, 16); qnp += __shfl_xor(qnp, 32);
#pragma unroll
        for (int i = 0; i < 4; ++i) N2[i] *= cs;
        if (0 <= (w >> 1)) mlstm_B<0>(N2, lds, bvB, t, fq);
        if (1 <= (w >> 1)) mlstm_B<1>(N2, lds, bvB, t, fq);
        if (2 <= (w >> 1)) mlstm_B<2>(N2, lds, bvB, t, fq);
        if (3 <= (w >> 1)) mlstm_B<3>(N2, lds, bvB, t, fq);
        {
            const float den = den1 + cs * qnp;
            const float inv = 1.0f / fmaxf(fabsf(den), expnm[t]);
            const size_t grow = grow_base + row0 + t;
#pragma unroll
            for (int c4 = 0; c4 < 4; ++c4) {
                const float y0 = N2[c4][0] * inv, y1 = N2[c4][1] * inv, y2 = N2[c4][2] * inv, y3 = N2[c4][3] * inv;
                u32x2 wv; wv.x = cvt_pk_bf16(y0, y1); wv.y = cvt_pk_bf16(y2, y3);
                *(u32x2*)(MG + grow * DMG + 1024 + h * 256 + js * 64 + 16 * c4 + 4 * fq) = wv;
            }
        }
        if (c < 15) ML_PREPASS((c + 1) & 1);
    }
    __syncthreads();
    {
        const int tid = tid0, w = tid >> 6, lane = tid & 63, fr = lane & 15, fq = lane >> 4, cD = w & 3, gD = w >> 2;
        float* pC = p.out + O_PC + ((size_t)((l * 8 + b) * 4 + h)) * 65536;
#pragma unroll
        for (int i = 0; i < 8; ++i)
#pragma unroll
            for (int j = 0; j < 4; ++j) pC[(size_t)(gD * 128 + 16 * i + 4 * fq + j) * 256 + js * 64 + 16 * cD + fr] = CTacc[i][j];
        if (js == 0) {
            if (tid < 256) p.out[O_PN + ((size_t)((l * 8 + b) * 4 + h)) * 256 + tid] = nbuf[tid];
            if (tid == 0) p.out[O_PM + (l * 8 + b) * 4 + h] = sm[1024 + 8 + 1];
        }
    }
    __syncthreads();
#undef ML_LOAD_QK
#undef ML_STORE_QK
#undef ML_LOAD_VG
#undef ML_PREPASS
}

constexpr int R_XAI = 0, R_XCF = 16768, R_XCB = 49536, R_AA = 67968, R_UU = 100736, R_PT = 133504, R_HC = 137600, R_CW = 138112, R_CH = 139392, R_WG = 140160;
__device__ void rglru_item(const Params& p, int l, int b, int cb, bool decm, LAS unsigned char* lds) {
    const int tid = otid(), w = __builtin_amdgcn_readfirstlane(tid >> 6), lane = tid & 63, fr = lane & 15, fq = lane >> 4;
    const bf16_t* U = (const bf16_t*)(p.ws + WS_U); bf16_t* MG = (bf16_t*)(p.ws + WS_MG);
    const bf16_t* WGT = (const bf16_t*)(p.ws + WS_WGT);
    LAS float* XCF = (LAS float*)(lds + R_XCF); LAS float* AA = (LAS float*)(lds + R_AA); LAS float* UU = (LAS float*)(lds + R_UU);
    LAS float* PT = (LAS float*)(lds + R_PT); LAS float* HC = (LAS float*)(lds + R_HC); LAS float* CW = (LAS float*)(lds + R_CW); LAS float* CH = (LAS float*)(lds + R_CH);
    const int ch0 = cb * 64;
    const size_t grow_base = decm ? (size_t)MP : (size_t)b * 2048;
    const int nchunk = decm ? 1 : 16;
    __syncthreads();
    if (tid < 64) {
        const int ch = ch0 + tid;
#pragma unroll
        for (int j = 0; j < 4; ++j) CW[j * 64 + tid] = p.conv_w[(size_t)(l * 4 + j) * 1024 + ch];
        CW[256 + tid] = p.conv_b[l * 1024 + ch];
        CH[tid] = p.b_r[l * 1024 + ch]; CH[64 + tid] = p.b_i[l * 1024 + ch]; CH[128 + tid] = 8.0f * softplusf_(-p.lam[l * 1024 + ch]);
        HC[tid] = 0.f; HC[64 + tid] = 0.f;
    }
    if (tid < 24) *(LAS u32x4*)(lds + R_XAI + tid * 16) = (u32x4){0u, 0u, 0u, 0u};
#pragma unroll
    for (int i = 0; i < 2; ++i) {
        const int id = tid + NT * i, g = id >> 9, r = (id >> 3) & 63, cq = id & 7;
        *(LAS u32x4*)(lds + R_WG + (g * 64 + r) * 144 + cq * 16) = *(const u32x4*)(WGT + (size_t)((l * 2 + g) * 16 + cb) * 4096 + r * 64 + cq * 8);
    }
    u32x4 xreg[2], zreg[2];
#pragma unroll
    for (int i = 0; i < 2; ++i) { const int id = tid + NT * i, r = id >> 3, cq = id & 7; const bf16_t* rp = U + (grow_base + r) * NU + ch0 + cq * 8; xreg[i] = *(const u32x4*)rp; zreg[i] = *(const u32x4*)(rp + 1024); }
    for (int c = 0; c < nchunk; ++c) {
        const int row0 = c * 128;
        __syncthreads();
        if (c > 0) {
#pragma unroll
            for (int i = 0; i < 2; ++i) { const int id = tid + NT * i, r = id >> 3, cq = id & 7; *(u32x4*)(MG + (grow_base + row0 - 128 + r) * DMG + ch0 + cq * 8) = *(const LAS u32x4*)(lds + R_XCF + r * 128 + cq * 16); }
        }
        u32x4 zcur[2];
#pragma unroll
        for (int i = 0; i < 2; ++i) { const int id = tid + NT * i, r = id >> 3, cq = id & 7; *(LAS u32x4*)(lds + R_XAI + (3 + r) * 128 + cq * 16) = xreg[i]; zcur[i] = zreg[i]; }
        if (c + 1 < nchunk) {
#pragma unroll
            for (int i = 0; i < 2; ++i) { const int id = tid + NT * i, r = id >> 3, cq = id & 7; const bf16_t* rp = U + (grow_base + row0 + 128 + r) * NU + ch0 + cq * 8; xreg[i] = *(const u32x4*)rp; zreg[i] = *(const u32x4*)(rp + 1024); }
        }
        __syncthreads();
        {
            const int t = tid >> 2, c0 = (tid & 3) * 16;
            float xc[16];
#pragma unroll
            for (int k = 0; k < 16; ++k) xc[k] = CW[256 + c0 + k];
            if (!decm) {
#pragma unroll
                for (int j = 0; j < 4; ++j) {
                    const u32x4 a = *(const LAS u32x4*)(lds + R_XAI + (t + j) * 128 + c0 * 2), bq = *(const LAS u32x4*)(lds + R_XAI + (t + j) * 128 + c0 * 2 + 16);
                    const unsigned wv[8] = {a.x, a.y, a.z, a.w, bq.x, bq.y, bq.z, bq.w};
#pragma unroll
                    for (int k = 0; k < 8; ++k) { xc[2 * k] += CW[j * 64 + c0 + 2 * k] * lo16(wv[k]); xc[2 * k + 1] += CW[j * 64 + c0 + 2 * k + 1] * hi16(wv[k]); }
                }
            } else {
                const float* stp = p.st_conv + ((size_t)(l * 128 + t) * 3) * 1024 + ch0 + c0;
                float* so = p.out + O_SCONV + ((size_t)(l * 128 + t) * 3) * 1024 + ch0 + c0;
#pragma unroll
                for (int j = 0; j < 3; ++j)
#pragma unroll
                    for (int k4 = 0; k4 < 4; ++k4) {
                        const f32x4 sv = *(const f32x4*)(stp + (size_t)j * 1024 + k4 * 4);
#pragma unroll
                        for (int e = 0; e < 4; ++e) xc[k4 * 4 + e] += CW[j * 64 + c0 + k4 * 4 + e] * sv[e];
                        if (j >= 1) *(f32x4*)(so + (size_t)(j - 1) * 1024 + k4 * 4) = sv;
                    }
                const u32x4 a = *(const LAS u32x4*)(lds + R_XAI + (t + 3) * 128 + c0 * 2), bq = *(const LAS u32x4*)(lds + R_XAI + (t + 3) * 128 + c0 * 2 + 16);
                const unsigned wv[8] = {a.x, a.y, a.z, a.w, bq.x, bq.y, bq.z, bq.w};
#pragma unroll
                for (int k = 0; k < 8; ++k) {
                    const float x0 = lo16(wv[k]), x1 = hi16(wv[k]);
                    xc[2 * k] += CW[3 * 64 + c0 + 2 * k] * x0; xc[2 * k + 1] += CW[3 * 64 + c0 + 2 * k + 1] * x1;
                    so[2 * 1024 + 2 * k] = x0; so[2 * 1024 + 2 * k + 1] = x1;
                }
            }
#pragma unroll
            for (int k4 = 0; k4 < 4; ++k4) *(LAS f32x4*)(XCF + t * 64 + c0 + k4 * 4) = (f32x4){xc[k4 * 4], xc[k4 * 4 + 1], xc[k4 * 4 + 2], xc[k4 * 4 + 3]};
            u32x4 o0, o1;
            o0.x = cvt_pk_bf16(xc[0], xc[1]); o0.y = cvt_pk_bf16(xc[2], xc[3]); o0.z = cvt_pk_bf16(xc[4], xc[5]); o0.w = cvt_pk_bf16(xc[6], xc[7]);
            o1.x = cvt_pk_bf16(xc[8], xc[9]); o1.y = cvt_pk_bf16(xc[10], xc[11]); o1.z = cvt_pk_bf16(xc[12], xc[13]); o1.w = cvt_pk_bf16(xc[14], xc[15]);
            *(LAS u32x4*)(lds + R_XCB + t * 144 + c0 * 2) = o0; *(LAS u32x4*)(lds + R_XCB + t * 144 + c0 * 2 + 16) = o1;
        }
        __syncthreads();
        if (!decm && tid < 24) { const u32x4 v = *(const LAS u32x4*)(lds + R_XAI + 128 * 128 + tid * 16); *(LAS u32x4*)(lds + R_XAI + tid * 16) = v; }
        {
            bf16x8 xf[2];
#pragma unroll
            for (int ks = 0; ks < 2; ++ks) xf[ks] = *(const LAS bf16x8*)(lds + R_XCB + (16 * w + fr) * 144 + ks * 64 + fq * 16);
            const int t = 16 * w + fr;
#pragma unroll
            for (int c4 = 0; c4 < 4; ++c4) {
                f32x4 ar = zero4(), ai = ar;
#pragma unroll
                for (int ks = 0; ks < 2; ++ks) {
                    const bf16x8 wfr = *(const LAS bf16x8*)(lds + R_WG + (16 * c4 + fr) * 144 + ks * 64 + fq * 16);
                    const bf16x8 wfi = *(const LAS bf16x8*)(lds + R_WG + (64 + 16 * c4 + fr) * 144 + ks * 64 + fq * 16);
                    ar = __builtin_amdgcn_mfma_f32_16x16x32_bf16(wfr, xf[ks], ar, 0, 0, 0); ai = __builtin_amdgcn_mfma_f32_16x16x32_bf16(wfi, xf[ks], ai, 0, 0, 0); }
                const int d = 16 * c4 + 4 * fq;
                const f32x4 xcv = *(const LAS f32x4*)(XCF + t * 64 + d);
                f32x4 av, uv;
#pragma unroll
                for (int j = 0; j < 4; ++j) {
                    const float r = sigmoidf_(ar[j] + CH[d + j]), ig = sigmoidf_(ai[j] + CH[64 + d + j]);
                    const float la = -r * CH[128 + d + j];
                    const float x2 = 2.0f * la;
                    const float ser = -x2 * (1.0f + x2 * (0.5f + x2 * (0.16666667f + x2 * (0.041666668f + x2 * (0.0083333338f + x2 * 0.0013888889f)))));
                    const float om = x2 > -0.3f ? ser : 1.0f - __expf(x2);
                    av[j] = __expf(la); uv[j] = __builtin_amdgcn_sqrtf(om) * (ig * xcv[j]);
                }
                if (!decm) { *(LAS f32x4*)(AA + t * 64 + d) = av; *(LAS f32x4*)(UU + t * 64 + d) = uv; }
                else {
                    const f32x4 h0 = *(const f32x4*)(p.st_h + (size_t)(l * 128 + t) * 1024 + ch0 + d);
                    const f32x4 hn = av * h0 + uv;
                    *(f32x4*)(p.out + O_SH + (size_t)(l * 128 + t) * 1024 + ch0 + d) = hn;
                    const u32x2 zv = *(const u32x2*)(U + (grow_base + t) * NU + 1024 + ch0 + d);
                    u32x2 wv; wv.x = cvt_pk_bf16(hn[0] * lo16(zv.x), hn[1] * hi16(zv.x)); wv.y = cvt_pk_bf16(hn[2] * lo16(zv.y), hn[3] * hi16(zv.y));
                    *(u32x2*)(MG + (grow_base + t) * DMG + ch0 + d) = wv;
                }
            }
        }
        if (decm) break;
        __syncthreads();
#pragma unroll
        for (int i = 0; i < 2; ++i) { const int id = tid + NT * i, r = id >> 3, cq = id & 7; *(LAS u32x4*)(lds + R_XCB + r * 144 + cq * 16) = zcur[i]; }
        const int ch = tid & 63, part = tid >> 6;
        {
            float hh = 0.f, Ac = 1.f;
#pragma unroll 4
            for (int k = 0; k < 16; ++k) { const int t = part * 16 + k; const float a = AA[t * 64 + ch], u = UU[t * 64 + ch]; hh = a * hh + u; Ac *= a; UU[t * 64 + ch] = hh; AA[t * 64 + ch] = Ac; }
            PT[(part * 64 + ch) * 2] = Ac; PT[(part * 64 + ch) * 2 + 1] = hh;
        }
        __syncthreads();
        {
            float hin = HC[(c & 1) * 64 + ch];
            for (int q = 0; q < part; ++q) hin = PT[(q * 64 + ch) * 2] * hin + PT[(q * 64 + ch) * 2 + 1];
            float hf = hin;
#pragma unroll 4
            for (int k = 0; k < 16; ++k) {
                const int t = part * 16 + k; hf = AA[t * 64 + ch] * hin + UU[t * 64 + ch];
                const float z = bf2f(*(const LAS unsigned short*)(lds + R_XCB + t * 144 + ch * 2));
                const float y = hf * z;
                *(LAS unsigned short*)(lds + R_XCF + t * 128 + ch * 2) = (unsigned short)(cvt_pk_bf16(y, y) & 0xffffu);
            }
            if (part == 7) {
                HC[((c + 1) & 1) * 64 + ch] = hf;
                if (c == 15) p.out[O_PH + (size_t)(l * 8 + b) * 1024 + ch0 + ch] = hf;
            }
        }
        if (c == 15 && tid < 192) {
            const int j = tid >> 6, cc = tid & 63;
            p.out[O_PCONV + ((size_t)(l * 8 + b) * 3 + j) * 1024 + ch0 + cc] = bf2f(*(const LAS unsigned short*)(lds + R_XAI + j * 128 + cc * 2));
        }
    }
    __syncthreads();
    if (!decm) {
#pragma unroll
        for (int i = 0; i < 2; ++i) { const int id = tid + NT * i, r = id >> 3, cq = id & 7; *(u32x4*)(MG + (grow_base + 15 * 128 + r) * DMG + ch0 + cq * 8) = *(const LAS u32x4*)(lds + R_XCF + r * 128 + cq * 16); }
    }
    __syncthreads();
}

__device__ void mlstm_decode(const Params& p, int l, int b, int h, LAS unsigned char* lds) {
    const int tid = otid(), lane = tid & 63;
    const bf16_t* U = (const bf16_t*)(p.ws + WS_U); const float* G = (const float*)(p.ws + WS_G);
    bf16_t* MG = (bf16_t*)(p.ws + WS_MG);
    LAS float* qs = (LAS float*)lds; LAS float* ks = qs + 256; LAS float* vs = qs + 512; LAS float* ns = qs + 768; LAS float* red = qs + 1024; LAS float* red2 = qs + 1024 + 2048;
    const size_t row = (size_t)MP + b;
    const size_t sidx = (size_t)((l * 128 + b) * 4 + h);
    __syncthreads();
    if (tid < 256) {
        qs[tid] = bf2f(U[row * NU + 2048 + h * 256 + tid]); ks[tid] = bf2f(U[row * NU + 3072 + h * 256 + tid]); vs[tid] = bf2f(U[row * NU + 4096 + h * 256 + tid]);
        ns[tid] = p.st_n[sidx * 256 + tid];
    }
    const float ig = G[row * 8 + h], lf = G[row * 8 + 4 + h], m0 = p.st_m[sidx];
    __syncthreads();
    float qk = 0.f, qn = 0.f;
#pragma unroll
    for (int j = 0; j < 4; ++j) { const float qv = qs[lane * 4 + j]; qk += qv * ks[lane * 4 + j]; qn += qv * ns[lane * 4 + j]; }
#pragma unroll
    for (int o = 32; o >= 1; o >>= 1) { qk += __shfl_xor(qk, o); qn += __shfl_xor(qn, o); }
    const float mt = fmaxf(lf + m0, ig), wg = __expf(ig - mt), gi = __expf(lf + m0 - mt);
    const int dvq = tid & 63, dkg = tid >> 6;
    float o_pre = 0.f, zg_pre = 0.f;
    if (tid < 256) { o_pre = bf2f(U[row * NU + 5120 + h * 256 + tid]); zg_pre = p.g_mhead[l * 1024 + h * 256 + tid] * bf2f(U[row * NU + 6144 + h * 256 + tid]); }
    const float* C0 = p.st_C + sidx * 65536; float* C1 = p.out + O_SC + sidx * 65536;
    const f32x4 v4 = *(const LAS f32x4*)(vs + dvq * 4);
    f32x4 qc = zero4();
#pragma unroll 16
    for (int i = 0; i < 32; ++i) {
        const int dk = dkg * 32 + i;
        const f32x4 c4 = __builtin_nontemporal_load((const f32x4*)(C0 + (size_t)dk * 256 + dvq * 4));
        const float qv = qs[dk], kv = wg * ks[dk];
        qc += qv * c4;
        const f32x4 cn = gi * c4 + kv * v4;
        __builtin_nontemporal_store(cn, (f32x4*)(C1 + (size_t)dk * 256 + dvq * 4));
    }
    *(LAS f32x4*)(red + dkg * 256 + dvq * 4) = qc;
    __syncthreads();
    float yv = 0.f;
    if (tid < 256) {
        float qcv = 0.f;
#pragma unroll
        for (int g = 0; g < 8; ++g) qcv += red[g * 256 + tid];
        const float num = wg * qk * vs[tid] + gi * qcv, den = wg * qk + gi * qn;
        const float hh = num / fmaxf(fabsf(den), __expf(-mt));
        yv = hh * o_pre;
        float ss = yv * yv;
#pragma unroll
        for (int o = 32; o >= 1; o >>= 1) ss += __shfl_xor(ss, o);
        if (lane == 0) red2[tid >> 6] = ss;
        p.out[O_SN + sidx * 256 + tid] = gi * ns[tid] + wg * ks[tid];
    }
    __syncthreads();
    if (tid < 256) {
        const float rstd = rsqrtf(((red2[0] + red2[1]) + (red2[2] + red2[3])) * (1.0f / 256.0f) + EPSF);
        const float ov = yv * rstd * zg_pre;
        MG[row * DMG + 1024 + h * 256 + tid] = (bf16_t)(cvt_pk_bf16(ov, ov) & 0xffffu);
    }
    if (tid == 0) p.out[O_SM + sidx] = mt;
}

__device__ void decode_items(const Params& p, int l, LAS unsigned char* lds, int max_items) {
    unsigned* ctr = (unsigned*)(p.ws + WS_BAR) + 3584 + 64 * l;
    volatile LAS unsigned* slot = (volatile LAS unsigned*)(lds + LDS_BYTES - 32);
    for (int n = 0; n < max_items; ++n) {
        __syncthreads();
        if (threadIdx.x == 0) *slot = __hip_atomic_fetch_add(ctr, 1u, __ATOMIC_RELAXED, __HIP_MEMORY_SCOPE_AGENT);
        __syncthreads();
        const int item = (int)*slot;
        if (item >= 512) break;
        mlstm_decode(p, l, item >> 2, item & 3, lds);
    }
}

__device__ void phase_mixers(const Params& p, int l, LAS unsigned char* lds) {
    const int G = gridDim.x, bid = obid();
    const bool split = G >= 256;
    const int r = split ? bid - 128 : bid, R = split ? G - 128 : G;
    if (!split || bid < 128) { for (int item = bid; item < 128; item += (split ? 128 : G)) mlstm_prompt(p, l, item, lds); }
    if (r >= 0) {
        for (int item = r; item < 128; item += R) rglru_item(p, l, item >> 4, item & 15, false, lds);
        for (int item = r; item < 16; item += R) rglru_item(p, l, 0, item, true, lds);
    }
    decode_items(p, l, lds, 1 << 30);
}

__device__ void phase_headnorm(const Params& p, int l) {
    const bf16_t* U = (const bf16_t*)(p.ws + WS_U); bf16_t* MG = (bf16_t*)(p.ws + WS_MG);
    const float* gm = p.g_mhead + l * 1024;
    const int G = gridDim.x, bid = obid();
    const int b0 = G > 8 ? bid - 4 : bid, GG = G > 8 ? G - 4 : G;
    if (b0 < 0) return;
    for (size_t idx = (size_t)b0 * NT + otid(); idx < (size_t)MP * 128; idx += (size_t)GG * NT) {
        const size_t row = idx >> 7; const int col = (int)(idx & 127) * 8;
        const u32x4 hv = *(const u32x4*)(MG + row * DMG + 1024 + col);
        const u32x4 ov = *(const u32x4*)(U + row * NU + 5120 + col);
        const u32x4 zv = *(const u32x4*)(U + row * NU + 6144 + col);
        float y[8];
        y[0] = lo16(hv.x) * lo16(ov.x); y[1] = hi16(hv.x) * hi16(ov.x); y[2] = lo16(hv.y) * lo16(ov.y); y[3] = hi16(hv.y) * hi16(ov.y);
        y[4] = lo16(hv.z) * lo16(ov.z); y[5] = hi16(hv.z) * hi16(ov.z); y[6] = lo16(hv.w) * lo16(ov.w); y[7] = hi16(hv.w) * hi16(ov.w);
        float ss = ((y[0] * y[0] + y[1] * y[1]) + (y[2] * y[2] + y[3] * y[3])) + ((y[4] * y[4] + y[5] * y[5]) + (y[6] * y[6] + y[7] * y[7]));
#pragma unroll
        for (int o = 1; o < 32; o <<= 1) ss += __shfl_xor(ss, o);
        const float rstd = rsqrtf(ss * (1.0f / 256.0f) + EPSF);
        const f32x4 g0 = *(const f32x4*)(gm + col), g1 = *(const f32x4*)(gm + col + 4);
        u32x4 o;
        o.x = cvt_pk_bf16(y[0] * rstd * g0[0] * lo16(zv.x), y[1] * rstd * g0[1] * hi16(zv.x));
        o.y = cvt_pk_bf16(y[2] * rstd * g0[2] * lo16(zv.y), y[3] * rstd * g0[3] * hi16(zv.y));
        o.z = cvt_pk_bf16(y[4] * rstd * g1[0] * lo16(zv.z), y[5] * rstd * g1[1] * hi16(zv.z));
        o.w = cvt_pk_bf16(y[6] * rstd * g1[2] * lo16(zv.w), y[7] * rstd * g1[3] * hi16(zv.w));
        *(u32x4*)(MG + row * DMG + 1024 + col) = o;
    }
}

__device__ void phase_final(const Params& p) {
    const bf16_t* XB = (const bf16_t*)(p.ws + WS_XB); const float* SS = (const float*)(p.ws + WS_SS);
    const int tidf = otid(); const int wid = tidf >> 6, lane = tidf & 63;
    for (int row = blockIdx.x * 8 + wid; row < MV; row += gridDim.x * 8) {
        const f32x4* sp = (const f32x4*)(SS + (size_t)row * 16);
        const f32x4 s0 = sp[0], s1 = sp[1], s2 = sp[2], s3 = sp[3];
        const float ss = ((s0[0] + s0[1]) + (s0[2] + s0[3])) + ((s1[0] + s1[1]) + (s1[2] + s1[3])) + ((s2[0] + s2[1]) + (s2[2] + s2[3])) + ((s3[0] + s3[1]) + (s3[2] + s3[3]));
        const float rstd = rsqrtf(ss * (1.0f / 1024.0f) + EPSF);
        float* op = row < MP ? p.out + O_YP + (size_t)row * DM : p.out + O_YS + (size_t)(row - MP) * DM;
#pragma unroll
        for (int i = 0; i < 2; ++i) {
            const int c = i * 512 + lane * 8;
            const u32x4 xv = *(const u32x4*)(XB + (size_t)row * DM + c);
            const f32x4 g0 = *(const f32x4*)(p.g_final + c), g1 = *(const f32x4*)(p.g_final + c + 4);
            *(f32x4*)(op + c) = (f32x4){lo16(xv.x) * rstd * g0[0], hi16(xv.x) * rstd * g0[1], lo16(xv.y) * rstd * g0[2], hi16(xv.y) * rstd * g0[3]};
            *(f32x4*)(op + c + 4) = (f32x4){lo16(xv.z) * rstd * g1[0], hi16(xv.z) * rstd * g1[1], lo16(xv.w) * rstd * g1[2], hi16(xv.w) * rstd * g1[3]};
        }
    }
}

#define XB_XCNT(j) (64 * (j))
#define XB_XSUB(j) (1024 + 64 * (j))
#define XB_XGEN(j) (2048 + 64 * (j))
#define XB_TOP 3072
#define XB_TOPGEN 3136
__device__ __forceinline__ unsigned xb_ld(unsigned* p) { return __hip_atomic_load(p, __ATOMIC_RELAXED, __HIP_MEMORY_SCOPE_AGENT); }
__device__ __forceinline__ unsigned xb_add(unsigned* p, unsigned v) { return __hip_atomic_fetch_add(p, v, __ATOMIC_RELAXED, __HIP_MEMORY_SCOPE_AGENT); }
__device__ __forceinline__ unsigned xb_xcc_id() { return (unsigned)__builtin_amdgcn_s_getreg((3 << 11) | 20) & 0xFu; }
#define XB_SPIN(cond) do { unsigned sp_ = 0; while (cond) { __builtin_amdgcn_s_sleep(1); if (++sp_ > (1u << 24)) break; } } while (0)
__device__ __forceinline__ void gbar(unsigned* bar, volatile LAS unsigned* st) {
    asm volatile("s_waitcnt vmcnt(0) lgkmcnt(0)" ::: "memory");
    __syncthreads();
    if (threadIdx.x == 0) {
        const unsigned x = xb_xcc_id(), nloc = st[0], nx = st[1];
        const unsigned old = xb_add(&bar[XB_XSUB(x)], 1u);
        const unsigned gen = old / nloc;
        if (old + 1u == (gen + 1u) * nloc) {
            __builtin_amdgcn_fence(__ATOMIC_RELEASE, "agent");
            asm volatile("s_waitcnt vmcnt(0)" ::: "memory");
            const unsigned og = xb_add(&bar[XB_TOP], 1u);
            const unsigned tg = og / nx;
            if (og + 1u == (tg + 1u) * nx) xb_add(&bar[XB_TOPGEN], 1u);
            else XB_SPIN(xb_ld(&bar[XB_TOPGEN]) == tg);
            __builtin_amdgcn_fence(__ATOMIC_ACQUIRE, "agent");
            xb_add(&bar[XB_XGEN(x)], 1u);
            asm volatile("s_waitcnt vmcnt(0)" ::: "memory");
        } else {
            XB_SPIN(xb_ld(&bar[XB_XGEN(x)]) == gen);
            __builtin_amdgcn_fence(__ATOMIC_ACQUIRE, "agent");
            asm volatile("s_waitcnt vmcnt(0)" ::: "memory");
        }
    }
    __syncthreads();
}

__global__ void __launch_bounds__(NT, 2) hymba_fwd(Params p) {
    extern __shared__ __attribute__((aligned(16))) unsigned char lds_raw[];
    LAS unsigned char* lds = (LAS unsigned char*)lds_raw;
    cg::grid_group grid = cg::this_grid();
    bf16_t* XB = (bf16_t*)(p.ws + WS_XB); bf16_t* U = (bf16_t*)(p.ws + WS_U); float* G = (float*)(p.ws + WS_G); bf16_t* MG = (bf16_t*)(p.ws + WS_MG);
    float* SS = (float*)(p.ws + WS_SS);
    unsigned* bar = (unsigned*)(p.ws + WS_BAR);
    volatile LAS unsigned* st = (volatile LAS unsigned*)(lds + LDS_BYTES - 16);
    if (threadIdx.x == 0) (void)xb_add(&bar[XB_XCNT(xb_xcc_id())], 1u);
    if (p.out == nullptr) grid.sync();
    phase_prep(p, lds);
    if (threadIdx.x == 0) {
        const unsigned x = xb_xcc_id(), Gn = gridDim.x; unsigned mine = 1u, cnt = 1u, sp = 0u;
        for (;;) {
            unsigned sum = 0u; cnt = 0u;
            for (unsigned j = 0; j < 16; ++j) { const unsigned c = xb_ld(&bar[XB_XCNT(j)]); sum += c; cnt += c > 0u ? 1u : 0u; if (j == x) mine = c; }
            if (sum == Gn || ++sp > (1u << 22)) break;
            __builtin_amdgcn_s_sleep(1);
        }
        st[0] = mine > 0u ? mine : 1u; st[1] = cnt > 0u ? cnt : 1u;
    }
    __syncthreads();
    gbar(bar, st);
    for (int l = 0; l < 2; ++l) {
        {
            pg8::Gemm g; g.A = XB; g.Bt = (const bf16_t*)(p.ws + WS_WT1) + (size_t)l * NW1 * DM; g.M = MR; g.N = NW1; g.K = DM;
            unsigned* dctr = bar + 3712 + 64 * l;
            pg8::InOrder so; so.G = gridDim.x; so.c = obid(); so.done_ctr = dctr;
            EpiIn e; e.U = U; e.G = G; e.SS = SS; e.bmi = p.b_mi + l * 4; e.bmf = p.b_mf + l * 4;
            pg8::gemm_phase<EpiIn, pg8::InOrder, DM>(lds, g, so, e);
            const int Gn = gridDim.x, maxu = (pg8::IN_UNITS + Gn - 1) / Gn, mine = (pg8::IN_UNITS - so.c + Gn - 1) / Gn;
            if (mine < maxu) {
                if (threadIdx.x == 0) {
                    unsigned sp = 0u;
                    while (__hip_atomic_load(dctr, __ATOMIC_RELAXED, __HIP_MEMORY_SCOPE_AGENT) < 8u * pg8::IN_DEC_UNITS) { __builtin_amdgcn_s_sleep(2); if (++sp > (1u << 24)) break; }
                    __builtin_amdgcn_fence(__ATOMIC_ACQUIRE, "agent");
                    asm volatile("s_waitcnt vmcnt(0)" ::: "memory");
                }
                __syncthreads();
                decode_items(p, l, lds, 1);
            }
        }
        gbar(bar, st);
        phase_mixers(p, l, lds);
        gbar(bar, st);
        for (int pass = 0; pass < 2; ++pass) {
            if (pass == 0) phase_headnorm(p, l);
            pg8::Gemm g; g.A = MG; g.Bt = (const bf16_t*)(p.ws + WS_WT2) + (size_t)l * DM * DMG; g.M = MR; g.N = DM; g.K = DMG;
            pg8::OutOrder so; so.G = gridDim.x; so.c = obid(); so.mode = pass;
            EpiOut e; e.basep = p.xp; e.bases = p.xs; e.split = l == 0 ? 1 : 0; e.XBo = XB; e.SSo = SS;
            pg8::gemm_phase<EpiOut, pg8::OutOrder, DMG>(lds, g, so, e);
            gbar(bar, st);
        }
    }
    phase_final(p);
}

extern "C" void kernel_launch(void* const* d_in, const int* in_sizes, int n_in, void* d_out, int out_size, void* d_ws, size_t ws_size, hipStream_t stream) {
    static int grid_blocks = 0;
    if (!grid_blocks) {
        int dev = 0, cus = 0, per_cu = 0;
        hipGetDevice(&dev);
        hipDeviceGetAttribute(&cus, hipDeviceAttributeMultiprocessorCount, dev);
        hipFuncSetAttribute((const void*)hymba_fwd, hipFuncAttributeMaxDynamicSharedMemorySize, LDS_BYTES);
        hipOccupancyMaxActiveBlocksPerMultiprocessor(&per_cu, (const void*)hymba_fwd, NT, LDS_BYTES);
        if (per_cu < 1) per_cu = 1;
        grid_blocks = cus * per_cu;
        (void)hipGetLastError();
    }
    if (ws_size < WS_END) { fprintf(stderr, "workspace too small: %zu < %zu\n", ws_size, (size_t)WS_END); return; }
    Params p{};
    p.xp = (const float*)d_in[0]; p.xs = (const float*)d_in[1]; p.st_h = (const float*)d_in[2]; p.st_conv = (const float*)d_in[3];
    p.st_C = (const float*)d_in[4]; p.st_n = (const float*)d_in[5]; p.st_m = (const float*)d_in[6]; p.g_norm = (const float*)d_in[7];
    p.w_in = (const float*)d_in[8]; p.conv_w = (const float*)d_in[9]; p.conv_b = (const float*)d_in[10]; p.w_r = (const float*)d_in[11];
    p.b_r = (const float*)d_in[12]; p.w_i = (const float*)d_in[13]; p.b_i = (const float*)d_in[14]; p.lam = (const float*)d_in[15];
    p.b_mi = (const float*)d_in[16]; p.b_mf = (const float*)d_in[17]; p.g_mhead = (const float*)d_in[18]; p.w_out = (const float*)d_in[19];
    p.g_final = (const float*)d_in[20];
    p.out = (float*)d_out; p.ws = (unsigned char*)d_ws;
    (void)hipMemsetAsync((unsigned char*)d_ws + WS_BAR, 0, 16384, stream);
    void* args[] = {&p};
    hipError_t e = hipLaunchCooperativeKernel((const void*)hymba_fwd, dim3(grid_blocks), dim3(NT), args, LDS_BYTES, stream);
    if (e != hipSuccess) fprintf(stderr, "cooperative launch failed: %s (grid %d)\n", hipGetErrorString(e), grid_blocks);
}
```

```cpp
#include <hip/hip_runtime.h>
#include <hip/hip_cooperative_groups.h>
#include <cstdio>
namespace cg = cooperative_groups;

#define LAS __attribute__((address_space(3)))
typedef unsigned short bf16_t;
typedef short bf16x8 __attribute__((ext_vector_type(8)));
typedef short bf16x4 __attribute__((ext_vector_type(4)));
typedef float f32x4 __attribute__((ext_vector_type(4)));
typedef unsigned u32x4 __attribute__((ext_vector_type(4)));
typedef unsigned u32x2 __attribute__((ext_vector_type(2)));

constexpr int NT = 512;
constexpr int LDS_BYTES = 163840;
constexpr int MP = 16384, MV = 16512, MR = 16640;
constexpr int DM = 1024, NU = 7168, NW1 = 7424, DIN = 7176, DMG = 2048;
constexpr float EPSF = 1e-6f;

constexpr size_t WS_XB = 0;
constexpr size_t WS_WT1 = WS_XB + (size_t)MR * DM * 2;
constexpr size_t WS_WT2 = WS_WT1 + (size_t)2 * NW1 * DM * 2;
constexpr size_t WS_WGT = WS_WT2 + (size_t)2 * DM * DMG * 2;
constexpr size_t WS_U = WS_WGT + (size_t)2 * 2 * 16 * 64 * 64 * 2;
constexpr size_t WS_G = WS_U + (size_t)MR * NU * 2;
constexpr size_t WS_MG = WS_G + (size_t)MR * 8 * 4;
constexpr size_t WS_X1 = WS_MG + (size_t)MR * DMG * 2;
constexpr size_t WS_X2 = WS_X1 + (size_t)MR * DM * 4;
constexpr size_t WS_SS = WS_X2 + (size_t)MR * DM * 4;
constexpr size_t WS_YSS = WS_SS + (size_t)MR * 16 * 4;
constexpr size_t WS_BAR = WS_YSS + (size_t)MR * 16 * 4;
constexpr size_t WS_END = WS_BAR + 16384;

struct Params {
    const float* xp; const float* xs; const float* st_h; const float* st_conv; const float* st_C; const float* st_n; const float* st_m;
    const float* g_norm; const float* w_in; const float* conv_w; const float* conv_b; const float* w_r; const float* b_r; const float* w_i; const float* b_i;
    const float* lam; const float* b_mi; const float* b_mf; const float* g_mhead; const float* w_out; const float* g_final;
    float* out; unsigned char* ws;
};

constexpr size_t O_YP = 0;
constexpr size_t O_YS = O_YP + (size_t)MP * DM;
constexpr size_t O_PH = O_YS + (size_t)128 * DM;
constexpr size_t O_PCONV = O_PH + 2 * 8 * 1024;
constexpr size_t O_PC = O_PCONV + 2 * 8 * 3 * 1024;
constexpr size_t O_PN = O_PC + (size_t)2 * 8 * 4 * 65536;
constexpr size_t O_PM = O_PN + 2 * 8 * 4 * 256;
constexpr size_t O_SH = O_PM + 2 * 8 * 4;
constexpr size_t O_SCONV = O_SH + 2 * 128 * 1024;
constexpr size_t O_SC = O_SCONV + 2 * 128 * 3 * 1024;
constexpr size_t O_SN = O_SC + (size_t)2 * 128 * 4 * 65536;
constexpr size_t O_SM = O_SN + 2 * 128 * 4 * 256;

__device__ __forceinline__ float bf2f(unsigned short v) { return __uint_as_float(((unsigned)v) << 16); }
__device__ __forceinline__ unsigned cvt_pk_bf16(float lo, float hi) { unsigned r; asm volatile("v_cvt_pk_bf16_f32 %0, %1, %2" : "=v"(r) : "v"(lo), "v"(hi)); return r; }
__device__ __forceinline__ float sigmoidf_(float x) { return __builtin_amdgcn_rcpf(1.0f + __builtin_amdgcn_exp2f(-1.44269504f * x)); }
__device__ __forceinline__ float siluf_(float x) { return x * __builtin_amdgcn_rcpf(1.0f + __builtin_amdgcn_exp2f(-1.44269504f * x)); }
__device__ __forceinline__ float softplusf_(float x) { return fmaxf(x, 0.f) + log1pf(__expf(-fabsf(x))); }
__device__ __forceinline__ int otid() { int t = threadIdx.x; asm volatile("" : "+v"(t)); return t; }
__device__ __forceinline__ int obid() { int t = blockIdx.x; asm volatile("" : "+s"(t)); return t; }
__device__ __forceinline__ f32x4 zero4() { float z = 0.f; asm volatile("" : "+v"(z)); return (f32x4){z, z, z, z}; }
__device__ __forceinline__ float lo16(unsigned w) { return __uint_as_float(w << 16); }
__device__ __forceinline__ float hi16(unsigned w) { return __uint_as_float(w & 0xffff0000u); }

namespace pg8 {
constexpr int BM = 256, BK = 64, HALF = 128, HTB = HALF * BK * 2, STAGE_BYTES = 8 * HTB, NXCD = 8, WGM = 2;
__host__ __device__ __forceinline__ int lds_byte(int r, int c) { const int st = (r >> 4) * 2 + (c >> 5), rr = r & 15, cc = c & 31, ob = rr * 64 + cc * 2; return st * 1024 + (ob ^ (((ob >> 9) & 1) << 5)); }
__host__ __device__ __forceinline__ void stage_rc(int b, int& R, int& C) { const int st = b / 1024, sb = b % 1024, swz = sb ^ (((sb >> 9) & 1) << 5); R = (st >> 1) * 16 + swz / 64; C = (st & 1) * 32 + (swz % 64) / 2; }
__host__ __device__ __forceinline__ int perm32(int rho) { const int n = rho >> 4, i = rho & 15; return 8 * (i >> 2) + 4 * n + (i & 3); }
struct Unit { int pm, pn; };
struct Gemm { const bf16_t* A; const bf16_t* Bt; int M, N, K; };
template <int NM_, int NN_>
struct StaticOrder {
    static constexpr int nM = NM_, nN = NN_, nwg = NM_ * NN_;
    int G, c;
    __device__ void init(int G_, int c_) { G = G_; c = c_; }
    __device__ static void map(int L, Unit& u) {
        int wgid = L; { constexpr int q = nwg / NXCD, r = nwg % NXCD; const int xcd = wgid % NXCD, off = wgid / NXCD; wgid = (xcd < r ? xcd * (q + 1) : r * (q + 1) + (xcd - r) * q) + off; }
        constexpr int nig = WGM * nN; const int gid = wgid / nig, fm = gid * WGM, gsz = (nM - fm) < WGM ? (nM - fm) : WGM;
        u.pm = fm + ((wgid % nig) % gsz); u.pn = (wgid % nig) / gsz;
    }
    __device__ bool next(int i, Unit& u) const { const int L = i * G + c; if (L >= nwg) return false; map(L, u); return true; }
    __device__ __forceinline__ void done(const Unit&, int) const {}
};

struct OutOrder {
    int G, c, mode;
    __device__ bool next(int i, Unit& u) const {
        const int L = i * G + c;
        if (mode == 0) { if (L >= 4) return false; u.pm = 64; u.pn = L; return true; }
        if (L >= 256) return false; StaticOrder<64, 4>::map(L, u); return true;
    }
    __device__ __forceinline__ void done(const Unit&, int) const {}
};

constexpr int IN_UNITS = 65 * 29, IN_DEC_UNITS = 29;
struct InOrder {
    int G, c; unsigned* done_ctr;
    __device__ bool next(int i, Unit& u) const {
        const int L = i * G + c; if (L >= IN_UNITS) return false;
        if (L < IN_DEC_UNITS) { u.pm = 64; u.pn = L; return true; }
        StaticOrder<64, 29>::map(L - IN_DEC_UNITS, u); return true;
    }
    __device__ __forceinline__ void done(const Unit& u, int lane) const {
        if (u.pm == 64) {
            asm volatile("s_waitcnt vmcnt(0)" ::: "memory");
            __builtin_amdgcn_fence(__ATOMIC_RELEASE, "agent");
            asm volatile("s_waitcnt vmcnt(0)" ::: "memory");
            if (lane == 0) __hip_atomic_fetch_add(done_ctr, 1u, __ATOMIC_RELAXED, __HIP_MEMORY_SCOPE_AGENT);
        }
    }
};

template <class Epi, class Sched, int KK>
__device__ __forceinline__ void gemm_phase(LAS unsigned char* lds, const Gemm g, const Sched& S, const Epi& E) {
    const int tid = otid(), wid = __builtin_amdgcn_readfirstlane(tid >> 6), lane = tid & 63, wr = wid >> 2, wc = wid & 3, fr = lane & 15, fq = lane >> 4;
    constexpr int K = KK, nt = K / BK;
    unsigned voffA[2], voffB[2];
#pragma unroll
    for (int i = 0; i < 2; ++i) { int R, C; stage_rc(tid * 16 + i * 8192, R, C); const int Rb = Epi::PERM ? ((R & ~31) + perm32(R & 31)) : R;
        voffA[i] = (unsigned)(R * K + C) * 2u; voffB[i] = (unsigned)(Rb * K + C) * 2u; }
    const size_t kstep = (size_t)(BK * 2);
    const size_t hstep = (size_t)HALF * K * 2;
    const size_t tstep = 2 * hstep;
    const unsigned ldsw = (unsigned)wid * 1024u;
    const int aoff = lds_byte(wr * 64 + fr, fq * 8), boff = lds_byte(wc * 32 + fr, fq * 8);
#define PG8_SA(b, h) (((b) * 2 + (h)) * HTB)
#define PG8_SB(b, h) ((4 + (b) * 2 + (h)) * HTB)
#define PG8_STAGE(bufoff, gbase, voff) do { _Pragma("unroll") for (int _i = 0; _i < 2; ++_i) \
        __builtin_amdgcn_global_load_lds((const unsigned*)((const char*)(gbase) + (voff)[_i]), (LAS unsigned*)(lds + (bufoff) + ldsw + _i * 8192), 16, 0, 0); } while (0)
#define PG8_LDA(dst, b, h) do { _Pragma("unroll") for (int m = 0; m < 4; ++m) _Pragma("unroll") for (int k = 0; k < 2; ++k) dst[m][k] = *(const LAS bf16x8*)(lds + PG8_SA(b, h) + aoff + m * 2048 + k * 1024); } while (0)
#define PG8_LDB(dst, b, h) do { _Pragma("unroll") for (int n = 0; n < 2; ++n) _Pragma("unroll") for (int k = 0; k < 2; ++k) dst[n][k] = *(const LAS bf16x8*)(lds + PG8_SB(b, h) + boff + n * 2048 + k * 1024); } while (0)
#define PG8_MMA(ai, bj, At, Bt) do { __builtin_amdgcn_s_setprio(1); _Pragma("unroll") for (int m = 0; m < 4; ++m) _Pragma("unroll") for (int n = 0; n < 2; ++n) _Pragma("unroll") for (int k = 0; k < 2; ++k) \
        acc[ai][bj][m][n] = __builtin_amdgcn_mfma_f32_16x16x32_bf16(Bt[n][k], At[m][k], acc[ai][bj][m][n], 0, 0, 0); __builtin_amdgcn_s_setprio(0); } while (0)
#define PG8_WAIT_V(n) asm volatile("s_waitcnt vmcnt(" #n ")" ::: "memory")
#define PG8_WAIT_L(n) asm volatile("s_waitcnt lgkmcnt(" #n ")" ::: "memory")
#define PG8_BAR __builtin_amdgcn_s_barrier()
#define PG8_SCHED __builtin_amdgcn_sched_barrier(0)
    Unit cur, nxt; int ui = 0;
    if (!S.next(0, cur)) return;
    f32x4 acc[2][2][4][2];
#pragma unroll
    for (int a = 0; a < 2; ++a)
#pragma unroll
        for (int b = 0; b < 2; ++b)
#pragma unroll
            for (int m = 0; m < 4; ++m)
#pragma unroll
                for (int n = 0; n < 2; ++n) acc[a][b][m][n] = zero4();
    bf16x8 At[4][2], B0[2][2], B1[2][2];
    const char* cA = (const char*)g.A + (size_t)cur.pm * tstep; const char* cB = (const char*)g.Bt + (size_t)cur.pn * tstep;
    PG8_STAGE(PG8_SB(0, 0), cB, voffB); PG8_STAGE(PG8_SA(0, 0), cA, voffA); PG8_STAGE(PG8_SB(0, 1), cB + hstep, voffB); PG8_STAGE(PG8_SA(0, 1), cA + hstep, voffA);
    if (wr == 1) PG8_BAR;
    PG8_WAIT_V(4); PG8_BAR;
    PG8_STAGE(PG8_SB(1, 0), cB + kstep, voffB); PG8_STAGE(PG8_SA(1, 0), cA + kstep, voffA); PG8_STAGE(PG8_SB(1, 1), cB + hstep + kstep, voffB);
    PG8_WAIT_V(6); PG8_BAR;
    for (;;) {
        const bool has_next = S.next(ui + 1, nxt);
        const char* nA = has_next ? (const char*)g.A + (size_t)nxt.pm * tstep : cA; const char* nB = has_next ? (const char*)g.Bt + (size_t)nxt.pn * tstep : cB;
        for (int t = 0; t < nt; t += 2) {
            const bool last = (t == nt - 2);
            const char* a1 = cA + (size_t)(t + 1) * kstep;
            const char* a2 = last ? nA : cA + (size_t)(t + 2) * kstep; const char* b2 = last ? nB : cB + (size_t)(t + 2) * kstep;
            const char* a3 = a2 + kstep; const char* b3 = b2 + kstep;
            PG8_LDB(B0, 0, 0); PG8_SCHED; PG8_LDA(At, 0, 0); PG8_STAGE(PG8_SA(1, 1), a1 + hstep, voffA);
            PG8_WAIT_L(8); PG8_BAR; PG8_WAIT_L(0); PG8_MMA(0, 0, At, B0); PG8_BAR; PG8_SCHED;
            PG8_LDB(B1, 0, 1); PG8_STAGE(PG8_SB(0, 0), b2, voffB);
            PG8_BAR; PG8_WAIT_L(0); PG8_MMA(0, 1, At, B1); PG8_BAR;
            PG8_LDA(At, 0, 1); PG8_STAGE(PG8_SA(0, 0), a2, voffA);
            PG8_BAR; PG8_WAIT_L(0); PG8_MMA(1, 0, At, B0); PG8_BAR; PG8_SCHED;
            PG8_STAGE(PG8_SB(0, 1), b2 + hstep, voffB);
            PG8_WAIT_V(6); PG8_BAR; PG8_MMA(1, 1, At, B1); PG8_BAR;
            PG8_LDB(B0, 1, 0); PG8_SCHED; PG8_LDA(At, 1, 0); PG8_STAGE(PG8_SA(0, 1), a2 + hstep, voffA);
            PG8_WAIT_L(8); PG8_BAR; PG8_WAIT_L(0); PG8_MMA(0, 0, At, B0); PG8_BAR; PG8_SCHED;
            PG8_LDB(B1, 1, 1); PG8_STAGE(PG8_SB(1, 0), b3, voffB);
            PG8_BAR; PG8_WAIT_L(0); PG8_MMA(0, 1, At, B1); PG8_BAR;
            PG8_LDA(At, 1, 1); PG8_STAGE(PG8_SA(1, 0), a3, voffA);
            PG8_BAR; PG8_WAIT_L(0); PG8_MMA(1, 0, At, B0); PG8_BAR; PG8_SCHED;
            PG8_STAGE(PG8_SB(1, 1), b3 + hstep, voffB);
            PG8_WAIT_V(6); PG8_BAR; PG8_MMA(1, 1, At, B1); PG8_BAR;
        }
        E(acc, cur, wr, wc, fr, fq);
        S.done(cur, lane);
        if (!has_next) break;
#pragma unroll
        for (int a = 0; a < 2; ++a)
#pragma unroll
            for (int b = 0; b < 2; ++b)
#pragma unroll
                for (int m = 0; m < 4; ++m)
#pragma unroll
                    for (int n = 0; n < 2; ++n) acc[a][b][m][n] = zero4();
        cur = nxt; cA = nA; cB = nB; ++ui;
    }
    PG8_WAIT_V(0);
    if (wr == 0) PG8_BAR;
    PG8_BAR;
#undef PG8_SA
#undef PG8_SB
#undef PG8_STAGE
#undef PG8_LDA
#undef PG8_LDB
#undef PG8_MMA
#undef PG8_WAIT_V
#undef PG8_WAIT_L
#undef PG8_BAR
#undef PG8_SCHED
}
}

struct EpiIn {
    static constexpr bool PERM = true;
    bf16_t* U; float* G; const float* SS; const float* bmi; const float* bmf;
    __device__ __forceinline__ void operator()(const f32x4 (&acc)[2][2][4][2], const pg8::Unit& u, int wr, int wc, int fr, int fq) const {
        const int row0 = u.pm * 256 + wr * 64 + fr;
        const int pn = u.pn;
        const int mode = ((pn >= 4 && pn < 8) || (pn >= 24 && pn < 28)) ? 1 : ((pn >= 20 && pn < 24) ? 2 : 0);
        f32x4 cur[4];
        { const f32x4* sp = (const f32x4*)(SS + (size_t)row0 * 16); cur[0] = sp[0]; cur[1] = sp[1]; cur[2] = sp[2]; cur[3] = sp[3]; }
#pragma unroll
        for (int r = 0; r < 8; ++r) {
            const int ai = r >> 2, m = r & 3;
            const int row = row0 + ai * 128 + m * 16;
            f32x4 nxt[4];
            if (r < 7) {
                const f32x4* sp = (const f32x4*)(SS + (size_t)(row0 + ((r + 1) >> 2) * 128 + ((r + 1) & 3) * 16) * 16);
                nxt[0] = sp[0]; nxt[1] = sp[1]; nxt[2] = sp[2]; nxt[3] = sp[3];
            }
            const float ss = ((cur[0][0] + cur[0][1]) + (cur[0][2] + cur[0][3])) + ((cur[1][0] + cur[1][1]) + (cur[1][2] + cur[1][3])) + ((cur[2][0] + cur[2][1]) + (cur[2][2] + cur[2][3])) + ((cur[3][0] + cur[3][1]) + (cur[3][2] + cur[3][3]));
            const float rstd = rsqrtf(ss * (1.0f / 1024.0f) + EPSF);
            if (pn < 28) {
                bf16_t* rowp = U + (size_t)row * NU + pn * 256 + wc * 32 + 8 * fq;
#pragma unroll
                for (int bj = 0; bj < 2; ++bj) {
                    f32x4 v0 = acc[ai][bj][m][0] * rstd, v1 = acc[ai][bj][m][1] * rstd;
                    if (mode == 1) {
#pragma unroll
                        for (int j = 0; j < 4; ++j) { v0[j] = siluf_(v0[j]); v1[j] = siluf_(v1[j]); }
                    } else if (mode == 2) {
#pragma unroll
                        for (int j = 0; j < 4; ++j) { v0[j] = sigmoidf_(v0[j]); v1[j] = sigmoidf_(v1[j]); }
                    }
                    u32x4 w; w.x = cvt_pk_bf16(v0[0], v0[1]); w.y = cvt_pk_bf16(v0[2], v0[3]); w.z = cvt_pk_bf16(v1[0], v1[1]); w.w = cvt_pk_bf16(v1[2], v1[3]);
                    *(u32x4*)(rowp + bj * 128) = w;
                }
            } else if (wc == 0 && fq == 0) {
                const f32x4 v0 = acc[ai][0][m][0] * rstd, v1 = acc[ai][0][m][1] * rstd;
                f32x4 gi, gf;
#pragma unroll
                for (int j = 0; j < 4; ++j) { gi[j] = v0[j] + bmi[j]; const float x = v1[j] + bmf[j]; gf[j] = fminf(x, 0.f) - log1pf(__expf(-fabsf(x))); }
                *(f32x4*)(G + (size_t)row * 8) = gi; *(f32x4*)(G + (size_t)row * 8 + 4) = gf;
            }
            if (r < 7) { cur[0] = nxt[0]; cur[1] = nxt[1]; cur[2] = nxt[2]; cur[3] = nxt[3]; }
        }
    }
};

struct EpiOut {
    static constexpr bool PERM = false;
    const float* basep; const float* bases; int split;
    bf16_t* XBo; float* SSo;
    __device__ __forceinline__ void operator()(const f32x4 (&acc)[2][2][4][2], const pg8::Unit& u, int wr, int wc, int fr, int fq) const {
        const int row0 = u.pm * 256 + wr * 64 + fr, col0 = u.pn * 256 + wc * 32 + 4 * fq;
#pragma unroll
        for (int g2 = 0; g2 < 4; ++g2) {
            const int ai = g2 >> 1;
            f32x4 bs[2][2][2];
#pragma unroll
            for (int mm = 0; mm < 2; ++mm) {
                const int m = (g2 & 1) * 2 + mm;
                const int row = row0 + ai * 128 + m * 16;
                if (split) {
                    const float* bp = basep + (size_t)row * DM;
                    bool have = true;
                    if (row >= MV) have = false; else if (row >= MP) bp = bases + (size_t)(row - MP) * DM;
#pragma unroll
                    for (int bj = 0; bj < 2; ++bj)
#pragma unroll
                        for (int n = 0; n < 2; ++n) { bs[mm][bj][n] = zero4(); if (have) bs[mm][bj][n] = *(const f32x4*)(bp + col0 + bj * 128 + n * 16); }
                } else {
#pragma unroll
                    for (int bj = 0; bj < 2; ++bj)
#pragma unroll
                        for (int n = 0; n < 2; ++n) { const u32x2 v = *(const u32x2*)(XBo + (size_t)row * DM + col0 + bj * 128 + n * 16); bs[mm][bj][n] = (f32x4){lo16(v.x), hi16(v.x), lo16(v.y), hi16(v.y)}; }
                }
            }
#pragma unroll
            for (int mm = 0; mm < 2; ++mm) {
                const int m = (g2 & 1) * 2 + mm;
                const int row = row0 + ai * 128 + m * 16;
                float ss = 0.f;
#pragma unroll
                for (int bj = 0; bj < 2; ++bj)
#pragma unroll
                    for (int n = 0; n < 2; ++n) {
                        const int c = col0 + bj * 128 + n * 16;
                        const f32x4 o = bs[mm][bj][n] + acc[ai][bj][m][n];
                        u32x2 w; w.x = cvt_pk_bf16(o[0], o[1]); w.y = cvt_pk_bf16(o[2], o[3]); *(u32x2*)(XBo + (size_t)row * DM + c) = w;
                        ss += (o[0] * o[0] + o[1] * o[1]) + (o[2] * o[2] + o[3] * o[3]);
                    }
                ss += __shfl_xor(ss, 16); ss += __shfl_xor(ss, 32);
                if (fq == 0) SSo[(size_t)row * 16 + u.pn * 4 + wc] = ss;
            }
        }
    }
};

__device__ void transpose_tile(const float* src, int ldn, int nvalid, int k0, int n0, bf16_t* dst, int ldk, const float* sk, float sn, LAS float* T) {
    const int tid = otid();
    {
        const int r = tid >> 4, c4 = tid & 15;
#pragma unroll
        for (int i = 0; i < 2; ++i) {
            const int k = r + 32 * i; const int n = n0 + 4 * c4;
            f32x4 v = zero4();
            if (n + 3 < nvalid) v = *(const f32x4*)(src + (size_t)(k0 + k) * ldn + n);
            const float s = (sk ? sk[k0 + k] : 1.0f) * sn;
            T[k * 65 + 4 * c4 + 0] = v[0] * s; T[k * 65 + 4 * c4 + 1] = v[1] * s; T[k * 65 + 4 * c4 + 2] = v[2] * s; T[k * 65 + 4 * c4 + 3] = v[3] * s;
        }
    }
    __syncthreads();
    {
        const int n = tid >> 3, kq = tid & 7;
        float f[8];
#pragma unroll
        for (int j = 0; j < 8; ++j) f[j] = T[(kq * 8 + j) * 65 + n];
        u32x4 w; w.x = cvt_pk_bf16(f[0], f[1]); w.y = cvt_pk_bf16(f[2], f[3]); w.z = cvt_pk_bf16(f[4], f[5]); w.w = cvt_pk_bf16(f[6], f[7]);
        *(u32x4*)(dst + (size_t)(n0 + n) * ldk + k0 + kq * 8) = w;
    }
    __syncthreads();
}

__device__ void phase_prep(const Params& p, LAS unsigned char* lds) {
    LAS float* T = (LAS float*)lds;
    bf16_t* WT1 = (bf16_t*)(p.ws + WS_WT1); bf16_t* WT2 = (bf16_t*)(p.ws + WS_WT2); bf16_t* WGT = (bf16_t*)(p.ws + WS_WGT);
    bf16_t* XB = (bf16_t*)(p.ws + WS_XB); float* SS = (float*)(p.ws + WS_SS); bf16_t* MG = (bf16_t*)(p.ws + WS_MG);
    constexpr int JA = 2 * 16 * 116, JB = 2 * 32 * 16, JC = 64, JD = MR / 8;
    for (int job = blockIdx.x; job < JA + JB + JC + JD; job += gridDim.x) {
        if (job < JA) {
            const int l = job / (16 * 116), r = job % (16 * 116), ntile = r / 16, kt = r % 16;
            const int n0 = ntile * 64;
            const float sn = (n0 >= 3072 && n0 < 4096) ? 0.0625f : 1.0f;
            transpose_tile(p.w_in + (size_t)l * DM * DIN, DIN, DIN, kt * 64, n0, WT1 + (size_t)l * NW1 * DM, DM, p.g_norm + l * DM, sn, T);
        } else if (job < JA + JB) {
            const int j = job - JA, l = j / 512, r = j % 512, ntile = r / 32, kt = r % 32;
            transpose_tile(p.w_out + (size_t)l * DMG * DM, DM, DM, kt * 64, ntile * 64, WT2 + (size_t)l * DM * DMG, DMG, nullptr, 1.0f, T);
        } else if (job < JA + JB + JC) {
            const int j = job - JA - JB, l = j >> 5, gate = (j >> 4) & 1, blk = j & 15;
            const float* src = (gate ? p.w_i : p.w_r) + (size_t)(l * 16 + blk) * 4096;
            transpose_tile(src, 64, 64, 0, 0, WGT + (size_t)((l * 2 + gate) * 16 + blk) * 4096, 64, nullptr, 1.0f, T);
        } else {
            const int j = job - JA - JB - JC; const int tidp = otid(); const int wid = tidp >> 6, lane = tidp & 63;
            const int row = j * 8 + wid;
            const float* src = row < MP ? p.xp + (size_t)row * DM : (row < MV ? p.xs + (size_t)(row - MP) * DM : nullptr);
            f32x4 v[4]; float ss = 0.f;
#pragma unroll
            for (int i = 0; i < 4; ++i) { v[i] = src ? *(const f32x4*)(src + lane * 16 + i * 4) : zero4(); ss += (v[i][0] * v[i][0] + v[i][1] * v[i][1]) + (v[i][2] * v[i][2] + v[i][3] * v[i][3]); }
#pragma unroll
            for (int o = 32; o >= 1; o >>= 1) ss += __shfl_xor(ss, o);
            u32x4 w0, w1;
            w0.x = cvt_pk_bf16(v[0][0], v[0][1]); w0.y = cvt_pk_bf16(v[0][2], v[0][3]); w0.z = cvt_pk_bf16(v[1][0], v[1][1]); w0.w = cvt_pk_bf16(v[1][2], v[1][3]);
            w1.x = cvt_pk_bf16(v[2][0], v[2][1]); w1.y = cvt_pk_bf16(v[2][2], v[2][3]); w1.z = cvt_pk_bf16(v[3][0], v[3][1]); w1.w = cvt_pk_bf16(v[3][2], v[3][3]);
            *(u32x4*)(XB + (size_t)row * DM + lane * 16) = w0; *(u32x4*)(XB + (size_t)row * DM + lane * 16 + 8) = w1;
            if (lane < 16) SS[(size_t)row * 16 + lane] = lane == 0 ? ss : 0.f;
            if (row >= MV) { const u32x4 z = (u32x4){0u, 0u, 0u, 0u}; u32x4* mp = (u32x4*)(MG + (size_t)row * DMG + lane * 32); mp[0] = z; mp[1] = z; mp[2] = z; mp[3] = z; }
        }
    }
}

constexpr int M_QI = 0, M_KI = 38912, M_VI = 77824, M_CTI = 96256, M_SM = 130048;
constexpr int RS_QK = 304, RS_V = 144, RS_CT = 528;

template <int OFF0, int OFF1>
__device__ __forceinline__ bf16x8 tr_frag(unsigned base) {
    bf16x4 lo, hi;
    asm volatile("ds_read_b64_tr_b16 %0, %2 offset:%3\n\tds_read_b64_tr_b16 %1, %2 offset:%4\n\ts_waitcnt lgkmcnt(0)" : "=&v"(lo), "=&v"(hi) : "v"(base), "i"(OFF0), "i"(OFF1) : "memory");
    bf16x8 r; r[0] = lo[0]; r[1] = lo[1]; r[2] = lo[2]; r[3] = lo[3]; r[4] = hi[0]; r[5] = hi[1]; r[6] = hi[2]; r[7] = hi[3]; return r;
}

template <int O0, int O1, int HI>
__device__ __forceinline__ void tr_frag2(unsigned base, bf16x8& f0, bf16x8& f1) {
    bf16x4 a0, a1, b0, b1;
    asm volatile("ds_read_b64_tr_b16 %0, %4 offset:%5\n\tds_read_b64_tr_b16 %1, %4 offset:%6\n\tds_read_b64_tr_b16 %2, %4 offset:%7\n\tds_read_b64_tr_b16 %3, %4 offset:%8\n\ts_waitcnt lgkmcnt(0)"
                 : "=&v"(a0), "=&v"(a1), "=&v"(b0), "=&v"(b1) : "v"(base), "i"(O0), "i"(O0 + HI), "i"(O1), "i"(O1 + HI) : "memory");
    f0 = __builtin_shufflevector(a0, a1, 0, 1, 2, 3, 4, 5, 6, 7); f1 = __builtin_shufflevector(b0, b1, 0, 1, 2, 3, 4, 5, 6, 7);
}
template <int KS>
__device__ __forceinline__ void mlstm_D(f32x4 (&CT)[8], unsigned bvD, unsigned bkD) {
    const bf16x8 vdf = tr_frag<KS * 32 * RS_V, KS * 32 * RS_V + 4 * RS_V>(bvD);
    bf16x8 k0, k1;
    tr_frag2<KS * 32 * RS_QK + 0, KS * 32 * RS_QK + 32, 4 * RS_QK>(bkD, k0, k1);
    CT[0] = __builtin_amdgcn_mfma_f32_16x16x32_bf16(k0, vdf, CT[0], 0, 0, 0);
    CT[1] = __builtin_amdgcn_mfma_f32_16x16x32_bf16(k1, vdf, CT[1], 0, 0, 0);
    tr_frag2<KS * 32 * RS_QK + 64, KS * 32 * RS_QK + 96, 4 * RS_QK>(bkD, k0, k1);
    CT[2] = __builtin_amdgcn_mfma_f32_16x16x32_bf16(k0, vdf, CT[2], 0, 0, 0);
    CT[3] = __builtin_amdgcn_mfma_f32_16x16x32_bf16(k1, vdf, CT[3], 0, 0, 0);
    tr_frag2<KS * 32 * RS_QK + 128, KS * 32 * RS_QK + 160, 4 * RS_QK>(bkD, k0, k1);
    CT[4] = __builtin_amdgcn_mfma_f32_16x16x32_bf16(k0, vdf, CT[4], 0, 0, 0);
    CT[5] = __builtin_amdgcn_mfma_f32_16x16x32_bf16(k1, vdf, CT[5], 0, 0, 0);
    tr_frag2<KS * 32 * RS_QK + 192, KS * 32 * RS_QK + 224, 4 * RS_QK>(bkD, k0, k1);
    CT[6] = __builtin_amdgcn_mfma_f32_16x16x32_bf16(k0, vdf, CT[6], 0, 0, 0);
    CT[7] = __builtin_amdgcn_mfma_f32_16x16x32_bf16(k1, vdf, CT[7], 0, 0, 0);
}
template <int O, int STEP, int HI>
__device__ __forceinline__ void tr_frag4(unsigned base, bf16x8& f0, bf16x8& f1, bf16x8& f2, bf16x8& f3) {
    bf16x4 a0, a1, b0, b1, c0, c1, d0, d1;
    asm volatile("ds_read_b64_tr_b16 %0, %8 offset:%9\n\tds_read_b64_tr_b16 %1, %8 offset:%10\n\tds_read_b64_tr_b16 %2, %8 offset:%11\n\tds_read_b64_tr_b16 %3, %8 offset:%12\n\t"
                 "ds_read_b64_tr_b16 %4, %8 offset:%13\n\tds_read_b64_tr_b16 %5, %8 offset:%14\n\tds_read_b64_tr_b16 %6, %8 offset:%15\n\tds_read_b64_tr_b16 %7, %8 offset:%16\n\ts_waitcnt lgkmcnt(0)"
                 : "=&v"(a0), "=&v"(a1), "=&v"(b0), "=&v"(b1), "=&v"(c0), "=&v"(c1), "=&v"(d0), "=&v"(d1)
                 : "v"(base), "i"(O), "i"(O + HI), "i"(O + STEP), "i"(O + STEP + HI), "i"(O + 2 * STEP), "i"(O + 2 * STEP + HI), "i"(O + 3 * STEP), "i"(O + 3 * STEP + HI) : "memory");
    f0 = __builtin_shufflevector(a0, a1, 0, 1, 2, 3, 4, 5, 6, 7); f1 = __builtin_shufflevector(b0, b1, 0, 1, 2, 3, 4, 5, 6, 7);
    f2 = __builtin_shufflevector(c0, c1, 0, 1, 2, 3, 4, 5, 6, 7); f3 = __builtin_shufflevector(d0, d1, 0, 1, 2, 3, 4, 5, 6, 7);
}
template <int KS>
__device__ __forceinline__ void mlstm_B(f32x4 (&N1)[4], LAS unsigned char* lds, unsigned bvB, int t, int fq) {
    const bf16x8 pf = *(const LAS bf16x8*)(lds + M_QI + t * RS_QK + KS * 64 + fq * 16);
    bf16x8 v0, v1, v2, v3;
    tr_frag4<KS * 32 * RS_V, 32, 4 * RS_V>(bvB, v0, v1, v2, v3);
    N1[0] = __builtin_amdgcn_mfma_f32_16x16x32_bf16(v0, pf, N1[0], 0, 0, 0);
    N1[1] = __builtin_amdgcn_mfma_f32_16x16x32_bf16(v1, pf, N1[1], 0, 0, 0);
    N1[2] = __builtin_amdgcn_mfma_f32_16x16x32_bf16(v2, pf, N1[2], 0, 0, 0);
    N1[3] = __builtin_amdgcn_mfma_f32_16x16x32_bf16(v3, pf, N1[3], 0, 0, 0);
}

__device__ void mlstm_prompt(const Params& p, int l, int item, LAS unsigned char* lds) {
    const int tid0 = otid();
    const int js = item & 3, h = (item >> 2) & 3, b = item >> 4;
    const unsigned ldsb = (unsigned)(size_t)lds;
    LAS float* sm = (LAS float*)(lds + M_SM);
    LAS float* nbuf = sm + 512; LAS float* npart = sm + 1552;
    const bf16_t* U = (const bf16_t*)(p.ws + WS_U); const float* G = (const float*)(p.ws + WS_G);
    bf16_t* MG = (bf16_t*)(p.ws + WS_MG);
    const size_t grow_base = (size_t)b * 2048;
    const int qcol = 2048 + h * 256, kcol = 3072 + h * 256, vcol = 4096 + h * 256 + js * 64;

    __syncthreads();
    for (int i = tid0; i < RS_CT * 64 / 16; i += NT) *(LAS u32x4*)(lds + M_CTI + i * 16) = (u32x4){0u, 0u, 0u, 0u};
    nbuf[tid0] = 0.f;
    f32x4 CTacc[8];
#pragma unroll
    for (int i = 0; i < 8; ++i) CTacc[i] = zero4();
    float m_prev = 0.f;
    u32x4 qreg[4], kreg[4], vreg[2]; float igr[2] = {0.f, 0.f}, lfr[2] = {0.f, 0.f};

#define ML_LOAD_QK(row0_, hd_) do { _Pragma("unroll") for (int i_ = 0; i_ < 4; ++i_) { const int id_ = tid + NT * i_, r_ = id_ >> 4, cq_ = id_ & 15; \
        const bf16_t* rp_ = U + (grow_base + (row0_) + r_) * NU + (hd_) * 128 + cq_ * 8; qreg[i_] = *(const u32x4*)(rp_ + qcol); kreg[i_] = *(const u32x4*)(rp_ + kcol); } } while (0)
#define ML_STORE_QK() do { _Pragma("unroll") for (int i_ = 0; i_ < 4; ++i_) { const int id_ = tid + NT * i_, r_ = id_ >> 4, cq_ = id_ & 15; \
        *(LAS u32x4*)(lds + M_QI + r_ * RS_QK + cq_ * 16) = qreg[i_]; *(LAS u32x4*)(lds + M_KI + r_ * RS_QK + cq_ * 16) = kreg[i_]; } } while (0)
#define ML_LOAD_VG(row0_) do { _Pragma("unroll") for (int i_ = 0; i_ < 2; ++i_) { const int id_ = tid + NT * i_, s_ = id_ >> 3, cq_ = id_ & 7; \
        vreg[i_] = *(const u32x4*)(U + (grow_base + (row0_) + s_) * NU + vcol + cq_ * 8); } \
        if (w == 0) { const float* gp_ = G + (grow_base + (row0_) + 2 * lane) * 8 + h; igr[0] = gp_[0]; lfr[0] = gp_[4]; igr[1] = gp_[8]; lfr[1] = gp_[12]; } } while (0)

#define ML_PREPASS(buf_) do { if (w == 0) { LAS float* dec_ = sm + 128 * (buf_); LAS float* expnm_ = sm + 256 + 128 * (buf_); LAS float* scal_ = sm + 1024 + 8 * (buf_); \
            const float s2 = lfr[0] + lfr[1]; float incl = s2; \
            _Pragma("unroll") for (int o = 1; o < 64; o <<= 1) { const float t_ = __shfl_up(incl, o); if (lane >= o) incl += t_; } \
            const float b0 = incl - s2 + lfr[0], b1 = incl; \
            const float a0 = igr[0] - b0, a1 = igr[1] - b1; float im = fmaxf(a0, a1); \
            _Pragma("unroll") for (int o = 1; o < 64; o <<= 1) { const float t_ = __shfl_up(im, o); if (lane >= o) im = fmaxf(im, t_); } \
            float ex = __shfl_up(im, 1); if (lane == 0) ex = -INFINITY; \
            const float M0 = fmaxf(ex, a0), M1 = fmaxf(M0, a1); \
            const float mt1 = b1 + fmaxf(m_prev, M1); \
            const float bL = __shfl(b1, 63), mL = __shfl(mt1, 63); \
            expnm_[2 * lane] = __expf(bL - mL - b0); expnm_[2 * lane + 1] = __expf(bL - mL - b1); \
            dec_[2 * lane] = __expf(bL - b0 + igr[0] - mL); dec_[2 * lane + 1] = __expf(bL - b1 + igr[1] - mL); \
            if (lane == 0) { scal_[0] = __expf(bL + m_prev - mL); scal_[1] = mL; } \
            m_prev = mL; } } while (0)
    { const int tid = tid0, w = tid >> 6, lane = tid & 63; ML_LOAD_QK(0, 0); ML_LOAD_VG(0); ML_PREPASS(0); }
#pragma unroll 1
    for (int c = 0; c < 16; ++c) {
        int tid = tid0; asm volatile("" : "+v"(tid));
        const int w = __builtin_amdgcn_readfirstlane(tid >> 6), lane = tid & 63, fr = lane & 15, fq = lane >> 4;
        const int cD = w & 3, gD = w >> 2, qq = (lane & 15) >> 2, pp = lane & 3;
        const unsigned bvB = ldsb + M_VI + (8 * fq + qq) * RS_V + 8 * pp;
        const unsigned bvD = bvB + cD * 32;
        const int row0 = c * 128;
        LAS float* nC = nbuf + (c & 1) * 256; LAS float* nN = nbuf + ((c + 1) & 1) * 256;
        __syncthreads();
        ML_STORE_QK();
        LAS float* dec = sm + 128 * (c & 1); LAS float* expnm = sm + 256 + 128 * (c & 1); LAS float* scal = sm + 1024 + 8 * (c & 1);
        const float cs = scal[0];
#pragma unroll
        for (int i = 0; i < 2; ++i) {
            const int id = tid + NT * i, s = id >> 3, cq = id & 7; const float d = dec[s];
            u32x4 v = vreg[i], o;
            o.x = cvt_pk_bf16(lo16(v.x) * d, hi16(v.x) * d); o.y = cvt_pk_bf16(lo16(v.y) * d, hi16(v.y) * d);
            o.z = cvt_pk_bf16(lo16(v.z) * d, hi16(v.z) * d); o.w = cvt_pk_bf16(lo16(v.w) * d, hi16(v.w) * d);
            *(LAS u32x4*)(lds + M_VI + s * RS_V + cq * 16) = o;
        }
        if (tid < 256) nN[tid] = cs * nC[tid];
        ML_LOAD_QK(row0, 1);
        f32x4 Sacc[8], N2[4];
#pragma unroll
        for (int i = 0; i < 8; ++i) Sacc[i] = zero4();
#pragma unroll
        for (int i = 0; i < 4; ++i) N2[i] = zero4();
        float qnp = 0.f;
#pragma unroll 1
        for (int hd = 0; hd < 2; ++hd) {
            __syncthreads();
#pragma unroll
            for (int ks = 0; ks < 4; ++ks) {
                const bf16x8 qf = *(const LAS bf16x8*)(lds + M_QI + (16 * w + fr) * RS_QK + ks * 64 + fq * 16);
#pragma unroll
                for (int g = 0; g < 2; ++g) if (4 * g <= w) {
                    bf16x8 kf[4];
#pragma unroll
                    for (int e = 0; e < 4; ++e) kf[e] = *(const LAS bf16x8*)(lds + M_KI + (64 * g + 16 * e + fr) * RS_QK + ks * 64 + fq * 16);
#pragma unroll
                    for (int e = 0; e < 4; ++e) Sacc[4 * g + e] = __builtin_amdgcn_mfma_f32_16x16x32_bf16(kf[e], qf, Sacc[4 * g + e], 0, 0, 0);
                }
#pragma unroll
                for (int c4 = 0; c4 < 4; ++c4) {
                    const bf16x8 ctf = *(const LAS bf16x8*)(lds + M_CTI + (16 * c4 + fr) * RS_CT + hd * 256 + ks * 64 + fq * 16);
                    N2[c4] = __builtin_amdgcn_mfma_f32_16x16x32_bf16(ctf, qf, N2[c4], 0, 0, 0);
                }
                const LAS float* np = nC + hd * 128 + ks * 32 + fq * 8;
#pragma unroll
                for (int j = 0; j < 8; ++j) qnp += bf2f((unsigned short)qf[j]) * np[j];
                __builtin_amdgcn_sched_barrier(0);
            }
            if (gD == hd) {
                const unsigned bkD = ldsb + M_KI + (8 * fq + qq) * RS_QK + 8 * pp;
#pragma unroll
                for (int i = 0; i < 8; ++i) CTacc[i] *= cs;
                mlstm_D<0>(CTacc, bvD, bkD); __builtin_amdgcn_sched_barrier(0); mlstm_D<1>(CTacc, bvD, bkD); __builtin_amdgcn_sched_barrier(0); mlstm_D<2>(CTacc, bvD, bkD); __builtin_amdgcn_sched_barrier(0); mlstm_D<3>(CTacc, bvD, bkD); __builtin_amdgcn_sched_barrier(0);
            }
            if (gD != hd) {
                const int lidx = (w & 3) * 64 + lane, dk4 = lidx & 31, part = lidx >> 5; float a0 = 0.f, a1 = 0.f, a2 = 0.f, a3 = 0.f;
#pragma unroll 2
                for (int s = 16 * part; s < 16 * part + 16; ++s) {
                    const u32x2 kv = *(const LAS u32x2*)(lds + M_KI + s * RS_QK + dk4 * 8); const float d = dec[s];
                    a0 += d * lo16(kv.x); a1 += d * hi16(kv.x); a2 += d * lo16(kv.y); a3 += d * hi16(kv.y);
                }
                *(LAS f32x4*)(npart + part * 128 + 4 * dk4) = (f32x4){a0, a1, a2, a3};
            }
            __syncthreads();
            if (tid < 128) nN[hd * 128 + tid] += ((npart[tid] + npart[128 + tid]) + (npart[256 + tid] + npart[384 + tid])) + ((npart[512 + tid] + npart[640 + tid]) + (npart[768 + tid] + npart[896 + tid]));
            if (gD == hd) {
#pragma unroll
                for (int i = 0; i < 8; ++i) {
                    u32x2 wv; wv.x = cvt_pk_bf16(CTacc[i][0], CTacc[i][1]); wv.y = cvt_pk_bf16(CTacc[i][2], CTacc[i][3]);
                    *(LAS u32x2*)(lds + M_CTI + (16 * cD + fr) * RS_CT + (hd * 128 + 16 * i + 4 * fq) * 2) = wv;
                }
            }
            if (hd == 0) {
                ML_STORE_QK();
                if (c < 15) { ML_LOAD_QK(row0 + 128, 0); }
            }
        }
        if (c < 15) { ML_LOAD_VG(row0 + 128); }
        const int t = 16 * w + fr;
        float den1 = 0.f;
#pragma unroll
        for (int g = 0; g < 4; ++g) if (2 * g <= w) {
            const f32x4 dv0 = *(const LAS f32x4*)(dec + 32 * g + 4 * fq), dv1 = *(const LAS f32x4*)(dec + 32 * g + 16 + 4 * fq);
            f32x4 s0 = Sacc[2 * g], s1 = Sacc[2 * g + 1];
#pragma unroll
            for (int j = 0; j < 4; ++j) {
                const int sa = 32 * g + 4 * fq + j, sb = sa + 16;
                if (sa > t) s0[j] = 0.f;
                if (sb > t || 2 * g + 1 > w) s1[j] = 0.f;
                den1 += s0[j] * dv0[j] + s1[j] * dv1[j];
            }
            u32x2 w0, w1; w0.x = cvt_pk_bf16(s0[0], s0[1]); w0.y = cvt_pk_bf16(s0[2], s0[3]); w1.x = cvt_pk_bf16(s1[0], s1[1]); w1.y = cvt_pk_bf16(s1[2], s1[3]);
            *(LAS u32x2*)(lds + M_QI + t * RS_QK + (32 * g + 4 * fq) * 2) = w0;
            *(LAS u32x2*)(lds + M_QI + t * RS_QK + (32 * g + 16 + 4 * fq) * 2) = w1;
        }
        den1 += __shfl_xor(den1, 16); den1 += __shfl_xor(den1, 32);
        qnp += __shfl_xor(qnp, 16); qnp += __shfl_xor(qnp, 32);
#pragma unroll
        for (int i = 0; i < 4; ++i) N2[i] *= cs;
        if (0 <= (w >> 1)) mlstm_B<0>(N2, lds, bvB, t, fq);
        if (1 <= (w >> 1)) mlstm_B<1>(N2, lds, bvB, t, fq);
        if (2 <= (w >> 1)) mlstm_B<2>(N2, lds, bvB, t, fq);
        if (3 <= (w >> 1)) mlstm_B<3>(N2, lds, bvB, t, fq);
        {
            const float den = den1 + cs * qnp;
            const float inv = 1.0f / fmaxf(fabsf(den), expnm[t]);
            const size_t grow = grow_base + row0 + t;
#pragma unroll
            for (int c4 = 0; c4 < 4; ++c4) {
                const float y0 = N2[c4][0] * inv, y1 = N2[c4][1] * inv, y2 = N2[c4][2] * inv, y3 = N2[c4][3] * inv;
                u32x2 wv; wv.x = cvt_pk_bf16(y0, y1); wv.y = cvt_pk_bf16(y2, y3);
                *(u32x2*)(MG + grow * DMG + 1024 + h * 256 + js * 64 + 16 * c4 + 4 * fq) = wv;
            }
        }
        if (c < 15) ML_PREPASS((c + 1) & 1);
    }
    __syncthreads();
    {
        const int tid = tid0, w = tid >> 6, lane = tid & 63, fr = lane & 15, fq = lane >> 4, cD = w & 3, gD = w >> 2;
        float* pC = p.out + O_PC + ((size_t)((l * 8 + b) * 4 + h)) * 65536;
#pragma unroll
        for (int i = 0; i < 8; ++i)
#pragma unroll
            for (int j = 0; j < 4; ++j) pC[(size_t)(gD * 128 + 16 * i + 4 * fq + j) * 256 + js * 64 + 16 * cD + fr] = CTacc[i][j];
        if (js == 0) {
            if (tid < 256) p.out[O_PN + ((size_t)((l * 8 + b) * 4 + h)) * 256 + tid] = nbuf[tid];
            if (tid == 0) p.out[O_PM + (l * 8 + b) * 4 + h] = sm[1024 + 8 + 1];
        }
    }
    __syncthreads();
#undef ML_LOAD_QK
#undef ML_STORE_QK
#undef ML_LOAD_VG
#undef ML_PREPASS
}

constexpr int R_XAI = 0, R_XCF = 16768, R_XCB = 49536, R_AA = 67968, R_UU = 100736, R_PT = 133504, R_HC = 137600, R_CW = 138112, R_CH = 139392, R_WG = 140160;
__device__ void rglru_item(const Params& p, int l, int b, int cb, bool decm, LAS unsigned char* lds) {
    const int tid = otid(), w = __builtin_amdgcn_readfirstlane(tid >> 6), lane = tid & 63, fr = lane & 15, fq = lane >> 4;
    const bf16_t* U = (const bf16_t*)(p.ws + WS_U); bf16_t* MG = (bf16_t*)(p.ws + WS_MG);
    const bf16_t* WGT = (const bf16_t*)(p.ws + WS_WGT);
    LAS float* XCF = (LAS float*)(lds + R_XCF); LAS float* AA = (LAS float*)(lds + R_AA); LAS float* UU = (LAS float*)(lds + R_UU);
    LAS float* PT = (LAS float*)(lds + R_PT); LAS float* HC = (LAS float*)(lds + R_HC); LAS float* CW = (LAS float*)(lds + R_CW); LAS float* CH = (LAS float*)(lds + R_CH);
    const int ch0 = cb * 64;
    const size_t grow_base = decm ? (size_t)MP : (size_t)b * 2048;
    const int nchunk = decm ? 1 : 16;
    __syncthreads();
    if (tid < 64) {
        const int ch = ch0 + tid;
#pragma unroll
        for (int j = 0; j < 4; ++j) CW[j * 64 + tid] = p.conv_w[(size_t)(l * 4 + j) * 1024 + ch];
        CW[256 + tid] = p.conv_b[l * 1024 + ch];
        CH[tid] = p.b_r[l * 1024 + ch]; CH[64 + tid] = p.b_i[l * 1024 + ch]; CH[128 + tid] = 8.0f * softplusf_(-p.lam[l * 1024 + ch]);
        HC[tid] = 0.f; HC[64 + tid] = 0.f;
    }
    if (tid < 24) *(LAS u32x4*)(lds + R_XAI + tid * 16) = (u32x4){0u, 0u, 0u, 0u};
#pragma unroll
    for (int i = 0; i < 2; ++i) {
        const int id = tid + NT * i, g = id >> 9, r = (id >> 3) & 63, cq = id & 7;
        *(LAS u32x4*)(lds + R_WG + (g * 64 + r) * 144 + cq * 16) = *(const u32x4*)(WGT + (size_t)((l * 2 + g) * 16 + cb) * 4096 + r * 64 + cq * 8);
    }
    u32x4 xreg[2], zreg[2];
#pragma unroll
    for (int i = 0; i < 2; ++i) { const int id = tid + NT * i, r = id >> 3, cq = id & 7; const bf16_t* rp = U + (grow_base + r) * NU + ch0 + cq * 8; xreg[i] = *(const u32x4*)rp; zreg[i] = *(const u32x4*)(rp + 1024); }
    for (int c = 0; c < nchunk; ++c) {
        const int row0 = c * 128;
        __syncthreads();
        if (c > 0) {
#pragma unroll
            for (int i = 0; i < 2; ++i) { const int id = tid + NT * i, r = id >> 3, cq = id & 7; *(u32x4*)(MG + (grow_base + row0 - 128 + r) * DMG + ch0 + cq * 8) = *(const LAS u32x4*)(lds + R_XCF + r * 128 + cq * 16); }
        }
        u32x4 zcur[2];
#pragma unroll
        for (int i = 0; i < 2; ++i) { const int id = tid + NT * i, r = id >> 3, cq = id & 7; *(LAS u32x4*)(lds + R_XAI + (3 + r) * 128 + cq * 16) = xreg[i]; zcur[i] = zreg[i]; }
        if (c + 1 < nchunk) {
#pragma unroll
            for (int i = 0; i < 2; ++i) { const int id = tid + NT * i, r = id >> 3, cq = id & 7; const bf16_t* rp = U + (grow_base + row0 + 128 + r) * NU + ch0 + cq * 8; xreg[i] = *(const u32x4*)rp; zreg[i] = *(const u32x4*)(rp + 1024); }
        }
        __syncthreads();
        {
            const int t = tid >> 2, c0 = (tid & 3) * 16;
            float xc[16];
#pragma unroll
            for (int k = 0; k < 16; ++k) xc[k] = CW[256 + c0 + k];
            if (!decm) {
#pragma unroll
                for (int j = 0; j < 4; ++j) {
                    const u32x4 a = *(const LAS u32x4*)(lds + R_XAI + (t + j) * 128 + c0 * 2), bq = *(const LAS u32x4*)(lds + R_XAI + (t + j) * 128 + c0 * 2 + 16);
                    const unsigned wv[8] = {a.x, a.y, a.z, a.w, bq.x, bq.y, bq.z, bq.w};
#pragma unroll
                    for (int k = 0; k < 8; ++k) { xc[2 * k] += CW[j * 64 + c0 + 2 * k] * lo16(wv[k]); xc[2 * k + 1] += CW[j * 64 + c0 + 2 * k + 1] * hi16(wv[k]); }
                }
            } else {
                const float* stp = p.st_conv + ((size_t)(l * 128 + t) * 3) * 1024 + ch0 + c0;
                float* so = p.out + O_SCONV + ((size_t)(l * 128 + t) * 3) * 1024 + ch0 + c0;
#pragma unroll
                for (int j = 0; j < 3; ++j)
#pragma unroll
                    for (int k4 = 0; k4 < 4; ++k4) {
                        const f32x4 sv = *(const f32x4*)(stp + (size_t)j * 1024 + k4 * 4);
#pragma unroll
                        for (int e = 0; e < 4; ++e) xc[k4 * 4 + e] += CW[j * 64 + c0 + k4 * 4 + e] * sv[e];
                        if (j >= 1) *(f32x4*)(so + (size_t)(j - 1) * 1024 + k4 * 4) = sv;
                    }
                const u32x4 a = *(const LAS u32x4*)(lds + R_XAI + (t + 3) * 128 + c0 * 2), bq = *(const LAS u32x4*)(lds + R_XAI + (t + 3) * 128 + c0 * 2 + 16);
                const unsigned wv[8] = {a.x, a.y, a.z, a.w, bq.x, bq.y, bq.z, bq.w};
#pragma unroll
                for (int k = 0; k < 8; ++k) {
                    const float x0 = lo16(wv[k]), x1 = hi16(wv[k]);
                    xc[2 * k] += CW[3 * 64 + c0 + 2 * k] * x0; xc[2 * k + 1] += CW[3 * 64 + c0 + 2 * k + 1] * x1;
                    so[2 * 1024 + 2 * k] = x0; so[2 * 1024 + 2 * k + 1] = x1;
                }
            }
#pragma unroll
            for (int k4 = 0; k4 < 4; ++k4) *(LAS f32x4*)(XCF + t * 64 + c0 + k4 * 4) = (f32x4){xc[k4 * 4], xc[k4 * 4 + 1], xc[k4 * 4 + 2], xc[k4 * 4 + 3]};
            u32x4 o0, o1;
            o0.x = cvt_pk_bf16(xc[0], xc[1]); o0.y = cvt_pk_bf16(xc[2], xc[3]); o0.z = cvt_pk_bf16(xc[4], xc[5]); o0.w = cvt_pk_bf16(xc[6], xc[7]);
            o1.x = cvt_pk_bf16(xc[8], xc[9]); o1.y = cvt_pk_bf16(xc[10], xc[11]); o1.z = cvt_pk_bf16(xc[12], xc[13]); o1.w = cvt_pk_bf16(xc[14], xc[15]);
            *(LAS u32x4*)(lds + R_XCB + t * 144 + c0 * 2) = o0; *(LAS u32x4*)(lds + R_XCB + t * 144 + c0 * 2 + 16) = o1;
        }
        __syncthreads();
        if (!decm && tid < 24) { const u32x4 v = *(const LAS u32x4*)(lds + R_XAI + 128 * 128 + tid * 16); *(LAS u32x4*)(lds + R_XAI + tid * 16) = v; }
        {
            bf16x8 xf[2];
#pragma unroll
            for (int ks = 0; ks < 2; ++ks) xf[ks] = *(const LAS bf16x8*)(lds + R_XCB + (16 * w + fr) * 144 + ks * 64 + fq * 16);
            const int t = 16 * w + fr;
#pragma unroll
            for (int c4 = 0; c4 < 4; ++c4) {
                f32x4 ar = zero4(), ai = ar;
#pragma unroll
                for (int ks = 0; ks < 2; ++ks) {
                    const bf16x8 wfr = *(const LAS bf16x8*)(lds + R_WG + (16 * c4 + fr) * 144 + ks * 64 + fq * 16);
                    const bf16x8 wfi = *(const LAS bf16x8*)(lds + R_WG + (64 + 16 * c4 + fr) * 144 + ks * 64 + fq * 16);
                    ar = __builtin_amdgcn_mfma_f32_16x16x32_bf16(wfr, xf[ks], ar, 0, 0, 0); ai = __builtin_amdgcn_mfma_f32_16x16x32_bf16(wfi, xf[ks], ai, 0, 0, 0); }
                const int d = 16 * c4 + 4 * fq;
                const f32x4 xcv = *(const LAS f32x4*)(XCF + t * 64 + d);
                f32x4 av, uv;
#pragma unroll
                for (int j = 0; j < 4; ++j) {
                    const float r = sigmoidf_(ar[j] + CH[d + j]), ig = sigmoidf_(ai[j] + CH[64 + d + j]);
                    const float la = -r * CH[128 + d + j];
                    const float x2 = 2.0f * la;
                    const float ser = -x2 * (1.0f + x2 * (0.5f + x2 * (0.16666667f + x2 * (0.041666668f + x2 * (0.0083333338f + x2 * 0.0013888889f)))));
                    const float om = x2 > -0.3f ? ser : 1.0f - __expf(x2);
                    av[j] = __expf(la); uv[j] = __builtin_amdgcn_sqrtf(om) * (ig * xcv[j]);
                }
                if (!decm) { *(LAS f32x4*)(AA + t * 64 + d) = av; *(LAS f32x4*)(UU + t * 64 + d) = uv; }
                else {
                    const f32x4 h0 = *(const f32x4*)(p.st_h + (size_t)(l * 128 + t) * 1024 + ch0 + d);
                    const f32x4 hn = av * h0 + uv;
                    *(f32x4*)(p.out + O_SH + (size_t)(l * 128 + t) * 1024 + ch0 + d) = hn;
                    const u32x2 zv = *(const u32x2*)(U + (grow_base + t) * NU + 1024 + ch0 + d);
                    u32x2 wv; wv.x = cvt_pk_bf16(hn[0] * lo16(zv.x), hn[1] * hi16(zv.x)); wv.y = cvt_pk_bf16(hn[2] * lo16(zv.y), hn[3] * hi16(zv.y));
                    *(u32x2*)(MG + (grow_base + t) * DMG + ch0 + d) = wv;
                }
            }
        }
        if (decm) break;
        __syncthreads();
#pragma unroll
        for (int i = 0; i < 2; ++i) { const int id = tid + NT * i, r = id >> 3, cq = id & 7; *(LAS u32x4*)(lds + R_XCB + r * 144 + cq * 16) = zcur[i]; }
        const int ch = tid & 63, part = tid >> 6;
        float av[16], uv[16];
#pragma unroll
        for (int k = 0; k < 16; ++k) { av[k] = AA[(part * 16 + k) * 64 + ch]; uv[k] = UU[(part * 16 + k) * 64 + ch]; }
        {
            float hh = 0.f, Ac = 1.f;
#pragma unroll
            for (int k = 0; k < 16; ++k) { hh = av[k] * hh + uv[k]; Ac *= av[k]; uv[k] = hh; av[k] = Ac; }
            PT[(part * 64 + ch) * 2] = Ac; PT[(part * 64 + ch) * 2 + 1] = hh;
        }
        __syncthreads();
        {
            float zv[16];
#pragma unroll
            for (int k = 0; k < 16; ++k) zv[k] = bf2f(*(const LAS unsigned short*)(lds + R_XCB + (part * 16 + k) * 144 + ch * 2));
            float hin = HC[(c & 1) * 64 + ch];
            for (int q = 0; q < part; ++q) hin = PT[(q * 64 + ch) * 2] * hin + PT[(q * 64 + ch) * 2 + 1];
            float hf = hin;
#pragma unroll
            for (int k = 0; k < 16; ++k) {
                hf = av[k] * hin + uv[k];
                const float y = hf * zv[k];
                *(LAS unsigned short*)(lds + R_XCF + (part * 16 + k) * 128 + ch * 2) = (unsigned short)(cvt_pk_bf16(y, y) & 0xffffu);
            }
            if (part == 7) {
                HC[((c + 1) & 1) * 64 + ch] = hf;
                if (c == 15) p.out[O_PH + (size_t)(l * 8 + b) * 1024 + ch0 + ch] = hf;
            }
        }
        if (c == 15 && tid < 192) {
            const int j = tid >> 6, cc = tid & 63;
            p.out[O_PCONV + ((size_t)(l * 8 + b) * 3 + j) * 1024 + ch0 + cc] = bf2f(*(const LAS unsigned short*)(lds + R_XAI + j * 128 + cc * 2));
        }
    }
    __syncthreads();
    if (!decm) {
#pragma unroll
        for (int i = 0; i < 2; ++i) { const int id = tid + NT * i, r = id >> 3, cq = id & 7; *(u32x4*)(MG + (grow_base + 15 * 128 + r) * DMG + ch0 + cq * 8) = *(const LAS u32x4*)(lds + R_XCF + r * 128 + cq * 16); }
    }
    __syncthreads();
}

__device__ void mlstm_decode(const Params& p, int l, int b, int h, LAS unsigned char* lds) {
    const int tid = otid(), lane = tid & 63;
    const bf16_t* U = (const bf16_t*)(p.ws + WS_U); const float* G = (const float*)(p.ws + WS_G);
    bf16_t* MG = (bf16_t*)(p.ws + WS_MG);
    LAS float* qs = (LAS float*)lds; LAS float* ks = qs + 256; LAS float* vs = qs + 512; LAS float* ns = qs + 768; LAS float* red = qs + 1024; LAS float* red2 = qs + 1024 + 2048;
    const size_t row = (size_t)MP + b;
    const size_t sidx = (size_t)((l * 128 + b) * 4 + h);
    __syncthreads();
    if (tid < 256) {
        qs[tid] = bf2f(U[row * NU + 2048 + h * 256 + tid]); ks[tid] = bf2f(U[row * NU + 3072 + h * 256 + tid]); vs[tid] = bf2f(U[row * NU + 4096 + h * 256 + tid]);
        ns[tid] = p.st_n[sidx * 256 + tid];
    }
    const float ig = G[row * 8 + h], lf = G[row * 8 + 4 + h], m0 = p.st_m[sidx];
    __syncthreads();
    float qk = 0.f, qn = 0.f;
#pragma unroll
    for (int j = 0; j < 4; ++j) { const float qv = qs[lane * 4 + j]; qk += qv * ks[lane * 4 + j]; qn += qv * ns[lane * 4 + j]; }
#pragma unroll
    for (int o = 32; o >= 1; o >>= 1) { qk += __shfl_xor(qk, o); qn += __shfl_xor(qn, o); }
    const float mt = fmaxf(lf + m0, ig), wg = __expf(ig - mt), gi = __expf(lf + m0 - mt);
    const int dvq = tid & 63, dkg = tid >> 6;
    float o_pre = 0.f, zg_pre = 0.f;
    if (tid < 256) { o_pre = bf2f(U[row * NU + 5120 + h * 256 + tid]); zg_pre = p.g_mhead[l * 1024 + h * 256 + tid] * bf2f(U[row * NU + 6144 + h * 256 + tid]); }
    const float* C0 = p.st_C + sidx * 65536; float* C1 = p.out + O_SC + sidx * 65536;
    const f32x4 v4 = *(const LAS f32x4*)(vs + dvq * 4);
    f32x4 qc = zero4();
#pragma unroll 16
    for (int i = 0; i < 32; ++i) {
        const int dk = dkg * 32 + i;
        const f32x4 c4 = __builtin_nontemporal_load((const f32x4*)(C0 + (size_t)dk * 256 + dvq * 4));
        const float qv = qs[dk], kv = wg * ks[dk];
        qc += qv * c4;
        const f32x4 cn = gi * c4 + kv * v4;
        __builtin_nontemporal_store(cn, (f32x4*)(C1 + (size_t)dk * 256 + dvq * 4));
    }
    *(LAS f32x4*)(red + dkg * 256 + dvq * 4) = qc;
    __syncthreads();
    float yv = 0.f;
    if (tid < 256) {
        float qcv = 0.f;
#pragma unroll
        for (int g = 0; g < 8; ++g) qcv += red[g * 256 + tid];
        const float num = wg * qk * vs[tid] + gi * qcv, den = wg * qk + gi * qn;
        const float hh = num / fmaxf(fabsf(den), __expf(-mt));
        yv = hh * o_pre;
        float ss = yv * yv;
#pragma unroll
        for (int o = 32; o >= 1; o >>= 1) ss += __shfl_xor(ss, o);
        if (lane == 0) red2[tid >> 6] = ss;
        p.out[O_SN + sidx * 256 + tid] = gi * ns[tid] + wg * ks[tid];
    }
    __syncthreads();
    if (tid < 256) {
        const float rstd = rsqrtf(((red2[0] + red2[1]) + (red2[2] + red2[3])) * (1.0f / 256.0f) + EPSF);
        const float ov = yv * rstd * zg_pre;
        MG[row * DMG + 1024 + h * 256 + tid] = (bf16_t)(cvt_pk_bf16(ov, ov) & 0xffffu);
    }
    if (tid == 0) p.out[O_SM + sidx] = mt;
}

__device__ void decode_items(const Params& p, int l, LAS unsigned char* lds, int max_items) {
    unsigned* ctr = (unsigned*)(p.ws + WS_BAR) + 3584 + 64 * l;
    volatile LAS unsigned* slot = (volatile LAS unsigned*)(lds + LDS_BYTES - 32);
    for (int n = 0; n < max_items; ++n) {
        __syncthreads();
        if (threadIdx.x == 0) *slot = __hip_atomic_fetch_add(ctr, 1u, __ATOMIC_RELAXED, __HIP_MEMORY_SCOPE_AGENT);
        __syncthreads();
        const int item = (int)*slot;
        if (item >= 512) break;
        mlstm_decode(p, l, item >> 2, item & 3, lds);
    }
}

__device__ void phase_mixers(const Params& p, int l, LAS unsigned char* lds) {
    const int G = gridDim.x, bid = obid();
    const bool split = G >= 256;
    const int r = split ? bid - 128 : bid, R = split ? G - 128 : G;
    if (!split || bid < 128) { for (int item = bid; item < 128; item += (split ? 128 : G)) mlstm_prompt(p, l, item, lds); }
    if (r >= 0) {
        for (int item = r; item < 128; item += R) rglru_item(p, l, item >> 4, item & 15, false, lds);
        for (int item = r; item < 16; item += R) rglru_item(p, l, 0, item, true, lds);
    }
    decode_items(p, l, lds, 1 << 30);
}

__device__ void phase_headnorm(const Params& p, int l) {
    const bf16_t* U = (const bf16_t*)(p.ws + WS_U); bf16_t* MG = (bf16_t*)(p.ws + WS_MG);
    const float* gm = p.g_mhead + l * 1024;
    const int G = gridDim.x, bid = obid();
    const int b0 = G > 8 ? bid - 4 : bid, GG = G > 8 ? G - 4 : G;
    if (b0 < 0) return;
    for (size_t idx = (size_t)b0 * NT + otid(); idx < (size_t)MP * 128; idx += (size_t)GG * NT) {
        const size_t row = idx >> 7; const int col = (int)(idx & 127) * 8;
        const u32x4 hv = *(const u32x4*)(MG + row * DMG + 1024 + col);
        const u32x4 ov = *(const u32x4*)(U + row * NU + 5120 + col);
        const u32x4 zv = *(const u32x4*)(U + row * NU + 6144 + col);
        float y[8];
        y[0] = lo16(hv.x) * lo16(ov.x); y[1] = hi16(hv.x) * hi16(ov.x); y[2] = lo16(hv.y) * lo16(ov.y); y[3] = hi16(hv.y) * hi16(ov.y);
        y[4] = lo16(hv.z) * lo16(ov.z); y[5] = hi16(hv.z) * hi16(ov.z); y[6] = lo16(hv.w) * lo16(ov.w); y[7] = hi16(hv.w) * hi16(ov.w);
        float ss = ((y[0] * y[0] + y[1] * y[1]) + (y[2] * y[2] + y[3] * y[3])) + ((y[4] * y[4] + y[5] * y[5]) + (y[6] * y[6] + y[7] * y[7]));
#pragma unroll
        for (int o = 1; o < 32; o <<= 1) ss += __shfl_xor(ss, o);
        const float rstd = rsqrtf(ss * (1.0f / 256.0f) + EPSF);
        const f32x4 g0 = *(const f32x4*)(gm + col), g1 = *(const f32x4*)(gm + col + 4);
        u32x4 o;
        o.x = cvt_pk_bf16(y[0] * rstd * g0[0] * lo16(zv.x), y[1] * rstd * g0[1] * hi16(zv.x));
        o.y = cvt_pk_bf16(y[2] * rstd * g0[2] * lo16(zv.y), y[3] * rstd * g0[3] * hi16(zv.y));
        o.z = cvt_pk_bf16(y[4] * rstd * g1[0] * lo16(zv.z), y[5] * rstd * g1[1] * hi16(zv.z));
        o.w = cvt_pk_bf16(y[6] * rstd * g1[2] * lo16(zv.w), y[7] * rstd * g1[3] * hi16(zv.w));
        *(u32x4*)(MG + row * DMG + 1024 + col) = o;
    }
}

__device__ void phase_final(const Params& p) {
    const bf16_t* XB = (const bf16_t*)(p.ws + WS_XB); const float* SS = (const float*)(p.ws + WS_SS);
    const int tidf = otid(); const int wid = tidf >> 6, lane = tidf & 63;
    for (int row = blockIdx.x * 8 + wid; row < MV; row += gridDim.x * 8) {
        const f32x4* sp = (const f32x4*)(SS + (size_t)row * 16);
        const f32x4 s0 = sp[0], s1 = sp[1], s2 = sp[2], s3 = sp[3];
        const float ss = ((s0[0] + s0[1]) + (s0[2] + s0[3])) + ((s1[0] + s1[1]) + (s1[2] + s1[3])) + ((s2[0] + s2[1]) + (s2[2] + s2[3])) + ((s3[0] + s3[1]) + (s3[2] + s3[3]));
        const float rstd = rsqrtf(ss * (1.0f / 1024.0f) + EPSF);
        float* op = row < MP ? p.out + O_YP + (size_t)row * DM : p.out + O_YS + (size_t)(row - MP) * DM;
#pragma unroll
        for (int i = 0; i < 2; ++i) {
            const int c = i * 512 + lane * 8;
            const u32x4 xv = *(const u32x4*)(XB + (size_t)row * DM + c);
            const f32x4 g0 = *(const f32x4*)(p.g_final + c), g1 = *(const f32x4*)(p.g_final + c + 4);
            *(f32x4*)(op + c) = (f32x4){lo16(xv.x) * rstd * g0[0], hi16(xv.x) * rstd * g0[1], lo16(xv.y) * rstd * g0[2], hi16(xv.y) * rstd * g0[3]};
            *(f32x4*)(op + c + 4) = (f32x4){lo16(xv.z) * rstd * g1[0], hi16(xv.z) * rstd * g1[1], lo16(xv.w) * rstd * g1[2], hi16(xv.w) * rstd * g1[3]};
        }
    }
}

#define XB_XCNT(j) (64 * (j))
#define XB_XSUB(j) (1024 + 64 * (j))
#define XB_XGEN(j) (2048 + 64 * (j))
#define XB_TOP 3072
#define XB_TOPGEN 3136
__device__ __forceinline__ unsigned xb_ld(unsigned* p) { return __hip_atomic_load(p, __ATOMIC_RELAXED, __HIP_MEMORY_SCOPE_AGENT); }
__device__ __forceinline__ unsigned xb_add(unsigned* p, unsigned v) { return __hip_atomic_fetch_add(p, v, __ATOMIC_RELAXED, __HIP_MEMORY_SCOPE_AGENT); }
__device__ __forceinline__ unsigned xb_xcc_id() { return (unsigned)__builtin_amdgcn_s_getreg((3 << 11) | 20) & 0xFu; }
#define XB_SPIN(cond) do { unsigned sp_ = 0; while (cond) { __builtin_amdgcn_s_sleep(1); if (++sp_ > (1u << 24)) break; } } while (0)
__device__ __forceinline__ void gbar(unsigned* bar, volatile LAS unsigned* st) {
    asm volatile("s_waitcnt vmcnt(0) lgkmcnt(0)" ::: "memory");
    __syncthreads();
    if (threadIdx.x == 0) {
        const unsigned x = xb_xcc_id(), nloc = st[0], nx = st[1];
        const unsigned old = xb_add(&bar[XB_XSUB(x)], 1u);
        const unsigned gen = old / nloc;
        if (old + 1u == (gen + 1u) * nloc) {
            __builtin_amdgcn_fence(__ATOMIC_RELEASE, "agent");
            asm volatile("s_waitcnt vmcnt(0)" ::: "memory");
            const unsigned og = xb_add(&bar[XB_TOP], 1u);
            const unsigned tg = og / nx;
            if (og + 1u == (tg + 1u) * nx) xb_add(&bar[XB_TOPGEN], 1u);
            else XB_SPIN(xb_ld(&bar[XB_TOPGEN]) == tg);
            __builtin_amdgcn_fence(__ATOMIC_ACQUIRE, "agent");
            xb_add(&bar[XB_XGEN(x)], 1u);
            asm volatile("s_waitcnt vmcnt(0)" ::: "memory");
        } else {
            XB_SPIN(xb_ld(&bar[XB_XGEN(x)]) == gen);
            __builtin_amdgcn_fence(__ATOMIC_ACQUIRE, "agent");
            asm volatile("s_waitcnt vmcnt(0)" ::: "memory");
        }
    }
    __syncthreads();
}

__global__ void __launch_bounds__(NT, 2) hymba_fwd(Params p) {
    extern __shared__ __attribute__((aligned(16))) unsigned char lds_raw[];
    LAS unsigned char* lds = (LAS unsigned char*)lds_raw;
    cg::grid_group grid = cg::this_grid();
    bf16_t* XB = (bf16_t*)(p.ws + WS_XB); bf16_t* U = (bf16_t*)(p.ws + WS_U); float* G = (float*)(p.ws + WS_G); bf16_t* MG = (bf16_t*)(p.ws + WS_MG);
    float* SS = (float*)(p.ws + WS_SS);
    unsigned* bar = (unsigned*)(p.ws + WS_BAR);
    volatile LAS unsigned* st = (volatile LAS unsigned*)(lds + LDS_BYTES - 16);
    if (threadIdx.x == 0) (void)xb_add(&bar[XB_XCNT(xb_xcc_id())], 1u);
    if (p.out == nullptr) grid.sync();
    phase_prep(p, lds);
    if (threadIdx.x == 0) {
        const unsigned x = xb_xcc_id(), Gn = gridDim.x; unsigned mine = 1u, cnt = 1u, sp = 0u;
        for (;;) {
            unsigned sum = 0u; cnt = 0u;
            for (unsigned j = 0; j < 16; ++j) { const unsigned c = xb_ld(&bar[XB_XCNT(j)]); sum += c; cnt += c > 0u ? 1u : 0u; if (j == x) mine = c; }
            if (sum == Gn || ++sp > (1u << 22)) break;
            __builtin_amdgcn_s_sleep(1);
        }
        st[0] = mine > 0u ? mine : 1u; st[1] = cnt > 0u ? cnt : 1u;
    }
    __syncthreads();
    gbar(bar, st);
    for (int l = 0; l < 2; ++l) {
        {
            pg8::Gemm g; g.A = XB; g.Bt = (const bf16_t*)(p.ws + WS_WT1) + (size_t)l * NW1 * DM; g.M = MR; g.N = NW1; g.K = DM;
            unsigned* dctr = bar + 3712 + 64 * l;
            pg8::InOrder so; so.G = gridDim.x; so.c = obid(); so.done_ctr = dctr;
            EpiIn e; e.U = U; e.G = G; e.SS = SS; e.bmi = p.b_mi + l * 4; e.bmf = p.b_mf + l * 4;
            pg8::gemm_phase<EpiIn, pg8::InOrder, DM>(lds, g, so, e);
            const int Gn = gridDim.x, maxu = (pg8::IN_UNITS + Gn - 1) / Gn, mine = (pg8::IN_UNITS - so.c + Gn - 1) / Gn;
            if (mine < maxu) {
                if (threadIdx.x == 0) {
                    unsigned sp = 0u;
                    while (__hip_atomic_load(dctr, __ATOMIC_RELAXED, __HIP_MEMORY_SCOPE_AGENT) < 8u * pg8::IN_DEC_UNITS) { __builtin_amdgcn_s_sleep(2); if (++sp > (1u << 24)) break; }
                    __builtin_amdgcn_fence(__ATOMIC_ACQUIRE, "agent");
                    asm volatile("s_waitcnt vmcnt(0)" ::: "memory");
                }
                __syncthreads();
                decode_items(p, l, lds, 1);
            }
        }
        gbar(bar, st);
        phase_mixers(p, l, lds);
        gbar(bar, st);
        for (int pass = 0; pass < 2; ++pass) {
            if (pass == 0) phase_headnorm(p, l);
            pg8::Gemm g; g.A = MG; g.Bt = (const bf16_t*)(p.ws + WS_WT2) + (size_t)l * DM * DMG; g.M = MR; g.N = DM; g.K = DMG;
            pg8::OutOrder so; so.G = gridDim.x; so.c = obid(); so.mode = pass;
            EpiOut e; e.basep = p.xp; e.bases = p.xs; e.split = l == 0 ? 1 : 0; e.XBo = XB; e.SSo = SS;
            pg8::gemm_phase<EpiOut, pg8::OutOrder, DMG>(lds, g, so, e);
            gbar(bar, st);
        }
    }
    phase_final(p);
}

extern "C" void kernel_launch(void* const* d_in, const int* in_sizes, int n_in, void* d_out, int out_size, void* d_ws, size_t ws_size, hipStream_t stream) {
    static int grid_blocks = 0;
    if (!grid_blocks) {
        int dev = 0, cus = 0, per_cu = 0;
        hipGetDevice(&dev);
        hipDeviceGetAttribute(&cus, hipDeviceAttributeMultiprocessorCount, dev);
        hipFuncSetAttribute((const void*)hymba_fwd, hipFuncAttributeMaxDynamicSharedMemorySize, LDS_BYTES);
        hipOccupancyMaxActiveBlocksPerMultiprocessor(&per_cu, (const void*)hymba_fwd, NT, LDS_BYTES);
        if (per_cu < 1) per_cu = 1;
        grid_blocks = cus * per_cu;
        (void)hipGetLastError();
    }
    if (ws_size < WS_END) { fprintf(stderr, "workspace too small: %zu < %zu\n", ws_size, (size_t)WS_END); return; }
    Params p{};
    p.xp = (const float*)d_in[0]; p.xs = (const float*)d_in[1]; p.st_h = (const float*)d_in[2]; p.st_conv = (const float*)d_in[3];
    p.st_C = (const float*)d_in[4]; p.st_n = (const float*)d_in[5]; p.st_m = (const float*)d_in[6]; p.g_norm = (const float*)d_in[7];
    p.w_in = (const float*)d_in[8]; p.conv_w = (const float*)d_in[9]; p.conv_b = (const float*)d_in[10]; p.w_r = (const float*)d_in[11];
    p.b_r = (const float*)d_in[12]; p.w_i = (const float*)d_in[13]; p.b_i = (const float*)d_in[14]; p.lam = (const float*)d_in[15];
    p.b_mi = (const float*)d_in[16]; p.b_mf = (const float*)d_in[17]; p.g_mhead = (const float*)d_in[18]; p.w_out = (const float*)d_in[19];
    p.g_final = (const float*)d_in[20];
    p.out = (float*)d_out; p.ws = (unsigned char*)d_ws;
    (void)hipMemsetAsync((unsigned char*)d_ws + WS_BAR, 0, 16384, stream);
    void* args[] = {&p};
    hipError_t e = hipLaunchCooperativeKernel((const void*)hymba_fwd, dim3(grid_blocks), dim3(NT), args, LDS_BYTES, stream);
    if (e != hipSuccess) fprintf(stderr, "cooperative launch failed: %s (grid %d)\n", hipGetErrorString(e), grid_blocks);
}
```

```cpp
#include <hip/hip_runtime.h>
#include <hip/hip_cooperative_groups.h>
#include <cstdio>
namespace cg = cooperative_groups;

#define LAS __attribute__((address_space(3)))
typedef unsigned short bf16_t;
typedef short bf16x8 __attribute__((ext_vector_type(8)));
typedef short bf16x4 __attribute__((ext_vector_type(4)));
typedef float f32x4 __attribute__((ext_vector_type(4)));
typedef unsigned u32x4 __attribute__((ext_vector_type(4)));
typedef unsigned u32x2 __attribute__((ext_vector_type(2)));

constexpr int NT = 512;
constexpr int LDS_BYTES = 163840;
constexpr int MP = 16384, MV = 16512, MR = 16640;
constexpr int DM = 1024, NU = 7168, NW1 = 7424, DIN = 7176, DMG = 2048;
constexpr float EPSF = 1e-6f;

constexpr size_t WS_XB = 0;
constexpr size_t WS_WT1 = WS_XB + (size_t)MR * DM * 2;
constexpr size_t WS_WT2 = WS_WT1 + (size_t)2 * NW1 * DM * 2;
constexpr size_t WS_WGT = WS_WT2 + (size_t)2 * DM * DMG * 2;
constexpr size_t WS_U = WS_WGT + (size_t)2 * 2 * 16 * 64 * 64 * 2;
constexpr size_t WS_G = WS_U + (size_t)MR * NU * 2;
constexpr size_t WS_MG = WS_G + (size_t)MR * 8 * 4;
constexpr size_t WS_X1 = WS_MG + (size_t)MR * DMG * 2;
constexpr size_t WS_X2 = WS_X1 + (size_t)MR * DM * 4;
constexpr size_t WS_SS = WS_X2 + (size_t)MR * DM * 4;
constexpr size_t WS_YSS = WS_SS + (size_t)MR * 16 * 4;
constexpr size_t WS_BAR = WS_YSS + (size_t)MR * 16 * 4;
constexpr size_t WS_END = WS_BAR + 16384;

struct Params {
    const float* xp; const float* xs; const float* st_h; const float* st_conv; const float* st_C; const float* st_n; const float* st_m;
    const float* g_norm; const float* w_in; const float* conv_w; const float* conv_b; const float* w_r; const float* b_r; const float* w_i; const float* b_i;
    const float* lam; const float* b_mi; const float* b_mf; const float* g_mhead; const float* w_out; const float* g_final;
    float* out; unsigned char* ws;
};

constexpr size_t O_YP = 0;
constexpr size_t O_YS = O_YP + (size_t)MP * DM;
constexpr size_t O_PH = O_YS + (size_t)128 * DM;
constexpr size_t O_PCONV = O_PH + 2 * 8 * 1024;
constexpr size_t O_PC = O_PCONV + 2 * 8 * 3 * 1024;
constexpr size_t O_PN = O_PC + (size_t)2 * 8 * 4 * 65536;
constexpr size_t O_PM = O_PN + 2 * 8 * 4 * 256;
constexpr size_t O_SH = O_PM + 2 * 8 * 4;
constexpr size_t O_SCONV = O_SH + 2 * 128 * 1024;
constexpr size_t O_SC = O_SCONV + 2 * 128 * 3 * 1024;
constexpr size_t O_SN = O_SC + (size_t)2 * 128 * 4 * 65536;
constexpr size_t O_SM = O_SN + 2 * 128 * 4 * 256;

__device__ __forceinline__ float bf2f(unsigned short v) { return __uint_as_float(((unsigned)v) << 16); }
__device__ __forceinline__ unsigned cvt_pk_bf16(float lo, float hi) { unsigned r; asm volatile("v_cvt_pk_bf16_f32 %0, %1, %2" : "=v"(r) : "v"(lo), "v"(hi)); return r; }
__device__ __forceinline__ float sigmoidf_(float x) { return __builtin_amdgcn_rcpf(1.0f + __builtin_amdgcn_exp2f(-1.44269504f * x)); }
__device__ __forceinline__ float siluf_(float x) { return x * __builtin_amdgcn_rcpf(1.0f + __builtin_amdgcn_exp2f(-1.44269504f * x)); }
__device__ __forceinline__ float softplusf_(float x) { return fmaxf(x, 0.f) + log1pf(__expf(-fabsf(x))); }
__device__ __forceinline__ int otid() { int t = threadIdx.x; asm volatile("" : "+v"(t)); return t; }
__device__ __forceinline__ int obid() { int t = blockIdx.x; asm volatile("" : "+s"(t)); return t; }
__device__ __forceinline__ f32x4 zero4() { float z = 0.f; asm volatile("" : "+v"(z)); return (f32x4){z, z, z, z}; }
__device__ __forceinline__ float lo16(unsigned w) { return __uint_as_float(w << 16); }
__device__ __forceinline__ float hi16(unsigned w) { return __uint_as_float(w & 0xffff0000u); }

namespace pg8 {
constexpr int BM = 256, BK = 64, HALF = 128, HTB = HALF * BK * 2, STAGE_BYTES = 8 * HTB, NXCD = 8, WGM = 2;
__host__ __device__ __forceinline__ int lds_byte(int r, int c) { const int st = (r >> 4) * 2 + (c >> 5), rr = r & 15, cc = c & 31, ob = rr * 64 + cc * 2; return st * 1024 + (ob ^ (((ob >> 9) & 1) << 5)); }
__host__ __device__ __forceinline__ void stage_rc(int b, int& R, int& C) { const int st = b / 1024, sb = b % 1024, swz = sb ^ (((sb >> 9) & 1) << 5); R = (st >> 1) * 16 + swz / 64; C = (st & 1) * 32 + (swz % 64) / 2; }
__host__ __device__ __forceinline__ int perm32(int rho) { const int n = rho >> 4, i = rho & 15; return 8 * (i >> 2) + 4 * n + (i & 3); }
struct Unit { int pm, pn; };
struct Gemm { const bf16_t* A; const bf16_t* Bt; int M, N, K; };
template <int NM_, int NN_>
struct StaticOrder {
    static constexpr int nM = NM_, nN = NN_, nwg = NM_ * NN_;
    int G, c;
    __device__ void init(int G_, int c_) { G = G_; c = c_; }
    __device__ static void map(int L, Unit& u) {
        int wgid = L; { constexpr int q = nwg / NXCD, r = nwg % NXCD; const int xcd = wgid % NXCD, off = wgid / NXCD; wgid = (xcd < r ? xcd * (q + 1) : r * (q + 1) + (xcd - r) * q) + off; }
        constexpr int nig = WGM * nN; const int gid = wgid / nig, fm = gid * WGM, gsz = (nM - fm) < WGM ? (nM - fm) : WGM;
        u.pm = fm + ((wgid % nig) % gsz); u.pn = (wgid % nig) / gsz;
    }
    __device__ bool next(int i, Unit& u) const { const int L = i * G + c; if (L >= nwg) return false; map(L, u); return true; }
    __device__ __forceinline__ void done(const Unit&, int) const {}
};

struct OutOrder {
    int G, c, mode;
    __device__ bool next(int i, Unit& u) const {
        const int L = i * G + c;
        if (mode == 0) { if (L >= 4) return false; u.pm = 64; u.pn = L; return true; }
        if (L >= 256) return false; StaticOrder<64, 4>::map(L, u); return true;
    }
    __device__ __forceinline__ void done(const Unit&, int) const {}
};

constexpr int IN_UNITS = 65 * 29, IN_DEC_UNITS = 29;
struct InOrder {
    int G, c; unsigned* done_ctr;
    __device__ bool next(int i, Unit& u) const {
        const int L = i * G + c; if (L >= IN_UNITS) return false;
        if (L < IN_DEC_UNITS) { u.pm = 64; u.pn = L; return true; }
        StaticOrder<64, 29>::map(L - IN_DEC_UNITS, u); return true;
    }
    __device__ __forceinline__ void done(const Unit& u, int lane) const {
        if (u.pm == 64) {
            asm volatile("s_waitcnt vmcnt(0)" ::: "memory");
            __builtin_amdgcn_fence(__ATOMIC_RELEASE, "agent");
            asm volatile("s_waitcnt vmcnt(0)" ::: "memory");
            if (lane == 0) __hip_atomic_fetch_add(done_ctr, 1u, __ATOMIC_RELAXED, __HIP_MEMORY_SCOPE_AGENT);
        }
    }
};

template <class Epi, class Sched, int KK>
__device__ __forceinline__ void gemm_phase(LAS unsigned char* lds, const Gemm g, const Sched& S, const Epi& E) {
    const int tid = otid(), wid = __builtin_amdgcn_readfirstlane(tid >> 6), lane = tid & 63, wr = wid >> 2, wc = wid & 3, fr = lane & 15, fq = lane >> 4;
    constexpr int K = KK, nt = K / BK;
    unsigned voffA[2], voffB[2];
#pragma unroll
    for (int i = 0; i < 2; ++i) { int R, C; stage_rc(tid * 16 + i * 8192, R, C); const int Rb = Epi::PERM ? ((R & ~31) + perm32(R & 31)) : R;
        voffA[i] = (unsigned)(R * K + C) * 2u; voffB[i] = (unsigned)(Rb * K + C) * 2u; }
    const size_t kstep = (size_t)(BK * 2);
    const size_t hstep = (size_t)HALF * K * 2;
    const size_t tstep = 2 * hstep;
    const unsigned ldsw = (unsigned)wid * 1024u;
    const int aoff = lds_byte(wr * 64 + fr, fq * 8), boff = lds_byte(wc * 32 + fr, fq * 8);
#define PG8_SA(b, h) (((b) * 2 + (h)) * HTB)
#define PG8_SB(b, h) ((4 + (b) * 2 + (h)) * HTB)
#define PG8_STAGE(bufoff, gbase, voff) do { _Pragma("unroll") for (int _i = 0; _i < 2; ++_i) \
        __builtin_amdgcn_global_load_lds((const unsigned*)((const char*)(gbase) + (voff)[_i]), (LAS unsigned*)(lds + (bufoff) + ldsw + _i * 8192), 16, 0, 0); } while (0)
#define PG8_LDA(dst, b, h) do { _Pragma("unroll") for (int m = 0; m < 4; ++m) _Pragma("unroll") for (int k = 0; k < 2; ++k) dst[m][k] = *(const LAS bf16x8*)(lds + PG8_SA(b, h) + aoff + m * 2048 + k * 1024); } while (0)
#define PG8_LDB(dst, b, h) do { _Pragma("unroll") for (int n = 0; n < 2; ++n) _Pragma("unroll") for (int k = 0; k < 2; ++k) dst[n][k] = *(const LAS bf16x8*)(lds + PG8_SB(b, h) + boff + n * 2048 + k * 1024); } while (0)
#define PG8_MMA(ai, bj, At, Bt) do { __builtin_amdgcn_s_setprio(1); _Pragma("unroll") for (int m = 0; m < 4; ++m) _Pragma("unroll") for (int n = 0; n < 2; ++n) _Pragma("unroll") for (int k = 0; k < 2; ++k) \
        acc[ai][bj][m][n] = __builtin_amdgcn_mfma_f32_16x16x32_bf16(Bt[n][k], At[m][k], acc[ai][bj][m][n], 0, 0, 0); __builtin_amdgcn_s_setprio(0); } while (0)
#define PG8_WAIT_V(n) asm volatile("s_waitcnt vmcnt(" #n ")" ::: "memory")
#define PG8_WAIT_L(n) asm volatile("s_waitcnt lgkmcnt(" #n ")" ::: "memory")
#define PG8_BAR __builtin_amdgcn_s_barrier()
#define PG8_SCHED __builtin_amdgcn_sched_barrier(0)
    Unit cur, nxt; int ui = 0;
    if (!S.next(0, cur)) return;
    f32x4 acc[2][2][4][2];
#pragma unroll
    for (int a = 0; a < 2; ++a)
#pragma unroll
        for (int b = 0; b < 2; ++b)
#pragma unroll
            for (int m = 0; m < 4; ++m)
#pragma unroll
                for (int n = 0; n < 2; ++n) acc[a][b][m][n] = zero4();
    bf16x8 At[4][2], B0[2][2], B1[2][2];
    const char* cA = (const char*)g.A + (size_t)cur.pm * tstep; const char* cB = (const char*)g.Bt + (size_t)cur.pn * tstep;
    PG8_STAGE(PG8_SB(0, 0), cB, voffB); PG8_STAGE(PG8_SA(0, 0), cA, voffA); PG8_STAGE(PG8_SB(0, 1), cB + hstep, voffB); PG8_STAGE(PG8_SA(0, 1), cA + hstep, voffA);
    if (wr == 1) PG8_BAR;
    PG8_WAIT_V(4); PG8_BAR;
    PG8_STAGE(PG8_SB(1, 0), cB + kstep, voffB); PG8_STAGE(PG8_SA(1, 0), cA + kstep, voffA); PG8_STAGE(PG8_SB(1, 1), cB + hstep + kstep, voffB);
    PG8_WAIT_V(6); PG8_BAR;
    for (;;) {
        const bool has_next = S.next(ui + 1, nxt);
        const char* nA = has_next ? (const char*)g.A + (size_t)nxt.pm * tstep : cA; const char* nB = has_next ? (const char*)g.Bt + (size_t)nxt.pn * tstep : cB;
        for (int t = 0; t < nt; t += 2) {
            const bool last = (t == nt - 2);
            const char* a1 = cA + (size_t)(t + 1) * kstep;
            const char* a2 = last ? nA : cA + (size_t)(t + 2) * kstep; const char* b2 = last ? nB : cB + (size_t)(t + 2) * kstep;
            const char* a3 = a2 + kstep; const char* b3 = b2 + kstep;
            PG8_LDB(B0, 0, 0); PG8_SCHED; PG8_LDA(At, 0, 0); PG8_STAGE(PG8_SA(1, 1), a1 + hstep, voffA);
            PG8_WAIT_L(8); PG8_BAR; PG8_WAIT_L(0); PG8_MMA(0, 0, At, B0); PG8_BAR; PG8_SCHED;
            PG8_LDB(B1, 0, 1); PG8_STAGE(PG8_SB(0, 0), b2, voffB);
            PG8_BAR; PG8_WAIT_L(0); PG8_MMA(0, 1, At, B1); PG8_BAR;
            PG8_LDA(At, 0, 1); PG8_STAGE(PG8_SA(0, 0), a2, voffA);
            PG8_BAR; PG8_WAIT_L(0); PG8_MMA(1, 0, At, B0); PG8_BAR; PG8_SCHED;
            PG8_STAGE(PG8_SB(0, 1), b2 + hstep, voffB);
            PG8_WAIT_V(6); PG8_BAR; PG8_MMA(1, 1, At, B1); PG8_BAR;
            PG8_LDB(B0, 1, 0); PG8_SCHED; PG8_LDA(At, 1, 0); PG8_STAGE(PG8_SA(0, 1), a2 + hstep, voffA);
            PG8_WAIT_L(8); PG8_BAR; PG8_WAIT_L(0); PG8_MMA(0, 0, At, B0); PG8_BAR; PG8_SCHED;
            PG8_LDB(B1, 1, 1); PG8_STAGE(PG8_SB(1, 0), b3, voffB);
            PG8_BAR; PG8_WAIT_L(0); PG8_MMA(0, 1, At, B1); PG8_BAR;
            PG8_LDA(At, 1, 1); PG8_STAGE(PG8_SA(1, 0), a3, voffA);
            PG8_BAR; PG8_WAIT_L(0); PG8_MMA(1, 0, At, B0); PG8_BAR; PG8_SCHED;
            PG8_STAGE(PG8_SB(1, 1), b3 + hstep, voffB);
            PG8_WAIT_V(6); PG8_BAR; PG8_MMA(1, 1, At, B1); PG8_BAR;
        }
        E(acc, cur, wr, wc, fr, fq);
        S.done(cur, lane);
        if (!has_next) break;
#pragma unroll
        for (int a = 0; a < 2; ++a)
#pragma unroll
            for (int b = 0; b < 2; ++b)
#pragma unroll
                for (int m = 0; m < 4; ++m)
#pragma unroll
                    for (int n = 0; n < 2; ++n) acc[a][b][m][n] = zero4();
        cur = nxt; cA = nA; cB = nB; ++ui;
    }
    PG8_WAIT_V(0);
    if (wr == 0) PG8_BAR;
    PG8_BAR;
#undef PG8_SA
#undef PG8_SB
#undef PG8_STAGE
#undef PG8_LDA
#undef PG8_LDB
#undef PG8_MMA
#undef PG8_WAIT_V
#undef PG8_WAIT_L
#undef PG8_BAR
#undef PG8_SCHED
}
}

struct EpiIn {
    static constexpr bool PERM = true;
    bf16_t* U; float* G; const float* SS; const float* bmi; const float* bmf;
    __device__ __forceinline__ void operator()(const f32x4 (&acc)[2][2][4][2], const pg8::Unit& u, int wr, int wc, int fr, int fq) const {
        const int row0 = u.pm * 256 + wr * 64 + fr;
        const int pn = u.pn;
        const int mode = ((pn >= 4 && pn < 8) || (pn >= 24 && pn < 28)) ? 1 : ((pn >= 20 && pn < 24) ? 2 : 0);
        f32x4 cur[4];
        { const f32x4* sp = (const f32x4*)(SS + (size_t)row0 * 16); cur[0] = sp[0]; cur[1] = sp[1]; cur[2] = sp[2]; cur[3] = sp[3]; }
#pragma unroll
        for (int r = 0; r < 8; ++r) {
            const int ai = r >> 2, m = r & 3;
            const int row = row0 + ai * 128 + m * 16;
            f32x4 nxt[4];
            if (r < 7) {
                const f32x4* sp = (const f32x4*)(SS + (size_t)(row0 + ((r + 1) >> 2) * 128 + ((r + 1) & 3) * 16) * 16);
                nxt[0] = sp[0]; nxt[1] = sp[1]; nxt[2] = sp[2]; nxt[3] = sp[3];
            }
            const float ss = ((cur[0][0] + cur[0][1]) + (cur[0][2] + cur[0][3])) + ((cur[1][0] + cur[1][1]) + (cur[1][2] + cur[1][3])) + ((cur[2][0] + cur[2][1]) + (cur[2][2] + cur[2][3])) + ((cur[3][0] + cur[3][1]) + (cur[3][2] + cur[3][3]));
            const float rstd = rsqrtf(ss * (1.0f / 1024.0f) + EPSF);
            if (pn < 28) {
                bf16_t* rowp = U + (size_t)row * NU + pn * 256 + wc * 32 + 8 * fq;
#pragma unroll
                for (int bj = 0; bj < 2; ++bj) {
                    f32x4 v0 = acc[ai][bj][m][0] * rstd, v1 = acc[ai][bj][m][1] * rstd;
                    if (mode == 1) {
#pragma unroll
                        for (int j = 0; j < 4; ++j) { v0[j] = siluf_(v0[j]); v1[j] = siluf_(v1[j]); }
                    } else if (mode == 2) {
#pragma unroll
                        for (int j = 0; j < 4; ++j) { v0[j] = sigmoidf_(v0[j]); v1[j] = sigmoidf_(v1[j]); }
                    }
                    u32x4 w; w.x = cvt_pk_bf16(v0[0], v0[1]); w.y = cvt_pk_bf16(v0[2], v0[3]); w.z = cvt_pk_bf16(v1[0], v1[1]); w.w = cvt_pk_bf16(v1[2], v1[3]);
                    *(u32x4*)(rowp + bj * 128) = w;
                }
            } else if (wc == 0 && fq == 0) {
                const f32x4 v0 = acc[ai][0][m][0] * rstd, v1 = acc[ai][0][m][1] * rstd;
                f32x4 gi, gf;
#pragma unroll
                for (int j = 0; j < 4; ++j) { gi[j] = v0[j] + bmi[j]; const float x = v1[j] + bmf[j]; gf[j] = fminf(x, 0.f) - log1pf(__expf(-fabsf(x))); }
                *(f32x4*)(G + (size_t)row * 8) = gi; *(f32x4*)(G + (size_t)row * 8 + 4) = gf;
            }
            if (r < 7) { cur[0] = nxt[0]; cur[1] = nxt[1]; cur[2] = nxt[2]; cur[3] = nxt[3]; }
        }
    }
};

struct EpiOut {
    static constexpr bool PERM = false;
    const float* basep; const float* bases; int split;
    bf16_t* XBo; float* SSo;
    __device__ __forceinline__ void operator()(const f32x4 (&acc)[2][2][4][2], const pg8::Unit& u, int wr, int wc, int fr, int fq) const {
        const int row0 = u.pm * 256 + wr * 64 + fr, col0 = u.pn * 256 + wc * 32 + 4 * fq;
#pragma unroll
        for (int g2 = 0; g2 < 4; ++g2) {
            const int ai = g2 >> 1;
            f32x4 bs[2][2][2];
#pragma unroll
            for (int mm = 0; mm < 2; ++mm) {
                const int m = (g2 & 1) * 2 + mm;
                const int row = row0 + ai * 128 + m * 16;
                if (split) {
                    const float* bp = basep + (size_t)row * DM;
                    bool have = true;
                    if (row >= MV) have = false; else if (row >= MP) bp = bases + (size_t)(row - MP) * DM;
#pragma unroll
                    for (int bj = 0; bj < 2; ++bj)
#pragma unroll
                        for (int n = 0; n < 2; ++n) { bs[mm][bj][n] = zero4(); if (have) bs[mm][bj][n] = *(const f32x4*)(bp + col0 + bj * 128 + n * 16); }
                } else {
#pragma unroll
                    for (int bj = 0; bj < 2; ++bj)
#pragma unroll
                        for (int n = 0; n < 2; ++n) { const u32x2 v = *(const u32x2*)(XBo + (size_t)row * DM + col0 + bj * 128 + n * 16); bs[mm][bj][n] = (f32x4){lo16(v.x), hi16(v.x), lo16(v.y), hi16(v.y)}; }
                }
            }
#pragma unroll
            for (int mm = 0; mm < 2; ++mm) {
                const int m = (g2 & 1) * 2 + mm;
                const int row = row0 + ai * 128 + m * 16;
                float ss = 0.f;
#pragma unroll
                for (int bj = 0; bj < 2; ++bj)
#pragma unroll
                    for (int n = 0; n < 2; ++n) {
                        const int c = col0 + bj * 128 + n * 16;
                        const f32x4 o = bs[mm][bj][n] + acc[ai][bj][m][n];
                        u32x2 w; w.x = cvt_pk_bf16(o[0], o[1]); w.y = cvt_pk_bf16(o[2], o[3]); *(u32x2*)(XBo + (size_t)row * DM + c) = w;
                        ss += (o[0] * o[0] + o[1] * o[1]) + (o[2] * o[2] + o[3] * o[3]);
                    }
                ss += __shfl_xor(ss, 16); ss += __shfl_xor(ss, 32);
                if (fq == 0) SSo[(size_t)row * 16 + u.pn * 4 + wc] = ss;
            }
        }
    }
};

__device__ void transpose_tile(const float* src, int ldn, int nvalid, int k0, int n0, bf16_t* dst, int ldk, const float* sk, float sn, LAS float* T) {
    const int tid = otid();
    {
        const int r = tid >> 4, c4 = tid & 15;
#pragma unroll
        for (int i = 0; i < 2; ++i) {
            const int k = r + 32 * i; const int n = n0 + 4 * c4;
            f32x4 v = zero4();
            if (n + 3 < nvalid) v = *(const f32x4*)(src + (size_t)(k0 + k) * ldn + n);
            const float s = (sk ? sk[k0 + k] : 1.0f) * sn;
            T[k * 65 + 4 * c4 + 0] = v[0] * s; T[k * 65 + 4 * c4 + 1] = v[1] * s; T[k * 65 + 4 * c4 + 2] = v[2] * s; T[k * 65 + 4 * c4 + 3] = v[3] * s;
        }
    }
    __syncthreads();
    {
        const int n = tid >> 3, kq = tid & 7;
        float f[8];
#pragma unroll
        for (int j = 0; j < 8; ++j) f[j] = T[(kq * 8 + j) * 65 + n];
        u32x4 w; w.x = cvt_pk_bf16(f[0], f[1]); w.y = cvt_pk_bf16(f[2], f[3]); w.z = cvt_pk_bf16(f[4], f[5]); w.w = cvt_pk_bf16(f[6], f[7]);
        *(u32x4*)(dst + (size_t)(n0 + n) * ldk + k0 + kq * 8) = w;
    }
    __syncthreads();
}

__device__ void phase_prep(const Params& p, LAS unsigned char* lds) {
    LAS float* T = (LAS float*)lds;
    bf16_t* WT1 = (bf16_t*)(p.ws + WS_WT1); bf16_t* WT2 = (bf16_t*)(p.ws + WS_WT2); bf16_t* WGT = (bf16_t*)(p.ws + WS_WGT);
    bf16_t* XB = (bf16_t*)(p.ws + WS_XB); float* SS = (float*)(p.ws + WS_SS); bf16_t* MG = (bf16_t*)(p.ws + WS_MG);
    constexpr int JA = 2 * 16 * 116, JB = 2 * 32 * 16, JC = 64, JD = MR / 8;
    for (int job = blockIdx.x; job < JA + JB + JC + JD; job += gridDim.x) {
        if (job < JA) {
            const int l = job / (16 * 116), r = job % (16 * 116), ntile = r / 16, kt = r % 16;
            const int n0 = ntile * 64;
            const float sn = (n0 >= 3072 && n0 < 4096) ? 0.0625f : 1.0f;
            transpose_tile(p.w_in + (size_t)l * DM * DIN, DIN, DIN, kt * 64, n0, WT1 + (size_t)l * NW1 * DM, DM, p.g_norm + l * DM, sn, T);
        } else if (job < JA + JB) {
            const int j = job - JA, l = j / 512, r = j % 512, ntile = r / 32, kt = r % 32;
            transpose_tile(p.w_out + (size_t)l * DMG * DM, DM, DM, kt * 64, ntile * 64, WT2 + (size_t)l * DM * DMG, DMG, nullptr, 1.0f, T);
        } else if (job < JA + JB + JC) {
            const int j = job - JA - JB, l = j >> 5, gate = (j >> 4) & 1, blk = j & 15;
            const float* src = (gate ? p.w_i : p.w_r) + (size_t)(l * 16 + blk) * 4096;
            transpose_tile(src, 64, 64, 0, 0, WGT + (size_t)((l * 2 + gate) * 16 + blk) * 4096, 64, nullptr, 1.0f, T);
        } else {
            const int j = job - JA - JB - JC; const int tidp = otid(); const int wid = tidp >> 6, lane = tidp & 63;
            const int row = j * 8 + wid;
            const float* src = row < MP ? p.xp + (size_t)row * DM : (row < MV ? p.xs + (size_t)(row - MP) * DM : nullptr);
            f32x4 v[4]; float ss = 0.f;
#pragma unroll
            for (int i = 0; i < 4; ++i) { v[i] = src ? *(const f32x4*)(src + lane * 16 + i * 4) : zero4(); ss += (v[i][0] * v[i][0] + v[i][1] * v[i][1]) + (v[i][2] * v[i][2] + v[i][3] * v[i][3]); }
#pragma unroll
            for (int o = 32; o >= 1; o >>= 1) ss += __shfl_xor(ss, o);
            u32x4 w0, w1;
            w0.x = cvt_pk_bf16(v[0][0], v[0][1]); w0.y = cvt_pk_bf16(v[0][2], v[0][3]); w0.z = cvt_pk_bf16(v[1][0], v[1][1]); w0.w = cvt_pk_bf16(v[1][2], v[1][3]);
            w1.x = cvt_pk_bf16(v[2][0], v[2][1]); w1.y = cvt_pk_bf16(v[2][2], v[2][3]); w1.z = cvt_pk_bf16(v[3][0], v[3][1]); w1.w = cvt_pk_bf16(v[3][2], v[3][3]);
            *(u32x4*)(XB + (size_t)row * DM + lane * 16) = w0; *(u32x4*)(XB + (size_t)row * DM + lane * 16 + 8) = w1;
            if (lane < 16) SS[(size_t)row * 16 + lane] = lane == 0 ? ss : 0.f;
            if (row >= MV) { const u32x4 z = (u32x4){0u, 0u, 0u, 0u}; u32x4* mp = (u32x4*)(MG + (size_t)row * DMG + lane * 32); mp[0] = z; mp[1] = z; mp[2] = z; mp[3] = z; }
        }
    }
}

constexpr int M_QI = 0, M_KI = 38912, M_VI = 77824, M_CTI = 96256, M_SM = 130048;
constexpr int RS_QK = 304, RS_V = 144, RS_CT = 528;

template <int OFF0, int OFF1>
__device__ __forceinline__ bf16x8 tr_frag(unsigned base) {
    bf16x4 lo, hi;
    asm volatile("ds_read_b64_tr_b16 %0, %2 offset:%3\n\tds_read_b64_tr_b16 %1, %2 offset:%4\n\ts_waitcnt lgkmcnt(0)" : "=&v"(lo), "=&v"(hi) : "v"(base), "i"(OFF0), "i"(OFF1) : "memory");
    bf16x8 r; r[0] = lo[0]; r[1] = lo[1]; r[2] = lo[2]; r[3] = lo[3]; r[4] = hi[0]; r[5] = hi[1]; r[6] = hi[2]; r[7] = hi[3]; return r;
}

template <int O0, int O1, int HI>
__device__ __forceinline__ void tr_frag2(unsigned base, bf16x8& f0, bf16x8& f1) {
    bf16x4 a0, a1, b0, b1;
    asm volatile("ds_read_b64_tr_b16 %0, %4 offset:%5\n\tds_read_b64_tr_b16 %1, %4 offset:%6\n\tds_read_b64_tr_b16 %2, %4 offset:%7\n\tds_read_b64_tr_b16 %3, %4 offset:%8\n\ts_waitcnt lgkmcnt(0)"
                 : "=&v"(a0), "=&v"(a1), "=&v"(b0), "=&v"(b1) : "v"(base), "i"(O0), "i"(O0 + HI), "i"(O1), "i"(O1 + HI) : "memory");
    f0 = __builtin_shufflevector(a0, a1, 0, 1, 2, 3, 4, 5, 6, 7); f1 = __builtin_shufflevector(b0, b1, 0, 1, 2, 3, 4, 5, 6, 7);
}
template <int KS>
__device__ __forceinline__ void mlstm_D(f32x4 (&CT)[8], unsigned bvD, unsigned bkD) {
    const bf16x8 vdf = tr_frag<KS * 32 * RS_V, KS * 32 * RS_V + 4 * RS_V>(bvD);
    bf16x8 k0, k1;
    tr_frag2<KS * 32 * RS_QK + 0, KS * 32 * RS_QK + 32, 4 * RS_QK>(bkD, k0, k1);
    CT[0] = __builtin_amdgcn_mfma_f32_16x16x32_bf16(k0, vdf, CT[0], 0, 0, 0);
    CT[1] = __builtin_amdgcn_mfma_f32_16x16x32_bf16(k1, vdf, CT[1], 0, 0, 0);
    tr_frag2<KS * 32 * RS_QK + 64, KS * 32 * RS_QK + 96, 4 * RS_QK>(bkD, k0, k1);
    CT[2] = __builtin_amdgcn_mfma_f32_16x16x32_bf16(k0, vdf, CT[2], 0, 0, 0);
    CT[3] = __builtin_amdgcn_mfma_f32_16x16x32_bf16(k1, vdf, CT[3], 0, 0, 0);
    tr_frag2<KS * 32 * RS_QK + 128, KS * 32 * RS_QK + 160, 4 * RS_QK>(bkD, k0, k1);
    CT[4] = __builtin_amdgcn_mfma_f32_16x16x32_bf16(k0, vdf, CT[4], 0, 0, 0);
    CT[5] = __builtin_amdgcn_mfma_f32_16x16x32_bf16(k1, vdf, CT[5], 0, 0, 0);
    tr_frag2<KS * 32 * RS_QK + 192, KS * 32 * RS_QK + 224, 4 * RS_QK>(bkD, k0, k1);
    CT[6] = __builtin_amdgcn_mfma_f32_16x16x32_bf16(k0, vdf, CT[6], 0, 0, 0);
    CT[7] = __builtin_amdgcn_mfma_f32_16x16x32_bf16(k1, vdf, CT[7], 0, 0, 0);
}
template <int O, int STEP, int HI>
__device__ __forceinline__ void tr_frag4(unsigned base, bf16x8& f0, bf16x8& f1, bf16x8& f2, bf16x8& f3) {
    bf16x4 a0, a1, b0, b1, c0, c1, d0, d1;
    asm volatile("ds_read_b64_tr_b16 %0, %8 offset:%9\n\tds_read_b64_tr_b16 %1, %8 offset:%10\n\tds_read_b64_tr_b16 %2, %8 offset:%11\n\tds_read_b64_tr_b16 %3, %8 offset:%12\n\t"
                 "ds_read_b64_tr_b16 %4, %8 offset:%13\n\tds_read_b64_tr_b16 %5, %8 offset:%14\n\tds_read_b64_tr_b16 %6, %8 offset:%15\n\tds_read_b64_tr_b16 %7, %8 offset:%16\n\ts_waitcnt lgkmcnt(0)"
                 : "=&v"(a0), "=&v"(a1), "=&v"(b0), "=&v"(b1), "=&v"(c0), "=&v"(c1), "=&v"(d0), "=&v"(d1)
                 : "v"(base), "i"(O), "i"(O + HI), "i"(O + STEP), "i"(O + STEP + HI), "i"(O + 2 * STEP), "i"(O + 2 * STEP + HI), "i"(O + 3 * STEP), "i"(O + 3 * STEP + HI) : "memory");
    f0 = __builtin_shufflevector(a0, a1, 0, 1, 2, 3, 4, 5, 6, 7); f1 = __builtin_shufflevector(b0, b1, 0, 1, 2, 3, 4, 5, 6, 7);
    f2 = __builtin_shufflevector(c0, c1, 0, 1, 2, 3, 4, 5, 6, 7); f3 = __builtin_shufflevector(d0, d1, 0, 1, 2, 3, 4, 5, 6, 7);
}
template <int KS>
__device__ __forceinline__ void mlstm_B(f32x4 (&N1)[4], LAS unsigned char* lds, unsigned bvB, int t, int fq) {
    const bf16x8 pf = *(const LAS bf16x8*)(lds + M_QI + t * RS_QK + KS * 64 + fq * 16);
    bf16x8 v0, v1, v2, v3;
    tr_frag4<KS * 32 * RS_V, 32, 4 * RS_V>(bvB, v0, v1, v2, v3);
    N1[0] = __builtin_amdgcn_mfma_f32_16x16x32_bf16(v0, pf, N1[0], 0, 0, 0);
    N1[1] = __builtin_amdgcn_mfma_f32_16x16x32_bf16(v1, pf, N1[1], 0, 0, 0);
    N1[2] = __builtin_amdgcn_mfma_f32_16x16x32_bf16(v2, pf, N1[2], 0, 0, 0);
    N1[3] = __builtin_amdgcn_mfma_f32_16x16x32_bf16(v3, pf, N1[3], 0, 0, 0);
}

__device__ void mlstm_prompt(const Params& p, int l, int item, LAS unsigned char* lds) {
    const int tid0 = otid();
    const int js = item & 3, h = (item >> 2) & 3, b = item >> 4;
    const unsigned ldsb = (unsigned)(size_t)lds;
    LAS float* sm = (LAS float*)(lds + M_SM);
    LAS float* nbuf = sm + 512; LAS float* npart = sm + 1552;
    const bf16_t* U = (const bf16_t*)(p.ws + WS_U); const float* G = (const float*)(p.ws + WS_G);
    bf16_t* MG = (bf16_t*)(p.ws + WS_MG);
    const size_t grow_base = (size_t)b * 2048;
    const int qcol = 2048 + h * 256, kcol = 3072 + h * 256, vcol = 4096 + h * 256 + js * 64;

    __syncthreads();
    for (int i = tid0; i < RS_CT * 64 / 16; i += NT) *(LAS u32x4*)(lds + M_CTI + i * 16) = (u32x4){0u, 0u, 0u, 0u};
    nbuf[tid0] = 0.f;
    f32x4 CTacc[8];
#pragma unroll
    for (int i = 0; i < 8; ++i) CTacc[i] = zero4();
    float m_prev = 0.f;
    u32x4 qreg[4], kreg[4], vreg[2]; float igr[2] = {0.f, 0.f}, lfr[2] = {0.f, 0.f};

#define ML_LOAD_QK(row0_, hd_) do { _Pragma("unroll") for (int i_ = 0; i_ < 4; ++i_) { const int id_ = tid + NT * i_, r_ = id_ >> 4, cq_ = id_ & 15; \
        const bf16_t* rp_ = U + (grow_base + (row0_) + r_) * NU + (hd_) * 128 + cq_ * 8; qreg[i_] = *(const u32x4*)(rp_ + qcol); kreg[i_] = *(const u32x4*)(rp_ + kcol); } } while (0)
#define ML_STORE_QK() do { _Pragma("unroll") for (int i_ = 0; i_ < 4; ++i_) { const int id_ = tid + NT * i_, r_ = id_ >> 4, cq_ = id_ & 15; \
        *(LAS u32x4*)(lds + M_QI + r_ * RS_QK + cq_ * 16) = qreg[i_]; *(LAS u32x4*)(lds + M_KI + r_ * RS_QK + cq_ * 16) = kreg[i_]; } } while (0)
#define ML_LOAD_VG(row0_) do { _Pragma("unroll") for (int i_ = 0; i_ < 2; ++i_) { const int id_ = tid + NT * i_, s_ = id_ >> 3, cq_ = id_ & 7; \
        vreg[i_] = *(const u32x4*)(U + (grow_base + (row0_) + s_) * NU + vcol + cq_ * 8); } \
        if (w == 0) { const float* gp_ = G + (grow_base + (row0_) + 2 * lane) * 8 + h; igr[0] = gp_[0]; lfr[0] = gp_[4]; igr[1] = gp_[8]; lfr[1] = gp_[12]; } } while (0)

#define ML_PREPASS(buf_) do { if (w == 0) { LAS float* dec_ = sm + 128 * (buf_); LAS float* expnm_ = sm + 256 + 128 * (buf_); LAS float* scal_ = sm + 1024 + 8 * (buf_); \
            const float s2 = lfr[0] + lfr[1]; float incl = s2; \
            _Pragma("unroll") for (int o = 1; o < 64; o <<= 1) { const float t_ = __shfl_up(incl, o); if (lane >= o) incl += t_; } \
            const float b0 = incl - s2 + lfr[0], b1 = incl; \
            const float a0 = igr[0] - b0, a1 = igr[1] - b1; float im = fmaxf(a0, a1); \
            _Pragma("unroll") for (int o = 1; o < 64; o <<= 1) { const float t_ = __shfl_up(im, o); if (lane >= o) im = fmaxf(im, t_); } \
            float ex = __shfl_up(im, 1); if (lane == 0) ex = -INFINITY; \
            const float M0 = fmaxf(ex, a0), M1 = fmaxf(M0, a1); \
            const float mt1 = b1 + fmaxf(m_prev, M1); \
            const float bL = __shfl(b1, 63), mL = __shfl(mt1, 63); \
            expnm_[2 * lane] = __expf(bL - mL - b0); expnm_[2 * lane + 1] = __expf(bL - mL - b1); \
            dec_[2 * lane] = __expf(bL - b0 + igr[0] - mL); dec_[2 * lane + 1] = __expf(bL - b1 + igr[1] - mL); \
            if (lane == 0) { scal_[0] = __expf(bL + m_prev - mL); scal_[1] = mL; } \
            m_prev = mL; } } while (0)
    { const int tid = tid0, w = tid >> 6, lane = tid & 63; ML_LOAD_QK(0, 0); ML_LOAD_VG(0); ML_PREPASS(0); }
#pragma unroll 1
    for (int c = 0; c < 16; ++c) {
        int tid = tid0; asm volatile("" : "+v"(tid));
        const int w = __builtin_amdgcn_readfirstlane(tid >> 6), lane = tid & 63, fr = lane & 15, fq = lane >> 4;
        const int cD = w & 3, gD = w >> 2, qq = (lane & 15) >> 2, pp = lane & 3;
        const unsigned bvB = ldsb + M_VI + (8 * fq + qq) * RS_V + 8 * pp;
        const unsigned bvD = bvB + cD * 32;
        const int row0 = c * 128;
        LAS float* nC = nbuf + (c & 1) * 256; LAS float* nN = nbuf + ((c + 1) & 1) * 256;
        __syncthreads();
        ML_STORE_QK();
        LAS float* dec = sm + 128 * (c & 1); LAS float* expnm = sm + 256 + 128 * (c & 1); LAS float* scal = sm + 1024 + 8 * (c & 1);
        const float cs = scal[0];
#pragma unroll
        for (int i = 0; i < 2; ++i) {
            const int id = tid + NT * i, s = id >> 3, cq = id & 7; const float d = dec[s];
            u32x4 v = vreg[i], o;
            o.x = cvt_pk_bf16(lo16(v.x) * d, hi16(v.x) * d); o.y = cvt_pk_bf16(lo16(v.y) * d, hi16(v.y) * d);
            o.z = cvt_pk_bf16(lo16(v.z) * d, hi16(v.z) * d); o.w = cvt_pk_bf16(lo16(v.w) * d, hi16(v.w) * d);
            *(LAS u32x4*)(lds + M_VI + s * RS_V + cq * 16) = o;
        }
        if (tid < 256) nN[tid] = cs * nC[tid];
        ML_LOAD_QK(row0, 1);
        f32x4 Sacc[8], N2[4];
#pragma unroll
        for (int i = 0; i < 8; ++i) Sacc[i] = zero4();
#pragma unroll
        for (int i = 0; i < 4; ++i) N2[i] = zero4();
        float qnp = 0.f;
#pragma unroll 1
        for (int hd = 0; hd < 2; ++hd) {
            __syncthreads();
#pragma unroll
            for (int ks = 0; ks < 4; ++ks) {
                const bf16x8 qf = *(const LAS bf16x8*)(lds + M_QI + (16 * w + fr) * RS_QK + ks * 64 + fq * 16);
#pragma unroll
                for (int g = 0; g < 2; ++g) if (4 * g <= w) {
                    bf16x8 kf[4];
#pragma unroll
                    for (int e = 0; e < 4; ++e) kf[e] = *(const LAS bf16x8*)(lds + M_KI + (64 * g + 16 * e + fr) * RS_QK + ks * 64 + fq * 16);
#pragma unroll
                    for (int e = 0; e < 4; ++e) Sacc[4 * g + e] = __builtin_amdgcn_mfma_f32_16x16x32_bf16(kf[e], qf, Sacc[4 * g + e], 0, 0, 0);
                }
#pragma unroll
                for (int c4 = 0; c4 < 4; ++c4) {
                    const bf16x8 ctf = *(const LAS bf16x8*)(lds + M_CTI + (16 * c4 + fr) * RS_CT + hd * 256 + ks * 64 + fq * 16);
                    N2[c4] = __builtin_amdgcn_mfma_f32_16x16x32_bf16(ctf, qf, N2[c4], 0, 0, 0);
                }
                const LAS float* np = nC + hd * 128 + ks * 32 + fq * 8;
#pragma unroll
                for (int j = 0; j < 8; ++j) qnp += bf2f((unsigned short)qf[j]) * np[j];
                __builtin_amdgcn_sched_barrier(0);
            }
            if (gD == hd) {
                const unsigned bkD = ldsb + M_KI + (8 * fq + qq) * RS_QK + 8 * pp;
#pragma unroll
                for (int i = 0; i < 8; ++i) CTacc[i] *= cs;
                mlstm_D<0>(CTacc, bvD, bkD); __builtin_amdgcn_sched_barrier(0); mlstm_D<1>(CTacc, bvD, bkD); __builtin_amdgcn_sched_barrier(0); mlstm_D<2>(CTacc, bvD, bkD); __builtin_amdgcn_sched_barrier(0); mlstm_D<3>(CTacc, bvD, bkD); __builtin_amdgcn_sched_barrier(0);
            }
            if (gD != hd) {
                const int lidx = (w & 3) * 64 + lane, dk4 = lidx & 31, part = lidx >> 5; float a0 = 0.f, a1 = 0.f, a2 = 0.f, a3 = 0.f;
#pragma unroll 2
                for (int s = 16 * part; s < 16 * part + 16; ++s) {
                    const u32x2 kv = *(const LAS u32x2*)(lds + M_KI + s * RS_QK + dk4 * 8); const float d = dec[s];
                    a0 += d * lo16(kv.x); a1 += d * hi16(kv.x); a2 += d * lo16(kv.y); a3 += d * hi16(kv.y);
                }
                *(LAS f32x4*)(npart + part * 128 + 4 * dk4) = (f32x4){a0, a1, a2, a3};
            }
            __syncthreads();
            if (tid < 128) nN[hd * 128 + tid] += ((npart[tid] + npart[128 + tid]) + (npart[256 + tid] + npart[384 + tid])) + ((npart[512 + tid] + npart[640 + tid]) + (npart[768 + tid] + npart[896 + tid]));
            if (gD == hd) {
#pragma unroll
                for (int i = 0; i < 8; ++i) {
                    u32x2 wv; wv.x = cvt_pk_bf16(CTacc[i][0], CTacc[i][1]); wv.y = cvt_pk_bf16(CTacc[i][2], CTacc[i][3]);
                    *(LAS u32x2*)(lds + M_CTI + (16 * cD + fr) * RS_CT + (hd * 128 + 16 * i + 4 * fq) * 2) = wv;
                }
            }
            if (hd == 0) {
                ML_STORE_QK();
                if (c < 15) { ML_LOAD_QK(row0 + 128, 0); }
            }
        }
        if (c < 15) { ML_LOAD_VG(row0 + 128); }
        const int t = 16 * w + fr;
        float den1 = 0.f;
#pragma unroll
        for (int g = 0; g < 4; ++g) if (2 * g <= w) {
            const f32x4 dv0 = *(const LAS f32x4*)(dec + 32 * g + 4 * fq), dv1 = *(const LAS f32x4*)(dec + 32 * g + 16 + 4 * fq);
            f32x4 s0 = Sacc[2 * g], s1 = Sacc[2 * g + 1];
#pragma unroll
            for (int j = 0; j < 4; ++j) {
                const int sa = 32 * g + 4 * fq + j, sb = sa + 16;
                if (sa > t) s0[j] = 0.f;
                if (sb > t || 2 * g + 1 > w) s1[j] = 0.f;
                den1 += s0[j] * dv0[j] + s1[j] * dv1[j];
            }
            u32x2 w0, w1; w0.x = cvt_pk_bf16(s0[0], s0[1]); w0.y = cvt_pk_bf16(s0[2], s0[3]); w1.x = cvt_pk_bf16(s1[0], s1[1]); w1.y = cvt_pk_bf16(s1[2], s1[3]);
            *(LAS u32x2*)(lds + M_QI + t * RS_QK + (32 * g + 4 * fq) * 2) = w0;
            *(LAS u32x2*)(lds + M_QI + t * RS_QK + (32 * g + 16 + 4 * fq) * 2) = w1;
        }
        den1 += __shfl_xor(den1, 16); den1 += __shfl_xor(den1, 32);
        qnp += __shfl_xor(qnp, 16); qnp += __shfl_xor(qnp, 32);
#pragma unroll
        for (int i = 0; i < 4; ++i) N2[i] *= cs;
        if (0 <= (w >> 1)) mlstm_B<0>(N2, lds, bvB, t, fq);
        if (1 <= (w >> 1)) mlstm_B<1>(N2, lds, bvB, t, fq);
        if (2 <= (w >> 1)) mlstm_B<2>(N2, lds, bvB, t, fq);
        if (3 <= (w >> 1)) mlstm_B<3>(N2, lds, bvB, t, fq);
        {
            const float den = den1 + cs * qnp;
            const float inv = 1.0f / fmaxf(fabsf(den), expnm[t]);
            const size_t grow = grow_base + row0 + t;
#pragma unroll
            for (int c4 = 0; c4 < 4; ++c4) {
                const float y0 = N2[c4][0] * inv, y1 = N2[c4][1] * inv, y2 = N2[c4][2] * inv, y3 = N2[c4][3] * inv;
                u32x2 wv; wv.x = cvt_pk_bf16(y0, y1); wv.y = cvt_pk_bf16(y2, y3);
                *(u32x2*)(MG + grow * DMG + 1024 + h * 256 + js * 64 + 16 * c4 + 4 * fq) = wv;
            }
        }
        if (c < 15) ML_PREPASS((c + 1) & 1);
    }
    __syncthreads();
    {
        const int tid = tid0, w = tid >> 6, lane = tid & 63, fr = lane & 15, fq = lane >> 4, cD = w & 3, gD = w >> 2;
        float* pC = p.out + O_PC + ((size_t)((l * 8 + b) * 4 + h)) * 65536;
#pragma unroll
        for (int i = 0; i < 8; ++i)
#pragma unroll
            for (int j = 0; j < 4; ++j) pC[(size_t)(gD * 128 + 16 * i + 4 * fq + j) * 256 + js * 64 + 16 * cD + fr] = CTacc[i][j];
        if (js == 0) {
            if (tid < 256) p.out[O_PN + ((size_t)((l * 8 + b) * 4 + h)) * 256 + tid] = nbuf[tid];
            if (tid == 0) p.out[O_PM + (l * 8 + b) * 4 + h] = sm[1024 + 8 + 1];
        }
    }
    __syncthreads();
#undef ML_LOAD_QK
#undef ML_STORE_QK
#undef ML_LOAD_VG
#undef ML_PREPASS
}

constexpr int R_XAI = 0, R_XCF = 16768, R_XCB = 49536, R_AA = 67968, R_UU = 100736, R_PT = 133504, R_HC = 137600, R_CW = 138112, R_CH = 139392, R_WG = 140160;
__device__ void rglru_item(const Params& p, int l, int b, int cb, bool decm, LAS unsigned char* lds) {
    const int tid = otid(), w = __builtin_amdgcn_readfirstlane(tid >> 6), lane = tid & 63, fr = lane & 15, fq = lane >> 4;
    const bf16_t* U = (const bf16_t*)(p.ws + WS_U); bf16_t* MG = (bf16_t*)(p.ws + WS_MG);
    const bf16_t* WGT = (const bf16_t*)(p.ws + WS_WGT);
    LAS float* XCF = (LAS float*)(lds + R_XCF); LAS float* AA = (LAS float*)(lds + R_AA); LAS float* UU = (LAS float*)(lds + R_UU);
    LAS float* PT = (LAS float*)(lds + R_PT); LAS float* HC = (LAS float*)(lds + R_HC); LAS float* CW = (LAS float*)(lds + R_CW); LAS float* CH = (LAS float*)(lds + R_CH);
    const int ch0 = cb * 64;
    const size_t grow_base = decm ? (size_t)MP : (size_t)b * 2048;
    const int nchunk = decm ? 1 : 16;
    __syncthreads();
    if (tid < 64) {
        const int ch = ch0 + tid;
#pragma unroll
        for (int j = 0; j < 4; ++j) CW[j * 64 + tid] = p.conv_w[(size_t)(l * 4 + j) * 1024 + ch];
        CW[256 + tid] = p.conv_b[l * 1024 + ch];
        CH[tid] = p.b_r[l * 1024 + ch]; CH[64 + tid] = p.b_i[l * 1024 + ch]; CH[128 + tid] = 8.0f * softplusf_(-p.lam[l * 1024 + ch]);
        HC[tid] = 0.f; HC[64 + tid] = 0.f;
    }
    if (tid < 24) *(LAS u32x4*)(lds + R_XAI + tid * 16) = (u32x4){0u, 0u, 0u, 0u};
#pragma unroll
    for (int i = 0; i < 2; ++i) {
        const int id = tid + NT * i, g = id >> 9, r = (id >> 3) & 63, cq = id & 7;
        *(LAS u32x4*)(lds + R_WG + (g * 64 + r) * 144 + cq * 16) = *(const u32x4*)(WGT + (size_t)((l * 2 + g) * 16 + cb) * 4096 + r * 64 + cq * 8);
    }
    u32x4 xreg[2], zreg[2];
#pragma unroll
    for (int i = 0; i < 2; ++i) { const int id = tid + NT * i, r = id >> 3, cq = id & 7; const bf16_t* rp = U + (grow_base + r) * NU + ch0 + cq * 8; xreg[i] = *(const u32x4*)rp; zreg[i] = *(const u32x4*)(rp + 1024); }
    for (int c = 0; c < nchunk; ++c) {
        const int row0 = c * 128;
        __syncthreads();
        if (c > 0) {
#pragma unroll
            for (int i = 0; i < 2; ++i) { const int id = tid + NT * i, r = id >> 3, cq = id & 7; *(u32x4*)(MG + (grow_base + row0 - 128 + r) * DMG + ch0 + cq * 8) = *(const LAS u32x4*)(lds + R_XCF + r * 128 + cq * 16); }
        }
        u32x4 zcur[2];
#pragma unroll
        for (int i = 0; i < 2; ++i) { const int id = tid + NT * i, r = id >> 3, cq = id & 7; *(LAS u32x4*)(lds + R_XAI + (3 + r) * 128 + cq * 16) = xreg[i]; zcur[i] = zreg[i]; }
        if (c + 1 < nchunk) {
#pragma unroll
            for (int i = 0; i < 2; ++i) { const int id = tid + NT * i, r = id >> 3, cq = id & 7; const bf16_t* rp = U + (grow_base + row0 + 128 + r) * NU + ch0 + cq * 8; xreg[i] = *(const u32x4*)rp; zreg[i] = *(const u32x4*)(rp + 1024); }
        }
        __syncthreads();
        {
            const int t = tid >> 2, c0 = (tid & 3) * 16;
            float xc[16];
#pragma unroll
            for (int k = 0; k < 16; ++k) xc[k] = CW[256 + c0 + k];
            if (!decm) {
#pragma unroll
                for (int j = 0; j < 4; ++j) {
                    const u32x4 a = *(const LAS u32x4*)(lds + R_XAI + (t + j) * 128 + c0 * 2), bq = *(const LAS u32x4*)(lds + R_XAI + (t + j) * 128 + c0 * 2 + 16);
                    const unsigned wv[8] = {a.x, a.y, a.z, a.w, bq.x, bq.y, bq.z, bq.w};
#pragma unroll
                    for (int k = 0; k < 8; ++k) { xc[2 * k] += CW[j * 64 + c0 + 2 * k] * lo16(wv[k]); xc[2 * k + 1] += CW[j * 64 + c0 + 2 * k + 1] * hi16(wv[k]); }
                }
            } else {
                const float* stp = p.st_conv + ((size_t)(l * 128 + t) * 3) * 1024 + ch0 + c0;
                float* so = p.out + O_SCONV + ((size_t)(l * 128 + t) * 3) * 1024 + ch0 + c0;
#pragma unroll
                for (int j = 0; j < 3; ++j)
#pragma unroll
                    for (int k4 = 0; k4 < 4; ++k4) {
                        const f32x4 sv = *(const f32x4*)(stp + (size_t)j * 1024 + k4 * 4);
#pragma unroll
                        for (int e = 0; e < 4; ++e) xc[k4 * 4 + e] += CW[j * 64 + c0 + k4 * 4 + e] * sv[e];
                        if (j >= 1) *(f32x4*)(so + (size_t)(j - 1) * 1024 + k4 * 4) = sv;
                    }
                const u32x4 a = *(const LAS u32x4*)(lds + R_XAI + (t + 3) * 128 + c0 * 2), bq = *(const LAS u32x4*)(lds + R_XAI + (t + 3) * 128 + c0 * 2 + 16);
                const unsigned wv[8] = {a.x, a.y, a.z, a.w, bq.x, bq.y, bq.z, bq.w};
#pragma unroll
                for (int k = 0; k < 8; ++k) {
                    const float x0 = lo16(wv[k]), x1 = hi16(wv[k]);
                    xc[2 * k] += CW[3 * 64 + c0 + 2 * k] * x0; xc[2 * k + 1] += CW[3 * 64 + c0 + 2 * k + 1] * x1;
                    so[2 * 1024 + 2 * k] = x0; so[2 * 1024 + 2 * k + 1] = x1;
                }
            }
#pragma unroll
            for (int k4 = 0; k4 < 4; ++k4) *(LAS f32x4*)(XCF + t * 64 + c0 + k4 * 4) = (f32x4){xc[k4 * 4], xc[k4 * 4 + 1], xc[k4 * 4 + 2], xc[k4 * 4 + 3]};
            u32x4 o0, o1;
            o0.x = cvt_pk_bf16(xc[0], xc[1]); o0.y = cvt_pk_bf16(xc[2], xc[3]); o0.z = cvt_pk_bf16(xc[4], xc[5]); o0.w = cvt_pk_bf16(xc[6], xc[7]);
            o1.x = cvt_pk_bf16(xc[8], xc[9]); o1.y = cvt_pk_bf16(xc[10], xc[11]); o1.z = cvt_pk_bf16(xc[12], xc[13]); o1.w = cvt_pk_bf16(xc[14], xc[15]);
            *(LAS u32x4*)(lds + R_XCB + t * 144 + c0 * 2) = o0; *(LAS u32x4*)(lds + R_XCB + t * 144 + c0 * 2 + 16) = o1;
        }
        __syncthreads();
        if (!decm && tid < 24) { const u32x4 v = *(const LAS u32x4*)(lds + R_XAI + 128 * 128 + tid * 16); *(LAS u32x4*)(lds + R_XAI + tid * 16) = v; }
        {
            bf16x8 xf[2];
#pragma unroll
            for (int ks = 0; ks < 2; ++ks) xf[ks] = *(const LAS bf16x8*)(lds + R_XCB + (16 * w + fr) * 144 + ks * 64 + fq * 16);
            const int t = 16 * w + fr;
#pragma unroll
            for (int c4 = 0; c4 < 4; ++c4) {
                f32x4 ar = zero4(), ai = ar;
#pragma unroll
                for (int ks = 0; ks < 2; ++ks) {
                    const bf16x8 wfr = *(const LAS bf16x8*)(lds + R_WG + (16 * c4 + fr) * 144 + ks * 64 + fq * 16);
                    const bf16x8 wfi = *(const LAS bf16x8*)(lds + R_WG + (64 + 16 * c4 + fr) * 144 + ks * 64 + fq * 16);
                    ar = __builtin_amdgcn_mfma_f32_16x16x32_bf16(wfr, xf[ks], ar, 0, 0, 0); ai = __builtin_amdgcn_mfma_f32_16x16x32_bf16(wfi, xf[ks], ai, 0, 0, 0); }
                const int d = 16 * c4 + 4 * fq;
                const f32x4 xcv = *(const LAS f32x4*)(XCF + t * 64 + d);
                f32x4 av, uv;
#pragma unroll
                for (int j = 0; j < 4; ++j) {
                    const float r = sigmoidf_(ar[j] + CH[d + j]), ig = sigmoidf_(ai[j] + CH[64 + d + j]);
                    const float la = -r * CH[128 + d + j];
                    const float x2 = 2.0f * la;
                    const float ser = -x2 * (1.0f + x2 * (0.5f + x2 * (0.16666667f + x2 * (0.041666668f + x2 * (0.0083333338f + x2 * 0.0013888889f)))));
                    const float om = x2 > -0.3f ? ser : 1.0f - __expf(x2);
                    av[j] = __expf(la); uv[j] = __builtin_amdgcn_sqrtf(om) * (ig * xcv[j]);
                }
                if (!decm) { *(LAS f32x4*)(AA + t * 64 + d) = av; *(LAS f32x4*)(UU + t * 64 + d) = uv; }
                else {
                    const f32x4 h0 = *(const f32x4*)(p.st_h + (size_t)(l * 128 + t) * 1024 + ch0 + d);
                    const f32x4 hn = av * h0 + uv;
                    *(f32x4*)(p.out + O_SH + (size_t)(l * 128 + t) * 1024 + ch0 + d) = hn;
                    const u32x2 zv = *(const u32x2*)(U + (grow_base + t) * NU + 1024 + ch0 + d);
                    u32x2 wv; wv.x = cvt_pk_bf16(hn[0] * lo16(zv.x), hn[1] * hi16(zv.x)); wv.y = cvt_pk_bf16(hn[2] * lo16(zv.y), hn[3] * hi16(zv.y));
                    *(u32x2*)(MG + (grow_base + t) * DMG + ch0 + d) = wv;
                }
            }
        }
        if (decm) break;
        __syncthreads();
#pragma unroll
        for (int i = 0; i < 2; ++i) { const int id = tid + NT * i, r = id >> 3, cq = id & 7; *(LAS u32x4*)(lds + R_XCB + r * 144 + cq * 16) = zcur[i]; }
        const int ch = tid & 63, part = tid >> 6;
        float av[16], uv[16];
#pragma unroll
        for (int k = 0; k < 16; ++k) { av[k] = AA[(part * 16 + k) * 64 + ch]; uv[k] = UU[(part * 16 + k) * 64 + ch]; }
        {
            float hh = 0.f, Ac = 1.f;
#pragma unroll
            for (int k = 0; k < 16; ++k) { hh = av[k] * hh + uv[k]; Ac *= av[k]; uv[k] = hh; av[k] = Ac; }
            PT[(part * 64 + ch) * 2] = Ac; PT[(part * 64 + ch) * 2 + 1] = hh;
        }
        __syncthreads();
        {
            float zv[16];
#pragma unroll
            for (int k = 0; k < 16; ++k) zv[k] = bf2f(*(const LAS unsigned short*)(lds + R_XCB + (part * 16 + k) * 144 + ch * 2));
            float hin = HC[(c & 1) * 64 + ch];
            for (int q = 0; q < part; ++q) hin = PT[(q * 64 + ch) * 2] * hin + PT[(q * 64 + ch) * 2 + 1];
            float hf = hin;
#pragma unroll
            for (int k = 0; k < 16; ++k) {
                hf = av[k] * hin + uv[k];
                const float y = hf * zv[k];
                *(LAS unsigned short*)(lds + R_XCF + (part * 16 + k) * 128 + ch * 2) = (unsigned short)(cvt_pk_bf16(y, y) & 0xffffu);
            }
            if (part == 7) {
                HC[((c + 1) & 1) * 64 + ch] = hf;
                if (c == 15) p.out[O_PH + (size_t)(l * 8 + b) * 1024 + ch0 + ch] = hf;
            }
        }
        if (c == 15 && tid < 192) {
            const int j = tid >> 6, cc = tid & 63;
            p.out[O_PCONV + ((size_t)(l * 8 + b) * 3 + j) * 1024 + ch0 + cc] = bf2f(*(const LAS unsigned short*)(lds + R_XAI + j * 128 + cc * 2));
        }
    }
    __syncthreads();
    if (!decm) {
#pragma unroll
        for (int i = 0; i < 2; ++i) { const int id = tid + NT * i, r = id >> 3, cq = id & 7; *(u32x4*)(MG + (grow_base + 15 * 128 + r) * DMG + ch0 + cq * 8) = *(const LAS u32x4*)(lds + R_XCF + r * 128 + cq * 16); }
    }
    __syncthreads();
}

__device__ void mlstm_decode(const Params& p, int l, int b, int h, LAS unsigned char* lds) {
    const int tid = otid(), lane = tid & 63;
    const bf16_t* U = (const bf16_t*)(p.ws + WS_U); const float* G = (const float*)(p.ws + WS_G);
    bf16_t* MG = (bf16_t*)(p.ws + WS_MG);
    LAS float* qs = (LAS float*)lds; LAS float* ks = qs + 256; LAS float* vs = qs + 512; LAS float* ns = qs + 768; LAS float* red = qs + 1024; LAS float* red2 = qs + 1024 + 2048;
    const size_t row = (size_t)MP + b;
    const size_t sidx = (size_t)((l * 128 + b) * 4 + h);
    __syncthreads();
    if (tid < 256) {
        qs[tid] = bf2f(U[row * NU + 2048 + h * 256 + tid]); ks[tid] = bf2f(U[row * NU + 3072 + h * 256 + tid]); vs[tid] = bf2f(U[row * NU + 4096 + h * 256 + tid]);
        ns[tid] = p.st_n[sidx * 256 + tid];
    }
    const float ig = G[row * 8 + h], lf = G[row * 8 + 4 + h], m0 = p.st_m[sidx];
    __syncthreads();
    float qk = 0.f, qn = 0.f;
#pragma unroll
    for (int j = 0; j < 4; ++j) { const float qv = qs[lane * 4 + j]; qk += qv * ks[lane * 4 + j]; qn += qv * ns[lane * 4 + j]; }
#pragma unroll
    for (int o = 32; o >= 1; o >>= 1) { qk += __shfl_xor(qk, o); qn += __shfl_xor(qn, o); }
    const float mt = fmaxf(lf + m0, ig), wg = __expf(ig - mt), gi = __expf(lf + m0 - mt);
    const int dvq = tid & 63, dkg = tid >> 6;
    float o_pre = 0.f, zg_pre = 0.f;
    if (tid < 256) { o_pre = bf2f(U[row * NU + 5120 + h * 256 + tid]); zg_pre = p.g_mhead[l * 1024 + h * 256 + tid] * bf2f(U[row * NU + 6144 + h * 256 + tid]); }
    const float* C0 = p.st_C + sidx * 65536; float* C1 = p.out + O_SC + sidx * 65536;
    const f32x4 v4 = *(const LAS f32x4*)(vs + dvq * 4);
    f32x4 qc = zero4();
#pragma unroll 1
    for (int i0 = 0; i0 < 32; i0 += 16) {
        f32x4 cv[16];
#pragma unroll
        for (int j = 0; j < 16; ++j) cv[j] = __builtin_nontemporal_load((const f32x4*)(C0 + (size_t)(dkg * 32 + i0 + j) * 256 + dvq * 4));
#pragma unroll
        for (int j = 0; j < 16; ++j) {
            const int dk = dkg * 32 + i0 + j;
            const float qv = qs[dk], kv = wg * ks[dk];
            qc += qv * cv[j];
            const f32x4 cn = gi * cv[j] + kv * v4;
            __builtin_nontemporal_store(cn, (f32x4*)(C1 + (size_t)dk * 256 + dvq * 4));
        }
    }
    *(LAS f32x4*)(red + dkg * 256 + dvq * 4) = qc;
    __syncthreads();
    float yv = 0.f;
    if (tid < 256) {
        float qcv = 0.f;
#pragma unroll
        for (int g = 0; g < 8; ++g) qcv += red[g * 256 + tid];
        const float num = wg * qk * vs[tid] + gi * qcv, den = wg * qk + gi * qn;
        const float hh = num / fmaxf(fabsf(den), __expf(-mt));
        yv = hh * o_pre;
        float ss = yv * yv;
#pragma unroll
        for (int o = 32; o >= 1; o >>= 1) ss += __shfl_xor(ss, o);
        if (lane == 0) red2[tid >> 6] = ss;
        p.out[O_SN + sidx * 256 + tid] = gi * ns[tid] + wg * ks[tid];
    }
    __syncthreads();
    if (tid < 256) {
        const float rstd = rsqrtf(((red2[0] + red2[1]) + (red2[2] + red2[3])) * (1.0f / 256.0f) + EPSF);
        const float ov = yv * rstd * zg_pre;
        MG[row * DMG + 1024 + h * 256 + tid] = (bf16_t)(cvt_pk_bf16(ov, ov) & 0xffffu);
    }
    if (tid == 0) p.out[O_SM + sidx] = mt;
}

__device__ void decode_items(const Params& p, int l, LAS unsigned char* lds, int max_items) {
    unsigned* ctr = (unsigned*)(p.ws + WS_BAR) + 3584 + 64 * l;
    volatile LAS unsigned* slot = (volatile LAS unsigned*)(lds + LDS_BYTES - 32);
    for (int n = 0; n < max_items; ++n) {
        __syncthreads();
        if (threadIdx.x == 0) *slot = __hip_atomic_fetch_add(ctr, 1u, __ATOMIC_RELAXED, __HIP_MEMORY_SCOPE_AGENT);
        __syncthreads();
        const int item = (int)*slot;
        if (item >= 512) break;
        mlstm_decode(p, l, item >> 2, item & 3, lds);
    }
}

__device__ void phase_mixers(const Params& p, int l, LAS unsigned char* lds) {
    const int G = gridDim.x, bid = obid();
    const bool split = G >= 256;
    const int r = split ? bid - 128 : bid, R = split ? G - 128 : G;
    if (!split || bid < 128) { for (int item = bid; item < 128; item += (split ? 128 : G)) mlstm_prompt(p, l, item, lds); }
    if (r >= 0) {
        for (int item = r; item < 128; item += R) rglru_item(p, l, item >> 4, item & 15, false, lds);
        for (int item = r; item < 16; item += R) rglru_item(p, l, 0, item, true, lds);
    }
    decode_items(p, l, lds, 1 << 30);
}

__device__ void phase_headnorm(const Params& p, int l) {
    const bf16_t* U = (const bf16_t*)(p.ws + WS_U); bf16_t* MG = (bf16_t*)(p.ws + WS_MG);
    const float* gm = p.g_mhead + l * 1024;
    const int G = gridDim.x, bid = obid();
    const int b0 = G > 8 ? bid - 4 : bid, GG = G > 8 ? G - 4 : G;
    if (b0 < 0) return;
    for (size_t idx = (size_t)b0 * NT + otid(); idx < (size_t)MP * 128; idx += (size_t)GG * NT) {
        const size_t row = idx >> 7; const int col = (int)(idx & 127) * 8;
        const u32x4 hv = *(const u32x4*)(MG + row * DMG + 1024 + col);
        const u32x4 ov = *(const u32x4*)(U + row * NU + 5120 + col);
        const u32x4 zv = *(const u32x4*)(U + row * NU + 6144 + col);
        float y[8];
        y[0] = lo16(hv.x) * lo16(ov.x); y[1] = hi16(hv.x) * hi16(ov.x); y[2] = lo16(hv.y) * lo16(ov.y); y[3] = hi16(hv.y) * hi16(ov.y);
        y[4] = lo16(hv.z) * lo16(ov.z); y[5] = hi16(hv.z) * hi16(ov.z); y[6] = lo16(hv.w) * lo16(ov.w); y[7] = hi16(hv.w) * hi16(ov.w);
        float ss = ((y[0] * y[0] + y[1] * y[1]) + (y[2] * y[2] + y[3] * y[3])) + ((y[4] * y[4] + y[5] * y[5]) + (y[6] * y[6] + y[7] * y[7]));
#pragma unroll
        for (int o = 1; o < 32; o <<= 1) ss += __shfl_xor(ss, o);
        const float rstd = rsqrtf(ss * (1.0f / 256.0f) + EPSF);
        const f32x4 g0 = *(const f32x4*)(gm + col), g1 = *(const f32x4*)(gm + col + 4);
        u32x4 o;
        o.x = cvt_pk_bf16(y[0] * rstd * g0[0] * lo16(zv.x), y[1] * rstd * g0[1] * hi16(zv.x));
        o.y = cvt_pk_bf16(y[2] * rstd * g0[2] * lo16(zv.y), y[3] * rstd * g0[3] * hi16(zv.y));
        o.z = cvt_pk_bf16(y[4] * rstd * g1[0] * lo16(zv.z), y[5] * rstd * g1[1] * hi16(zv.z));
        o.w = cvt_pk_bf16(y[6] * rstd * g1[2] * lo16(zv.w), y[7] * rstd * g1[3] * hi16(zv.w));
        *(u32x4*)(MG + row * DMG + 1024 + col) = o;
    }
}

__device__ void phase_final(const Params& p) {
    const bf16_t* XB = (const bf16_t*)(p.ws + WS_XB); const float* SS = (const float*)(p.ws + WS_SS);
    const int tidf = otid(); const int wid = tidf >> 6, lane = tidf & 63;
    for (int row = blockIdx.x * 8 + wid; row < MV; row += gridDim.x * 8) {
        const f32x4* sp = (const f32x4*)(SS + (size_t)row * 16);
        const f32x4 s0 = sp[0], s1 = sp[1], s2 = sp[2], s3 = sp[3];
        const float ss = ((s0[0] + s0[1]) + (s0[2] + s0[3])) + ((s1[0] + s1[1]) + (s1[2] + s1[3])) + ((s2[0] + s2[1]) + (s2[2] + s2[3])) + ((s3[0] + s3[1]) + (s3[2] + s3[3]));
        const float rstd = rsqrtf(ss * (1.0f / 1024.0f) + EPSF);
        float* op = row < MP ? p.out + O_YP + (size_t)row * DM : p.out + O_YS + (size_t)(row - MP) * DM;
#pragma unroll
        for (int i = 0; i < 2; ++i) {
            const int c = i * 512 + lane * 8;
            const u32x4 xv = *(const u32x4*)(XB + (size_t)row * DM + c);
            const f32x4 g0 = *(const f32x4*)(p.g_final + c), g1 = *(const f32x4*)(p.g_final + c + 4);
            *(f32x4*)(op + c) = (f32x4){lo16(xv.x) * rstd * g0[0], hi16(xv.x) * rstd * g0[1], lo16(xv.y) * rstd * g0[2], hi16(xv.y) * rstd * g0[3]};
            *(f32x4*)(op + c + 4) = (f32x4){lo16(xv.z) * rstd * g1[0], hi16(xv.z) * rstd * g1[1], lo16(xv.w) * rstd * g1[2], hi16(xv.w) * rstd * g1[3]};
        }
    }
}

#define XB_XCNT(j) (64 * (j))
#define XB_XSUB(j) (1024 + 64 * (j))
#define XB_XGEN(j) (2048 + 64 * (j))
#define XB_TOP 3072
#define XB_TOPGEN 3136
__device__ __forceinline__ unsigned xb_ld(unsigned* p) { return __hip_atomic_load(p, __ATOMIC_RELAXED, __HIP_MEMORY_SCOPE_AGENT); }
__device__ __forceinline__ unsigned xb_add(unsigned* p, unsigned v) { return __hip_atomic_fetch_add(p, v, __ATOMIC_RELAXED, __HIP_MEMORY_SCOPE_AGENT); }
__device__ __forceinline__ unsigned xb_xcc_id() { return (unsigned)__builtin_amdgcn_s_getreg((3 << 11) | 20) & 0xFu; }
#define XB_SPIN(cond) do { unsigned sp_ = 0; while (cond) { __builtin_amdgcn_s_sleep(1); if (++sp_ > (1u << 24)) break; } } while (0)
__device__ __forceinline__ void gbar(unsigned* bar, volatile LAS unsigned* st) {
    asm volatile("s_waitcnt vmcnt(0) lgkmcnt(0)" ::: "memory");
    __syncthreads();
    if (threadIdx.x == 0) {
        const unsigned x = xb_xcc_id(), nloc = st[0], nx = st[1];
        const unsigned old = xb_add(&bar[XB_XSUB(x)], 1u);
        const unsigned gen = old / nloc;
        if (old + 1u == (gen + 1u) * nloc) {
            __builtin_amdgcn_fence(__ATOMIC_RELEASE, "agent");
            asm volatile("s_waitcnt vmcnt(0)" ::: "memory");
            const unsigned og = xb_add(&bar[XB_TOP], 1u);
            const unsigned tg = og / nx;
            if (og + 1u == (tg + 1u) * nx) xb_add(&bar[XB_TOPGEN], 1u);
            else XB_SPIN(xb_ld(&bar[XB_TOPGEN]) == tg);
            __builtin_amdgcn_fence(__ATOMIC_ACQUIRE, "agent");
            xb_add(&bar[XB_XGEN(x)], 1u);
            asm volatile("s_waitcnt vmcnt(0)" ::: "memory");
        } else {
            XB_SPIN(xb_ld(&bar[XB_XGEN(x)]) == gen);
            __builtin_amdgcn_fence(__ATOMIC_ACQUIRE, "agent");
            asm volatile("s_waitcnt vmcnt(0)" ::: "memory");
        }
    }
    __syncthreads();
}

__global__ void __launch_bounds__(NT, 2) hymba_fwd(Params p) {
    extern __shared__ __attribute__((aligned(16))) unsigned char lds_raw[];
    LAS unsigned char* lds = (LAS unsigned char*)lds_raw;
    cg::grid_group grid = cg::this_grid();
    bf16_t* XB = (bf16_t*)(p.ws + WS_XB); bf16_t* U = (bf16_t*)(p.ws + WS_U); float* G = (float*)(p.ws + WS_G); bf16_t* MG = (bf16_t*)(p.ws + WS_MG);
    float* SS = (float*)(p.ws + WS_SS);
    unsigned* bar = (unsigned*)(p.ws + WS_BAR);
    volatile LAS unsigned* st = (volatile LAS unsigned*)(lds + LDS_BYTES - 16);
    if (threadIdx.x == 0) (void)xb_add(&bar[XB_XCNT(xb_xcc_id())], 1u);
    if (p.out == nullptr) grid.sync();
    phase_prep(p, lds);
    if (threadIdx.x == 0) {
        const unsigned x = xb_xcc_id(), Gn = gridDim.x; unsigned mine = 1u, cnt = 1u, sp = 0u;
        for (;;) {
            unsigned sum = 0u; cnt = 0u;
            for (unsigned j = 0; j < 16; ++j) { const unsigned c = xb_ld(&bar[XB_XCNT(j)]); sum += c; cnt += c > 0u ? 1u : 0u; if (j == x) mine = c; }
            if (sum == Gn || ++sp > (1u << 22)) break;
            __builtin_amdgcn_s_sleep(1);
        }
        st[0] = mine > 0u ? mine : 1u; st[1] = cnt > 0u ? cnt : 1u;
    }
    __syncthreads();
    gbar(bar, st);
    for (int l = 0; l < 2; ++l) {
        {
            pg8::Gemm g; g.A = XB; g.Bt = (const bf16_t*)(p.ws + WS_WT1) + (size_t)l * NW1 * DM; g.M = MR; g.N = NW1; g.K = DM;
            unsigned* dctr = bar + 3712 + 64 * l;
            pg8::InOrder so; so.G = gridDim.x; so.c = obid(); so.done_ctr = dctr;
            EpiIn e; e.U = U; e.G = G; e.SS = SS; e.bmi = p.b_mi + l * 4; e.bmf = p.b_mf + l * 4;
            pg8::gemm_phase<EpiIn, pg8::InOrder, DM>(lds, g, so, e);
            const int Gn = gridDim.x, maxu = (pg8::IN_UNITS + Gn - 1) / Gn, mine = (pg8::IN_UNITS - so.c + Gn - 1) / Gn;
            if (mine < maxu) {
                if (threadIdx.x == 0) {
                    unsigned sp = 0u;
                    while (__hip_atomic_load(dctr, __ATOMIC_RELAXED, __HIP_MEMORY_SCOPE_AGENT) < 8u * pg8::IN_DEC_UNITS) { __builtin_amdgcn_s_sleep(2); if (++sp > (1u << 24)) break; }
                    __builtin_amdgcn_fence(__ATOMIC_ACQUIRE, "agent");
                    asm volatile("s_waitcnt vmcnt(0)" ::: "memory");
                }
                __syncthreads();
                decode_items(p, l, lds, 1);
            }
        }
        gbar(bar, st);
        phase_mixers(p, l, lds);
        gbar(bar, st);
        for (int pass = 0; pass < 2; ++pass) {
            if (pass == 0) phase_headnorm(p, l);
            pg8::Gemm g; g.A = MG; g.Bt = (const bf16_t*)(p.ws + WS_WT2) + (size_t)l * DM * DMG; g.M = MR; g.N = DM; g.K = DMG;
            pg8::OutOrder so; so.G = gridDim.x; so.c = obid(); so.mode = pass;
            EpiOut e; e.basep = p.xp; e.bases = p.xs; e.split = l == 0 ? 1 : 0; e.XBo = XB; e.SSo = SS;
            pg8::gemm_phase<EpiOut, pg8::OutOrder, DMG>(lds, g, so, e);
            gbar(bar, st);
        }
    }
    phase_final(p);
}

extern "C" void kernel_launch(void* const* d_in, const int* in_sizes, int n_in, void* d_out, int out_size, void* d_ws, size_t ws_size, hipStream_t stream) {
    static int grid_blocks = 0;
    if (!grid_blocks) {
        int dev = 0, cus = 0, per_cu = 0;
        hipGetDevice(&dev);
        hipDeviceGetAttribute(&cus, hipDeviceAttributeMultiprocessorCount, dev);
        hipFuncSetAttribute((const void*)hymba_fwd, hipFuncAttributeMaxDynamicSharedMemorySize, LDS_BYTES);
        hipOccupancyMaxActiveBlocksPerMultiprocessor(&per_cu, (const void*)hymba_fwd, NT, LDS_BYTES);
        if (per_cu < 1) per_cu = 1;
        grid_blocks = cus * per_cu;
        (void)hipGetLastError();
    }
    if (ws_size < WS_END) { fprintf(stderr, "workspace too small: %zu < %zu\n", ws_size, (size_t)WS_END); return; }
    Params p{};
    p.xp = (const float*)d_in[0]; p.xs = (const float*)d_in[1]; p.st_h = (const float*)d_in[2]; p.st_conv = (const float*)d_in[3];
    p.st_C = (const float*)d_in[4]; p.st_n = (const float*)d_in[5]; p.st_m = (const float*)d_in[6]; p.g_norm = (const float*)d_in[7];
    p.w_in = (const float*)d_in[8]; p.conv_w = (const float*)d_in[9]; p.conv_b = (const float*)d_in[10]; p.w_r = (const float*)d_in[11];
    p.b_r = (const float*)d_in[12]; p.w_i = (const float*)d_in[13]; p.b_i = (const float*)d_in[14]; p.lam = (const float*)d_in[15];
    p.b_mi = (const float*)d_in[16]; p.b_mf = (const float*)d_in[17]; p.g_mhead = (const float*)d_in[18]; p.w_out = (const float*)d_in[19];
    p.g_final = (const float*)d_in[20];
    p.out = (float*)d_out; p.ws = (unsigned char*)d_ws;
    (void)hipMemsetAsync((unsigned char*)d_ws + WS_BAR, 0, 16384, stream);
    void* args[] = {&p};
    hipError_t e = hipLaunchCooperativeKernel((const void*)hymba_fwd, dim3(grid_blocks), dim3(NT), args, LDS_BYTES, stream);
    if (e != hipSuccess) fprintf(stderr, "cooperative launch failed: %s (grid %d)\n", hipGetErrorString(e), grid_blocks);
}
```

```cpp
#include <hip/hip_runtime.h>
#include <hip/hip_cooperative_groups.h>
#include <cstdio>
namespace cg = cooperative_groups;

#define LAS __attribute__((address_space(3)))
typedef unsigned short bf16_t;
typedef short bf16x8 __attribute__((ext_vector_type(8)));
typedef short bf16x4 __attribute__((ext_vector_type(4)));
typedef float f32x4 __attribute__((ext_vector_type(4)));
typedef unsigned u32x4 __attribute__((ext_vector_type(4)));
typedef unsigned u32x2 __attribute__((ext_vector_type(2)));

constexpr int NT = 512;
constexpr int LDS_BYTES = 163840;
constexpr int MP = 16384, MV = 16512, MR = 16640;
constexpr int DM = 1024, NU = 7168, NW1 = 7424, DIN = 7176, DMG = 2048;
constexpr float EPSF = 1e-6f;

constexpr size_t WS_XB = 0;
constexpr size_t WS_WT1 = WS_XB + (size_t)MR * DM * 2;
constexpr size_t WS_WT2 = WS_WT1 + (size_t)2 * NW1 * DM * 2;
constexpr size_t WS_WGT = WS_WT2 + (size_t)2 * DM * DMG * 2;
constexpr size_t WS_U = WS_WGT + (size_t)2 * 2 * 16 * 64 * 64 * 2;
constexpr size_t WS_G = WS_U + (size_t)MR * NU * 2;
constexpr size_t WS_MG = WS_G + (size_t)MR * 8 * 4;
constexpr size_t WS_X1 = WS_MG + (size_t)MR * DMG * 2;
constexpr size_t WS_X2 = WS_X1 + (size_t)MR * DM * 4;
constexpr size_t WS_SS = WS_X2 + (size_t)MR * DM * 4;
constexpr size_t WS_YSS = WS_SS + (size_t)MR * 16 * 4;
constexpr size_t WS_BAR = WS_YSS + (size_t)MR * 16 * 4;
constexpr size_t WS_END = WS_BAR + 16384;

struct Params {
    const float* xp; const float* xs; const float* st_h; const float* st_conv; const float* st_C; const float* st_n; const float* st_m;
    const float* g_norm; const float* w_in; const float* conv_w; const float* conv_b; const float* w_r; const float* b_r; const float* w_i; const float* b_i;
    const float* lam; const float* b_mi; const float* b_mf; const float* g_mhead; const float* w_out; const float* g_final;
    float* out; unsigned char* ws;
};

constexpr size_t O_YP = 0;
constexpr size_t O_YS = O_YP + (size_t)MP * DM;
constexpr size_t O_PH = O_YS + (size_t)128 * DM;
constexpr size_t O_PCONV = O_PH + 2 * 8 * 1024;
constexpr size_t O_PC = O_PCONV + 2 * 8 * 3 * 1024;
constexpr size_t O_PN = O_PC + (size_t)2 * 8 * 4 * 65536;
constexpr size_t O_PM = O_PN + 2 * 8 * 4 * 256;
constexpr size_t O_SH = O_PM + 2 * 8 * 4;
constexpr size_t O_SCONV = O_SH + 2 * 128 * 1024;
constexpr size_t O_SC = O_SCONV + 2 * 128 * 3 * 1024;
constexpr size_t O_SN = O_SC + (size_t)2 * 128 * 4 * 65536;
constexpr size_t O_SM = O_SN + 2 * 128 * 4 * 256;

__device__ __forceinline__ float bf2f(unsigned short v) { return __uint_as_float(((unsigned)v) << 16); }
__device__ __forceinline__ unsigned cvt_pk_bf16(float lo, float hi) { unsigned r; asm volatile("v_cvt_pk_bf16_f32 %0, %1, %2" : "=v"(r) : "v"(lo), "v"(hi)); return r; }
__device__ __forceinline__ float sigmoidf_(float x) { return __builtin_amdgcn_rcpf(1.0f + __builtin_amdgcn_exp2f(-1.44269504f * x)); }
__device__ __forceinline__ float siluf_(float x) { return x * __builtin_amdgcn_rcpf(1.0f + __builtin_amdgcn_exp2f(-1.44269504f * x)); }
__device__ __forceinline__ float softplusf_(float x) { return fmaxf(x, 0.f) + log1pf(__expf(-fabsf(x))); }
__device__ __forceinline__ int otid() { int t = threadIdx.x; asm volatile("" : "+v"(t)); return t; }
__device__ __forceinline__ int obid() { int t = blockIdx.x; asm volatile("" : "+s"(t)); return t; }
__device__ __forceinline__ f32x4 zero4() { float z = 0.f; asm volatile("" : "+v"(z)); return (f32x4){z, z, z, z}; }
__device__ __forceinline__ float lo16(unsigned w) { return __uint_as_float(w << 16); }
__device__ __forceinline__ float hi16(unsigned w) { return __uint_as_float(w & 0xffff0000u); }

namespace pg8 {
constexpr int BM = 256, BK = 64, HALF = 128, HTB = HALF * BK * 2, STAGE_BYTES = 8 * HTB, NXCD = 8, WGM = 2;
__host__ __device__ __forceinline__ int lds_byte(int r, int c) { const int st = (r >> 4) * 2 + (c >> 5), rr = r & 15, cc = c & 31, ob = rr * 64 + cc * 2; return st * 1024 + (ob ^ (((ob >> 9) & 1) << 5)); }
__host__ __device__ __forceinline__ void stage_rc(int b, int& R, int& C) { const int st = b / 1024, sb = b % 1024, swz = sb ^ (((sb >> 9) & 1) << 5); R = (st >> 1) * 16 + swz / 64; C = (st & 1) * 32 + (swz % 64) / 2; }
__host__ __device__ __forceinline__ int perm32(int rho) { const int n = rho >> 4, i = rho & 15; return 8 * (i >> 2) + 4 * n + (i & 3); }
struct Unit { int pm, pn; };
struct Gemm { const bf16_t* A; const bf16_t* Bt; int M, N, K; };
template <int NM_, int NN_>
struct StaticOrder {
    static constexpr int nM = NM_, nN = NN_, nwg = NM_ * NN_;
    int G, c;
    __device__ void init(int G_, int c_) { G = G_; c = c_; }
    __device__ static void map(int L, Unit& u) {
        int wgid = L; { constexpr int q = nwg / NXCD, r = nwg % NXCD; const int xcd = wgid % NXCD, off = wgid / NXCD; wgid = (xcd < r ? xcd * (q + 1) : r * (q + 1) + (xcd - r) * q) + off; }
        constexpr int nig = WGM * nN; const int gid = wgid / nig, fm = gid * WGM, gsz = (nM - fm) < WGM ? (nM - fm) : WGM;
        u.pm = fm + ((wgid % nig) % gsz); u.pn = (wgid % nig) / gsz;
    }
    __device__ bool next(int i, Unit& u) const { const int L = i * G + c; if (L >= nwg) return false; map(L, u); return true; }
    __device__ __forceinline__ void done(const Unit&, int) const {}
};

struct OutOrder {
    int G, c, mode;
    __device__ bool next(int i, Unit& u) const {
        const int L = i * G + c;
        if (mode == 0) { if (L >= 4) return false; u.pm = 64; u.pn = L; return true; }
        if (L >= 256) return false; StaticOrder<64, 4>::map(L, u); return true;
    }
    __device__ __forceinline__ void done(const Unit&, int) const {}
};

constexpr int IN_UNITS = 65 * 29, IN_DEC_UNITS = 29;
struct InOrder {
    int G, c; unsigned* done_ctr;
    __device__ bool next(int i, Unit& u) const {
        const int L = i * G + c; if (L >= IN_UNITS) return false;
        if (L < IN_DEC_UNITS) { u.pm = 64; u.pn = L; return true; }
        StaticOrder<64, 29>::map(L - IN_DEC_UNITS, u); return true;
    }
    __device__ __forceinline__ void done(const Unit& u, int lane) const {
        if (u.pm == 64) {
            asm volatile("s_waitcnt vmcnt(0)" ::: "memory");
            __builtin_amdgcn_fence(__ATOMIC_RELEASE, "agent");
            asm volatile("s_waitcnt vmcnt(0)" ::: "memory");
            if (lane == 0) __hip_atomic_fetch_add(done_ctr, 1u, __ATOMIC_RELAXED, __HIP_MEMORY_SCOPE_AGENT);
        }
    }
};

template <class Epi, class Sched, int KK>
__device__ __forceinline__ void gemm_phase(LAS unsigned char* lds, const Gemm g, const Sched& S, const Epi& E) {
    const int tid = otid(), wid = __builtin_amdgcn_readfirstlane(tid >> 6), lane = tid & 63, wr = wid >> 2, wc = wid & 3, fr = lane & 15, fq = lane >> 4;
    constexpr int K = KK, nt = K / BK;
    unsigned voffA[2], voffB[2];
#pragma unroll
    for (int i = 0; i < 2; ++i) { int R, C; stage_rc(tid * 16 + i * 8192, R, C); const int Rb = Epi::PERM ? ((R & ~31) + perm32(R & 31)) : R;
        voffA[i] = (unsigned)(R * K + C) * 2u; voffB[i] = (unsigned)(Rb * K + C) * 2u; }
    const size_t kstep = (size_t)(BK * 2);
    const size_t hstep = (size_t)HALF * K * 2;
    const size_t tstep = 2 * hstep;
    const unsigned ldsw = (unsigned)wid * 1024u;
    const int aoff = lds_byte(wr * 64 + fr, fq * 8), boff = lds_byte(wc * 32 + fr, fq * 8);
#define PG8_SA(b, h) (((b) * 2 + (h)) * HTB)
#define PG8_SB(b, h) ((4 + (b) * 2 + (h)) * HTB)
#define PG8_STAGE(bufoff, gbase, voff) do { _Pragma("unroll") for (int _i = 0; _i < 2; ++_i) \
        __builtin_amdgcn_global_load_lds((const unsigned*)((const char*)(gbase) + (voff)[_i]), (LAS unsigned*)(lds + (bufoff) + ldsw + _i * 8192), 16, 0, 0); } while (0)
#define PG8_LDA(dst, b, h) do { _Pragma("unroll") for (int m = 0; m < 4; ++m) _Pragma("unroll") for (int k = 0; k < 2; ++k) dst[m][k] = *(const LAS bf16x8*)(lds + PG8_SA(b, h) + aoff + m * 2048 + k * 1024); } while (0)
#define PG8_LDB(dst, b, h) do { _Pragma("unroll") for (int n = 0; n < 2; ++n) _Pragma("unroll") for (int k = 0; k < 2; ++k) dst[n][k] = *(const LAS bf16x8*)(lds + PG8_SB(b, h) + boff + n * 2048 + k * 1024); } while (0)
#define PG8_MMA(ai, bj, At, Bt) do { __builtin_amdgcn_s_setprio(1); _Pragma("unroll") for (int m = 0; m < 4; ++m) _Pragma("unroll") for (int n = 0; n < 2; ++n) _Pragma("unroll") for (int k = 0; k < 2; ++k) \
        acc[ai][bj][m][n] = __builtin_amdgcn_mfma_f32_16x16x32_bf16(Bt[n][k], At[m][k], acc[ai][bj][m][n], 0, 0, 0); __builtin_amdgcn_s_setprio(0); } while (0)
#define PG8_WAIT_V(n) asm volatile("s_waitcnt vmcnt(" #n ")" ::: "memory")
#define PG8_WAIT_L(n) asm volatile("s_waitcnt lgkmcnt(" #n ")" ::: "memory")
#define PG8_BAR __builtin_amdgcn_s_barrier()
#define PG8_SCHED __builtin_amdgcn_sched_barrier(0)
    Unit cur, nxt; int ui = 0;
    if (!S.next(0, cur)) return;
    f32x4 acc[2][2][4][2];
#pragma unroll
    for (int a = 0; a < 2; ++a)
#pragma unroll
        for (int b = 0; b < 2; ++b)
#pragma unroll
            for (int m = 0; m < 4; ++m)
#pragma unroll
                for (int n = 0; n < 2; ++n) acc[a][b][m][n] = zero4();
    bf16x8 At[4][2], B0[2][2], B1[2][2];
    const char* cA = (const char*)g.A + (size_t)cur.pm * tstep; const char* cB = (const char*)g.Bt + (size_t)cur.pn * tstep;
    PG8_STAGE(PG8_SB(0, 0), cB, voffB); PG8_STAGE(PG8_SA(0, 0), cA, voffA); PG8_STAGE(PG8_SB(0, 1), cB + hstep, voffB); PG8_STAGE(PG8_SA(0, 1), cA + hstep, voffA);
    if (wr == 1) PG8_BAR;
    PG8_WAIT_V(4); PG8_BAR;
    PG8_STAGE(PG8_SB(1, 0), cB + kstep, voffB); PG8_STAGE(PG8_SA(1, 0), cA + kstep, voffA); PG8_STAGE(PG8_SB(1, 1), cB + hstep + kstep, voffB);
    PG8_WAIT_V(6); PG8_BAR;
    for (;;) {
        const bool has_next = S.next(ui + 1, nxt);
        const char* nA = has_next ? (const char*)g.A + (size_t)nxt.pm * tstep : cA; const char* nB = has_next ? (const char*)g.Bt + (size_t)nxt.pn * tstep : cB;
        for (int t = 0; t < nt; t += 2) {
            const bool last = (t == nt - 2);
            const char* a1 = cA + (size_t)(t + 1) * kstep;
            const char* a2 = last ? nA : cA + (size_t)(t + 2) * kstep; const char* b2 = last ? nB : cB + (size_t)(t + 2) * kstep;
            const char* a3 = a2 + kstep; const char* b3 = b2 + kstep;
            PG8_LDB(B0, 0, 0); PG8_SCHED; PG8_LDA(At, 0, 0); PG8_STAGE(PG8_SA(1, 1), a1 + hstep, voffA);
            PG8_WAIT_L(8); PG8_BAR; PG8_WAIT_L(0); PG8_MMA(0, 0, At, B0); PG8_BAR; PG8_SCHED;
            PG8_LDB(B1, 0, 1); PG8_STAGE(PG8_SB(0, 0), b2, voffB);
            PG8_BAR; PG8_WAIT_L(0); PG8_MMA(0, 1, At, B1); PG8_BAR;
            PG8_LDA(At, 0, 1); PG8_STAGE(PG8_SA(0, 0), a2, voffA);
            PG8_BAR; PG8_WAIT_L(0); PG8_MMA(1, 0, At, B0); PG8_BAR; PG8_SCHED;
            PG8_STAGE(PG8_SB(0, 1), b2 + hstep, voffB);
            PG8_WAIT_V(6); PG8_BAR; PG8_MMA(1, 1, At, B1); PG8_BAR;
            PG8_LDB(B0, 1, 0); PG8_SCHED; PG8_LDA(At, 1, 0); PG8_STAGE(PG8_SA(0, 1), a2 + hstep, voffA);
            PG8_WAIT_L(8); PG8_BAR; PG8_WAIT_L(0); PG8_MMA(0, 0, At, B0); PG8_BAR; PG8_SCHED;
            PG8_LDB(B1, 1, 1); PG8_STAGE(PG8_SB(1, 0), b3, voffB);
            PG8_BAR; PG8_WAIT_L(0); PG8_MMA(0, 1, At, B1); PG8_BAR;
            PG8_LDA(At, 1, 1); PG8_STAGE(PG8_SA(1, 0), a3, voffA);
            PG8_BAR; PG8_WAIT_L(0); PG8_MMA(1, 0, At, B0); PG8_BAR; PG8_SCHED;
            PG8_STAGE(PG8_SB(1, 1), b3 + hstep, voffB);
            PG8_WAIT_V(6); PG8_BAR; PG8_MMA(1, 1, At, B1); PG8_BAR;
        }
        E(acc, cur, wr, wc, fr, fq);
        S.done(cur, lane);
        if (!has_next) break;
#pragma unroll
        for (int a = 0; a < 2; ++a)
#pragma unroll
            for (int b = 0; b < 2; ++b)
#pragma unroll
                for (int m = 0; m < 4; ++m)
#pragma unroll
                    for (int n = 0; n < 2; ++n) acc[a][b][m][n] = zero4();
        cur = nxt; cA = nA; cB = nB; ++ui;
    }
    PG8_WAIT_V(0);
    if (wr == 0) PG8_BAR;
    PG8_BAR;
#undef PG8_SA
#undef PG8_SB
#undef PG8_STAGE
#undef PG8_LDA
#undef PG8_LDB
#undef PG8_MMA
#undef PG8_WAIT_V
#undef PG8_WAIT_L
#undef PG8_BAR
#undef PG8_SCHED
}
}

struct EpiIn {
    static constexpr bool PERM = true;
    bf16_t* U; float* G; const float* SS; const float* bmi; const float* bmf;
    __device__ __forceinline__ void operator()(const f32x4 (&acc)[2][2][4][2], const pg8::Unit& u, int wr, int wc, int fr, int fq) const {
        const int row0 = u.pm * 256 + wr * 64 + fr;
        const int pn = u.pn;
        const int mode = ((pn >= 4 && pn < 8) || (pn >= 24 && pn < 28)) ? 1 : ((pn >= 20 && pn < 24) ? 2 : 0);
        f32x4 cur[4];
        { const f32x4* sp = (const f32x4*)(SS + (size_t)row0 * 16); cur[0] = sp[0]; cur[1] = sp[1]; cur[2] = sp[2]; cur[3] = sp[3]; }
#pragma unroll
        for (int r = 0; r < 8; ++r) {
            const int ai = r >> 2, m = r & 3;
            const int row = row0 + ai * 128 + m * 16;
            f32x4 nxt[4];
            if (r < 7) {
                const f32x4* sp = (const f32x4*)(SS + (size_t)(row0 + ((r + 1) >> 2) * 128 + ((r + 1) & 3) * 16) * 16);
                nxt[0] = sp[0]; nxt[1] = sp[1]; nxt[2] = sp[2]; nxt[3] = sp[3];
            }
            const float ss = ((cur[0][0] + cur[0][1]) + (cur[0][2] + cur[0][3])) + ((cur[1][0] + cur[1][1]) + (cur[1][2] + cur[1][3])) + ((cur[2][0] + cur[2][1]) + (cur[2][2] + cur[2][3])) + ((cur[3][0] + cur[3][1]) + (cur[3][2] + cur[3][3]));
            const float rstd = rsqrtf(ss * (1.0f / 1024.0f) + EPSF);
            if (pn < 28) {
                bf16_t* rowp = U + (size_t)row * NU + pn * 256 + wc * 32 + 8 * fq;
#pragma unroll
                for (int bj = 0; bj < 2; ++bj) {
                    f32x4 v0 = acc[ai][bj][m][0] * rstd, v1 = acc[ai][bj][m][1] * rstd;
                    if (mode == 1) {
#pragma unroll
                        for (int j = 0; j < 4; ++j) { v0[j] = siluf_(v0[j]); v1[j] = siluf_(v1[j]); }
                    } else if (mode == 2) {
#pragma unroll
                        for (int j = 0; j < 4; ++j) { v0[j] = sigmoidf_(v0[j]); v1[j] = sigmoidf_(v1[j]); }
                    }
                    u32x4 w; w.x = cvt_pk_bf16(v0[0], v0[1]); w.y = cvt_pk_bf16(v0[2], v0[3]); w.z = cvt_pk_bf16(v1[0], v1[1]); w.w = cvt_pk_bf16(v1[2], v1[3]);
                    *(u32x4*)(rowp + bj * 128) = w;
                }
            } else if (wc == 0 && fq == 0) {
                const f32x4 v0 = acc[ai][0][m][0] * rstd, v1 = acc[ai][0][m][1] * rstd;
                f32x4 gi, gf;
#pragma unroll
                for (int j = 0; j < 4; ++j) { gi[j] = v0[j] + bmi[j]; const float x = v1[j] + bmf[j]; gf[j] = fminf(x, 0.f) - log1pf(__expf(-fabsf(x))); }
                *(f32x4*)(G + (size_t)row * 8) = gi; *(f32x4*)(G + (size_t)row * 8 + 4) = gf;
            }
            if (r < 7) { cur[0] = nxt[0]; cur[1] = nxt[1]; cur[2] = nxt[2]; cur[3] = nxt[3]; }
        }
    }
};

struct EpiOut {
    static constexpr bool PERM = false;
    const float* basep; const float* bases; int split;
    bf16_t* XBo; float* SSo;
    __device__ __forceinline__ void operator()(const f32x4 (&acc)[2][2][4][2], const pg8::Unit& u, int wr, int wc, int fr, int fq) const {
        const int row0 = u.pm * 256 + wr * 64 + fr, col0 = u.pn * 256 + wc * 32 + 4 * fq;
#pragma unroll
        for (int g2 = 0; g2 < 4; ++g2) {
            const int ai = g2 >> 1;
            f32x4 bs[2][2][2];
#pragma unroll
            for (int mm = 0; mm < 2; ++mm) {
                const int m = (g2 & 1) * 2 + mm;
                const int row = row0 + ai * 128 + m * 16;
                if (split) {
                    const float* bp = basep + (size_t)row * DM;
                    bool have = true;
                    if (row >= MV) have = false; else if (row >= MP) bp = bases + (size_t)(row - MP) * DM;
#pragma unroll
                    for (int bj = 0; bj < 2; ++bj)
#pragma unroll
                        for (int n = 0; n < 2; ++n) { bs[mm][bj][n] = zero4(); if (have) bs[mm][bj][n] = *(const f32x4*)(bp + col0 + bj * 128 + n * 16); }
                } else {
#pragma unroll
                    for (int bj = 0; bj < 2; ++bj)
#pragma unroll
                        for (int n = 0; n < 2; ++n) { const u32x2 v = *(const u32x2*)(XBo + (size_t)row * DM + col0 + bj * 128 + n * 16); bs[mm][bj][n] = (f32x4){lo16(v.x), hi16(v.x), lo16(v.y), hi16(v.y)}; }
                }
            }
#pragma unroll
            for (int mm = 0; mm < 2; ++mm) {
                const int m = (g2 & 1) * 2 + mm;
                const int row = row0 + ai * 128 + m * 16;
                float ss = 0.f;
#pragma unroll
                for (int bj = 0; bj < 2; ++bj)
#pragma unroll
                    for (int n = 0; n < 2; ++n) {
                        const int c = col0 + bj * 128 + n * 16;
                        const f32x4 o = bs[mm][bj][n] + acc[ai][bj][m][n];
                        u32x2 w; w.x = cvt_pk_bf16(o[0], o[1]); w.y = cvt_pk_bf16(o[2], o[3]); *(u32x2*)(XBo + (size_t)row * DM + c) = w;
                        ss += (o[0] * o[0] + o[1] * o[1]) + (o[2] * o[2] + o[3] * o[3]);
                    }
                ss += __shfl_xor(ss, 16); ss += __shfl_xor(ss, 32);
                if (fq == 0) SSo[(size_t)row * 16 + u.pn * 4 + wc] = ss;
            }
        }
    }
};

__device__ void transpose_tile(const float* src, int ldn, int nvalid, int k0, int n0, bf16_t* dst, int ldk, const float* sk, float sn, LAS float* T) {
    const int tid = otid();
    {
        const int r = tid >> 4, c4 = tid & 15;
#pragma unroll
        for (int i = 0; i < 2; ++i) {
            const int k = r + 32 * i; const int n = n0 + 4 * c4;
            f32x4 v = zero4();
            if (n + 3 < nvalid) v = *(const f32x4*)(src + (size_t)(k0 + k) * ldn + n);
            const float s = (sk ? sk[k0 + k] : 1.0f) * sn;
            T[k * 65 + 4 * c4 + 0] = v[0] * s; T[k * 65 + 4 * c4 + 1] = v[1] * s; T[k * 65 + 4 * c4 + 2] = v[2] * s; T[k * 65 + 4 * c4 + 3] = v[3] * s;
        }
    }
    __syncthreads();
    {
        const int n = tid >> 3, kq = tid & 7;
        float f[8];
#pragma unroll
        for (int j = 0; j < 8; ++j) f[j] = T[(kq * 8 + j) * 65 + n];
        u32x4 w; w.x = cvt_pk_bf16(f[0], f[1]); w.y = cvt_pk_bf16(f[2], f[3]); w.z = cvt_pk_bf16(f[4], f[5]); w.w = cvt_pk_bf16(f[6], f[7]);
        *(u32x4*)(dst + (size_t)(n0 + n) * ldk + k0 + kq * 8) = w;
    }
    __syncthreads();
}

__device__ void phase_prep(const Params& p, LAS unsigned char* lds) {
    LAS float* T = (LAS float*)lds;
    bf16_t* WT1 = (bf16_t*)(p.ws + WS_WT1); bf16_t* WT2 = (bf16_t*)(p.ws + WS_WT2); bf16_t* WGT = (bf16_t*)(p.ws + WS_WGT);
    bf16_t* XB = (bf16_t*)(p.ws + WS_XB); float* SS = (float*)(p.ws + WS_SS); bf16_t* MG = (bf16_t*)(p.ws + WS_MG);
    constexpr int JA = 2 * 16 * 116, JB = 2 * 32 * 16, JC = 64, JD = MR / 8;
    for (int job = blockIdx.x; job < JA + JB + JC + JD; job += gridDim.x) {
        if (job < JA) {
            const int l = job / (16 * 116), r = job % (16 * 116), ntile = r / 16, kt = r % 16;
            const int n0 = ntile * 64;
            const float sn = (n0 >= 3072 && n0 < 4096) ? 0.0625f : 1.0f;
            transpose_tile(p.w_in + (size_t)l * DM * DIN, DIN, DIN, kt * 64, n0, WT1 + (size_t)l * NW1 * DM, DM, p.g_norm + l * DM, sn, T);
        } else if (job < JA + JB) {
            const int j = job - JA, l = j / 512, r = j % 512, ntile = r / 32, kt = r % 32;
            transpose_tile(p.w_out + (size_t)l * DMG * DM, DM, DM, kt * 64, ntile * 64, WT2 + (size_t)l * DM * DMG, DMG, nullptr, 1.0f, T);
        } else if (job < JA + JB + JC) {
            const int j = job - JA - JB, l = j >> 5, gate = (j >> 4) & 1, blk = j & 15;
            const float* src = (gate ? p.w_i : p.w_r) + (size_t)(l * 16 + blk) * 4096;
            transpose_tile(src, 64, 64, 0, 0, WGT + (size_t)((l * 2 + gate) * 16 + blk) * 4096, 64, nullptr, 1.0f, T);
        } else {
            const int j = job - JA - JB - JC; const int tidp = otid(); const int wid = tidp >> 6, lane = tidp & 63;
            const int row = j * 8 + wid;
            const float* src = row < MP ? p.xp + (size_t)row * DM : (row < MV ? p.xs + (size_t)(row - MP) * DM : nullptr);
            f32x4 v[4]; float ss = 0.f;
#pragma unroll
            for (int i = 0; i < 4; ++i) { v[i] = src ? *(const f32x4*)(src + lane * 16 + i * 4) : zero4(); ss += (v[i][0] * v[i][0] + v[i][1] * v[i][1]) + (v[i][2] * v[i][2] + v[i][3] * v[i][3]); }
#pragma unroll
            for (int o = 32; o >= 1; o >>= 1) ss += __shfl_xor(ss, o);
            u32x4 w0, w1;
            w0.x = cvt_pk_bf16(v[0][0], v[0][1]); w0.y = cvt_pk_bf16(v[0][2], v[0][3]); w0.z = cvt_pk_bf16(v[1][0], v[1][1]); w0.w = cvt_pk_bf16(v[1][2], v[1][3]);
            w1.x = cvt_pk_bf16(v[2][0], v[2][1]); w1.y = cvt_pk_bf16(v[2][2], v[2][3]); w1.z = cvt_pk_bf16(v[3][0], v[3][1]); w1.w = cvt_pk_bf16(v[3][2], v[3][3]);
            *(u32x4*)(XB + (size_t)row * DM + lane * 16) = w0; *(u32x4*)(XB + (size_t)row * DM + lane * 16 + 8) = w1;
            if (lane < 16) SS[(size_t)row * 16 + lane] = lane == 0 ? ss : 0.f;
            if (row >= MV) { const u32x4 z = (u32x4){0u, 0u, 0u, 0u}; u32x4* mp = (u32x4*)(MG + (size_t)row * DMG + lane * 32); mp[0] = z; mp[1] = z; mp[2] = z; mp[3] = z; }
        }
    }
}

constexpr int M_QI = 0, M_KI = 38912, M_VI = 77824, M_CTI = 96256, M_SM = 130048;
constexpr int RS_QK = 304, RS_V = 144, RS_CT = 528;

template <int OFF0, int OFF1>
__device__ __forceinline__ bf16x8 tr_frag(unsigned base) {
    bf16x4 lo, hi;
    asm volatile("ds_read_b64_tr_b16 %0, %2 offset:%3\n\tds_read_b64_tr_b16 %1, %2 offset:%4\n\ts_waitcnt lgkmcnt(0)" : "=&v"(lo), "=&v"(hi) : "v"(base), "i"(OFF0), "i"(OFF1) : "memory");
    bf16x8 r; r[0] = lo[0]; r[1] = lo[1]; r[2] = lo[2]; r[3] = lo[3]; r[4] = hi[0]; r[5] = hi[1]; r[6] = hi[2]; r[7] = hi[3]; return r;
}

template <int O0, int O1, int HI>
__device__ __forceinline__ void tr_frag2(unsigned base, bf16x8& f0, bf16x8& f1) {
    bf16x4 a0, a1, b0, b1;
    asm volatile("ds_read_b64_tr_b16 %0, %4 offset:%5\n\tds_read_b64_tr_b16 %1, %4 offset:%6\n\tds_read_b64_tr_b16 %2, %4 offset:%7\n\tds_read_b64_tr_b16 %3, %4 offset:%8\n\ts_waitcnt lgkmcnt(0)"
                 : "=&v"(a0), "=&v"(a1), "=&v"(b0), "=&v"(b1) : "v"(base), "i"(O0), "i"(O0 + HI), "i"(O1), "i"(O1 + HI) : "memory");
    f0 = __builtin_shufflevector(a0, a1, 0, 1, 2, 3, 4, 5, 6, 7); f1 = __builtin_shufflevector(b0, b1, 0, 1, 2, 3, 4, 5, 6, 7);
}
template <int KS>
__device__ __forceinline__ void mlstm_D(f32x4 (&CT)[8], unsigned bvD, unsigned bkD) {
    const bf16x8 vdf = tr_frag<KS * 32 * RS_V, KS * 32 * RS_V + 4 * RS_V>(bvD);
    bf16x8 k0, k1;
    tr_frag2<KS * 32 * RS_QK + 0, KS * 32 * RS_QK + 32, 4 * RS_QK>(bkD, k0, k1);
    CT[0] = __builtin_amdgcn_mfma_f32_16x16x32_bf16(k0, vdf, CT[0], 0, 0, 0);
    CT[1] = __builtin_amdgcn_mfma_f32_16x16x32_bf16(k1, vdf, CT[1], 0, 0, 0);
    tr_frag2<KS * 32 * RS_QK + 64, KS * 32 * RS_QK + 96, 4 * RS_QK>(bkD, k0, k1);
    CT[2] = __builtin_amdgcn_mfma_f32_16x16x32_bf16(k0, vdf, CT[2], 0, 0, 0);
    CT[3] = __builtin_amdgcn_mfma_f32_16x16x32_bf16(k1, vdf, CT[3], 0, 0, 0);
    tr_frag2<KS * 32 * RS_QK + 128, KS * 32 * RS_QK + 160, 4 * RS_QK>(bkD, k0, k1);
    CT[4] = __builtin_amdgcn_mfma_f32_16x16x32_bf16(k0, vdf, CT[4], 0, 0, 0);
    CT[5] = __builtin_amdgcn_mfma_f32_16x16x32_bf16(k1, vdf, CT[5], 0, 0, 0);
    tr_frag2<KS * 32 * RS_QK + 192, KS * 32 * RS_QK + 224, 4 * RS_QK>(bkD, k0, k1);
    CT[6] = __builtin_amdgcn_mfma_f32_16x16x32_bf16(k0, vdf, CT[6], 0, 0, 0);
    CT[7] = __builtin_amdgcn_mfma_f32_16x16x32_bf16(k1, vdf, CT[7], 0, 0, 0);
}
template <int O, int STEP, int HI>
__device__ __forceinline__ void tr_frag4(unsigned base, bf16x8& f0, bf16x8& f1, bf16x8& f2, bf16x8& f3) {
    bf16x4 a0, a1, b0, b1, c0, c1, d0, d1;
    asm volatile("ds_read_b64_tr_b16 %0, %8 offset:%9\n\tds_read_b64_tr_b16 %1, %8 offset:%10\n\tds_read_b64_tr_b16 %2, %8 offset:%11\n\tds_read_b64_tr_b16 %3, %8 offset:%12\n\t"
                 "ds_read_b64_tr_b16 %4, %8 offset:%13\n\tds_read_b64_tr_b16 %5, %8 offset:%14\n\tds_read_b64_tr_b16 %6, %8 offset:%15\n\tds_read_b64_tr_b16 %7, %8 offset:%16\n\ts_waitcnt lgkmcnt(0)"
                 : "=&v"(a0), "=&v"(a1), "=&v"(b0), "=&v"(b1), "=&v"(c0), "=&v"(c1), "=&v"(d0), "=&v"(d1)
                 : "v"(base), "i"(O), "i"(O + HI), "i"(O + STEP), "i"(O + STEP + HI), "i"(O + 2 * STEP), "i"(O + 2 * STEP + HI), "i"(O + 3 * STEP), "i"(O + 3 * STEP + HI) : "memory");
    f0 = __builtin_shufflevector(a0, a1, 0, 1, 2, 3, 4, 5, 6, 7); f1 = __builtin_shufflevector(b0, b1, 0, 1, 2, 3, 4, 5, 6, 7);
    f2 = __builtin_shufflevector(c0, c1, 0, 1, 2, 3, 4, 5, 6, 7); f3 = __builtin_shufflevector(d0, d1, 0, 1, 2, 3, 4, 5, 6, 7);
}
template <int KS>
__device__ __forceinline__ void mlstm_B(f32x4 (&N1)[4], LAS unsigned char* lds, unsigned bvB, int t, int fq) {
    const bf16x8 pf = *(const LAS bf16x8*)(lds + M_QI + t * RS_QK + KS * 64 + fq * 16);
    bf16x8 v0, v1, v2, v3;
    tr_frag4<KS * 32 * RS_V, 32, 4 * RS_V>(bvB, v0, v1, v2, v3);
    N1[0] = __builtin_amdgcn_mfma_f32_16x16x32_bf16(v0, pf, N1[0], 0, 0, 0);
    N1[1] = __builtin_amdgcn_mfma_f32_16x16x32_bf16(v1, pf, N1[1], 0, 0, 0);
    N1[2] = __builtin_amdgcn_mfma_f32_16x16x32_bf16(v2, pf, N1[2], 0, 0, 0);
    N1[3] = __builtin_amdgcn_mfma_f32_16x16x32_bf16(v3, pf, N1[3], 0, 0, 0);
}

__device__ void mlstm_prompt(const Params& p, int l, int item, LAS unsigned char* lds) {
    const int tid0 = otid();
    const int js = item & 3, h = (item >> 2) & 3, b = item >> 4;
    const unsigned ldsb = (unsigned)(size_t)lds;
    LAS float* sm = (LAS float*)(lds + M_SM);
    LAS float* nbuf = sm + 512; LAS float* npart = sm + 1552;
    const bf16_t* U = (const bf16_t*)(p.ws + WS_U); const float* G = (const float*)(p.ws + WS_G);
    bf16_t* MG = (bf16_t*)(p.ws + WS_MG);
    const size_t grow_base = (size_t)b * 2048;
    const int qcol = 2048 + h * 256, kcol = 3072 + h * 256, vcol = 4096 + h * 256 + js * 64;

    __syncthreads();
    for (int i = tid0; i < RS_CT * 64 / 16; i += NT) *(LAS u32x4*)(lds + M_CTI + i * 16) = (u32x4){0u, 0u, 0u, 0u};
    nbuf[tid0] = 0.f;
    f32x4 CTacc[8];
#pragma unroll
    for (int i = 0; i < 8; ++i) CTacc[i] = zero4();
    float m_prev = 0.f;
    u32x4 qreg[4], kreg[4], vreg[2]; float igr[2] = {0.f, 0.f}, lfr[2] = {0.f, 0.f};

#define ML_LOAD_QK(row0_, hd_) do { _Pragma("unroll") for (int i_ = 0; i_ < 4; ++i_) { const int id_ = tid + NT * i_, r_ = id_ >> 4, cq_ = id_ & 15; \
        const bf16_t* rp_ = U + (grow_base + (row0_) + r_) * NU + (hd_) * 128 + cq_ * 8; qreg[i_] = *(const u32x4*)(rp_ + qcol); kreg[i_] = *(const u32x4*)(rp_ + kcol); } } while (0)
#define ML_STORE_QK() do { _Pragma("unroll") for (int i_ = 0; i_ < 4; ++i_) { const int id_ = tid + NT * i_, r_ = id_ >> 4, cq_ = id_ & 15; \
        *(LAS u32x4*)(lds + M_QI + r_ * RS_QK + cq_ * 16) = qreg[i_]; *(LAS u32x4*)(lds + M_KI + r_ * RS_QK + cq_ * 16) = kreg[i_]; } } while (0)
#define ML_LOAD_VG(row0_) do { _Pragma("unroll") for (int i_ = 0; i_ < 2; ++i_) { const int id_ = tid + NT * i_, s_ = id_ >> 3, cq_ = id_ & 7; \
        vreg[i_] = *(const u32x4*)(U + (grow_base + (row0_) + s_) * NU + vcol + cq_ * 8); } \
        if (w == 0) { const float* gp_ = G + (grow_base + (row0_) + 2 * lane) * 8 + h; igr[0] = gp_[0]; lfr[0] = gp_[4]; igr[1] = gp_[8]; lfr[1] = gp_[12]; } } while (0)

#define ML_PREPASS(buf_) do { if (w == 0) { LAS float* dec_ = sm + 128 * (buf_); LAS float* expnm_ = sm + 256 + 128 * (buf_); LAS float* scal_ = sm + 1024 + 8 * (buf_); \
            const float s2 = lfr[0] + lfr[1]; float incl = s2; \
            _Pragma("unroll") for (int o = 1; o < 64; o <<= 1) { const float t_ = __shfl_up(incl, o); if (lane >= o) incl += t_; } \
            const float b0 = incl - s2 + lfr[0], b1 = incl; \
            const float a0 = igr[0] - b0, a1 = igr[1] - b1; float im = fmaxf(a0, a1); \
            _Pragma("unroll") for (int o = 1; o < 64; o <<= 1) { const float t_ = __shfl_up(im, o); if (lane >= o) im = fmaxf(im, t_); } \
            float ex = __shfl_up(im, 1); if (lane == 0) ex = -INFINITY; \
            const float M0 = fmaxf(ex, a0), M1 = fmaxf(M0, a1); \
            const float mt1 = b1 + fmaxf(m_prev, M1); \
            const float bL = __shfl(b1, 63), mL = __shfl(mt1, 63); \
            expnm_[2 * lane] = __expf(bL - mL - b0); expnm_[2 * lane + 1] = __expf(bL - mL - b1); \
            dec_[2 * lane] = __expf(bL - b0 + igr[0] - mL); dec_[2 * lane + 1] = __expf(bL - b1 + igr[1] - mL); \
            if (lane == 0) { scal_[0] = __expf(bL + m_prev - mL); scal_[1] = mL; } \
            m_prev = mL; } } while (0)
    { const int tid = tid0, w = tid >> 6, lane = tid & 63; ML_LOAD_QK(0, 0); ML_LOAD_VG(0); ML_PREPASS(0); }
#pragma unroll 1
    for (int c = 0; c < 16; ++c) {
        int tid = tid0; asm volatile("" : "+v"(tid));
        const int w = __builtin_amdgcn_readfirstlane(tid >> 6), lane = tid & 63, fr = lane & 15, fq = lane >> 4;
        const int cD = w & 3, gD = w >> 2, qq = (lane & 15) >> 2, pp = lane & 3;
        const unsigned bvB = ldsb + M_VI + (8 * fq + qq) * RS_V + 8 * pp;
        const unsigned bvD = bvB + cD * 32;
        const int row0 = c * 128;
        LAS float* nC = nbuf + (c & 1) * 256; LAS float* nN = nbuf + ((c + 1) & 1) * 256;
        __syncthreads();
        ML_STORE_QK();
        LAS float* dec = sm + 128 * (c & 1); LAS float* expnm = sm + 256 + 128 * (c & 1); LAS float* scal = sm + 1024 + 8 * (c & 1);
        const float cs = scal[0];
#pragma unroll
        for (int i = 0; i < 2; ++i) {
            const int id = tid + NT * i, s = id >> 3, cq = id & 7; const float d = dec[s];
            u32x4 v = vreg[i], o;
            o.x = cvt_pk_bf16(lo16(v.x) * d, hi16(v.x) * d); o.y = cvt_pk_bf16(lo16(v.y) * d, hi16(v.y) * d);
            o.z = cvt_pk_bf16(lo16(v.z) * d, hi16(v.z) * d); o.w = cvt_pk_bf16(lo16(v.w) * d, hi16(v.w) * d);
            *(LAS u32x4*)(lds + M_VI + s * RS_V + cq * 16) = o;
        }
        if (tid < 256) nN[tid] = cs * nC[tid];
        ML_LOAD_QK(row0, 1);
        f32x4 Sacc[8], N2[4];
#pragma unroll
        for (int i = 0; i < 8; ++i) Sacc[i] = zero4();
#pragma unroll
        for (int i = 0; i < 4; ++i) N2[i] = zero4();
        float qnp = 0.f;
#pragma unroll 1
        for (int hd = 0; hd < 2; ++hd) {
            __syncthreads();
#pragma unroll
            for (int ks = 0; ks < 4; ++ks) {
                const bf16x8 qf = *(const LAS bf16x8*)(lds + M_QI + (16 * w + fr) * RS_QK + ks * 64 + fq * 16);
#pragma unroll
                for (int g = 0; g < 2; ++g) if (4 * g <= w) {
                    bf16x8 kf[4];
#pragma unroll
                    for (int e = 0; e < 4; ++e) kf[e] = *(const LAS bf16x8*)(lds + M_KI + (64 * g + 16 * e + fr) * RS_QK + ks * 64 + fq * 16);
#pragma unroll
                    for (int e = 0; e < 4; ++e) Sacc[4 * g + e] = __builtin_amdgcn_mfma_f32_16x16x32_bf16(kf[e], qf, Sacc[4 * g + e], 0, 0, 0);
                }
#pragma unroll
                for (int c4 = 0; c4 < 4; ++c4) {
                    const bf16x8 ctf = *(const LAS bf16x8*)(lds + M_CTI + (16 * c4 + fr) * RS_CT + hd * 256 + ks * 64 + fq * 16);
                    N2[c4] = __builtin_amdgcn_mfma_f32_16x16x32_bf16(ctf, qf, N2[c4], 0, 0, 0);
                }
                const LAS float* np = nC + hd * 128 + ks * 32 + fq * 8;
#pragma unroll
                for (int j = 0; j < 8; ++j) qnp += bf2f((unsigned short)qf[j]) * np[j];
                __builtin_amdgcn_sched_barrier(0);
            }
            if (gD == hd) {
                const unsigned bkD = ldsb + M_KI + (8 * fq + qq) * RS_QK + 8 * pp;
#pragma unroll
                for (int i = 0; i < 8; ++i) CTacc[i] *= cs;
                mlstm_D<0>(CTacc, bvD, bkD); __builtin_amdgcn_sched_barrier(0); mlstm_D<1>(CTacc, bvD, bkD); __builtin_amdgcn_sched_barrier(0); mlstm_D<2>(CTacc, bvD, bkD); __builtin_amdgcn_sched_barrier(0); mlstm_D<3>(CTacc, bvD, bkD); __builtin_amdgcn_sched_barrier(0);
            }
            if (gD != hd) {
                const int lidx = (w & 3) * 64 + lane, dk4 = lidx & 31, part = lidx >> 5; float a0 = 0.f, a1 = 0.f, a2 = 0.f, a3 = 0.f;
#pragma unroll 2
                for (int s = 16 * part; s < 16 * part + 16; ++s) {
                    const u32x2 kv = *(const LAS u32x2*)(lds + M_KI + s * RS_QK + dk4 * 8); const float d = dec[s];
                    a0 += d * lo16(kv.x); a1 += d * hi16(kv.x); a2 += d * lo16(kv.y); a3 += d * hi16(kv.y);
                }
                *(LAS f32x4*)(npart + part * 128 + 4 * dk4) = (f32x4){a0, a1, a2, a3};
            }
            __syncthreads();
            if (tid < 128) nN[hd * 128 + tid] += ((npart[tid] + npart[128 + tid]) + (npart[256 + tid] + npart[384 + tid])) + ((npart[512 + tid] + npart[640 + tid]) + (npart[768 + tid] + npart[896 + tid]));
            if (gD == hd) {
#pragma unroll
                for (int i = 0; i < 8; ++i) {
                    u32x2 wv; wv.x = cvt_pk_bf16(CTacc[i][0], CTacc[i][1]); wv.y = cvt_pk_bf16(CTacc[i][2], CTacc[i][3]);
                    *(LAS u32x2*)(lds + M_CTI + (16 * cD + fr) * RS_CT + (hd * 128 + 16 * i + 4 * fq) * 2) = wv;
                }
            }
            if (hd == 0) {
                ML_STORE_QK();
                if (c < 15) { ML_LOAD_QK(row0 + 128, 0); }
            }
        }
        if (c < 15) { ML_LOAD_VG(row0 + 128); }
        const int t = 16 * w + fr;
        float den1 = 0.f;
#pragma unroll
        for (int g = 0; g < 4; ++g) if (2 * g <= w) {
            const f32x4 dv0 = *(const LAS f32x4*)(dec + 32 * g + 4 * fq), dv1 = *(const LAS f32x4*)(dec + 32 * g + 16 + 4 * fq);
            f32x4 s0 = Sacc[2 * g], s1 = Sacc[2 * g + 1];
#pragma unroll
            for (int j = 0; j < 4; ++j) {
                const int sa = 32 * g + 4 * fq + j, sb = sa + 16;
                if (sa > t) s0[j] = 0.f;
                if (sb > t || 2 * g + 1 > w) s1[j] = 0.f;
                den1 += s0[j] * dv0[j] + s1[j] * dv1[j];
            }
            u32x2 w0, w1; w0.x = cvt_pk_bf16(s0[0], s0[1]); w0.y = cvt_pk_bf16(s0[2], s0[3]); w1.x = cvt_pk_bf16(s1[0], s1[1]); w1.y = cvt_pk_bf16(s1[2], s1[3]);
            *(LAS u32x2*)(lds + M_QI + t * RS_QK + (32 * g + 4 * fq) * 2) = w0;
            *(LAS u32x2*)(lds + M_QI + t * RS_QK + (32 * g + 16 + 4 * fq) * 2) = w1;
        }
        den1 += __shfl_xor(den1, 16); den1 += __shfl_xor(den1, 32);
        qnp += __shfl_xor(qnp, 16); qnp += __shfl_xor(qnp, 32);
#pragma unroll
        for (int i = 0; i < 4; ++i) N2[i] *= cs;
        if (0 <= (w >> 1)) mlstm_B<0>(N2, lds, bvB, t, fq);
        if (1 <= (w >> 1)) mlstm_B<1>(N2, lds, bvB, t, fq);
        if (2 <= (w >> 1)) mlstm_B<2>(N2, lds, bvB, t, fq);
        if (3 <= (w >> 1)) mlstm_B<3>(N2, lds, bvB, t, fq);
        {
            const float den = den1 + cs * qnp;
            const float inv = 1.0f / fmaxf(fabsf(den), expnm[t]);
            const size_t grow = grow_base + row0 + t;
#pragma unroll
            for (int c4 = 0; c4 < 4; ++c4) {
                const float y0 = N2[c4][0] * inv, y1 = N2[c4][1] * inv, y2 = N2[c4][2] * inv, y3 = N2[c4][3] * inv;
                u32x2 wv; wv.x = cvt_pk_bf16(y0, y1); wv.y = cvt_pk_bf16(y2, y3);
                *(u32x2*)(MG + grow * DMG + 1024 + h * 256 + js * 64 + 16 * c4 + 4 * fq) = wv;
            }
        }
        if (c < 15) ML_PREPASS((c + 1) & 1);
    }
    __syncthreads();
    {
        const int tid = tid0, w = tid >> 6, lane = tid & 63, fr = lane & 15, fq = lane >> 4, cD = w & 3, gD = w >> 2;
        float* pC = p.out + O_PC + ((size_t)((l * 8 + b) * 4 + h)) * 65536;
#pragma unroll
        for (int i = 0; i < 8; ++i)
#pragma unroll
            for (int j = 0; j < 4; ++j) pC[(size_t)(gD * 128 + 16 * i + 4 * fq + j) * 256 + js * 64 + 16 * cD + fr] = CTacc[i][j];
        if (js == 0) {
            if (tid < 256) p.out[O_PN + ((size_t)((l * 8 + b) * 4 + h)) * 256 + tid] = nbuf[tid];
            if (tid == 0) p.out[O_PM + (l * 8 + b) * 4 + h] = sm[1024 + 8 + 1];
        }
    }
    __syncthreads();
#undef ML_LOAD_QK
#undef ML_STORE_QK
#undef ML_LOAD_VG
#undef ML_PREPASS
}

constexpr int R_XAI = 0, R_XCF = 16768, R_XCB = 49536, R_AA = 67968, R_UU = 100736, R_PT = 133504, R_HC = 137600, R_CW = 138112, R_CH = 139392, R_WG = 140160;
__device__ void rglru_item(const Params& p, int l, int b, int cb, bool decm, LAS unsigned char* lds) {
    const int tid = otid(), w = __builtin_amdgcn_readfirstlane(tid >> 6), lane = tid & 63, fr = lane & 15, fq = lane >> 4;
    const bf16_t* U = (const bf16_t*)(p.ws + WS_U); bf16_t* MG = (bf16_t*)(p.ws + WS_MG);
    const bf16_t* WGT = (const bf16_t*)(p.ws + WS_WGT);
    LAS float* XCF = (LAS float*)(lds + R_XCF); LAS float* AA = (LAS float*)(lds + R_AA); LAS float* UU = (LAS float*)(lds + R_UU);
    LAS float* PT = (LAS float*)(lds + R_PT); LAS float* HC = (LAS float*)(lds + R_HC); LAS float* CW = (LAS float*)(lds + R_CW); LAS float* CH = (LAS float*)(lds + R_CH);
    const int ch0 = cb * 64;
    const size_t grow_base = decm ? (size_t)MP : (size_t)b * 2048;
    const int nchunk = decm ? 1 : 16;
    __syncthreads();
    if (tid < 64) {
        const int ch = ch0 + tid;
#pragma unroll
        for (int j = 0; j < 4; ++j) CW[j * 64 + tid] = p.conv_w[(size_t)(l * 4 + j) * 1024 + ch];
        CW[256 + tid] = p.conv_b[l * 1024 + ch];
        CH[tid] = p.b_r[l * 1024 + ch]; CH[64 + tid] = p.b_i[l * 1024 + ch]; CH[128 + tid] = 8.0f * softplusf_(-p.lam[l * 1024 + ch]);
        HC[tid] = 0.f; HC[64 + tid] = 0.f;
    }
    if (tid < 24) *(LAS u32x4*)(lds + R_XAI + tid * 16) = (u32x4){0u, 0u, 0u, 0u};
#pragma unroll
    for (int i = 0; i < 2; ++i) {
        const int id = tid + NT * i, g = id >> 9, r = (id >> 3) & 63, cq = id & 7;
        *(LAS u32x4*)(lds + R_WG + (g * 64 + r) * 144 + cq * 16) = *(const u32x4*)(WGT + (size_t)((l * 2 + g) * 16 + cb) * 4096 + r * 64 + cq * 8);
    }
    u32x4 xreg[2], zreg[2];
#pragma unroll
    for (int i = 0; i < 2; ++i) { const int id = tid + NT * i, r = id >> 3, cq = id & 7; const bf16_t* rp = U + (grow_base + r) * NU + ch0 + cq * 8; xreg[i] = *(const u32x4*)rp; zreg[i] = *(const u32x4*)(rp + 1024); }
    for (int c = 0; c < nchunk; ++c) {
        const int row0 = c * 128;
        __syncthreads();
        if (c > 0) {
#pragma unroll
            for (int i = 0; i < 2; ++i) { const int id = tid + NT * i, r = id >> 3, cq = id & 7; *(u32x4*)(MG + (grow_base + row0 - 128 + r) * DMG + ch0 + cq * 8) = *(const LAS u32x4*)(lds + R_XCF + r * 128 + cq * 16); }
        }
        u32x4 zcur[2];
#pragma unroll
        for (int i = 0; i < 2; ++i) { const int id = tid + NT * i, r = id >> 3, cq = id & 7; *(LAS u32x4*)(lds + R_XAI + (3 + r) * 128 + cq * 16) = xreg[i]; zcur[i] = zreg[i]; }
        if (c + 1 < nchunk) {
#pragma unroll
            for (int i = 0; i < 2; ++i) { const int id = tid + NT * i, r = id >> 3, cq = id & 7; const bf16_t* rp = U + (grow_base + row0 + 128 + r) * NU + ch0 + cq * 8; xreg[i] = *(const u32x4*)rp; zreg[i] = *(const u32x4*)(rp + 1024); }
        }
        __syncthreads();
        {
            const int t = tid >> 2, c0 = (tid & 3) * 16;
            float xc[16];
#pragma unroll
            for (int k = 0; k < 16; ++k) xc[k] = CW[256 + c0 + k];
            if (!decm) {
#pragma unroll
                for (int j = 0; j < 4; ++j) {
                    const u32x4 a = *(const LAS u32x4*)(lds + R_XAI + (t + j) * 128 + c0 * 2), bq = *(const LAS u32x4*)(lds + R_XAI + (t + j) * 128 + c0 * 2 + 16);
                    const unsigned wv[8] = {a.x, a.y, a.z, a.w, bq.x, bq.y, bq.z, bq.w};
#pragma unroll
                    for (int k = 0; k < 8; ++k) { xc[2 * k] += CW[j * 64 + c0 + 2 * k] * lo16(wv[k]); xc[2 * k + 1] += CW[j * 64 + c0 + 2 * k + 1] * hi16(wv[k]); }
                }
            } else {
                const float* stp = p.st_conv + ((size_t)(l * 128 + t) * 3) * 1024 + ch0 + c0;
                float* so = p.out + O_SCONV + ((size_t)(l * 128 + t) * 3) * 1024 + ch0 + c0;
#pragma unroll
                for (int j = 0; j < 3; ++j)
#pragma unroll
                    for (int k4 = 0; k4 < 4; ++k4) {
                        const f32x4 sv = *(const f32x4*)(stp + (size_t)j * 1024 + k4 * 4);
#pragma unroll
                        for (int e = 0; e < 4; ++e) xc[k4 * 4 + e] += CW[j * 64 + c0 + k4 * 4 + e] * sv[e];
                        if (j >= 1) *(f32x4*)(so + (size_t)(j - 1) * 1024 + k4 * 4) = sv;
                    }
                const u32x4 a = *(const LAS u32x4*)(lds + R_XAI + (t + 3) * 128 + c0 * 2), bq = *(const LAS u32x4*)(lds + R_XAI + (t + 3) * 128 + c0 * 2 + 16);
                const unsigned wv[8] = {a.x, a.y, a.z, a.w, bq.x, bq.y, bq.z, bq.w};
#pragma unroll
                for (int k = 0; k < 8; ++k) {
                    const float x0 = lo16(wv[k]), x1 = hi16(wv[k]);
                    xc[2 * k] += CW[3 * 64 + c0 + 2 * k] * x0; xc[2 * k + 1] += CW[3 * 64 + c0 + 2 * k + 1] * x1;
                    so[2 * 1024 + 2 * k] = x0; so[2 * 1024 + 2 * k + 1] = x1;
                }
            }
#pragma unroll
            for (int k4 = 0; k4 < 4; ++k4) *(LAS f32x4*)(XCF + t * 64 + c0 + k4 * 4) = (f32x4){xc[k4 * 4], xc[k4 * 4 + 1], xc[k4 * 4 + 2], xc[k4 * 4 + 3]};
            u32x4 o0, o1;
            o0.x = cvt_pk_bf16(xc[0], xc[1]); o0.y = cvt_pk_bf16(xc[2], xc[3]); o0.z = cvt_pk_bf16(xc[4], xc[5]); o0.w = cvt_pk_bf16(xc[6], xc[7]);
            o1.x = cvt_pk_bf16(xc[8], xc[9]); o1.y = cvt_pk_bf16(xc[10], xc[11]); o1.z = cvt_pk_bf16(xc[12], xc[13]); o1.w = cvt_pk_bf16(xc[14], xc[15]);
            *(LAS u32x4*)(lds + R_XCB + t * 144 + c0 * 2) = o0; *(LAS u32x4*)(lds + R_XCB + t * 144 + c0 * 2 + 16) = o1;
        }
        __syncthreads();
        if (!decm && tid < 24) { const u32x4 v = *(const LAS u32x4*)(lds + R_XAI + 128 * 128 + tid * 16); *(LAS u32x4*)(lds + R_XAI + tid * 16) = v; }
        {
            bf16x8 xf[2];
#pragma unroll
            for (int ks = 0; ks < 2; ++ks) xf[ks] = *(const LAS bf16x8*)(lds + R_XCB + (16 * w + fr) * 144 + ks * 64 + fq * 16);
            const int t = 16 * w + fr;
#pragma unroll
            for (int c4 = 0; c4 < 4; ++c4) {
                f32x4 ar = zero4(), ai = ar;
#pragma unroll
                for (int ks = 0; ks < 2; ++ks) {
                    const bf16x8 wfr = *(const LAS bf16x8*)(lds + R_WG + (16 * c4 + fr) * 144 + ks * 64 + fq * 16);
                    const bf16x8 wfi = *(const LAS bf16x8*)(lds + R_WG + (64 + 16 * c4 + fr) * 144 + ks * 64 + fq * 16);
                    ar = __builtin_amdgcn_mfma_f32_16x16x32_bf16(wfr, xf[ks], ar, 0, 0, 0); ai = __builtin_amdgcn_mfma_f32_16x16x32_bf16(wfi, xf[ks], ai, 0, 0, 0); }
                const int d = 16 * c4 + 4 * fq;
                const f32x4 xcv = *(const LAS f32x4*)(XCF + t * 64 + d);
                f32x4 av, uv;
#pragma unroll
                for (int j = 0; j < 4; ++j) {
                    const float r = sigmoidf_(ar[j] + CH[d + j]), ig = sigmoidf_(ai[j] + CH[64 + d + j]);
                    const float la = -r * CH[128 + d + j];
                    const float x2 = 2.0f * la;
                    const float ser = -x2 * (1.0f + x2 * (0.5f + x2 * (0.16666667f + x2 * (0.041666668f + x2 * (0.0083333338f + x2 * 0.0013888889f)))));
                    const float om = x2 > -0.3f ? ser : 1.0f - __expf(x2);
                    av[j] = __expf(la); uv[j] = __builtin_amdgcn_sqrtf(om) * (ig * xcv[j]);
                }
                if (!decm) { *(LAS f32x4*)(AA + t * 64 + d) = av; *(LAS f32x4*)(UU + t * 64 + d) = uv; }
                else {
                    const f32x4 h0 = *(const f32x4*)(p.st_h + (size_t)(l * 128 + t) * 1024 + ch0 + d);
                    const f32x4 hn = av * h0 + uv;
                    *(f32x4*)(p.out + O_SH + (size_t)(l * 128 + t) * 1024 + ch0 + d) = hn;
                    const u32x2 zv = *(const u32x2*)(U + (grow_base + t) * NU + 1024 + ch0 + d);
                    u32x2 wv; wv.x = cvt_pk_bf16(hn[0] * lo16(zv.x), hn[1] * hi16(zv.x)); wv.y = cvt_pk_bf16(hn[2] * lo16(zv.y), hn[3] * hi16(zv.y));
                    *(u32x2*)(MG + (grow_base + t) * DMG + ch0 + d) = wv;
                }
            }
        }
        if (decm) break;
        __syncthreads();
#pragma unroll
        for (int i = 0; i < 2; ++i) { const int id = tid + NT * i, r = id >> 3, cq = id & 7; *(LAS u32x4*)(lds + R_XCB + r * 144 + cq * 16) = zcur[i]; }
        const int ch = tid & 63, part = tid >> 6;
        float av[16], uv[16];
#pragma unroll
        for (int k = 0; k < 16; ++k) { av[k] = AA[(part * 16 + k) * 64 + ch]; uv[k] = UU[(part * 16 + k) * 64 + ch]; }
        {
            float hh = 0.f, Ac = 1.f;
#pragma unroll
            for (int k = 0; k < 16; ++k) { hh = av[k] * hh + uv[k]; Ac *= av[k]; uv[k] = hh; av[k] = Ac; }
            PT[(part * 64 + ch) * 2] = Ac; PT[(part * 64 + ch) * 2 + 1] = hh;
        }
        __syncthreads();
        {
            float zv[16];
#pragma unroll
            for (int k = 0; k < 16; ++k) zv[k] = bf2f(*(const LAS unsigned short*)(lds + R_XCB + (part * 16 + k) * 144 + ch * 2));
            float hin = HC[(c & 1) * 64 + ch];
            for (int q = 0; q < part; ++q) hin = PT[(q * 64 + ch) * 2] * hin + PT[(q * 64 + ch) * 2 + 1];
            float hf = hin;
#pragma unroll
            for (int k = 0; k < 16; ++k) {
                hf = av[k] * hin + uv[k];
                const float y = hf * zv[k];
                *(LAS unsigned short*)(lds + R_XCF + (part * 16 + k) * 128 + ch * 2) = (unsigned short)(cvt_pk_bf16(y, y) & 0xffffu);
            }
            if (part == 7) {
                HC[((c + 1) & 1) * 64 + ch] = hf;
                if (c == 15) p.out[O_PH + (size_t)(l * 8 + b) * 1024 + ch0 + ch] = hf;
            }
        }
        if (c == 15 && tid < 192) {
            const int j = tid >> 6, cc = tid & 63;
            p.out[O_PCONV + ((size_t)(l * 8 + b) * 3 + j) * 1024 + ch0 + cc] = bf2f(*(const LAS unsigned short*)(lds + R_XAI + j * 128 + cc * 2));
        }
    }
    __syncthreads();
    if (!decm) {
#pragma unroll
        for (int i = 0; i < 2; ++i) { const int id = tid + NT * i, r = id >> 3, cq = id & 7; *(u32x4*)(MG + (grow_base + 15 * 128 + r) * DMG + ch0 + cq * 8) = *(const LAS u32x4*)(lds + R_XCF + r * 128 + cq * 16); }
    }
    __syncthreads();
}

__device__ void mlstm_decode(const Params& p, int l, int b, int h, LAS unsigned char* lds) {
    const int tid = otid(), lane = tid & 63;
    const bf16_t* U = (const bf16_t*)(p.ws + WS_U); const float* G = (const float*)(p.ws + WS_G);
    bf16_t* MG = (bf16_t*)(p.ws + WS_MG);
    LAS float* qs = (LAS float*)lds; LAS float* ks = qs + 256; LAS float* vs = qs + 512; LAS float* ns = qs + 768; LAS float* red = qs + 1024; LAS float* red2 = qs + 1024 + 2048;
    const size_t row = (size_t)MP + b;
    const size_t sidx = (size_t)((l * 128 + b) * 4 + h);
    __syncthreads();
    if (tid < 256) {
        qs[tid] = bf2f(U[row * NU + 2048 + h * 256 + tid]); ks[tid] = bf2f(U[row * NU + 3072 + h * 256 + tid]); vs[tid] = bf2f(U[row * NU + 4096 + h * 256 + tid]);
        ns[tid] = p.st_n[sidx * 256 + tid];
    }
    const float ig = G[row * 8 + h], lf = G[row * 8 + 4 + h], m0 = p.st_m[sidx];
    __syncthreads();
    float qk = 0.f, qn = 0.f;
#pragma unroll
    for (int j = 0; j < 4; ++j) { const float qv = qs[lane * 4 + j]; qk += qv * ks[lane * 4 + j]; qn += qv * ns[lane * 4 + j]; }
#pragma unroll
    for (int o = 32; o >= 1; o >>= 1) { qk += __shfl_xor(qk, o); qn += __shfl_xor(qn, o); }
    const float mt = fmaxf(lf + m0, ig), wg = __expf(ig - mt), gi = __expf(lf + m0 - mt);
    const int dvq = tid & 63, dkg = tid >> 6;
    float o_pre = 0.f, zg_pre = 0.f;
    if (tid < 256) { o_pre = bf2f(U[row * NU + 5120 + h * 256 + tid]); zg_pre = p.g_mhead[l * 1024 + h * 256 + tid] * bf2f(U[row * NU + 6144 + h * 256 + tid]); }
    const float* C0 = p.st_C + sidx * 65536; float* C1 = p.out + O_SC + sidx * 65536;
    const f32x4 v4 = *(const LAS f32x4*)(vs + dvq * 4);
    f32x4 qc = zero4();
#pragma unroll 1
    for (int i0 = 0; i0 < 32; i0 += 16) {
        f32x4 cv[16];
#pragma unroll
        for (int j = 0; j < 16; ++j) cv[j] = __builtin_nontemporal_load((const f32x4*)(C0 + (size_t)(dkg * 32 + i0 + j) * 256 + dvq * 4));
#pragma unroll
        for (int j = 0; j < 16; ++j) {
            const int dk = dkg * 32 + i0 + j;
            const float qv = qs[dk], kv = wg * ks[dk];
            qc += qv * cv[j];
            const f32x4 cn = gi * cv[j] + kv * v4;
            __builtin_nontemporal_store(cn, (f32x4*)(C1 + (size_t)dk * 256 + dvq * 4));
        }
    }
    *(LAS f32x4*)(red + dkg * 256 + dvq * 4) = qc;
    __syncthreads();
    float yv = 0.f;
    if (tid < 256) {
        float qcv = 0.f;
#pragma unroll
        for (int g = 0; g < 8; ++g) qcv += red[g * 256 + tid];
        const float num = wg * qk * vs[tid] + gi * qcv, den = wg * qk + gi * qn;
        const float hh = num / fmaxf(fabsf(den), __expf(-mt));
        yv = hh * o_pre;
        float ss = yv * yv;
#pragma unroll
        for (int o = 32; o >= 1; o >>= 1) ss += __shfl_xor(ss, o);
        if (lane == 0) red2[tid >> 6] = ss;
        p.out[O_SN + sidx * 256 + tid] = gi * ns[tid] + wg * ks[tid];
    }
    __syncthreads();
    if (tid < 256) {
        const float rstd = rsqrtf(((red2[0] + red2[1]) + (red2[2] + red2[3])) * (1.0f / 256.0f) + EPSF);
        const float ov = yv * rstd * zg_pre;
        MG[row * DMG + 1024 + h * 256 + tid] = (bf16_t)(cvt_pk_bf16(ov, ov) & 0xffffu);
    }
    if (tid == 0) p.out[O_SM + sidx] = mt;
}

__device__ void decode_items(const Params& p, int l, LAS unsigned char* lds, int max_items) {
    unsigned* ctr = (unsigned*)(p.ws + WS_BAR) + 3584 + 64 * l;
    volatile LAS unsigned* slot = (volatile LAS unsigned*)(lds + LDS_BYTES - 32);
    for (int n = 0; n < max_items; ++n) {
        __syncthreads();
        if (threadIdx.x == 0) *slot = __hip_atomic_fetch_add(ctr, 1u, __ATOMIC_RELAXED, __HIP_MEMORY_SCOPE_AGENT);
        __syncthreads();
        const int item = (int)*slot;
        if (item >= 512) break;
        mlstm_decode(p, l, item >> 2, item & 3, lds);
    }
}

__device__ void phase_mixers(const Params& p, int l, LAS unsigned char* lds) {
    const int G = gridDim.x, bid = obid();
    const bool split = G >= 256;
    const int r = split ? bid - 128 : bid, R = split ? G - 128 : G;
    if (!split || bid < 128) { for (int item = bid; item < 128; item += (split ? 128 : G)) mlstm_prompt(p, l, item, lds); }
    if (r >= 0) {
        for (int item = r; item < 128; item += R) rglru_item(p, l, item >> 4, item & 15, false, lds);
        for (int item = r; item < 16; item += R) rglru_item(p, l, 0, item, true, lds);
    }
    decode_items(p, l, lds, 1 << 30);
}

__device__ void phase_headnorm(const Params& p, int l) {
    const bf16_t* U = (const bf16_t*)(p.ws + WS_U); bf16_t* MG = (bf16_t*)(p.ws + WS_MG);
    const float* gm = p.g_mhead + l * 1024;
    const int G = gridDim.x, bid = obid();
    const int b0 = G > 8 ? bid - 4 : bid, GG = G > 8 ? G - 4 : G;
    if (b0 < 0) return;
    for (size_t idx = (size_t)b0 * NT + otid(); idx < (size_t)MP * 128; idx += (size_t)GG * NT) {
        const size_t row = idx >> 7; const int col = (int)(idx & 127) * 8;
        const u32x4 hv = *(const u32x4*)(MG + row * DMG + 1024 + col);
        const u32x4 ov = *(const u32x4*)(U + row * NU + 5120 + col);
        const u32x4 zv = *(const u32x4*)(U + row * NU + 6144 + col);
        float y[8];
        y[0] = lo16(hv.x) * lo16(ov.x); y[1] = hi16(hv.x) * hi16(ov.x); y[2] = lo16(hv.y) * lo16(ov.y); y[3] = hi16(hv.y) * hi16(ov.y);
        y[4] = lo16(hv.z) * lo16(ov.z); y[5] = hi16(hv.z) * hi16(ov.z); y[6] = lo16(hv.w) * lo16(ov.w); y[7] = hi16(hv.w) * hi16(ov.w);
        float ss = ((y[0] * y[0] + y[1] * y[1]) + (y[2] * y[2] + y[3] * y[3])) + ((y[4] * y[4] + y[5] * y[5]) + (y[6] * y[6] + y[7] * y[7]));
#pragma unroll
        for (int o = 1; o < 32; o <<= 1) ss += __shfl_xor(ss, o);
        const float rstd = rsqrtf(ss * (1.0f / 256.0f) + EPSF);
        const f32x4 g0 = *(const f32x4*)(gm + col), g1 = *(const f32x4*)(gm + col + 4);
        u32x4 o;
        o.x = cvt_pk_bf16(y[0] * rstd * g0[0] * lo16(zv.x), y[1] * rstd * g0[1] * hi16(zv.x));
        o.y = cvt_pk_bf16(y[2] * rstd * g0[2] * lo16(zv.y), y[3] * rstd * g0[3] * hi16(zv.y));
        o.z = cvt_pk_bf16(y[4] * rstd * g1[0] * lo16(zv.z), y[5] * rstd * g1[1] * hi16(zv.z));
        o.w = cvt_pk_bf16(y[6] * rstd * g1[2] * lo16(zv.w), y[7] * rstd * g1[3] * hi16(zv.w));
        *(u32x4*)(MG + row * DMG + 1024 + col) = o;
    }
}

__device__ void phase_final(const Params& p) {
    const bf16_t* XB = (const bf16_t*)(p.ws + WS_XB); const float* SS = (const float*)(p.ws + WS_SS);
    const int tidf = otid(); const int wid = tidf >> 6, lane = tidf & 63;
    for (int row = blockIdx.x * 8 + wid; row < MV; row += gridDim.x * 8) {
        const f32x4* sp = (const f32x4*)(SS + (size_t)row * 16);
        const f32x4 s0 = sp[0], s1 = sp[1], s2 = sp[2], s3 = sp[3];
        const float ss = ((s0[0] + s0[1]) + (s0[2] + s0[3])) + ((s1[0] + s1[1]) + (s1[2] + s1[3])) + ((s2[0] + s2[1]) + (s2[2] + s2[3])) + ((s3[0] + s3[1]) + (s3[2] + s3[3]));
        const float rstd = rsqrtf(ss * (1.0f / 1024.0f) + EPSF);
        float* op = row < MP ? p.out + O_YP + (size_t)row * DM : p.out + O_YS + (size_t)(row - MP) * DM;
#pragma unroll
        for (int i = 0; i < 2; ++i) {
            const int c = i * 512 + lane * 8;
            const u32x4 xv = *(const u32x4*)(XB + (size_t)row * DM + c);
            const f32x4 g0 = *(const f32x4*)(p.g_final + c), g1 = *(const f32x4*)(p.g_final + c + 4);
            *(f32x4*)(op + c) = (f32x4){lo16(xv.x) * rstd * g0[0], hi16(xv.x) * rstd * g0[1], lo16(xv.y) * rstd * g0[2], hi16(xv.y) * rstd * g0[3]};
            *(f32x4*)(op + c + 4) = (f32x4){lo16(xv.z) * rstd * g1[0], hi16(xv.z) * rstd * g1[1], lo16(xv.w) * rstd * g1[2], hi16(xv.w) * rstd * g1[3]};
        }
    }
}

#define XB_XCNT(j) (64 * (j))
#define XB_XSUB(j) (1024 + 64 * (j))
#define XB_XGEN(j) (2048 + 64 * (j))
#define XB_TOP 3072
#define XB_TOPGEN 3136
__device__ __forceinline__ unsigned xb_ld(unsigned* p) { return __hip_atomic_load(p, __ATOMIC_RELAXED, __HIP_MEMORY_SCOPE_AGENT); }
__device__ __forceinline__ unsigned xb_add(unsigned* p, unsigned v) { return __hip_atomic_fetch_add(p, v, __ATOMIC_RELAXED, __HIP_MEMORY_SCOPE_AGENT); }
__device__ __forceinline__ unsigned xb_xcc_id() { return (unsigned)__builtin_amdgcn_s_getreg((3 << 11) | 20) & 0xFu; }
#define XB_SPIN(cond) do { unsigned sp_ = 0; while (cond) { __builtin_amdgcn_s_sleep(1); if (++sp_ > (1u << 24)) break; } } while (0)
__device__ __forceinline__ void gbar(unsigned* bar, volatile LAS unsigned* st) {
    asm volatile("s_waitcnt vmcnt(0) lgkmcnt(0)" ::: "memory");
    __syncthreads();
    if (threadIdx.x == 0) {
        const unsigned x = xb_xcc_id(), nloc = st[0], nx = st[1];
        const unsigned old = xb_add(&bar[XB_XSUB(x)], 1u);
        const unsigned gen = old / nloc;
        if (old + 1u == (gen + 1u) * nloc) {
            __builtin_amdgcn_fence(__ATOMIC_RELEASE, "agent");
            asm volatile("s_waitcnt vmcnt(0)" ::: "memory");
            const unsigned og = xb_add(&bar[XB_TOP], 1u);
            const unsigned tg = og / nx;
            if (og + 1u == (tg + 1u) * nx) xb_add(&bar[XB_TOPGEN], 1u);
            else XB_SPIN(xb_ld(&bar[XB_TOPGEN]) == tg);
            __builtin_amdgcn_fence(__ATOMIC_ACQUIRE, "agent");
            xb_add(&bar[XB_XGEN(x)], 1u);
            asm volatile("s_waitcnt vmcnt(0)" ::: "memory");
        } else {
            XB_SPIN(xb_ld(&bar[XB_XGEN(x)]) == gen);
            __builtin_amdgcn_fence(__ATOMIC_ACQUIRE, "agent");
            asm volatile("s_waitcnt vmcnt(0)" ::: "memory");
        }
    }
    __syncthreads();
}

__global__ void __launch_bounds__(NT, 2) hymba_fwd(Params p) {
    extern __shared__ __attribute__((aligned(16))) unsigned char lds_raw[];
    LAS unsigned char* lds = (LAS unsigned char*)lds_raw;
    cg::grid_group grid = cg::this_grid();
    bf16_t* XB = (bf16_t*)(p.ws + WS_XB); bf16_t* U = (bf16_t*)(p.ws + WS_U); float* G = (float*)(p.ws + WS_G); bf16_t* MG = (bf16_t*)(p.ws + WS_MG);
    float* SS = (float*)(p.ws + WS_SS);
    unsigned* bar = (unsigned*)(p.ws + WS_BAR);
    volatile LAS unsigned* st = (volatile LAS unsigned*)(lds + LDS_BYTES - 16);
    if (threadIdx.x == 0) (void)xb_add(&bar[XB_XCNT(xb_xcc_id())], 1u);
    if (p.out == nullptr) grid.sync();
    phase_prep(p, lds);
    if (threadIdx.x == 0) {
        const unsigned x = xb_xcc_id(), Gn = gridDim.x; unsigned mine = 1u, cnt = 1u, sp = 0u;
        for (;;) {
            unsigned sum = 0u; cnt = 0u;
            for (unsigned j = 0; j < 16; ++j) { const unsigned c = xb_ld(&bar[XB_XCNT(j)]); sum += c; cnt += c > 0u ? 1u : 0u; if (j == x) mine = c; }
            if (sum == Gn || ++sp > (1u << 22)) break;
            __builtin_amdgcn_s_sleep(1);
        }
        st[0] = mine > 0u ? mine : 1u; st[1] = cnt > 0u ? cnt : 1u;
    }
    __syncthreads();
    gbar(bar, st);
    for (int l = 0; l < 2; ++l) {
        {
            pg8::Gemm g; g.A = XB; g.Bt = (const bf16_t*)(p.ws + WS_WT1) + (size_t)l * NW1 * DM; g.M = MR; g.N = NW1; g.K = DM;
            unsigned* dctr = bar + 3712 + 64 * l;
            pg8::InOrder so; so.G = gridDim.x; so.c = obid(); so.done_ctr = dctr;
            EpiIn e; e.U = U; e.G = G; e.SS = SS; e.bmi = p.b_mi + l * 4; e.bmf = p.b_mf + l * 4;
            pg8::gemm_phase<EpiIn, pg8::InOrder, DM>(lds, g, so, e);
            const int Gn = gridDim.x, maxu = (pg8::IN_UNITS + Gn - 1) / Gn, mine = (pg8::IN_UNITS - so.c + Gn - 1) / Gn;
            if (mine < maxu) {
                if (threadIdx.x == 0) {
                    unsigned sp = 0u;
                    while (__hip_atomic_load(dctr, __ATOMIC_RELAXED, __HIP_MEMORY_SCOPE_AGENT) < 8u * pg8::IN_DEC_UNITS) { __builtin_amdgcn_s_sleep(2); if (++sp > (1u << 24)) break; }
                    __builtin_amdgcn_fence(__ATOMIC_ACQUIRE, "agent");
                    asm volatile("s_waitcnt vmcnt(0)" ::: "memory");
                }
                __syncthreads();
                decode_items(p, l, lds, 2);
            }
        }
        gbar(bar, st);
        phase_mixers(p, l, lds);
        gbar(bar, st);
        for (int pass = 0; pass < 2; ++pass) {
            if (pass == 0) phase_headnorm(p, l);
            pg8::Gemm g; g.A = MG; g.Bt = (const bf16_t*)(p.ws + WS_WT2) + (size_t)l * DM * DMG; g.M = MR; g.N = DM; g.K = DMG;
            pg8::OutOrder so; so.G = gridDim.x; so.c = obid(); so.mode = pass;
            EpiOut e; e.basep = p.xp; e.bases = p.xs; e.split = l == 0 ? 1 : 0; e.XBo = XB; e.SSo = SS;
            pg8::gemm_phase<EpiOut, pg8::OutOrder, DMG>(lds, g, so, e);
            gbar(bar, st);
        }
    }
    phase_final(p);
}

extern "C" void kernel_launch(void* const* d_in, const int* in_sizes, int n_in, void* d_out, int out_size, void* d_ws, size_t ws_size, hipStream_t stream) {
    static int grid_blocks = 0;
    if (!grid_blocks) {
        int dev = 0, cus = 0, per_cu = 0;
        hipGetDevice(&dev);
        hipDeviceGetAttribute(&cus, hipDeviceAttributeMultiprocessorCount, dev);
        hipFuncSetAttribute((const void*)hymba_fwd, hipFuncAttributeMaxDynamicSharedMemorySize, LDS_BYTES);
        hipOccupancyMaxActiveBlocksPerMultiprocessor(&per_cu, (const void*)hymba_fwd, NT, LDS_BYTES);
        if (per_cu < 1) per_cu = 1;
        grid_blocks = cus * per_cu;
        (void)hipGetLastError();
    }
    if (ws_size < WS_END) { fprintf(stderr, "workspace too small: %zu < %zu\n", ws_size, (size_t)WS_END); return; }
    Params p{};
    p.xp = (const float*)d_in[0]; p.xs = (const float*)d_in[1]; p.st_h = (const float*)d_in[2]; p.st_conv = (const float*)d_in[3];
    p.st_C = (const float*)d_in[4]; p.st_n = (const float*)d_in[5]; p.st_m = (const float*)d_in[6]; p.g_norm = (const float*)d_in[7];
    p.w_in = (const float*)d_in[8]; p.conv_w = (const float*)d_in[9]; p.conv_b = (const float*)d_in[10]; p.w_r = (const float*)d_in[11];
    p.b_r = (const float*)d_in[12]; p.w_i = (const float*)d_in[13]; p.b_i = (const float*)d_in[14]; p.lam = (const float*)d_in[15];
    p.b_mi = (const float*)d_in[16]; p.b_mf = (const float*)d_in[17]; p.g_mhead = (const float*)d_in[18]; p.w_out = (const float*)d_in[19];
    p.g_final = (const float*)d_in[20];
    p.out = (float*)d_out; p.ws = (unsigned char*)d_ws;
    (void)hipMemsetAsync((unsigned char*)d_ws + WS_BAR, 0, 16384, stream);
    void* args[] = {&p};
    hipError_t e = hipLaunchCooperativeKernel((const void*)hymba_fwd, dim3(grid_blocks), dim3(NT), args, LDS_BYTES, stream);
    if (e != hipSuccess) fprintf(stderr, "cooperative launch failed: %s (grid %d)\n", hipGetErrorString(e), grid_blocks);
}
```

```cpp
#include <hip/hip_runtime.h>
#include <hip/hip_cooperative_groups.h>
#include <cstdio>
namespace cg = cooperative_groups;

#define LAS __attribute__((address_space(3)))
typedef unsigned short bf16_t;
typedef short bf16x8 __attribute__((ext_vector_type(8)));
typedef short bf16x4 __attribute__((ext_vector_type(4)));
typedef float f32x4 __attribute__((ext_vector_type(4)));
typedef unsigned u32x4 __attribute__((ext_vector_type(4)));
typedef unsigned u32x2 __attribute__((ext_vector_type(2)));

constexpr int NT = 512;
constexpr int LDS_BYTES = 163840;
constexpr int MP = 16384, MV = 16512, MR = 16640;
constexpr int DM = 1024, NU = 7168, NW1 = 7424, DIN = 7176, DMG = 2048;
constexpr float EPSF = 1e-6f;

constexpr size_t WS_XB = 0;
constexpr size_t WS_WT1 = WS_XB + (size_t)MR * DM * 2;
constexpr size_t WS_WT2 = WS_WT1 + (size_t)2 * NW1 * DM * 2;
constexpr size_t WS_WGT = WS_WT2 + (size_t)2 * DM * DMG * 2;
constexpr size_t WS_U = WS_WGT + (size_t)2 * 2 * 16 * 64 * 64 * 2;
constexpr size_t WS_G = WS_U + (size_t)MR * NU * 2;
constexpr size_t WS_MG = WS_G + (size_t)MR * 8 * 4;
constexpr size_t WS_X1 = WS_MG + (size_t)MR * DMG * 2;
constexpr size_t WS_X2 = WS_X1 + (size_t)MR * DM * 4;
constexpr size_t WS_SS = WS_X2 + (size_t)MR * DM * 4;
constexpr size_t WS_YSS = WS_SS + (size_t)MR * 16 * 4;
constexpr size_t WS_BAR = WS_YSS + (size_t)MR * 16 * 4;
constexpr size_t WS_END = WS_BAR + 16384;

struct Params {
    const float* xp; const float* xs; const float* st_h; const float* st_conv; const float* st_C; const float* st_n; const float* st_m;
    const float* g_norm; const float* w_in; const float* conv_w; const float* conv_b; const float* w_r; const float* b_r; const float* w_i; const float* b_i;
    const float* lam; const float* b_mi; const float* b_mf; const float* g_mhead; const float* w_out; const float* g_final;
    float* out; unsigned char* ws;
};

constexpr size_t O_YP = 0;
constexpr size_t O_YS = O_YP + (size_t)MP * DM;
constexpr size_t O_PH = O_YS + (size_t)128 * DM;
constexpr size_t O_PCONV = O_PH + 2 * 8 * 1024;
constexpr size_t O_PC = O_PCONV + 2 * 8 * 3 * 1024;
constexpr size_t O_PN = O_PC + (size_t)2 * 8 * 4 * 65536;
constexpr size_t O_PM = O_PN + 2 * 8 * 4 * 256;
constexpr size_t O_SH = O_PM + 2 * 8 * 4;
constexpr size_t O_SCONV = O_SH + 2 * 128 * 1024;
constexpr size_t O_SC = O_SCONV + 2 * 128 * 3 * 1024;
constexpr size_t O_SN = O_SC + (size_t)2 * 128 * 4 * 65536;
constexpr size_t O_SM = O_SN + 2 * 128 * 4 * 256;

__device__ __forceinline__ float bf2f(unsigned short v) { return __uint_as_float(((unsigned)v) << 16); }
__device__ __forceinline__ unsigned cvt_pk_bf16(float lo, float hi) { unsigned r; asm volatile("v_cvt_pk_bf16_f32 %0, %1, %2" : "=v"(r) : "v"(lo), "v"(hi)); return r; }
__device__ __forceinline__ float sigmoidf_(float x) { return __builtin_amdgcn_rcpf(1.0f + __builtin_amdgcn_exp2f(-1.44269504f * x)); }
__device__ __forceinline__ float siluf_(float x) { return x * __builtin_amdgcn_rcpf(1.0f + __builtin_amdgcn_exp2f(-1.44269504f * x)); }
__device__ __forceinline__ float softplusf_(float x) { return fmaxf(x, 0.f) + log1pf(__expf(-fabsf(x))); }
__device__ __forceinline__ int otid() { int t = threadIdx.x; asm volatile("" : "+v"(t)); return t; }
__device__ __forceinline__ int obid() { int t = blockIdx.x; asm volatile("" : "+s"(t)); return t; }
__device__ __forceinline__ f32x4 zero4() { float z = 0.f; asm volatile("" : "+v"(z)); return (f32x4){z, z, z, z}; }
__device__ __forceinline__ float lo16(unsigned w) { return __uint_as_float(w << 16); }
__device__ __forceinline__ float hi16(unsigned w) { return __uint_as_float(w & 0xffff0000u); }

namespace pg8 {
constexpr int BM = 256, BK = 64, HALF = 128, HTB = HALF * BK * 2, STAGE_BYTES = 8 * HTB, NXCD = 8, WGM = 2;
__host__ __device__ __forceinline__ int lds_byte(int r, int c) { const int st = (r >> 4) * 2 + (c >> 5), rr = r & 15, cc = c & 31, ob = rr * 64 + cc * 2; return st * 1024 + (ob ^ (((ob >> 9) & 1) << 5)); }
__host__ __device__ __forceinline__ void stage_rc(int b, int& R, int& C) { const int st = b / 1024, sb = b % 1024, swz = sb ^ (((sb >> 9) & 1) << 5); R = (st >> 1) * 16 + swz / 64; C = (st & 1) * 32 + (swz % 64) / 2; }
__host__ __device__ __forceinline__ int perm32(int rho) { const int n = rho >> 4, i = rho & 15; return 8 * (i >> 2) + 4 * n + (i & 3); }
struct Unit { int pm, pn; };
struct Gemm { const bf16_t* A; const bf16_t* Bt; int M, N, K; };
template <int NM_, int NN_>
struct StaticOrder {
    static constexpr int nM = NM_, nN = NN_, nwg = NM_ * NN_;
    int G, c;
    __device__ void init(int G_, int c_) { G = G_; c = c_; }
    __device__ static void map(int L, Unit& u) {
        int wgid = L; { constexpr int q = nwg / NXCD, r = nwg % NXCD; const int xcd = wgid % NXCD, off = wgid / NXCD; wgid = (xcd < r ? xcd * (q + 1) : r * (q + 1) + (xcd - r) * q) + off; }
        constexpr int nig = WGM * nN; const int gid = wgid / nig, fm = gid * WGM, gsz = (nM - fm) < WGM ? (nM - fm) : WGM;
        u.pm = fm + ((wgid % nig) % gsz); u.pn = (wgid % nig) / gsz;
    }
    __device__ bool next(int i, Unit& u) const { const int L = i * G + c; if (L >= nwg) return false; map(L, u); return true; }
    __device__ __forceinline__ void done(const Unit&, int) const {}
};

struct OutOrder {
    int G, c, mode;
    __device__ bool next(int i, Unit& u) const {
        const int L = i * G + c;
        if (mode == 0) { if (L >= 4) return false; u.pm = 64; u.pn = L; return true; }
        if (L >= 256) return false; StaticOrder<64, 4>::map(L, u); return true;
    }
    __device__ __forceinline__ void done(const Unit&, int) const {}
};

constexpr int IN_UNITS = 65 * 29, IN_DEC_UNITS = 29;
struct InOrder {
    int G, c; unsigned* done_ctr;
    __device__ bool next(int i, Unit& u) const {
        const int L = i * G + c; if (L >= IN_UNITS) return false;
        if (L < IN_DEC_UNITS) { u.pm = 64; u.pn = L; return true; }
        StaticOrder<64, 29>::map(L - IN_DEC_UNITS, u); return true;
    }
    __device__ __forceinline__ void done(const Unit& u, int lane) const {
        if (u.pm == 64) {
            asm volatile("s_waitcnt vmcnt(0)" ::: "memory");
            __builtin_amdgcn_fence(__ATOMIC_RELEASE, "agent");
            asm volatile("s_waitcnt vmcnt(0)" ::: "memory");
            if (lane == 0) __hip_atomic_fetch_add(done_ctr, 1u, __ATOMIC_RELAXED, __HIP_MEMORY_SCOPE_AGENT);
        }
    }
};

template <class Epi, class Sched, int KK>
__device__ __forceinline__ void gemm_phase(LAS unsigned char* lds, const Gemm g, const Sched& S, const Epi& E) {
    const int tid = otid(), wid = __builtin_amdgcn_readfirstlane(tid >> 6), lane = tid & 63, wr = wid >> 2, wc = wid & 3, fr = lane & 15, fq = lane >> 4;
    constexpr int K = KK, nt = K / BK;
    unsigned voffA[2], voffB[2];
#pragma unroll
    for (int i = 0; i < 2; ++i) { int R, C; stage_rc(tid * 16 + i * 8192, R, C); const int Rb = Epi::PERM ? ((R & ~31) + perm32(R & 31)) : R;
        voffA[i] = (unsigned)(R * K + C) * 2u; voffB[i] = (unsigned)(Rb * K + C) * 2u; }
    const size_t kstep = (size_t)(BK * 2);
    const size_t hstep = (size_t)HALF * K * 2;
    const size_t tstep = 2 * hstep;
    const unsigned ldsw = (unsigned)wid * 1024u;
    const int aoff = lds_byte(wr * 64 + fr, fq * 8), boff = lds_byte(wc * 32 + fr, fq * 8);
#define PG8_SA(b, h) (((b) * 2 + (h)) * HTB)
#define PG8_SB(b, h) ((4 + (b) * 2 + (h)) * HTB)
#define PG8_STAGE(bufoff, gbase, voff) do { _Pragma("unroll") for (int _i = 0; _i < 2; ++_i) \
        __builtin_amdgcn_global_load_lds((const unsigned*)((const char*)(gbase) + (voff)[_i]), (LAS unsigned*)(lds + (bufoff) + ldsw + _i * 8192), 16, 0, 0); } while (0)
#define PG8_LDA(dst, b, h) do { _Pragma("unroll") for (int m = 0; m < 4; ++m) _Pragma("unroll") for (int k = 0; k < 2; ++k) dst[m][k] = *(const LAS bf16x8*)(lds + PG8_SA(b, h) + aoff + m * 2048 + k * 1024); } while (0)
#define PG8_LDB(dst, b, h) do { _Pragma("unroll") for (int n = 0; n < 2; ++n) _Pragma("unroll") for (int k = 0; k < 2; ++k) dst[n][k] = *(const LAS bf16x8*)(lds + PG8_SB(b, h) + boff + n * 2048 + k * 1024); } while (0)
#define PG8_MMA(ai, bj, At, Bt) do { __builtin_amdgcn_s_setprio(1); _Pragma("unroll") for (int m = 0; m < 4; ++m) _Pragma("unroll") for (int n = 0; n < 2; ++n) _Pragma("unroll") for (int k = 0; k < 2; ++k) \
        acc[ai][bj][m][n] = __builtin_amdgcn_mfma_f32_16x16x32_bf16(Bt[n][k], At[m][k], acc[ai][bj][m][n], 0, 0, 0); __builtin_amdgcn_s_setprio(0); } while (0)
#define PG8_WAIT_V(n) asm volatile("s_waitcnt vmcnt(" #n ")" ::: "memory")
#define PG8_WAIT_L(n) asm volatile("s_waitcnt lgkmcnt(" #n ")" ::: "memory")
#define PG8_BAR __builtin_amdgcn_s_barrier()
#define PG8_SCHED __builtin_amdgcn_sched_barrier(0)
    Unit cur, nxt; int ui = 0;
    if (!S.next(0, cur)) return;
    f32x4 acc[2][2][4][2];
#pragma unroll
    for (int a = 0; a < 2; ++a)
#pragma unroll
        for (int b = 0; b < 2; ++b)
#pragma unroll
            for (int m = 0; m < 4; ++m)
#pragma unroll
                for (int n = 0; n < 2; ++n) acc[a][b][m][n] = zero4();
    bf16x8 At[4][2], B0[2][2], B1[2][2];
    const char* cA = (const char*)g.A + (size_t)cur.pm * tstep; const char* cB = (const char*)g.Bt + (size_t)cur.pn * tstep;
    PG8_STAGE(PG8_SB(0, 0), cB, voffB); PG8_STAGE(PG8_SA(0, 0), cA, voffA); PG8_STAGE(PG8_SB(0, 1), cB + hstep, voffB); PG8_STAGE(PG8_SA(0, 1), cA + hstep, voffA);
    if (wr == 1) PG8_BAR;
    PG8_WAIT_V(4); PG8_BAR;
    PG8_STAGE(PG8_SB(1, 0), cB + kstep, voffB); PG8_STAGE(PG8_SA(1, 0), cA + kstep, voffA); PG8_STAGE(PG8_SB(1, 1), cB + hstep + kstep, voffB);
    PG8_WAIT_V(6); PG8_BAR;
    for (;;) {
        const bool has_next = S.next(ui + 1, nxt);
        const char* nA = has_next ? (const char*)g.A + (size_t)nxt.pm * tstep : cA; const char* nB = has_next ? (const char*)g.Bt + (size_t)nxt.pn * tstep : cB;
        for (int t = 0; t < nt; t += 2) {
            const bool last = (t == nt - 2);
            const char* a1 = cA + (size_t)(t + 1) * kstep;
            const char* a2 = last ? nA : cA + (size_t)(t + 2) * kstep; const char* b2 = last ? nB : cB + (size_t)(t + 2) * kstep;
            const char* a3 = a2 + kstep; const char* b3 = b2 + kstep;
            PG8_LDB(B0, 0, 0); PG8_SCHED; PG8_LDA(At, 0, 0); PG8_STAGE(PG8_SA(1, 1), a1 + hstep, voffA);
            PG8_WAIT_L(8); PG8_BAR; PG8_WAIT_L(0); PG8_MMA(0, 0, At, B0); PG8_BAR; PG8_SCHED;
            PG8_LDB(B1, 0, 1); PG8_STAGE(PG8_SB(0, 0), b2, voffB);
            PG8_BAR; PG8_WAIT_L(0); PG8_MMA(0, 1, At, B1); PG8_BAR;
            PG8_LDA(At, 0, 1); PG8_STAGE(PG8_SA(0, 0), a2, voffA);
            PG8_BAR; PG8_WAIT_L(0); PG8_MMA(1, 0, At, B0); PG8_BAR; PG8_SCHED;
            PG8_STAGE(PG8_SB(0, 1), b2 + hstep, voffB);
            PG8_WAIT_V(6); PG8_BAR; PG8_MMA(1, 1, At, B1); PG8_BAR;
            PG8_LDB(B0, 1, 0); PG8_SCHED; PG8_LDA(At, 1, 0); PG8_STAGE(PG8_SA(0, 1), a2 + hstep, voffA);
            PG8_WAIT_L(8); PG8_BAR; PG8_WAIT_L(0); PG8_MMA(0, 0, At, B0); PG8_BAR; PG8_SCHED;
            PG8_LDB(B1, 1, 1); PG8_STAGE(PG8_SB(1, 0), b3, voffB);
            PG8_BAR; PG8_WAIT_L(0); PG8_MMA(0, 1, At, B1); PG8_BAR;
            PG8_LDA(At, 1, 1); PG8_STAGE(PG8_SA(1, 0), a3, voffA);
            PG8_BAR; PG8_WAIT_L(0); PG8_MMA(1, 0, At, B0); PG8_BAR; PG8_SCHED;
            PG8_STAGE(PG8_SB(1, 1), b3 + hstep, voffB);
            PG8_WAIT_V(6); PG8_BAR; PG8_MMA(1, 1, At, B1); PG8_BAR;
        }
        E(acc, cur, wr, wc, fr, fq);
        S.done(cur, lane);
        if (!has_next) break;
#pragma unroll
        for (int a = 0; a < 2; ++a)
#pragma unroll
            for (int b = 0; b < 2; ++b)
#pragma unroll
                for (int m = 0; m < 4; ++m)
#pragma unroll
                    for (int n = 0; n < 2; ++n) acc[a][b][m][n] = zero4();
        cur = nxt; cA = nA; cB = nB; ++ui;
    }
    PG8_WAIT_V(0);
    if (wr == 0) PG8_BAR;
    PG8_BAR;
#undef PG8_SA
#undef PG8_SB
#undef PG8_STAGE
#undef PG8_LDA
#undef PG8_LDB
#undef PG8_MMA
#undef PG8_WAIT_V
#undef PG8_WAIT_L
#undef PG8_BAR
#undef PG8_SCHED
}
}

struct EpiIn {
    static constexpr bool PERM = true;
    bf16_t* U; float* G; const float* SS; const float* bmi; const float* bmf;
    __device__ __forceinline__ void operator()(const f32x4 (&acc)[2][2][4][2], const pg8::Unit& u, int wr, int wc, int fr, int fq) const {
        const int row0 = u.pm * 256 + wr * 64 + fr;
        const int pn = u.pn;
        const int mode = ((pn >= 4 && pn < 8) || (pn >= 24 && pn < 28)) ? 1 : ((pn >= 20 && pn < 24) ? 2 : 0);
        f32x4 cur[4];
        { const f32x4* sp = (const f32x4*)(SS + (size_t)row0 * 16); cur[0] = sp[0]; cur[1] = sp[1]; cur[2] = sp[2]; cur[3] = sp[3]; }
#pragma unroll
        for (int r = 0; r < 8; ++r) {
            const int ai = r >> 2, m = r & 3;
            const int row = row0 + ai * 128 + m * 16;
            f32x4 nxt[4];
            if (r < 7) {
                const f32x4* sp = (const f32x4*)(SS + (size_t)(row0 + ((r + 1) >> 2) * 128 + ((r + 1) & 3) * 16) * 16);
                nxt[0] = sp[0]; nxt[1] = sp[1]; nxt[2] = sp[2]; nxt[3] = sp[3];
            }
            const float ss = ((cur[0][0] + cur[0][1]) + (cur[0][2] + cur[0][3])) + ((cur[1][0] + cur[1][1]) + (cur[1][2] + cur[1][3])) + ((cur[2][0] + cur[2][1]) + (cur[2][2] + cur[2][3])) + ((cur[3][0] + cur[3][1]) + (cur[3][2] + cur[3][3]));
            const float rstd = rsqrtf(ss * (1.0f / 1024.0f) + EPSF);
            if (pn < 28) {
                bf16_t* rowp = U + (size_t)row * NU + pn * 256 + wc * 32 + 8 * fq;
#pragma unroll
                for (int bj = 0; bj < 2; ++bj) {
                    f32x4 v0 = acc[ai][bj][m][0] * rstd, v1 = acc[ai][bj][m][1] * rstd;
                    if (mode == 1) {
#pragma unroll
                        for (int j = 0; j < 4; ++j) { v0[j] = siluf_(v0[j]); v1[j] = siluf_(v1[j]); }
                    } else if (mode == 2) {
#pragma unroll
                        for (int j = 0; j < 4; ++j) { v0[j] = sigmoidf_(v0[j]); v1[j] = sigmoidf_(v1[j]); }
                    }
                    u32x4 w; w.x = cvt_pk_bf16(v0[0], v0[1]); w.y = cvt_pk_bf16(v0[2], v0[3]); w.z = cvt_pk_bf16(v1[0], v1[1]); w.w = cvt_pk_bf16(v1[2], v1[3]);
                    *(u32x4*)(rowp + bj * 128) = w;
                }
            } else if (wc == 0 && fq == 0) {
                const f32x4 v0 = acc[ai][0][m][0] * rstd, v1 = acc[ai][0][m][1] * rstd;
                f32x4 gi, gf;
#pragma unroll
                for (int j = 0; j < 4; ++j) { gi[j] = v0[j] + bmi[j]; const float x = v1[j] + bmf[j]; gf[j] = fminf(x, 0.f) - log1pf(__expf(-fabsf(x))); }
                *(f32x4*)(G + (size_t)row * 8) = gi; *(f32x4*)(G + (size_t)row * 8 + 4) = gf;
            }
            if (r < 7) { cur[0] = nxt[0]; cur[1] = nxt[1]; cur[2] = nxt[2]; cur[3] = nxt[3]; }
        }
    }
};

struct EpiOut {
    static constexpr bool PERM = false;
    const float* basep; const float* bases; int split;
    bf16_t* XBo; float* SSo;
    __device__ __forceinline__ void operator()(const f32x4 (&acc)[2][2][4][2], const pg8::Unit& u, int wr, int wc, int fr, int fq) const {
        const int row0 = u.pm * 256 + wr * 64 + fr, col0 = u.pn * 256 + wc * 32 + 4 * fq;
#pragma unroll
        for (int g2 = 0; g2 < 4; ++g2) {
            const int ai = g2 >> 1;
            f32x4 bs[2][2][2];
#pragma unroll
            for (int mm = 0; mm < 2; ++mm) {
                const int m = (g2 & 1) * 2 + mm;
                const int row = row0 + ai * 128 + m * 16;
                if (split) {
                    const float* bp = basep + (size_t)row * DM;
                    bool have = true;
                    if (row >= MV) have = false; else if (row >= MP) bp = bases + (size_t)(row - MP) * DM;
#pragma unroll
                    for (int bj = 0; bj < 2; ++bj)
#pragma unroll
                        for (int n = 0; n < 2; ++n) { bs[mm][bj][n] = zero4(); if (have) bs[mm][bj][n] = *(const f32x4*)(bp + col0 + bj * 128 + n * 16); }
                } else {
#pragma unroll
                    for (int bj = 0; bj < 2; ++bj)
#pragma unroll
                        for (int n = 0; n < 2; ++n) { const u32x2 v = *(const u32x2*)(XBo + (size_t)row * DM + col0 + bj * 128 + n * 16); bs[mm][bj][n] = (f32x4){lo16(v.x), hi16(v.x), lo16(v.y), hi16(v.y)}; }
                }
            }
#pragma unroll
            for (int mm = 0; mm < 2; ++mm) {
                const int m = (g2 & 1) * 2 + mm;
                const int row = row0 + ai * 128 + m * 16;
                float ss = 0.f;
#pragma unroll
                for (int bj = 0; bj < 2; ++bj)
#pragma unroll
                    for (int n = 0; n < 2; ++n) {
                        const int c = col0 + bj * 128 + n * 16;
                        const f32x4 o = bs[mm][bj][n] + acc[ai][bj][m][n];
                        u32x2 w; w.x = cvt_pk_bf16(o[0], o[1]); w.y = cvt_pk_bf16(o[2], o[3]); *(u32x2*)(XBo + (size_t)row * DM + c) = w;
                        ss += (o[0] * o[0] + o[1] * o[1]) + (o[2] * o[2] + o[3] * o[3]);
                    }
                ss += __shfl_xor(ss, 16); ss += __shfl_xor(ss, 32);
                if (fq == 0) SSo[(size_t)row * 16 + u.pn * 4 + wc] = ss;
            }
        }
    }
};

struct TileJob { const float* src; int ldn, nvalid, k0, n0; bf16_t* dst; int ldk; const float* sk; float sn; };
__device__ __forceinline__ void tile_job(const Params& p, int job, TileJob& t) {
    bf16_t* WT1 = (bf16_t*)(p.ws + WS_WT1); bf16_t* WT2 = (bf16_t*)(p.ws + WS_WT2); bf16_t* WGT = (bf16_t*)(p.ws + WS_WGT);
    constexpr int JA = 2 * 16 * 116, JB = 2 * 32 * 16;
    if (job < JA) {
        const int l = job / (16 * 116), r = job % (16 * 116), ntile = r / 16, kt = r % 16, n0 = ntile * 64;
        t.src = p.w_in + (size_t)l * DM * DIN; t.ldn = DIN; t.nvalid = DIN; t.k0 = kt * 64; t.n0 = n0; t.dst = WT1 + (size_t)l * NW1 * DM; t.ldk = DM; t.sk = p.g_norm + l * DM;
        t.sn = (n0 >= 3072 && n0 < 4096) ? 0.0625f : 1.0f;
    } else if (job < JA + JB) {
        const int j = job - JA, l = j / 512, r = j % 512, ntile = r / 32, kt = r % 32;
        t.src = p.w_out + (size_t)l * DMG * DM; t.ldn = DM; t.nvalid = DM; t.k0 = kt * 64; t.n0 = ntile * 64; t.dst = WT2 + (size_t)l * DM * DMG; t.ldk = DMG; t.sk = nullptr; t.sn = 1.0f;
    } else {
        const int j = job - JA - JB, l = j >> 5, gate = (j >> 4) & 1, blk = j & 15;
        t.src = (gate ? p.w_i : p.w_r) + (size_t)(l * 16 + blk) * 4096; t.ldn = 64; t.nvalid = 64; t.k0 = 0; t.n0 = 0; t.dst = WGT + (size_t)((l * 2 + gate) * 16 + blk) * 4096; t.ldk = 64; t.sk = nullptr; t.sn = 1.0f;
    }
}
__device__ __forceinline__ void tile_load(const TileJob& t, int tid, f32x4 (&v)[2], float (&sc)[2]) {
    const int r = tid >> 4, c4 = tid & 15;
#pragma unroll
    for (int i = 0; i < 2; ++i) {
        const int k = r + 32 * i, n = t.n0 + 4 * c4;
        v[i] = zero4();
        if (n + 3 < t.nvalid) v[i] = *(const f32x4*)(t.src + (size_t)(t.k0 + k) * t.ldn + n);
        sc[i] = (t.sk ? t.sk[t.k0 + k] : 1.0f) * t.sn;
    }
}
__device__ __forceinline__ void tile_finish(const TileJob& t, int tid, const f32x4 (&v)[2], const float (&sc)[2], LAS float* T) {
    {
        const int r = tid >> 4, c4 = tid & 15;
#pragma unroll
        for (int i = 0; i < 2; ++i) {
            const int k = r + 32 * i; const float s = sc[i];
            T[k * 65 + 4 * c4 + 0] = v[i][0] * s; T[k * 65 + 4 * c4 + 1] = v[i][1] * s; T[k * 65 + 4 * c4 + 2] = v[i][2] * s; T[k * 65 + 4 * c4 + 3] = v[i][3] * s;
        }
    }
    __syncthreads();
    {
        const int n = tid >> 3, kq = tid & 7;
        float f[8];
#pragma unroll
        for (int j = 0; j < 8; ++j) f[j] = T[(kq * 8 + j) * 65 + n];
        u32x4 w; w.x = cvt_pk_bf16(f[0], f[1]); w.y = cvt_pk_bf16(f[2], f[3]); w.z = cvt_pk_bf16(f[4], f[5]); w.w = cvt_pk_bf16(f[6], f[7]);
        *(u32x4*)(t.dst + (size_t)(t.n0 + n) * t.ldk + t.k0 + kq * 8) = w;
    }
    __syncthreads();
}

__device__ void phase_prep(const Params& p, LAS unsigned char* lds) {
    LAS float* T = (LAS float*)lds;
    bf16_t* XB = (bf16_t*)(p.ws + WS_XB); float* SS = (float*)(p.ws + WS_SS); bf16_t* MG = (bf16_t*)(p.ws + WS_MG);
    constexpr int NTILE = 2 * 16 * 116 + 2 * 32 * 16 + 64, JD = MR / 8;
    const int G = gridDim.x, tid = otid();
    {
        int job = blockIdx.x; TileJob cur; f32x4 v[2]; float sc[2];
        bool have = job < NTILE;
        if (have) { tile_job(p, job, cur); tile_load(cur, tid, v, sc); }
        while (have) {
            const int nj = job + G; const bool hn = nj < NTILE;
            TileJob nxt = cur; f32x4 vn[2]; float scn[2];
            vn[0] = v[0]; vn[1] = v[1]; scn[0] = sc[0]; scn[1] = sc[1];
            if (hn) { tile_job(p, nj, nxt); tile_load(nxt, tid, vn, scn); }
            tile_finish(cur, tid, v, sc, T);
            cur = nxt; v[0] = vn[0]; v[1] = vn[1]; sc[0] = scn[0]; sc[1] = scn[1]; job = nj; have = hn;
        }
    }
    for (int j = blockIdx.x; j < JD; j += G) {
        const int wid = tid >> 6, lane = tid & 63;
        const int row = j * 8 + wid;
        const float* src = row < MP ? p.xp + (size_t)row * DM : (row < MV ? p.xs + (size_t)(row - MP) * DM : nullptr);
        f32x4 v[4]; float ss = 0.f;
#pragma unroll
        for (int i = 0; i < 4; ++i) { v[i] = src ? *(const f32x4*)(src + lane * 16 + i * 4) : zero4(); ss += (v[i][0] * v[i][0] + v[i][1] * v[i][1]) + (v[i][2] * v[i][2] + v[i][3] * v[i][3]); }
#pragma unroll
        for (int o = 32; o >= 1; o >>= 1) ss += __shfl_xor(ss, o);
        u32x4 w0, w1;
        w0.x = cvt_pk_bf16(v[0][0], v[0][1]); w0.y = cvt_pk_bf16(v[0][2], v[0][3]); w0.z = cvt_pk_bf16(v[1][0], v[1][1]); w0.w = cvt_pk_bf16(v[1][2], v[1][3]);
        w1.x = cvt_pk_bf16(v[2][0], v[2][1]); w1.y = cvt_pk_bf16(v[2][2], v[2][3]); w1.z = cvt_pk_bf16(v[3][0], v[3][1]); w1.w = cvt_pk_bf16(v[3][2], v[3][3]);
        *(u32x4*)(XB + (size_t)row * DM + lane * 16) = w0; *(u32x4*)(XB + (size_t)row * DM + lane * 16 + 8) = w1;
        if (lane < 16) SS[(size_t)row * 16 + lane] = lane == 0 ? ss : 0.f;
        if (row >= MV) { const u32x4 z = (u32x4){0u, 0u, 0u, 0u}; u32x4* mp = (u32x4*)(MG + (size_t)row * DMG + lane * 32); mp[0] = z; mp[1] = z; mp[2] = z; mp[3] = z; }
    }
}

constexpr int M_QI = 0, M_KI = 38912, M_VI = 77824, M_CTI = 96256, M_SM = 130048;
constexpr int RS_QK = 304, RS_V = 144, RS_CT = 528;

template <int OFF0, int OFF1>
__device__ __forceinline__ bf16x8 tr_frag(unsigned base) {
    bf16x4 lo, hi;
    asm volatile("ds_read_b64_tr_b16 %0, %2 offset:%3\n\tds_read_b64_tr_b16 %1, %2 offset:%4\n\ts_waitcnt lgkmcnt(0)" : "=&v"(lo), "=&v"(hi) : "v"(base), "i"(OFF0), "i"(OFF1) : "memory");
    bf16x8 r; r[0] = lo[0]; r[1] = lo[1]; r[2] = lo[2]; r[3] = lo[3]; r[4] = hi[0]; r[5] = hi[1]; r[6] = hi[2]; r[7] = hi[3]; return r;
}

template <int O0, int O1, int HI>
__device__ __forceinline__ void tr_frag2(unsigned base, bf16x8& f0, bf16x8& f1) {
    bf16x4 a0, a1, b0, b1;
    asm volatile("ds_read_b64_tr_b16 %0, %4 offset:%5\n\tds_read_b64_tr_b16 %1, %4 offset:%6\n\tds_read_b64_tr_b16 %2, %4 offset:%7\n\tds_read_b64_tr_b16 %3, %4 offset:%8\n\ts_waitcnt lgkmcnt(0)"
                 : "=&v"(a0), "=&v"(a1), "=&v"(b0), "=&v"(b1) : "v"(base), "i"(O0), "i"(O0 + HI), "i"(O1), "i"(O1 + HI) : "memory");
    f0 = __builtin_shufflevector(a0, a1, 0, 1, 2, 3, 4, 5, 6, 7); f1 = __builtin_shufflevector(b0, b1, 0, 1, 2, 3, 4, 5, 6, 7);
}
template <int KS>
__device__ __forceinline__ void mlstm_D(f32x4 (&CT)[8], unsigned bvD, unsigned bkD) {
    const bf16x8 vdf = tr_frag<KS * 32 * RS_V, KS * 32 * RS_V + 4 * RS_V>(bvD);
    bf16x8 k0, k1;
    tr_frag2<KS * 32 * RS_QK + 0, KS * 32 * RS_QK + 32, 4 * RS_QK>(bkD, k0, k1);
    CT[0] = __builtin_amdgcn_mfma_f32_16x16x32_bf16(k0, vdf, CT[0], 0, 0, 0);
    CT[1] = __builtin_amdgcn_mfma_f32_16x16x32_bf16(k1, vdf, CT[1], 0, 0, 0);
    tr_frag2<KS * 32 * RS_QK + 64, KS * 32 * RS_QK + 96, 4 * RS_QK>(bkD, k0, k1);
    CT[2] = __builtin_amdgcn_mfma_f32_16x16x32_bf16(k0, vdf, CT[2], 0, 0, 0);
    CT[3] = __builtin_amdgcn_mfma_f32_16x16x32_bf16(k1, vdf, CT[3], 0, 0, 0);
    tr_frag2<KS * 32 * RS_QK + 128, KS * 32 * RS_QK + 160, 4 * RS_QK>(bkD, k0, k1);
    CT[4] = __builtin_amdgcn_mfma_f32_16x16x32_bf16(k0, vdf, CT[4], 0, 0, 0);
    CT[5] = __builtin_amdgcn_mfma_f32_16x16x32_bf16(k1, vdf, CT[5], 0, 0, 0);
    tr_frag2<KS * 32 * RS_QK + 192, KS * 32 * RS_QK + 224, 4 * RS_QK>(bkD, k0, k1);
    CT[6] = __builtin_amdgcn_mfma_f32_16x16x32_bf16(k0, vdf, CT[6], 0, 0, 0);
    CT[7] = __builtin_amdgcn_mfma_f32_16x16x32_bf16(k1, vdf, CT[7], 0, 0, 0);
}
template <int O, int STEP, int HI>
__device__ __forceinline__ void tr_frag4(unsigned base, bf16x8& f0, bf16x8& f1, bf16x8& f2, bf16x8& f3) {
    bf16x4 a0, a1, b0, b1, c0, c1, d0, d1;
    asm volatile("ds_read_b64_tr_b16 %0, %8 offset:%9\n\tds_read_b64_tr_b16 %1, %8 offset:%10\n\tds_read_b64_tr_b16 %2, %8 offset:%11\n\tds_read_b64_tr_b16 %3, %8 offset:%12\n\t"
                 "ds_read_b64_tr_b16 %4, %8 offset:%13\n\tds_read_b64_tr_b16 %5, %8 offset:%14\n\tds_read_b64_tr_b16 %6, %8 offset:%15\n\tds_read_b64_tr_b16 %7, %8 offset:%16\n\ts_waitcnt lgkmcnt(0)"
                 : "=&v"(a0), "=&v"(a1), "=&v"(b0), "=&v"(b1), "=&v"(c0), "=&v"(c1), "=&v"(d0), "=&v"(d1)
                 : "v"(base), "i"(O), "i"(O + HI), "i"(O + STEP), "i"(O + STEP + HI), "i"(O + 2 * STEP), "i"(O + 2 * STEP + HI), "i"(O + 3 * STEP), "i"(O + 3 * STEP + HI) : "memory");
    f0 = __builtin_shufflevector(a0, a1, 0, 1, 2, 3, 4, 5, 6, 7); f1 = __builtin_shufflevector(b0, b1, 0, 1, 2, 3, 4, 5, 6, 7);
    f2 = __builtin_shufflevector(c0, c1, 0, 1, 2, 3, 4, 5, 6, 7); f3 = __builtin_shufflevector(d0, d1, 0, 1, 2, 3, 4, 5, 6, 7);
}
template <int KS>
__device__ __forceinline__ void mlstm_B(f32x4 (&N1)[4], LAS unsigned char* lds, unsigned bvB, int t, int fq) {
    const bf16x8 pf = *(const LAS bf16x8*)(lds + M_QI + t * RS_QK + KS * 64 + fq * 16);
    bf16x8 v0, v1, v2, v3;
    tr_frag4<KS * 32 * RS_V, 32, 4 * RS_V>(bvB, v0, v1, v2, v3);
    N1[0] = __builtin_amdgcn_mfma_f32_16x16x32_bf16(v0, pf, N1[0], 0, 0, 0);
    N1[1] = __builtin_amdgcn_mfma_f32_16x16x32_bf16(v1, pf, N1[1], 0, 0, 0);
    N1[2] = __builtin_amdgcn_mfma_f32_16x16x32_bf16(v2, pf, N1[2], 0, 0, 0);
    N1[3] = __builtin_amdgcn_mfma_f32_16x16x32_bf16(v3, pf, N1[3], 0, 0, 0);
}

__device__ void mlstm_prompt(const Params& p, int l, int item, LAS unsigned char* lds) {
    const int tid0 = otid();
    const int js = item & 3, h = (item >> 2) & 3, b = item >> 4;
    const unsigned ldsb = (unsigned)(size_t)lds;
    LAS float* sm = (LAS float*)(lds + M_SM);
    LAS float* nbuf = sm + 512; LAS float* npart = sm + 1552;
    const bf16_t* U = (const bf16_t*)(p.ws + WS_U); const float* G = (const float*)(p.ws + WS_G);
    bf16_t* MG = (bf16_t*)(p.ws + WS_MG);
    const size_t grow_base = (size_t)b * 2048;
    const int qcol = 2048 + h * 256, kcol = 3072 + h * 256, vcol = 4096 + h * 256 + js * 64;

    __syncthreads();
    for (int i = tid0; i < RS_CT * 64 / 16; i += NT) *(LAS u32x4*)(lds + M_CTI + i * 16) = (u32x4){0u, 0u, 0u, 0u};
    nbuf[tid0] = 0.f;
    f32x4 CTacc[8];
#pragma unroll
    for (int i = 0; i < 8; ++i) CTacc[i] = zero4();
    float m_prev = 0.f;
    u32x4 qreg[4], kreg[4], vreg[2]; float igr[2] = {0.f, 0.f}, lfr[2] = {0.f, 0.f};

#define ML_LOAD_QK(row0_, hd_) do { _Pragma("unroll") for (int i_ = 0; i_ < 4; ++i_) { const int id_ = tid + NT * i_, r_ = id_ >> 4, cq_ = id_ & 15; \
        const bf16_t* rp_ = U + (grow_base + (row0_) + r_) * NU + (hd_) * 128 + cq_ * 8; qreg[i_] = *(const u32x4*)(rp_ + qcol); kreg[i_] = *(const u32x4*)(rp_ + kcol); } } while (0)
#define ML_STORE_QK() do { _Pragma("unroll") for (int i_ = 0; i_ < 4; ++i_) { const int id_ = tid + NT * i_, r_ = id_ >> 4, cq_ = id_ & 15; \
        *(LAS u32x4*)(lds + M_QI + r_ * RS_QK + cq_ * 16) = qreg[i_]; *(LAS u32x4*)(lds + M_KI + r_ * RS_QK + cq_ * 16) = kreg[i_]; } } while (0)
#define ML_LOAD_VG(row0_) do { _Pragma("unroll") for (int i_ = 0; i_ < 2; ++i_) { const int id_ = tid + NT * i_, s_ = id_ >> 3, cq_ = id_ & 7; \
        vreg[i_] = *(const u32x4*)(U + (grow_base + (row0_) + s_) * NU + vcol + cq_ * 8); } \
        if (w == 0) { const float* gp_ = G + (grow_base + (row0_) + 2 * lane) * 8 + h; igr[0] = gp_[0]; lfr[0] = gp_[4]; igr[1] = gp_[8]; lfr[1] = gp_[12]; } } while (0)

#define ML_PREPASS(buf_) do { if (w == 0) { LAS float* dec_ = sm + 128 * (buf_); LAS float* expnm_ = sm + 256 + 128 * (buf_); LAS float* scal_ = sm + 1024 + 8 * (buf_); \
            const float s2 = lfr[0] + lfr[1]; float incl = s2; \
            _Pragma("unroll") for (int o = 1; o < 64; o <<= 1) { const float t_ = __shfl_up(incl, o); if (lane >= o) incl += t_; } \
            const float b0 = incl - s2 + lfr[0], b1 = incl; \
            const float a0 = igr[0] - b0, a1 = igr[1] - b1; float im = fmaxf(a0, a1); \
            _Pragma("unroll") for (int o = 1; o < 64; o <<= 1) { const float t_ = __shfl_up(im, o); if (lane >= o) im = fmaxf(im, t_); } \
            float ex = __shfl_up(im, 1); if (lane == 0) ex = -INFINITY; \
            const float M0 = fmaxf(ex, a0), M1 = fmaxf(M0, a1); \
            const float mt1 = b1 + fmaxf(m_prev, M1); \
            const float bL = __shfl(b1, 63), mL = __shfl(mt1, 63); \
            expnm_[2 * lane] = __expf(bL - mL - b0); expnm_[2 * lane + 1] = __expf(bL - mL - b1); \
            dec_[2 * lane] = __expf(bL - b0 + igr[0] - mL); dec_[2 * lane + 1] = __expf(bL - b1 + igr[1] - mL); \
            if (lane == 0) { scal_[0] = __expf(bL + m_prev - mL); scal_[1] = mL; } \
            m_prev = mL; } } while (0)
    { const int tid = tid0, w = tid >> 6, lane = tid & 63; ML_LOAD_QK(0, 0); ML_LOAD_VG(0); ML_PREPASS(0); }
#pragma unroll 1
    for (int c = 0; c < 16; ++c) {
        int tid = tid0; asm volatile("" : "+v"(tid));
        const int w = __builtin_amdgcn_readfirstlane(tid >> 6), lane = tid & 63, fr = lane & 15, fq = lane >> 4;
        const int cD = w & 3, gD = w >> 2, qq = (lane & 15) >> 2, pp = lane & 3;
        const unsigned bvB = ldsb + M_VI + (8 * fq + qq) * RS_V + 8 * pp;
        const unsigned bvD = bvB + cD * 32;
        const int row0 = c * 128;
        LAS float* nC = nbuf + (c & 1) * 256; LAS float* nN = nbuf + ((c + 1) & 1) * 256;
        __syncthreads();
        ML_STORE_QK();
        LAS float* dec = sm + 128 * (c & 1); LAS float* expnm = sm + 256 + 128 * (c & 1); LAS float* scal = sm + 1024 + 8 * (c & 1);
        const float cs = scal[0];
#pragma unroll
        for (int i = 0; i < 2; ++i) {
            const int id = tid + NT * i, s = id >> 3, cq = id & 7; const float d = dec[s];
            u32x4 v = vreg[i], o;
            o.x = cvt_pk_bf16(lo16(v.x) * d, hi16(v.x) * d); o.y = cvt_pk_bf16(lo16(v.y) * d, hi16(v.y) * d);
            o.z = cvt_pk_bf16(lo16(v.z) * d, hi16(v.z) * d); o.w = cvt_pk_bf16(lo16(v.w) * d, hi16(v.w) * d);
            *(LAS u32x4*)(lds + M_VI + s * RS_V + cq * 16) = o;
        }
        if (tid < 256) nN[tid] = cs * nC[tid];
        ML_LOAD_QK(row0, 1);
        f32x4 Sacc[8], N2[4];
#pragma unroll
        for (int i = 0; i < 8; ++i) Sacc[i] = zero4();
#pragma unroll
        for (int i = 0; i < 4; ++i) N2[i] = zero4();
        float qnp = 0.f;
#pragma unroll 1
        for (int hd = 0; hd < 2; ++hd) {
            __syncthreads();
#pragma unroll
            for (int ks = 0; ks < 4; ++ks) {
                const bf16x8 qf = *(const LAS bf16x8*)(lds + M_QI + (16 * w + fr) * RS_QK + ks * 64 + fq * 16);
#pragma unroll
                for (int g = 0; g < 2; ++g) if (4 * g <= w) {
                    bf16x8 kf[4];
#pragma unroll
                    for (int e = 0; e < 4; ++e) kf[e] = *(const LAS bf16x8*)(lds + M_KI + (64 * g + 16 * e + fr) * RS_QK + ks * 64 + fq * 16);
#pragma unroll
                    for (int e = 0; e < 4; ++e) Sacc[4 * g + e] = __builtin_amdgcn_mfma_f32_16x16x32_bf16(kf[e], qf, Sacc[4 * g + e], 0, 0, 0);
                }
#pragma unroll
                for (int c4 = 0; c4 < 4; ++c4) {
                    const bf16x8 ctf = *(const LAS bf16x8*)(lds + M_CTI + (16 * c4 + fr) * RS_CT + hd * 256 + ks * 64 + fq * 16);
                    N2[c4] = __builtin_amdgcn_mfma_f32_16x16x32_bf16(ctf, qf, N2[c4], 0, 0, 0);
                }
                const LAS float* np = nC + hd * 128 + ks * 32 + fq * 8;
#pragma unroll
                for (int j = 0; j < 8; ++j) qnp += bf2f((unsigned short)qf[j]) * np[j];
                __builtin_amdgcn_sched_barrier(0);
            }
            if (gD == hd) {
                const unsigned bkD = ldsb + M_KI + (8 * fq + qq) * RS_QK + 8 * pp;
#pragma unroll
                for (int i = 0; i < 8; ++i) CTacc[i] *= cs;
                mlstm_D<0>(CTacc, bvD, bkD); __builtin_amdgcn_sched_barrier(0); mlstm_D<1>(CTacc, bvD, bkD); __builtin_amdgcn_sched_barrier(0); mlstm_D<2>(CTacc, bvD, bkD); __builtin_amdgcn_sched_barrier(0); mlstm_D<3>(CTacc, bvD, bkD); __builtin_amdgcn_sched_barrier(0);
            }
            if (gD != hd) {
                const int lidx = (w & 3) * 64 + lane, dk4 = lidx & 31, part = lidx >> 5; float a0 = 0.f, a1 = 0.f, a2 = 0.f, a3 = 0.f;
#pragma unroll 2
                for (int s = 16 * part; s < 16 * part + 16; ++s) {
                    const u32x2 kv = *(const LAS u32x2*)(lds + M_KI + s * RS_QK + dk4 * 8); const float d = dec[s];
                    a0 += d * lo16(kv.x); a1 += d * hi16(kv.x); a2 += d * lo16(kv.y); a3 += d * hi16(kv.y);
                }
                *(LAS f32x4*)(npart + part * 128 + 4 * dk4) = (f32x4){a0, a1, a2, a3};
            }
            __syncthreads();
            if (tid < 128) nN[hd * 128 + tid] += ((npart[tid] + npart[128 + tid]) + (npart[256 + tid] + npart[384 + tid])) + ((npart[512 + tid] + npart[640 + tid]) + (npart[768 + tid] + npart[896 + tid]));
            if (gD == hd) {
#pragma unroll
                for (int i = 0; i < 8; ++i) {
                    u32x2 wv; wv.x = cvt_pk_bf16(CTacc[i][0], CTacc[i][1]); wv.y = cvt_pk_bf16(CTacc[i][2], CTacc[i][3]);
                    *(LAS u32x2*)(lds + M_CTI + (16 * cD + fr) * RS_CT + (hd * 128 + 16 * i + 4 * fq) * 2) = wv;
                }
            }
            if (hd == 0) {
                ML_STORE_QK();
                if (c < 15) { ML_LOAD_QK(row0 + 128, 0); }
            }
        }
        if (c < 15) { ML_LOAD_VG(row0 + 128); }
        const int t = 16 * w + fr;
        float den1 = 0.f;
#pragma unroll
        for (int g = 0; g < 4; ++g) if (2 * g <= w) {
            const f32x4 dv0 = *(const LAS f32x4*)(dec + 32 * g + 4 * fq), dv1 = *(const LAS f32x4*)(dec + 32 * g + 16 + 4 * fq);
            f32x4 s0 = Sacc[2 * g], s1 = Sacc[2 * g + 1];
#pragma unroll
            for (int j = 0; j < 4; ++j) {
                const int sa = 32 * g + 4 * fq + j, sb = sa + 16;
                if (sa > t) s0[j] = 0.f;
                if (sb > t || 2 * g + 1 > w) s1[j] = 0.f;
                den1 += s0[j] * dv0[j] + s1[j] * dv1[j];
            }
            u32x2 w0, w1; w0.x = cvt_pk_bf16(s0[0], s0[1]); w0.y = cvt_pk_bf16(s0[2], s0[3]); w1.x = cvt_pk_bf16(s1[0], s1[1]); w1.y = cvt_pk_bf16(s1[2], s1[3]);
            *(LAS u32x2*)(lds + M_QI + t * RS_QK + (32 * g + 4 * fq) * 2) = w0;
            *(LAS u32x2*)(lds + M_QI + t * RS_QK + (32 * g + 16 + 4 * fq) * 2) = w1;
        }
        den1 += __shfl_xor(den1, 16); den1 += __shfl_xor(den1, 32);
        qnp += __shfl_xor(qnp, 16); qnp += __shfl_xor(qnp, 32);
#pragma unroll
        for (int i = 0; i < 4; ++i) N2[i] *= cs;
        if (0 <= (w >> 1)) mlstm_B<0>(N2, lds, bvB, t, fq);
        if (1 <= (w >> 1)) mlstm_B<1>(N2, lds, bvB, t, fq);
        if (2 <= (w >> 1)) mlstm_B<2>(N2, lds, bvB, t, fq);
        if (3 <= (w >> 1)) mlstm_B<3>(N2, lds, bvB, t, fq);
        {
            const float den = den1 + cs * qnp;
            const float inv = 1.0f / fmaxf(fabsf(den), expnm[t]);
            const size_t grow = grow_base + row0 + t;
#pragma unroll
            for (int c4 = 0; c4 < 4; ++c4) {
                const float y0 = N2[c4][0] * inv, y1 = N2[c4][1] * inv, y2 = N2[c4][2] * inv, y3 = N2[c4][3] * inv;
                u32x2 wv; wv.x = cvt_pk_bf16(y0, y1); wv.y = cvt_pk_bf16(y2, y3);
                *(u32x2*)(MG + grow * DMG + 1024 + h * 256 + js * 64 + 16 * c4 + 4 * fq) = wv;
            }
        }
        if (c < 15) ML_PREPASS((c + 1) & 1);
    }
    __syncthreads();
    {
        const int tid = tid0, w = tid >> 6, lane = tid & 63, fr = lane & 15, fq = lane >> 4, cD = w & 3, gD = w >> 2;
        float* pC = p.out + O_PC + ((size_t)((l * 8 + b) * 4 + h)) * 65536;
#pragma unroll
        for (int i = 0; i < 8; ++i)
#pragma unroll
            for (int j = 0; j < 4; ++j) pC[(size_t)(gD * 128 + 16 * i + 4 * fq + j) * 256 + js * 64 + 16 * cD + fr] = CTacc[i][j];
        if (js == 0) {
            if (tid < 256) p.out[O_PN + ((size_t)((l * 8 + b) * 4 + h)) * 256 + tid] = nbuf[tid];
            if (tid == 0) p.out[O_PM + (l * 8 + b) * 4 + h] = sm[1024 + 8 + 1];
        }
    }
    __syncthreads();
#undef ML_LOAD_QK
#undef ML_STORE_QK
#undef ML_LOAD_VG
#undef ML_PREPASS
}

constexpr int R_XAI = 0, R_XCF = 16768, R_XCB = 49536, R_AA = 67968, R_UU = 100736, R_PT = 133504, R_HC = 137600, R_CW = 138112, R_CH = 139392, R_WG = 140160;
__device__ void rglru_item(const Params& p, int l, int b, int cb, bool decm, LAS unsigned char* lds) {
    const int tid = otid(), w = __builtin_amdgcn_readfirstlane(tid >> 6), lane = tid & 63, fr = lane & 15, fq = lane >> 4;
    const bf16_t* U = (const bf16_t*)(p.ws + WS_U); bf16_t* MG = (bf16_t*)(p.ws + WS_MG);
    const bf16_t* WGT = (const bf16_t*)(p.ws + WS_WGT);
    LAS float* XCF = (LAS float*)(lds + R_XCF); LAS float* AA = (LAS float*)(lds + R_AA); LAS float* UU = (LAS float*)(lds + R_UU);
    LAS float* PT = (LAS float*)(lds + R_PT); LAS float* HC = (LAS float*)(lds + R_HC); LAS float* CW = (LAS float*)(lds + R_CW); LAS float* CH = (LAS float*)(lds + R_CH);
    const int ch0 = cb * 64;
    const size_t grow_base = decm ? (size_t)MP : (size_t)b * 2048;
    const int nchunk = decm ? 1 : 16;
    __syncthreads();
    if (tid < 64) {
        const int ch = ch0 + tid;
#pragma unroll
        for (int j = 0; j < 4; ++j) CW[j * 64 + tid] = p.conv_w[(size_t)(l * 4 + j) * 1024 + ch];
        CW[256 + tid] = p.conv_b[l * 1024 + ch];
        CH[tid] = p.b_r[l * 1024 + ch]; CH[64 + tid] = p.b_i[l * 1024 + ch]; CH[128 + tid] = 8.0f * softplusf_(-p.lam[l * 1024 + ch]);
        HC[tid] = 0.f; HC[64 + tid] = 0.f;
    }
    if (tid < 24) *(LAS u32x4*)(lds + R_XAI + tid * 16) = (u32x4){0u, 0u, 0u, 0u};
#pragma unroll
    for (int i = 0; i < 2; ++i) {
        const int id = tid + NT * i, g = id >> 9, r = (id >> 3) & 63, cq = id & 7;
        *(LAS u32x4*)(lds + R_WG + (g * 64 + r) * 144 + cq * 16) = *(const u32x4*)(WGT + (size_t)((l * 2 + g) * 16 + cb) * 4096 + r * 64 + cq * 8);
    }
    u32x4 xreg[2], zreg[2];
#pragma unroll
    for (int i = 0; i < 2; ++i) { const int id = tid + NT * i, r = id >> 3, cq = id & 7; const bf16_t* rp = U + (grow_base + r) * NU + ch0 + cq * 8; xreg[i] = *(const u32x4*)rp; zreg[i] = *(const u32x4*)(rp + 1024); }
    for (int c = 0; c < nchunk; ++c) {
        const int row0 = c * 128;
        __syncthreads();
        if (c > 0) {
#pragma unroll
            for (int i = 0; i < 2; ++i) { const int id = tid + NT * i, r = id >> 3, cq = id & 7; *(u32x4*)(MG + (grow_base + row0 - 128 + r) * DMG + ch0 + cq * 8) = *(const LAS u32x4*)(lds + R_XCF + r * 128 + cq * 16); }
        }
        u32x4 zcur[2];
#pragma unroll
        for (int i = 0; i < 2; ++i) { const int id = tid + NT * i, r = id >> 3, cq = id & 7; *(LAS u32x4*)(lds + R_XAI + (3 + r) * 128 + cq * 16) = xreg[i]; zcur[i] = zreg[i]; }
        if (c + 1 < nchunk) {
#pragma unroll
            for (int i = 0; i < 2; ++i) { const int id = tid + NT * i, r = id >> 3, cq = id & 7; const bf16_t* rp = U + (grow_base + row0 + 128 + r) * NU + ch0 + cq * 8; xreg[i] = *(const u32x4*)rp; zreg[i] = *(const u32x4*)(rp + 1024); }
        }
        __syncthreads();
        {
            const int t = tid >> 2, c0 = (tid & 3) * 16;
            float xc[16];
#pragma unroll
            for (int k = 0; k < 16; ++k) xc[k] = CW[256 + c0 + k];
            if (!decm) {
#pragma unroll
                for (int j = 0; j < 4; ++j) {
                    const u32x4 a = *(const LAS u32x4*)(lds + R_XAI + (t + j) * 128 + c0 * 2), bq = *(const LAS u32x4*)(lds + R_XAI + (t + j) * 128 + c0 * 2 + 16);
                    const unsigned wv[8] = {a.x, a.y, a.z, a.w, bq.x, bq.y, bq.z, bq.w};
#pragma unroll
                    for (int k = 0; k < 8; ++k) { xc[2 * k] += CW[j * 64 + c0 + 2 * k] * lo16(wv[k]); xc[2 * k + 1] += CW[j * 64 + c0 + 2 * k + 1] * hi16(wv[k]); }
                }
            } else {
                const float* stp = p.st_conv + ((size_t)(l * 128 + t) * 3) * 1024 + ch0 + c0;
                float* so = p.out + O_SCONV + ((size_t)(l * 128 + t) * 3) * 1024 + ch0 + c0;
#pragma unroll
                for (int j = 0; j < 3; ++j)
#pragma unroll
                    for (int k4 = 0; k4 < 4; ++k4) {
                        const f32x4 sv = *(const f32x4*)(stp + (size_t)j * 1024 + k4 * 4);
#pragma unroll
                        for (int e = 0; e < 4; ++e) xc[k4 * 4 + e] += CW[j * 64 + c0 + k4 * 4 + e] * sv[e];
                        if (j >= 1) *(f32x4*)(so + (size_t)(j - 1) * 1024 + k4 * 4) = sv;
                    }
                const u32x4 a = *(const LAS u32x4*)(lds + R_XAI + (t + 3) * 128 + c0 * 2), bq = *(const LAS u32x4*)(lds + R_XAI + (t + 3) * 128 + c0 * 2 + 16);
                const unsigned wv[8] = {a.x, a.y, a.z, a.w, bq.x, bq.y, bq.z, bq.w};
#pragma unroll
                for (int k = 0; k < 8; ++k) {
                    const float x0 = lo16(wv[k]), x1 = hi16(wv[k]);
                    xc[2 * k] += CW[3 * 64 + c0 + 2 * k] * x0; xc[2 * k + 1] += CW[3 * 64 + c0 + 2 * k + 1] * x1;
                    so[2 * 1024 + 2 * k] = x0; so[2 * 1024 + 2 * k + 1] = x1;
                }
            }
#pragma unroll
            for (int k4 = 0; k4 < 4; ++k4) *(LAS f32x4*)(XCF + t * 64 + c0 + k4 * 4) = (f32x4){xc[k4 * 4], xc[k4 * 4 + 1], xc[k4 * 4 + 2], xc[k4 * 4 + 3]};
            u32x4 o0, o1;
            o0.x = cvt_pk_bf16(xc[0], xc[1]); o0.y = cvt_pk_bf16(xc[2], xc[3]); o0.z = cvt_pk_bf16(xc[4], xc[5]); o0.w = cvt_pk_bf16(xc[6], xc[7]);
            o1.x = cvt_pk_bf16(xc[8], xc[9]); o1.y = cvt_pk_bf16(xc[10], xc[11]); o1.z = cvt_pk_bf16(xc[12], xc[13]); o1.w = cvt_pk_bf16(xc[14], xc[15]);
            *(LAS u32x4*)(lds + R_XCB + t * 144 + c0 * 2) = o0; *(LAS u32x4*)(lds + R_XCB + t * 144 + c0 * 2 + 16) = o1;
        }
        __syncthreads();
        if (!decm && tid < 24) { const u32x4 v = *(const LAS u32x4*)(lds + R_XAI + 128 * 128 + tid * 16); *(LAS u32x4*)(lds + R_XAI + tid * 16) = v; }
        {
            bf16x8 xf[2];
#pragma unroll
            for (int ks = 0; ks < 2; ++ks) xf[ks] = *(const LAS bf16x8*)(lds + R_XCB + (16 * w + fr) * 144 + ks * 64 + fq * 16);
            const int t = 16 * w + fr;
#pragma unroll
            for (int c4 = 0; c4 < 4; ++c4) {
                f32x4 ar = zero4(), ai = ar;
#pragma unroll
                for (int ks = 0; ks < 2; ++ks) {
                    const bf16x8 wfr = *(const LAS bf16x8*)(lds + R_WG + (16 * c4 + fr) * 144 + ks * 64 + fq * 16);
                    const bf16x8 wfi = *(const LAS bf16x8*)(lds + R_WG + (64 + 16 * c4 + fr) * 144 + ks * 64 + fq * 16);
                    ar = __builtin_amdgcn_mfma_f32_16x16x32_bf16(wfr, xf[ks], ar, 0, 0, 0); ai = __builtin_amdgcn_mfma_f32_16x16x32_bf16(wfi, xf[ks], ai, 0, 0, 0); }
                const int d = 16 * c4 + 4 * fq;
                const f32x4 xcv = *(const LAS f32x4*)(XCF + t * 64 + d);
                f32x4 av, uv;
#pragma unroll
                for (int j = 0; j < 4; ++j) {
                    const float r = sigmoidf_(ar[j] + CH[d + j]), ig = sigmoidf_(ai[j] + CH[64 + d + j]);
                    const float la = -r * CH[128 + d + j];
                    const float x2 = 2.0f * la;
                    const float ser = -x2 * (1.0f + x2 * (0.5f + x2 * (0.16666667f + x2 * (0.041666668f + x2 * (0.0083333338f + x2 * 0.0013888889f)))));
                    const float om = x2 > -0.3f ? ser : 1.0f - __expf(x2);
                    av[j] = __expf(la); uv[j] = __builtin_amdgcn_sqrtf(om) * (ig * xcv[j]);
                }
                if (!decm) { *(LAS f32x4*)(AA + t * 64 + d) = av; *(LAS f32x4*)(UU + t * 64 + d) = uv; }
                else {
                    const f32x4 h0 = *(const f32x4*)(p.st_h + (size_t)(l * 128 + t) * 1024 + ch0 + d);
                    const f32x4 hn = av * h0 + uv;
                    *(f32x4*)(p.out + O_SH + (size_t)(l * 128 + t) * 1024 + ch0 + d) = hn;
                    const u32x2 zv = *(const u32x2*)(U + (grow_base + t) * NU + 1024 + ch0 + d);
                    u32x2 wv; wv.x = cvt_pk_bf16(hn[0] * lo16(zv.x), hn[1] * hi16(zv.x)); wv.y = cvt_pk_bf16(hn[2] * lo16(zv.y), hn[3] * hi16(zv.y));
                    *(u32x2*)(MG + (grow_base + t) * DMG + ch0 + d) = wv;
                }
            }
        }
        if (decm) break;
        __syncthreads();
#pragma unroll
        for (int i = 0; i < 2; ++i) { const int id = tid + NT * i, r = id >> 3, cq = id & 7; *(LAS u32x4*)(lds + R_XCB + r * 144 + cq * 16) = zcur[i]; }
        const int ch = tid & 63, part = tid >> 6;
        float av[16], uv[16];
#pragma unroll
        for (int k = 0; k < 16; ++k) { av[k] = AA[(part * 16 + k) * 64 + ch]; uv[k] = UU[(part * 16 + k) * 64 + ch]; }
        {
            float hh = 0.f, Ac = 1.f;
#pragma unroll
            for (int k = 0; k < 16; ++k) { hh = av[k] * hh + uv[k]; Ac *= av[k]; uv[k] = hh; av[k] = Ac; }
            PT[(part * 64 + ch) * 2] = Ac; PT[(part * 64 + ch) * 2 + 1] = hh;
        }
        __syncthreads();
        {
            float zv[16];
#pragma unroll
            for (int k = 0; k < 16; ++k) zv[k] = bf2f(*(const LAS unsigned short*)(lds + R_XCB + (part * 16 + k) * 144 + ch * 2));
            float hin = HC[(c & 1) * 64 + ch];
            for (int q = 0; q < part; ++q) hin = PT[(q * 64 + ch) * 2] * hin + PT[(q * 64 + ch) * 2 + 1];
            float hf = hin;
#pragma unroll
            for (int k = 0; k < 16; ++k) {
                hf = av[k] * hin + uv[k];
                const float y = hf * zv[k];
                *(LAS unsigned short*)(lds + R_XCF + (part * 16 + k) * 128 + ch * 2) = (unsigned short)(cvt_pk_bf16(y, y) & 0xffffu);
            }
            if (part == 7) {
                HC[((c + 1) & 1) * 64 + ch] = hf;
                if (c == 15) p.out[O_PH + (size_t)(l * 8 + b) * 1024 + ch0 + ch] = hf;
            }
        }
        if (c == 15 && tid < 192) {
            const int j = tid >> 6, cc = tid & 63;
            p.out[O_PCONV + ((size_t)(l * 8 + b) * 3 + j) * 1024 + ch0 + cc] = bf2f(*(const LAS unsigned short*)(lds + R_XAI + j * 128 + cc * 2));
        }
    }
    __syncthreads();
    if (!decm) {
#pragma unroll
        for (int i = 0; i < 2; ++i) { const int id = tid + NT * i, r = id >> 3, cq = id & 7; *(u32x4*)(MG + (grow_base + 15 * 128 + r) * DMG + ch0 + cq * 8) = *(const LAS u32x4*)(lds + R_XCF + r * 128 + cq * 16); }
    }
    __syncthreads();
}

__device__ void mlstm_decode(const Params& p, int l, int b, int h, LAS unsigned char* lds) {
    const int tid = otid(), lane = tid & 63;
    const bf16_t* U = (const bf16_t*)(p.ws + WS_U); const float* G = (const float*)(p.ws + WS_G);
    bf16_t* MG = (bf16_t*)(p.ws + WS_MG);
    LAS float* qs = (LAS float*)lds; LAS float* ks = qs + 256; LAS float* vs = qs + 512; LAS float* ns = qs + 768; LAS float* red = qs + 1024; LAS float* red2 = qs + 1024 + 2048;
    const size_t row = (size_t)MP + b;
    const size_t sidx = (size_t)((l * 128 + b) * 4 + h);
    __syncthreads();
    if (tid < 256) {
        qs[tid] = bf2f(U[row * NU + 2048 + h * 256 + tid]); ks[tid] = bf2f(U[row * NU + 3072 + h * 256 + tid]); vs[tid] = bf2f(U[row * NU + 4096 + h * 256 + tid]);
        ns[tid] = p.st_n[sidx * 256 + tid];
    }
    const float ig = G[row * 8 + h], lf = G[row * 8 + 4 + h], m0 = p.st_m[sidx];
    __syncthreads();
    float qk = 0.f, qn = 0.f;
#pragma unroll
    for (int j = 0; j < 4; ++j) { const float qv = qs[lane * 4 + j]; qk += qv * ks[lane * 4 + j]; qn += qv * ns[lane * 4 + j]; }
#pragma unroll
    for (int o = 32; o >= 1; o >>= 1) { qk += __shfl_xor(qk, o); qn += __shfl_xor(qn, o); }
    const float mt = fmaxf(lf + m0, ig), wg = __expf(ig - mt), gi = __expf(lf + m0 - mt);
    const int dvq = tid & 63, dkg = tid >> 6;
    float o_pre = 0.f, zg_pre = 0.f;
    if (tid < 256) { o_pre = bf2f(U[row * NU + 5120 + h * 256 + tid]); zg_pre = p.g_mhead[l * 1024 + h * 256 + tid] * bf2f(U[row * NU + 6144 + h * 256 + tid]); }
    const float* C0 = p.st_C + sidx * 65536; float* C1 = p.out + O_SC + sidx * 65536;
    const f32x4 v4 = *(const LAS f32x4*)(vs + dvq * 4);
    f32x4 qc = zero4();
#pragma unroll 1
    for (int i0 = 0; i0 < 32; i0 += 16) {
        f32x4 cv[16];
#pragma unroll
        for (int j = 0; j < 16; ++j) cv[j] = __builtin_nontemporal_load((const f32x4*)(C0 + (size_t)(dkg * 32 + i0 + j) * 256 + dvq * 4));
#pragma unroll
        for (int j = 0; j < 16; ++j) {
            const int dk = dkg * 32 + i0 + j;
            const float qv = qs[dk], kv = wg * ks[dk];
            qc += qv * cv[j];
            const f32x4 cn = gi * cv[j] + kv * v4;
            __builtin_nontemporal_store(cn, (f32x4*)(C1 + (size_t)dk * 256 + dvq * 4));
        }
    }
    *(LAS f32x4*)(red + dkg * 256 + dvq * 4) = qc;
    __syncthreads();
    float yv = 0.f;
    if (tid < 256) {
        float qcv = 0.f;
#pragma unroll
        for (int g = 0; g < 8; ++g) qcv += red[g * 256 + tid];
        const float num = wg * qk * vs[tid] + gi * qcv, den = wg * qk + gi * qn;
        const float hh = num / fmaxf(fabsf(den), __expf(-mt));
        yv = hh * o_pre;
        float ss = yv * yv;
#pragma unroll
        for (int o = 32; o >= 1; o >>= 1) ss += __shfl_xor(ss, o);
        if (lane == 0) red2[tid >> 6] = ss;
        p.out[O_SN + sidx * 256 + tid] = gi * ns[tid] + wg * ks[tid];
    }
    __syncthreads();
    if (tid < 256) {
        const float rstd = rsqrtf(((red2[0] + red2[1]) + (red2[2] + red2[3])) * (1.0f / 256.0f) + EPSF);
        const float ov = yv * rstd * zg_pre;
        MG[row * DMG + 1024 + h * 256 + tid] = (bf16_t)(cvt_pk_bf16(ov, ov) & 0xffffu);
    }
    if (tid == 0) p.out[O_SM + sidx] = mt;
}

__device__ void decode_items(const Params& p, int l, LAS unsigned char* lds, int max_items) {
    unsigned* ctr = (unsigned*)(p.ws + WS_BAR) + 3584 + 64 * l;
    volatile LAS unsigned* slot = (volatile LAS unsigned*)(lds + LDS_BYTES - 32);
    for (int n = 0; n < max_items; ++n) {
        __syncthreads();
        if (threadIdx.x == 0) *slot = __hip_atomic_fetch_add(ctr, 1u, __ATOMIC_RELAXED, __HIP_MEMORY_SCOPE_AGENT);
        __syncthreads();
        const int item = (int)*slot;
        if (item >= 512) break;
        mlstm_decode(p, l, item >> 2, item & 3, lds);
    }
}

__device__ void phase_mixers(const Params& p, int l, LAS unsigned char* lds) {
    const int G = gridDim.x, bid = obid();
    const bool split = G >= 256;
    const int r = split ? bid - 128 : bid, R = split ? G - 128 : G;
    if (!split || bid < 128) { for (int item = bid; item < 128; item += (split ? 128 : G)) mlstm_prompt(p, l, item, lds); }
    if (r >= 0) {
        for (int item = r; item < 128; item += R) rglru_item(p, l, item >> 4, item & 15, false, lds);
        for (int item = r; item < 16; item += R) rglru_item(p, l, 0, item, true, lds);
    }
    decode_items(p, l, lds, 1 << 30);
}

__device__ void phase_headnorm(const Params& p, int l) {
    const bf16_t* U = (const bf16_t*)(p.ws + WS_U); bf16_t* MG = (bf16_t*)(p.ws + WS_MG);
    const float* gm = p.g_mhead + l * 1024;
    const int G = gridDim.x, bid = obid();
    const int b0 = G > 8 ? bid - 4 : bid, GG = G > 8 ? G - 4 : G;
    if (b0 < 0) return;
    for (size_t idx = (size_t)b0 * NT + otid(); idx < (size_t)MP * 128; idx += (size_t)GG * NT) {
        const size_t row = idx >> 7; const int col = (int)(idx & 127) * 8;
        const u32x4 hv = *(const u32x4*)(MG + row * DMG + 1024 + col);
        const u32x4 ov = *(const u32x4*)(U + row * NU + 5120 + col);
        const u32x4 zv = *(const u32x4*)(U + row * NU + 6144 + col);
        float y[8];
        y[0] = lo16(hv.x) * lo16(ov.x); y[1] = hi16(hv.x) * hi16(ov.x); y[2] = lo16(hv.y) * lo16(ov.y); y[3] = hi16(hv.y) * hi16(ov.y);
        y[4] = lo16(hv.z) * lo16(ov.z); y[5] = hi16(hv.z) * hi16(ov.z); y[6] = lo16(hv.w) * lo16(ov.w); y[7] = hi16(hv.w) * hi16(ov.w);
        float ss = ((y[0] * y[0] + y[1] * y[1]) + (y[2] * y[2] + y[3] * y[3])) + ((y[4] * y[4] + y[5] * y[5]) + (y[6] * y[6] + y[7] * y[7]));
#pragma unroll
        for (int o = 1; o < 32; o <<= 1) ss += __shfl_xor(ss, o);
        const float rstd = rsqrtf(ss * (1.0f / 256.0f) + EPSF);
        const f32x4 g0 = *(const f32x4*)(gm + col), g1 = *(const f32x4*)(gm + col + 4);
        u32x4 o;
        o.x = cvt_pk_bf16(y[0] * rstd * g0[0] * lo16(zv.x), y[1] * rstd * g0[1] * hi16(zv.x));
        o.y = cvt_pk_bf16(y[2] * rstd * g0[2] * lo16(zv.y), y[3] * rstd * g0[3] * hi16(zv.y));
        o.z = cvt_pk_bf16(y[4] * rstd * g1[0] * lo16(zv.z), y[5] * rstd * g1[1] * hi16(zv.z));
        o.w = cvt_pk_bf16(y[6] * rstd * g1[2] * lo16(zv.w), y[7] * rstd * g1[3] * hi16(zv.w));
        *(u32x4*)(MG + row * DMG + 1024 + col) = o;
    }
}

__device__ void phase_final(const Params& p) {
    const bf16_t* XB = (const bf16_t*)(p.ws + WS_XB); const float* SS = (const float*)(p.ws + WS_SS);
    const int tidf = otid(); const int wid = tidf >> 6, lane = tidf & 63;
    for (int row = blockIdx.x * 8 + wid; row < MV; row += gridDim.x * 8) {
        const f32x4* sp = (const f32x4*)(SS + (size_t)row * 16);
        const f32x4 s0 = sp[0], s1 = sp[1], s2 = sp[2], s3 = sp[3];
        const float ss = ((s0[0] + s0[1]) + (s0[2] + s0[3])) + ((s1[0] + s1[1]) + (s1[2] + s1[3])) + ((s2[0] + s2[1]) + (s2[2] + s2[3])) + ((s3[0] + s3[1]) + (s3[2] + s3[3]));
        const float rstd = rsqrtf(ss * (1.0f / 1024.0f) + EPSF);
        float* op = row < MP ? p.out + O_YP + (size_t)row * DM : p.out + O_YS + (size_t)(row - MP) * DM;
#pragma unroll
        for (int i = 0; i < 2; ++i) {
            const int c = i * 512 + lane * 8;
            const u32x4 xv = *(const u32x4*)(XB + (size_t)row * DM + c);
            const f32x4 g0 = *(const f32x4*)(p.g_final + c), g1 = *(const f32x4*)(p.g_final + c + 4);
            *(f32x4*)(op + c) = (f32x4){lo16(xv.x) * rstd * g0[0], hi16(xv.x) * rstd * g0[1], lo16(xv.y) * rstd * g0[2], hi16(xv.y) * rstd * g0[3]};
            *(f32x4*)(op + c + 4) = (f32x4){lo16(xv.z) * rstd * g1[0], hi16(xv.z) * rstd * g1[1], lo16(xv.w) * rstd * g1[2], hi16(xv.w) * rstd * g1[3]};
        }
    }
}

#define XB_XCNT(j) (64 * (j))
#define XB_XSUB(j) (1024 + 64 * (j))
#define XB_XGEN(j) (2048 + 64 * (j))
#define XB_TOP 3072
#define XB_TOPGEN 3136
__device__ __forceinline__ unsigned xb_ld(unsigned* p) { return __hip_atomic_load(p, __ATOMIC_RELAXED, __HIP_MEMORY_SCOPE_AGENT); }
__device__ __forceinline__ unsigned xb_add(unsigned* p, unsigned v) { return __hip_atomic_fetch_add(p, v, __ATOMIC_RELAXED, __HIP_MEMORY_SCOPE_AGENT); }
__device__ __forceinline__ unsigned xb_xcc_id() { return (unsigned)__builtin_amdgcn_s_getreg((3 << 11) | 20) & 0xFu; }
#define XB_SPIN(cond) do { unsigned sp_ = 0; while (cond) { __builtin_amdgcn_s_sleep(1); if (++sp_ > (1u << 24)) break; } } while (0)
__device__ __forceinline__ void gbar(unsigned* bar, volatile LAS unsigned* st) {
    asm volatile("s_waitcnt vmcnt(0) lgkmcnt(0)" ::: "memory");
    __syncthreads();
    if (threadIdx.x == 0) {
        const unsigned x = xb_xcc_id(), nloc = st[0], nx = st[1];
        const unsigned old = xb_add(&bar[XB_XSUB(x)], 1u);
        const unsigned gen = old / nloc;
        if (old + 1u == (gen + 1u) * nloc) {
            __builtin_amdgcn_fence(__ATOMIC_RELEASE, "agent");
            asm volatile("s_waitcnt vmcnt(0)" ::: "memory");
            const unsigned og = xb_add(&bar[XB_TOP], 1u);
            const unsigned tg = og / nx;
            if (og + 1u == (tg + 1u) * nx) xb_add(&bar[XB_TOPGEN], 1u);
            else XB_SPIN(xb_ld(&bar[XB_TOPGEN]) == tg);
            __builtin_amdgcn_fence(__ATOMIC_ACQUIRE, "agent");
            xb_add(&bar[XB_XGEN(x)], 1u);
            asm volatile("s_waitcnt vmcnt(0)" ::: "memory");
        } else {
            XB_SPIN(xb_ld(&bar[XB_XGEN(x)]) == gen);
            __builtin_amdgcn_fence(__ATOMIC_ACQUIRE, "agent");
            asm volatile("s_waitcnt vmcnt(0)" ::: "memory");
        }
    }
    __syncthreads();
}

__global__ void __launch_bounds__(NT, 2) hymba_fwd(Params p) {
    extern __shared__ __attribute__((aligned(16))) unsigned char lds_raw[];
    LAS unsigned char* lds = (LAS unsigned char*)lds_raw;
    cg::grid_group grid = cg::this_grid();
    bf16_t* XB = (bf16_t*)(p.ws + WS_XB); bf16_t* U = (bf16_t*)(p.ws + WS_U); float* G = (float*)(p.ws + WS_G); bf16_t* MG = (bf16_t*)(p.ws + WS_MG);
    float* SS = (float*)(p.ws + WS_SS);
    unsigned* bar = (unsigned*)(p.ws + WS_BAR);
    volatile LAS unsigned* st = (volatile LAS unsigned*)(lds + LDS_BYTES - 16);
    if (threadIdx.x == 0) (void)xb_add(&bar[XB_XCNT(xb_xcc_id())], 1u);
    if (p.out == nullptr) grid.sync();
    phase_prep(p, lds);
    if (threadIdx.x == 0) {
        const unsigned x = xb_xcc_id(), Gn = gridDim.x; unsigned mine = 1u, cnt = 1u, sp = 0u;
        for (;;) {
            unsigned sum = 0u; cnt = 0u;
            for (unsigned j = 0; j < 16; ++j) { const unsigned c = xb_ld(&bar[XB_XCNT(j)]); sum += c; cnt += c > 0u ? 1u : 0u; if (j == x) mine = c; }
            if (sum == Gn || ++sp > (1u << 22)) break;
            __builtin_amdgcn_s_sleep(1);
        }
        st[0] = mine > 0u ? mine : 1u; st[1] = cnt > 0u ? cnt : 1u;
    }
    __syncthreads();
    gbar(bar, st);
    for (int l = 0; l < 2; ++l) {
        {
            pg8::Gemm g; g.A = XB; g.Bt = (const bf16_t*)(p.ws + WS_WT1) + (size_t)l * NW1 * DM; g.M = MR; g.N = NW1; g.K = DM;
            unsigned* dctr = bar + 3712 + 64 * l;
            pg8::InOrder so; so.G = gridDim.x; so.c = obid(); so.done_ctr = dctr;
            EpiIn e; e.U = U; e.G = G; e.SS = SS; e.bmi = p.b_mi + l * 4; e.bmf = p.b_mf + l * 4;
            pg8::gemm_phase<EpiIn, pg8::InOrder, DM>(lds, g, so, e);
            const int Gn = gridDim.x, maxu = (pg8::IN_UNITS + Gn - 1) / Gn, mine = (pg8::IN_UNITS - so.c + Gn - 1) / Gn;
            if (mine < maxu) {
                if (threadIdx.x == 0) {
                    unsigned sp = 0u;
                    while (__hip_atomic_load(dctr, __ATOMIC_RELAXED, __HIP_MEMORY_SCOPE_AGENT) < 8u * pg8::IN_DEC_UNITS) { __builtin_amdgcn_s_sleep(2); if (++sp > (1u << 24)) break; }
                    __builtin_amdgcn_fence(__ATOMIC_ACQUIRE, "agent");
                    asm volatile("s_waitcnt vmcnt(0)" ::: "memory");
                }
                __syncthreads();
                decode_items(p, l, lds, 2);
            }
        }
        gbar(bar, st);
        phase_mixers(p, l, lds);
        gbar(bar, st);
        for (int pass = 0; pass < 2; ++pass) {
            if (pass == 0) phase_headnorm(p, l);
            pg8::Gemm g; g.A = MG; g.Bt = (const bf16_t*)(p.ws + WS_WT2) + (size_t)l * DM * DMG; g.M = MR; g.N = DM; g.K = DMG;
            pg8::OutOrder so; so.G = gridDim.x; so.c = obid(); so.mode = pass;
            EpiOut e; e.basep = p.xp; e.bases = p.xs; e.split = l == 0 ? 1 : 0; e.XBo = XB; e.SSo = SS;
            pg8::gemm_phase<EpiOut, pg8::OutOrder, DMG>(lds, g, so, e);
            gbar(bar, st);
        }
    }
    phase_final(p);
}

extern "C" void kernel_launch(void* const* d_in, const int* in_sizes, int n_in, void* d_out, int out_size, void* d_ws, size_t ws_size, hipStream_t stream) {
    static int grid_blocks = 0;
    if (!grid_blocks) {
        int dev = 0, cus = 0, per_cu = 0;
        hipGetDevice(&dev);
        hipDeviceGetAttribute(&cus, hipDeviceAttributeMultiprocessorCount, dev);
        hipFuncSetAttribute((const void*)hymba_fwd, hipFuncAttributeMaxDynamicSharedMemorySize, LDS_BYTES);
        hipOccupancyMaxActiveBlocksPerMultiprocessor(&per_cu, (const void*)hymba_fwd, NT, LDS_BYTES);
        if (per_cu < 1) per_cu = 1;
        grid_blocks = cus * per_cu;
        (void)hipGetLastError();
    }
    if (ws_size < WS_END) { fprintf(stderr, "workspace too small: %zu < %zu\n", ws_size, (size_t)WS_END); return; }
    Params p{};
    p.xp = (const float*)d_in[0]; p.xs = (const float*)d_in[1]; p.st_h = (const float*)d_in[2]; p.st_conv = (const float*)d_in[3];
    p.st_C = (const float*)d_in[4]; p.st_n = (const float*)d_in[5]; p.st_m = (const float*)d_in[6]; p.g_norm = (const float*)d_in[7];
    p.w_in = (const float*)d_in[8]; p.conv_w = (const float*)d_in[9]; p.conv_b = (const float*)d_in[10]; p.w_r = (const float*)d_in[11];
    p.b_r = (const float*)d_in[12]; p.w_i = (const float*)d_in[13]; p.b_i = (const float*)d_in[14]; p.lam = (const float*)d_in[15];
    p.b_mi = (const float*)d_in[16]; p.b_mf = (const float*)d_in[17]; p.g_mhead = (const float*)d_in[18]; p.w_out = (const float*)d_in[19];
    p.g_final = (const float*)d_in[20];
    p.out = (float*)d_out; p.ws = (unsigned char*)d_ws;
    (void)hipMemsetAsync((unsigned char*)d_ws + WS_BAR, 0, 16384, stream);
    void* args[] = {&p};
    hipError_t e = hipLaunchCooperativeKernel((const void*)hymba_fwd, dim3(grid_blocks), dim3(NT), args, LDS_BYTES, stream);
    if (e != hipSuccess) fprintf(stderr, "cooperative launch failed: %s (grid %d)\n", hipGetErrorString(e), grid_blocks);
}
```

```cpp
#include <hip/hip_runtime.h>
#include <hip/hip_cooperative_groups.h>
#include <cstdio>
namespace cg = cooperative_groups;

#define LAS __attribute__((address_space(3)))
typedef unsigned short bf16_t;
typedef short bf16x8 __attribute__((ext_vector_type(8)));
typedef short bf16x4 __attribute__((ext_vector_type(4)));
typedef float f32x4 __attribute__((ext_vector_type(4)));
typedef unsigned u32x4 __attribute__((ext_vector_type(4)));
typedef unsigned u32x2 __attribute__((ext_vector_type(2)));

constexpr int NT = 512;
constexpr int LDS_BYTES = 163840;
constexpr int MP = 16384, MV = 16512, MR = 16640;
constexpr int DM = 1024, NU = 7168, NW1 = 7424, DIN = 7176, DMG = 2048;
constexpr float EPSF = 1e-6f;

constexpr size_t WS_XB = 0;
constexpr size_t WS_WT1 = WS_XB + (size_t)MR * DM * 2;
constexpr size_t WS_WT2 = WS_WT1 + (size_t)2 * NW1 * DM * 2;
constexpr size_t WS_WGT = WS_WT2 + (size_t)2 * DM * DMG * 2;
constexpr size_t WS_U = WS_WGT + (size_t)2 * 2 * 16 * 64 * 64 * 2;
constexpr size_t WS_G = WS_U + (size_t)MR * NU * 2;
constexpr size_t WS_MG = WS_G + (size_t)MR * 8 * 4;
constexpr size_t WS_X1 = WS_MG + (size_t)MR * DMG * 2;
constexpr size_t WS_X2 = WS_X1 + (size_t)MR * DM * 4;
constexpr size_t WS_SS = WS_X2 + (size_t)MR * DM * 4;
constexpr size_t WS_YSS = WS_SS + (size_t)MR * 16 * 4;
constexpr size_t WS_BAR = WS_YSS + (size_t)MR * 16 * 4;
constexpr size_t WS_END = WS_BAR + 16384;

struct Params {
    const float* xp; const float* xs; const float* st_h; const float* st_conv; const float* st_C; const float* st_n; const float* st_m;
    const float* g_norm; const float* w_in; const float* conv_w; const float* conv_b; const float* w_r; const float* b_r; const float* w_i; const float* b_i;
    const float* lam; const float* b_mi; const float* b_mf; const float* g_mhead; const float* w_out; const float* g_final;
    float* out; unsigned char* ws;
};

constexpr size_t O_YP = 0;
constexpr size_t O_YS = O_YP + (size_t)MP * DM;
constexpr size_t O_PH = O_YS + (size_t)128 * DM;
constexpr size_t O_PCONV = O_PH + 2 * 8 * 1024;
constexpr size_t O_PC = O_PCONV + 2 * 8 * 3 * 1024;
constexpr size_t O_PN = O_PC + (size_t)2 * 8 * 4 * 65536;
constexpr size_t O_PM = O_PN + 2 * 8 * 4 * 256;
constexpr size_t O_SH = O_PM + 2 * 8 * 4;
constexpr size_t O_SCONV = O_SH + 2 * 128 * 1024;
constexpr size_t O_SC = O_SCONV + 2 * 128 * 3 * 1024;
constexpr size_t O_SN = O_SC + (size_t)2 * 128 * 4 * 65536;
constexpr size_t O_SM = O_SN + 2 * 128 * 4 * 256;

__device__ __forceinline__ float bf2f(unsigned short v) { return __uint_as_float(((unsigned)v) << 16); }
__device__ __forceinline__ unsigned cvt_pk_bf16(float lo, float hi) { unsigned r; asm volatile("v_cvt_pk_bf16_f32 %0, %1, %2" : "=v"(r) : "v"(lo), "v"(hi)); return r; }
__device__ __forceinline__ float sigmoidf_(float x) { return __builtin_amdgcn_rcpf(1.0f + __builtin_amdgcn_exp2f(-1.44269504f * x)); }
__device__ __forceinline__ float siluf_(float x) { return x * __builtin_amdgcn_rcpf(1.0f + __builtin_amdgcn_exp2f(-1.44269504f * x)); }
__device__ __forceinline__ float softplusf_(float x) { return fmaxf(x, 0.f) + log1pf(__expf(-fabsf(x))); }
__device__ __forceinline__ int otid() { int t = threadIdx.x; asm volatile("" : "+v"(t)); return t; }
__device__ __forceinline__ int obid() { int t = blockIdx.x; asm volatile("" : "+s"(t)); return t; }
__device__ __forceinline__ f32x4 zero4() { float z = 0.f; asm volatile("" : "+v"(z)); return (f32x4){z, z, z, z}; }
__device__ __forceinline__ float lo16(unsigned w) { return __uint_as_float(w << 16); }
__device__ __forceinline__ float hi16(unsigned w) { return __uint_as_float(w & 0xffff0000u); }

namespace pg8 {
constexpr int BM = 256, BK = 64, HALF = 128, HTB = HALF * BK * 2, STAGE_BYTES = 8 * HTB, NXCD = 8, WGM = 2;
__host__ __device__ __forceinline__ int lds_byte(int r, int c) { const int st = (r >> 4) * 2 + (c >> 5), rr = r & 15, cc = c & 31, ob = rr * 64 + cc * 2; return st * 1024 + (ob ^ (((ob >> 9) & 1) << 5)); }
__host__ __device__ __forceinline__ void stage_rc(int b, int& R, int& C) { const int st = b / 1024, sb = b % 1024, swz = sb ^ (((sb >> 9) & 1) << 5); R = (st >> 1) * 16 + swz / 64; C = (st & 1) * 32 + (swz % 64) / 2; }
__host__ __device__ __forceinline__ int perm32(int rho) { const int n = rho >> 4, i = rho & 15; return 8 * (i >> 2) + 4 * n + (i & 3); }
struct Unit { int pm, pn; };
struct Gemm { const bf16_t* A; const bf16_t* Bt; int M, N, K; };
template <int NM_, int NN_>
struct StaticOrder {
    static constexpr int nM = NM_, nN = NN_, nwg = NM_ * NN_;
    int G, c;
    __device__ void init(int G_, int c_) { G = G_; c = c_; }
    __device__ static void map(int L, Unit& u) {
        int wgid = L; { constexpr int q = nwg / NXCD, r = nwg % NXCD; const int xcd = wgid % NXCD, off = wgid / NXCD; wgid = (xcd < r ? xcd * (q + 1) : r * (q + 1) + (xcd - r) * q) + off; }
        constexpr int nig = WGM * nN; const int gid = wgid / nig, fm = gid * WGM, gsz = (nM - fm) < WGM ? (nM - fm) : WGM;
        u.pm = fm + ((wgid % nig) % gsz); u.pn = (wgid % nig) / gsz;
    }
    __device__ bool next(int i, Unit& u) const { const int L = i * G + c; if (L >= nwg) return false; map(L, u); return true; }
    __device__ __forceinline__ void done(const Unit&, int) const {}
};

struct OutOrder {
    int G, c, mode;
    __device__ bool next(int i, Unit& u) const {
        const int L = i * G + c;
        if (mode == 0) { if (L >= 4) return false; u.pm = 64; u.pn = L; return true; }
        if (L >= 256) return false; StaticOrder<64, 4>::map(L, u); return true;
    }
    __device__ __forceinline__ void done(const Unit&, int) const {}
};

constexpr int IN_UNITS = 65 * 29, IN_DEC_UNITS = 29;
struct InOrder {
    int G, c; unsigned* done_ctr;
    __device__ bool next(int i, Unit& u) const {
        const int L = i * G + c; if (L >= IN_UNITS) return false;
        if (L < IN_DEC_UNITS) { u.pm = 64; u.pn = L; return true; }
        StaticOrder<64, 29>::map(L - IN_DEC_UNITS, u); return true;
    }
    __device__ __forceinline__ void done(const Unit& u, int lane) const {
        if (u.pm == 64) {
            asm volatile("s_waitcnt vmcnt(0)" ::: "memory");
            __builtin_amdgcn_fence(__ATOMIC_RELEASE, "agent");
            asm volatile("s_waitcnt vmcnt(0)" ::: "memory");
            if (lane == 0) __hip_atomic_fetch_add(done_ctr, 1u, __ATOMIC_RELAXED, __HIP_MEMORY_SCOPE_AGENT);
        }
    }
};

template <class Epi, class Sched, int KK>
__device__ __forceinline__ void gemm_phase(LAS unsigned char* lds, const Gemm g, const Sched& S, const Epi& E) {
    const int tid = otid(), wid = __builtin_amdgcn_readfirstlane(tid >> 6), lane = tid & 63, wr = wid >> 2, wc = wid & 3, fr = lane & 15, fq = lane >> 4;
    constexpr int K = KK, nt = K / BK;
    unsigned voffA[2], voffB[2];
#pragma unroll
    for (int i = 0; i < 2; ++i) { int R, C; stage_rc(tid * 16 + i * 8192, R, C); const int Rb = Epi::PERM ? ((R & ~31) + perm32(R & 31)) : R;
        voffA[i] = (unsigned)(R * K + C) * 2u; voffB[i] = (unsigned)(Rb * K + C) * 2u; }
    const size_t kstep = (size_t)(BK * 2);
    const size_t hstep = (size_t)HALF * K * 2;
    const size_t tstep = 2 * hstep;
    const unsigned ldsw = (unsigned)wid * 1024u;
    const int aoff = lds_byte(wr * 64 + fr, fq * 8), boff = lds_byte(wc * 32 + fr, fq * 8);
#define PG8_SA(b, h) (((b) * 2 + (h)) * HTB)
#define PG8_SB(b, h) ((4 + (b) * 2 + (h)) * HTB)
#define PG8_STAGE(bufoff, gbase, voff) do { _Pragma("unroll") for (int _i = 0; _i < 2; ++_i) \
        __builtin_amdgcn_global_load_lds((const unsigned*)((const char*)(gbase) + (voff)[_i]), (LAS unsigned*)(lds + (bufoff) + ldsw + _i * 8192), 16, 0, 0); } while (0)
#define PG8_LDA(dst, b, h) do { _Pragma("unroll") for (int m = 0; m < 4; ++m) _Pragma("unroll") for (int k = 0; k < 2; ++k) dst[m][k] = *(const LAS bf16x8*)(lds + PG8_SA(b, h) + aoff + m * 2048 + k * 1024); } while (0)
#define PG8_LDB(dst, b, h) do { _Pragma("unroll") for (int n = 0; n < 2; ++n) _Pragma("unroll") for (int k = 0; k < 2; ++k) dst[n][k] = *(const LAS bf16x8*)(lds + PG8_SB(b, h) + boff + n * 2048 + k * 1024); } while (0)
#define PG8_MMA(ai, bj, At, Bt) do { __builtin_amdgcn_s_setprio(1); _Pragma("unroll") for (int m = 0; m < 4; ++m) _Pragma("unroll") for (int n = 0; n < 2; ++n) _Pragma("unroll") for (int k = 0; k < 2; ++k) \
        acc[ai][bj][m][n] = __builtin_amdgcn_mfma_f32_16x16x32_bf16(Bt[n][k], At[m][k], acc[ai][bj][m][n], 0, 0, 0); __builtin_amdgcn_s_setprio(0); } while (0)
#define PG8_WAIT_V(n) asm volatile("s_waitcnt vmcnt(" #n ")" ::: "memory")
#define PG8_WAIT_L(n) asm volatile("s_waitcnt lgkmcnt(" #n ")" ::: "memory")
#define PG8_BAR __builtin_amdgcn_s_barrier()
#define PG8_SCHED __builtin_amdgcn_sched_barrier(0)
    Unit cur, nxt; int ui = 0;
    if (!S.next(0, cur)) return;
    f32x4 acc[2][2][4][2];
#pragma unroll
    for (int a = 0; a < 2; ++a)
#pragma unroll
        for (int b = 0; b < 2; ++b)
#pragma unroll
            for (int m = 0; m < 4; ++m)
#pragma unroll
                for (int n = 0; n < 2; ++n) acc[a][b][m][n] = zero4();
    bf16x8 At[4][2], B0[2][2], B1[2][2];
    const char* cA = (const char*)g.A + (size_t)cur.pm * tstep; const char* cB = (const char*)g.Bt + (size_t)cur.pn * tstep;
    PG8_STAGE(PG8_SB(0, 0), cB, voffB); PG8_STAGE(PG8_SA(0, 0), cA, voffA); PG8_STAGE(PG8_SB(0, 1), cB + hstep, voffB); PG8_STAGE(PG8_SA(0, 1), cA + hstep, voffA);
    if (wr == 1) PG8_BAR;
    PG8_WAIT_V(4); PG8_BAR;
    PG8_STAGE(PG8_SB(1, 0), cB + kstep, voffB); PG8_STAGE(PG8_SA(1, 0), cA + kstep, voffA); PG8_STAGE(PG8_SB(1, 1), cB + hstep + kstep, voffB);
    PG8_WAIT_V(6); PG8_BAR;
    for (;;) {
        const bool has_next = S.next(ui + 1, nxt);
        const char* nA = has_next ? (const char*)g.A + (size_t)nxt.pm * tstep : cA; const char* nB = has_next ? (const char*)g.Bt + (size_t)nxt.pn * tstep : cB;
        for (int t = 0; t < nt; t += 2) {
            const bool last = (t == nt - 2);
            const char* a1 = cA + (size_t)(t + 1) * kstep;
            const char* a2 = last ? nA : cA + (size_t)(t + 2) * kstep; const char* b2 = last ? nB : cB + (size_t)(t + 2) * kstep;
            const char* a3 = a2 + kstep; const char* b3 = b2 + kstep;
            PG8_LDB(B0, 0, 0); PG8_SCHED; PG8_LDA(At, 0, 0); PG8_STAGE(PG8_SA(1, 1), a1 + hstep, voffA);
            PG8_WAIT_L(8); PG8_BAR; PG8_WAIT_L(0); PG8_MMA(0, 0, At, B0); PG8_BAR; PG8_SCHED;
            PG8_LDB(B1, 0, 1); PG8_STAGE(PG8_SB(0, 0), b2, voffB);
            PG8_BAR; PG8_WAIT_L(0); PG8_MMA(0, 1, At, B1); PG8_BAR;
            PG8_LDA(At, 0, 1); PG8_STAGE(PG8_SA(0, 0), a2, voffA);
            PG8_BAR; PG8_WAIT_L(0); PG8_MMA(1, 0, At, B0); PG8_BAR; PG8_SCHED;
            PG8_STAGE(PG8_SB(0, 1), b2 + hstep, voffB);
            PG8_WAIT_V(6); PG8_BAR; PG8_MMA(1, 1, At, B1); PG8_BAR;
            PG8_LDB(B0, 1, 0); PG8_SCHED; PG8_LDA(At, 1, 0); PG8_STAGE(PG8_SA(0, 1), a2 + hstep, voffA);
            PG8_WAIT_L(8); PG8_BAR; PG8_WAIT_L(0); PG8_MMA(0, 0, At, B0); PG8_BAR; PG8_SCHED;
            PG8_LDB(B1, 1, 1); PG8_STAGE(PG8_SB(1, 0), b3, voffB);
            PG8_BAR; PG8_WAIT_L(0); PG8_MMA(0, 1, At, B1); PG8_BAR;
            PG8_LDA(At, 1, 1); PG8_STAGE(PG8_SA(1, 0), a3, voffA);
            PG8_BAR; PG8_WAIT_L(0); PG8_MMA(1, 0, At, B0); PG8_BAR; PG8_SCHED;
            PG8_STAGE(PG8_SB(1, 1), b3 + hstep, voffB);
            PG8_WAIT_V(6); PG8_BAR; PG8_MMA(1, 1, At, B1); PG8_BAR;
        }
        E(acc, cur, wr, wc, fr, fq);
        S.done(cur, lane);
        if (!has_next) break;
#pragma unroll
        for (int a = 0; a < 2; ++a)
#pragma unroll
            for (int b = 0; b < 2; ++b)
#pragma unroll
                for (int m = 0; m < 4; ++m)
#pragma unroll
                    for (int n = 0; n < 2; ++n) acc[a][b][m][n] = zero4();
        cur = nxt; cA = nA; cB = nB; ++ui;
    }
    PG8_WAIT_V(0);
    if (wr == 0) PG8_BAR;
    PG8_BAR;
#undef PG8_SA
#undef PG8_SB
#undef PG8_STAGE
#undef PG8_LDA
#undef PG8_LDB
#undef PG8_MMA
#undef PG8_WAIT_V
#undef PG8_WAIT_L
#undef PG8_BAR
#undef PG8_SCHED
}
}

struct EpiIn {
    static constexpr bool PERM = true;
    bf16_t* U; float* G; const float* SS; const float* bmi; const float* bmf;
    __device__ __forceinline__ void operator()(const f32x4 (&acc)[2][2][4][2], const pg8::Unit& u, int wr, int wc, int fr, int fq) const {
        const int row0 = u.pm * 256 + wr * 64 + fr;
        const int pn = u.pn;
        const int mode = ((pn >= 4 && pn < 8) || (pn >= 24 && pn < 28)) ? 1 : ((pn >= 20 && pn < 24) ? 2 : 0);
        f32x4 cur[4];
        { const f32x4* sp = (const f32x4*)(SS + (size_t)row0 * 16); cur[0] = sp[0]; cur[1] = sp[1]; cur[2] = sp[2]; cur[3] = sp[3]; }
#pragma unroll
        for (int r = 0; r < 8; ++r) {
            const int ai = r >> 2, m = r & 3;
            const int row = row0 + ai * 128 + m * 16;
            f32x4 nxt[4];
            if (r < 7) {
                const f32x4* sp = (const f32x4*)(SS + (size_t)(row0 + ((r + 1) >> 2) * 128 + ((r + 1) & 3) * 16) * 16);
                nxt[0] = sp[0]; nxt[1] = sp[1]; nxt[2] = sp[2]; nxt[3] = sp[3];
            }
            const float ss = ((cur[0][0] + cur[0][1]) + (cur[0][2] + cur[0][3])) + ((cur[1][0] + cur[1][1]) + (cur[1][2] + cur[1][3])) + ((cur[2][0] + cur[2][1]) + (cur[2][2] + cur[2][3])) + ((cur[3][0] + cur[3][1]) + (cur[3][2] + cur[3][3]));
            const float rstd = rsqrtf(ss * (1.0f / 1024.0f) + EPSF);
            if (pn < 28) {
                bf16_t* rowp = U + (size_t)row * NU + pn * 256 + wc * 32 + 8 * fq;
#pragma unroll
                for (int bj = 0; bj < 2; ++bj) {
                    f32x4 v0 = acc[ai][bj][m][0] * rstd, v1 = acc[ai][bj][m][1] * rstd;
                    if (mode == 1) {
#pragma unroll
                        for (int j = 0; j < 4; ++j) { v0[j] = siluf_(v0[j]); v1[j] = siluf_(v1[j]); }
                    } else if (mode == 2) {
#pragma unroll
                        for (int j = 0; j < 4; ++j) { v0[j] = sigmoidf_(v0[j]); v1[j] = sigmoidf_(v1[j]); }
                    }
                    u32x4 w; w.x = cvt_pk_bf16(v0[0], v0[1]); w.y = cvt_pk_bf16(v0[2], v0[3]); w.z = cvt_pk_bf16(v1[0], v1[1]); w.w = cvt_pk_bf16(v1[2], v1[3]);
                    *(u32x4*)(rowp + bj * 128) = w;
                }
            } else if (wc == 0 && fq == 0) {
                const f32x4 v0 = acc[ai][0][m][0] * rstd, v1 = acc[ai][0][m][1] * rstd;
                f32x4 gi, gf;
#pragma unroll
                for (int j = 0; j < 4; ++j) { gi[j] = v0[j] + bmi[j]; const float x = v1[j] + bmf[j]; gf[j] = fminf(x, 0.f) - log1pf(__expf(-fabsf(x))); }
                *(f32x4*)(G + (size_t)row * 8) = gi; *(f32x4*)(G + (size_t)row * 8 + 4) = gf;
            }
            if (r < 7) { cur[0] = nxt[0]; cur[1] = nxt[1]; cur[2] = nxt[2]; cur[3] = nxt[3]; }
        }
    }
};

struct EpiOut {
    static constexpr bool PERM = false;
    bf16_t* XBo; float* SSo;
    __device__ __forceinline__ void operator()(const f32x4 (&acc)[2][2][4][2], const pg8::Unit& u, int wr, int wc, int fr, int fq) const {
        const int row0 = u.pm * 256 + wr * 64 + fr, col0 = u.pn * 256 + wc * 32 + 4 * fq;
#pragma unroll
        for (int ai = 0; ai < 2; ++ai) {
            u32x2 bs[4][2][2];
#pragma unroll
            for (int m = 0; m < 4; ++m)
#pragma unroll
                for (int bj = 0; bj < 2; ++bj)
#pragma unroll
                    for (int n = 0; n < 2; ++n) bs[m][bj][n] = *(const u32x2*)(XBo + (size_t)(row0 + ai * 128 + m * 16) * DM + col0 + bj * 128 + n * 16);
#pragma unroll
            for (int m = 0; m < 4; ++m) {
                const int row = row0 + ai * 128 + m * 16;
                float ss = 0.f;
#pragma unroll
                for (int bj = 0; bj < 2; ++bj)
#pragma unroll
                    for (int n = 0; n < 2; ++n) {
                        const int c = col0 + bj * 128 + n * 16;
                        const u32x2 v = bs[m][bj][n];
                        const f32x4 o = (f32x4){lo16(v.x), hi16(v.x), lo16(v.y), hi16(v.y)} + acc[ai][bj][m][n];
                        u32x2 w; w.x = cvt_pk_bf16(o[0], o[1]); w.y = cvt_pk_bf16(o[2], o[3]); *(u32x2*)(XBo + (size_t)row * DM + c) = w;
                        ss += (o[0] * o[0] + o[1] * o[1]) + (o[2] * o[2] + o[3] * o[3]);
                    }
                ss += __shfl_xor(ss, 16); ss += __shfl_xor(ss, 32);
                if (fq == 0) SSo[(size_t)row * 16 + u.pn * 4 + wc] = ss;
            }
        }
    }
};

struct TileJob { const float* src; int ldn, nvalid, k0, n0; bf16_t* dst; int ldk; const float* sk; float sn; };
__device__ __forceinline__ void tile_job(const Params& p, int job, TileJob& t) {
    bf16_t* WT1 = (bf16_t*)(p.ws + WS_WT1); bf16_t* WT2 = (bf16_t*)(p.ws + WS_WT2); bf16_t* WGT = (bf16_t*)(p.ws + WS_WGT);
    constexpr int JA = 2 * 16 * 116, JB = 2 * 32 * 16;
    if (job < JA) {
        const int l = job / (16 * 116), r = job % (16 * 116), ntile = r / 16, kt = r % 16, n0 = ntile * 64;
        t.src = p.w_in + (size_t)l * DM * DIN; t.ldn = DIN; t.nvalid = DIN; t.k0 = kt * 64; t.n0 = n0; t.dst = WT1 + (size_t)l * NW1 * DM; t.ldk = DM; t.sk = p.g_norm + l * DM;
        t.sn = (n0 >= 3072 && n0 < 4096) ? 0.0625f : 1.0f;
    } else if (job < JA + JB) {
        const int j = job - JA, l = j / 512, r = j % 512, ntile = r / 32, kt = r % 32;
        t.src = p.w_out + (size_t)l * DMG * DM; t.ldn = DM; t.nvalid = DM; t.k0 = kt * 64; t.n0 = ntile * 64; t.dst = WT2 + (size_t)l * DM * DMG; t.ldk = DMG; t.sk = nullptr; t.sn = 1.0f;
    } else {
        const int j = job - JA - JB, l = j >> 5, gate = (j >> 4) & 1, blk = j & 15;
        t.src = (gate ? p.w_i : p.w_r) + (size_t)(l * 16 + blk) * 4096; t.ldn = 64; t.nvalid = 64; t.k0 = 0; t.n0 = 0; t.dst = WGT + (size_t)((l * 2 + gate) * 16 + blk) * 4096; t.ldk = 64; t.sk = nullptr; t.sn = 1.0f;
    }
}
__device__ __forceinline__ void tile_load(const TileJob& t, int tid, f32x4 (&v)[2], float (&sc)[2]) {
    const int r = tid >> 4, c4 = tid & 15;
#pragma unroll
    for (int i = 0; i < 2; ++i) {
        const int k = r + 32 * i, n = t.n0 + 4 * c4;
        v[i] = zero4();
        if (n + 3 < t.nvalid) v[i] = *(const f32x4*)(t.src + (size_t)(t.k0 + k) * t.ldn + n);
        sc[i] = (t.sk ? t.sk[t.k0 + k] : 1.0f) * t.sn;
    }
}
__device__ __forceinline__ void tile_finish(const TileJob& t, int tid, const f32x4 (&v)[2], const float (&sc)[2], LAS float* T) {
    {
        const int r = tid >> 4, c4 = tid & 15;
#pragma unroll
        for (int i = 0; i < 2; ++i) {
            const int k = r + 32 * i; const float s = sc[i];
            T[k * 65 + 4 * c4 + 0] = v[i][0] * s; T[k * 65 + 4 * c4 + 1] = v[i][1] * s; T[k * 65 + 4 * c4 + 2] = v[i][2] * s; T[k * 65 + 4 * c4 + 3] = v[i][3] * s;
        }
    }
    __syncthreads();
    {
        const int n = tid >> 3, kq = tid & 7;
        float f[8];
#pragma unroll
        for (int j = 0; j < 8; ++j) f[j] = T[(kq * 8 + j) * 65 + n];
        u32x4 w; w.x = cvt_pk_bf16(f[0], f[1]); w.y = cvt_pk_bf16(f[2], f[3]); w.z = cvt_pk_bf16(f[4], f[5]); w.w = cvt_pk_bf16(f[6], f[7]);
        *(u32x4*)(t.dst + (size_t)(t.n0 + n) * t.ldk + t.k0 + kq * 8) = w;
    }
    __syncthreads();
}

__device__ void phase_prep(const Params& p, LAS unsigned char* lds) {
    LAS float* T = (LAS float*)lds;
    bf16_t* XB = (bf16_t*)(p.ws + WS_XB); float* SS = (float*)(p.ws + WS_SS); bf16_t* MG = (bf16_t*)(p.ws + WS_MG);
    constexpr int NTILE = 2 * 16 * 116 + 2 * 32 * 16 + 64, JD = MR / 8;
    const int G = gridDim.x, tid = otid();
    {
        int job = blockIdx.x; TileJob cur; f32x4 v[2]; float sc[2];
        bool have = job < NTILE;
        if (have) { tile_job(p, job, cur); tile_load(cur, tid, v, sc); }
        while (have) {
            const int nj = job + G; const bool hn = nj < NTILE;
            TileJob nxt = cur; f32x4 vn[2]; float scn[2];
            vn[0] = v[0]; vn[1] = v[1]; scn[0] = sc[0]; scn[1] = sc[1];
            if (hn) { tile_job(p, nj, nxt); tile_load(nxt, tid, vn, scn); }
            tile_finish(cur, tid, v, sc, T);
            cur = nxt; v[0] = vn[0]; v[1] = vn[1]; sc[0] = scn[0]; sc[1] = scn[1]; job = nj; have = hn;
        }
    }
    for (int j = blockIdx.x; j < JD; j += G) {
        const int wid = tid >> 6, lane = tid & 63;
        const int row = j * 8 + wid;
        const float* src = row < MP ? p.xp + (size_t)row * DM : (row < MV ? p.xs + (size_t)(row - MP) * DM : nullptr);
        f32x4 v[4]; float ss = 0.f;
#pragma unroll
        for (int i = 0; i < 4; ++i) { v[i] = src ? *(const f32x4*)(src + lane * 16 + i * 4) : zero4(); ss += (v[i][0] * v[i][0] + v[i][1] * v[i][1]) + (v[i][2] * v[i][2] + v[i][3] * v[i][3]); }
#pragma unroll
        for (int o = 32; o >= 1; o >>= 1) ss += __shfl_xor(ss, o);
        u32x4 w0, w1;
        w0.x = cvt_pk_bf16(v[0][0], v[0][1]); w0.y = cvt_pk_bf16(v[0][2], v[0][3]); w0.z = cvt_pk_bf16(v[1][0], v[1][1]); w0.w = cvt_pk_bf16(v[1][2], v[1][3]);
        w1.x = cvt_pk_bf16(v[2][0], v[2][1]); w1.y = cvt_pk_bf16(v[2][2], v[2][3]); w1.z = cvt_pk_bf16(v[3][0], v[3][1]); w1.w = cvt_pk_bf16(v[3][2], v[3][3]);
        *(u32x4*)(XB + (size_t)row * DM + lane * 16) = w0; *(u32x4*)(XB + (size_t)row * DM + lane * 16 + 8) = w1;
        if (lane < 16) SS[(size_t)row * 16 + lane] = lane == 0 ? ss : 0.f;
        if (row >= MV) { const u32x4 z = (u32x4){0u, 0u, 0u, 0u}; u32x4* mp = (u32x4*)(MG + (size_t)row * DMG + lane * 32); mp[0] = z; mp[1] = z; mp[2] = z; mp[3] = z; }
    }
}

constexpr int M_QI = 0, M_KI = 38912, M_VI = 77824, M_CTI = 96256, M_SM = 130048;
constexpr int RS_QK = 304, RS_V = 144, RS_CT = 528;

template <int OFF0, int OFF1>
__device__ __forceinline__ bf16x8 tr_frag(unsigned base) {
    bf16x4 lo, hi;
    asm volatile("ds_read_b64_tr_b16 %0, %2 offset:%3\n\tds_read_b64_tr_b16 %1, %2 offset:%4\n\ts_waitcnt lgkmcnt(0)" : "=&v"(lo), "=&v"(hi) : "v"(base), "i"(OFF0), "i"(OFF1) : "memory");
    bf16x8 r; r[0] = lo[0]; r[1] = lo[1]; r[2] = lo[2]; r[3] = lo[3]; r[4] = hi[0]; r[5] = hi[1]; r[6] = hi[2]; r[7] = hi[3]; return r;
}

template <int O0, int O1, int HI>
__device__ __forceinline__ void tr_frag2(unsigned base, bf16x8& f0, bf16x8& f1) {
    bf16x4 a0, a1, b0, b1;
    asm volatile("ds_read_b64_tr_b16 %0, %4 offset:%5\n\tds_read_b64_tr_b16 %1, %4 offset:%6\n\tds_read_b64_tr_b16 %2, %4 offset:%7\n\tds_read_b64_tr_b16 %3, %4 offset:%8\n\ts_waitcnt lgkmcnt(0)"
                 : "=&v"(a0), "=&v"(a1), "=&v"(b0), "=&v"(b1) : "v"(base), "i"(O0), "i"(O0 + HI), "i"(O1), "i"(O1 + HI) : "memory");
    f0 = __builtin_shufflevector(a0, a1, 0, 1, 2, 3, 4, 5, 6, 7); f1 = __builtin_shufflevector(b0, b1, 0, 1, 2, 3, 4, 5, 6, 7);
}
template <int KS>
__device__ __forceinline__ void mlstm_D(f32x4 (&CT)[8], unsigned bvD, unsigned bkD) {
    const bf16x8 vdf = tr_frag<KS * 32 * RS_V, KS * 32 * RS_V + 4 * RS_V>(bvD);
    bf16x8 k0, k1;
    tr_frag2<KS * 32 * RS_QK + 0, KS * 32 * RS_QK + 32, 4 * RS_QK>(bkD, k0, k1);
    CT[0] = __builtin_amdgcn_mfma_f32_16x16x32_bf16(k0, vdf, CT[0], 0, 0, 0);
    CT[1] = __builtin_amdgcn_mfma_f32_16x16x32_bf16(k1, vdf, CT[1], 0, 0, 0);
    tr_frag2<KS * 32 * RS_QK + 64, KS * 32 * RS_QK + 96, 4 * RS_QK>(bkD, k0, k1);
    CT[2] = __builtin_amdgcn_mfma_f32_16x16x32_bf16(k0, vdf, CT[2], 0, 0, 0);
    CT[3] = __builtin_amdgcn_mfma_f32_16x16x32_bf16(k1, vdf, CT[3], 0, 0, 0);
    tr_frag2<KS * 32 * RS_QK + 128, KS * 32 * RS_QK + 160, 4 * RS_QK>(bkD, k0, k1);
    CT[4] = __builtin_amdgcn_mfma_f32_16x16x32_bf16(k0, vdf, CT[4], 0, 0, 0);
    CT[5] = __builtin_amdgcn_mfma_f32_16x16x32_bf16(k1, vdf, CT[5], 0, 0, 0);
    tr_frag2<KS * 32 * RS_QK + 192, KS * 32 * RS_QK + 224, 4 * RS_QK>(bkD, k0, k1);
    CT[6] = __builtin_amdgcn_mfma_f32_16x16x32_bf16(k0, vdf, CT[6], 0, 0, 0);
    CT[7] = __builtin_amdgcn_mfma_f32_16x16x32_bf16(k1, vdf, CT[7], 0, 0, 0);
}
template <int O, int STEP, int HI>
__device__ __forceinline__ void tr_frag4(unsigned base, bf16x8& f0, bf16x8& f1, bf16x8& f2, bf16x8& f3) {
    bf16x4 a0, a1, b0, b1, c0, c1, d0, d1;
    asm volatile("ds_read_b64_tr_b16 %0, %8 offset:%9\n\tds_read_b64_tr_b16 %1, %8 offset:%10\n\tds_read_b64_tr_b16 %2, %8 offset:%11\n\tds_read_b64_tr_b16 %3, %8 offset:%12\n\t"
                 "ds_read_b64_tr_b16 %4, %8 offset:%13\n\tds_read_b64_tr_b16 %5, %8 offset:%14\n\tds_read_b64_tr_b16 %6, %8 offset:%15\n\tds_read_b64_tr_b16 %7, %8 offset:%16\n\ts_waitcnt lgkmcnt(0)"
                 : "=&v"(a0), "=&v"(a1), "=&v"(b0), "=&v"(b1), "=&v"(c0), "=&v"(c1), "=&v"(d0), "=&v"(d1)
                 : "v"(base), "i"(O), "i"(O + HI), "i"(O + STEP), "i"(O + STEP + HI), "i"(O + 2 * STEP), "i"(O + 2 * STEP + HI), "i"(O + 3 * STEP), "i"(O + 3 * STEP + HI) : "memory");
    f0 = __builtin_shufflevector(a0, a1, 0, 1, 2, 3, 4, 5, 6, 7); f1 = __builtin_shufflevector(b0, b1, 0, 1, 2, 3, 4, 5, 6, 7);
    f2 = __builtin_shufflevector(c0, c1, 0, 1, 2, 3, 4, 5, 6, 7); f3 = __builtin_shufflevector(d0, d1, 0, 1, 2, 3, 4, 5, 6, 7);
}
template <int KS>
__device__ __forceinline__ void mlstm_B(f32x4 (&N1)[4], LAS unsigned char* lds, unsigned bvB, int t, int fq) {
    const bf16x8 pf = *(const LAS bf16x8*)(lds + M_QI + t * RS_QK + KS * 64 + fq * 16);
    bf16x8 v0, v1, v2, v3;
    tr_frag4<KS * 32 * RS_V, 32, 4 * RS_V>(bvB, v0, v1, v2, v3);
    N1[0] = __builtin_amdgcn_mfma_f32_16x16x32_bf16(v0, pf, N1[0], 0, 0, 0);
    N1[1] = __builtin_amdgcn_mfma_f32_16x16x32_bf16(v1, pf, N1[1], 0, 0, 0);
    N1[2] = __builtin_amdgcn_mfma_f32_16x16x32_bf16(v2, pf, N1[2], 0, 0, 0);
    N1[3] = __builtin_amdgcn_mfma_f32_16x16x32_bf16(v3, pf, N1[3], 0, 0, 0);
}

__device__ void mlstm_prompt(const Params& p, int l, int item, LAS unsigned char* lds) {
    const int tid0 = otid();
    const int js = item & 3, h = (item >> 2) & 3, b = item >> 4;
    const unsigned ldsb = (unsigned)(size_t)lds;
    LAS float* sm = (LAS float*)(lds + M_SM);
    LAS float* nbuf = sm + 512; LAS float* npart = sm + 1552;
    const bf16_t* U = (const bf16_t*)(p.ws + WS_U); const float* G = (const float*)(p.ws + WS_G);
    bf16_t* MG = (bf16_t*)(p.ws + WS_MG);
    const size_t grow_base = (size_t)b * 2048;
    const int qcol = 2048 + h * 256, kcol = 3072 + h * 256, vcol = 4096 + h * 256 + js * 64;

    __syncthreads();
    for (int i = tid0; i < RS_CT * 64 / 16; i += NT) *(LAS u32x4*)(lds + M_CTI + i * 16) = (u32x4){0u, 0u, 0u, 0u};
    nbuf[tid0] = 0.f;
    f32x4 CTacc[8];
#pragma unroll
    for (int i = 0; i < 8; ++i) CTacc[i] = zero4();
    float m_prev = 0.f;
    u32x4 qreg[4], kreg[4], vreg[2]; float igr[2] = {0.f, 0.f}, lfr[2] = {0.f, 0.f};

#define ML_LOAD_QK(row0_, hd_) do { _Pragma("unroll") for (int i_ = 0; i_ < 4; ++i_) { const int id_ = tid + NT * i_, r_ = id_ >> 4, cq_ = id_ & 15; \
        const bf16_t* rp_ = U + (grow_base + (row0_) + r_) * NU + (hd_) * 128 + cq_ * 8; qreg[i_] = *(const u32x4*)(rp_ + qcol); kreg[i_] = *(const u32x4*)(rp_ + kcol); } } while (0)
#define ML_STORE_QK() do { _Pragma("unroll") for (int i_ = 0; i_ < 4; ++i_) { const int id_ = tid + NT * i_, r_ = id_ >> 4, cq_ = id_ & 15; \
        *(LAS u32x4*)(lds + M_QI + r_ * RS_QK + cq_ * 16) = qreg[i_]; *(LAS u32x4*)(lds + M_KI + r_ * RS_QK + cq_ * 16) = kreg[i_]; } } while (0)
#define ML_LOAD_VG(row0_) do { _Pragma("unroll") for (int i_ = 0; i_ < 2; ++i_) { const int id_ = tid + NT * i_, s_ = id_ >> 3, cq_ = id_ & 7; \
        vreg[i_] = *(const u32x4*)(U + (grow_base + (row0_) + s_) * NU + vcol + cq_ * 8); } \
        if (w == 0) { const float* gp_ = G + (grow_base + (row0_) + 2 * lane) * 8 + h; igr[0] = gp_[0]; lfr[0] = gp_[4]; igr[1] = gp_[8]; lfr[1] = gp_[12]; } } while (0)

#define ML_PREPASS(buf_) do { if (w == 0) { LAS float* dec_ = sm + 128 * (buf_); LAS float* expnm_ = sm + 256 + 128 * (buf_); LAS float* scal_ = sm + 1024 + 8 * (buf_); \
            const float s2 = lfr[0] + lfr[1]; float incl = s2; \
            _Pragma("unroll") for (int o = 1; o < 64; o <<= 1) { const float t_ = __shfl_up(incl, o); if (lane >= o) incl += t_; } \
            const float b0 = incl - s2 + lfr[0], b1 = incl; \
            const float a0 = igr[0] - b0, a1 = igr[1] - b1; float im = fmaxf(a0, a1); \
            _Pragma("unroll") for (int o = 1; o < 64; o <<= 1) { const float t_ = __shfl_up(im, o); if (lane >= o) im = fmaxf(im, t_); } \
            float ex = __shfl_up(im, 1); if (lane == 0) ex = -INFINITY; \
            const float M0 = fmaxf(ex, a0), M1 = fmaxf(M0, a1); \
            const float mt1 = b1 + fmaxf(m_prev, M1); \
            const float bL = __shfl(b1, 63), mL = __shfl(mt1, 63); \
            expnm_[2 * lane] = __expf(bL - mL - b0); expnm_[2 * lane + 1] = __expf(bL - mL - b1); \
            dec_[2 * lane] = __expf(bL - b0 + igr[0] - mL); dec_[2 * lane + 1] = __expf(bL - b1 + igr[1] - mL); \
            if (lane == 0) { scal_[0] = __expf(bL + m_prev - mL); scal_[1] = mL; } \
            m_prev = mL; } } while (0)
    { const int tid = tid0, w = tid >> 6, lane = tid & 63; ML_LOAD_QK(0, 0); ML_LOAD_VG(0); ML_PREPASS(0); }
#pragma unroll 1
    for (int c = 0; c < 16; ++c) {
        int tid = tid0; asm volatile("" : "+v"(tid));
        const int w = __builtin_amdgcn_readfirstlane(tid >> 6), lane = tid & 63, fr = lane & 15, fq = lane >> 4;
        const int cD = w & 3, gD = w >> 2, qq = (lane & 15) >> 2, pp = lane & 3;
        const unsigned bvB = ldsb + M_VI + (8 * fq + qq) * RS_V + 8 * pp;
        const unsigned bvD = bvB + cD * 32;
        const int row0 = c * 128;
        LAS float* nC = nbuf + (c & 1) * 256; LAS float* nN = nbuf + ((c + 1) & 1) * 256;
        __syncthreads();
        ML_STORE_QK();
        LAS float* dec = sm + 128 * (c & 1); LAS float* expnm = sm + 256 + 128 * (c & 1); LAS float* scal = sm + 1024 + 8 * (c & 1);
        const float cs = scal[0];
#pragma unroll
        for (int i = 0; i < 2; ++i) {
            const int id = tid + NT * i, s = id >> 3, cq = id & 7; const float d = dec[s];
            u32x4 v = vreg[i], o;
            o.x = cvt_pk_bf16(lo16(v.x) * d, hi16(v.x) * d); o.y = cvt_pk_bf16(lo16(v.y) * d, hi16(v.y) * d);
            o.z = cvt_pk_bf16(lo16(v.z) * d, hi16(v.z) * d); o.w = cvt_pk_bf16(lo16(v.w) * d, hi16(v.w) * d);
            *(LAS u32x4*)(lds + M_VI + s * RS_V + cq * 16) = o;
        }
        if (tid < 256) nN[tid] = cs * nC[tid];
        ML_LOAD_QK(row0, 1);
        f32x4 Sacc[8], N2[4];
#pragma unroll
        for (int i = 0; i < 8; ++i) Sacc[i] = zero4();
#pragma unroll
        for (int i = 0; i < 4; ++i) N2[i] = zero4();
        float qnp = 0.f;
#pragma unroll 1
        for (int hd = 0; hd < 2; ++hd) {
            __syncthreads();
#pragma unroll
            for (int ks = 0; ks < 4; ++ks) {
                const bf16x8 qf = *(const LAS bf16x8*)(lds + M_QI + (16 * w + fr) * RS_QK + ks * 64 + fq * 16);
#pragma unroll
                for (int g = 0; g < 2; ++g) if (4 * g <= w) {
                    bf16x8 kf[4];
#pragma unroll
                    for (int e = 0; e < 4; ++e) kf[e] = *(const LAS bf16x8*)(lds + M_KI + (64 * g + 16 * e + fr) * RS_QK + ks * 64 + fq * 16);
#pragma unroll
                    for (int e = 0; e < 4; ++e) Sacc[4 * g + e] = __builtin_amdgcn_mfma_f32_16x16x32_bf16(kf[e], qf, Sacc[4 * g + e], 0, 0, 0);
                }
#pragma unroll
                for (int c4 = 0; c4 < 4; ++c4) {
                    const bf16x8 ctf = *(const LAS bf16x8*)(lds + M_CTI + (16 * c4 + fr) * RS_CT + hd * 256 + ks * 64 + fq * 16);
                    N2[c4] = __builtin_amdgcn_mfma_f32_16x16x32_bf16(ctf, qf, N2[c4], 0, 0, 0);
                }
                const LAS float* np = nC + hd * 128 + ks * 32 + fq * 8;
#pragma unroll
                for (int j = 0; j < 8; ++j) qnp += bf2f((unsigned short)qf[j]) * np[j];
                __builtin_amdgcn_sched_barrier(0);
            }
            if (gD == hd) {
                const unsigned bkD = ldsb + M_KI + (8 * fq + qq) * RS_QK + 8 * pp;
#pragma unroll
                for (int i = 0; i < 8; ++i) CTacc[i] *= cs;
                mlstm_D<0>(CTacc, bvD, bkD); __builtin_amdgcn_sched_barrier(0); mlstm_D<1>(CTacc, bvD, bkD); __builtin_amdgcn_sched_barrier(0); mlstm_D<2>(CTacc, bvD, bkD); __builtin_amdgcn_sched_barrier(0); mlstm_D<3>(CTacc, bvD, bkD); __builtin_amdgcn_sched_barrier(0);
            }
            if (gD != hd) {
                const int lidx = (w & 3) * 64 + lane, dk4 = lidx & 31, part = lidx >> 5; float a0 = 0.f, a1 = 0.f, a2 = 0.f, a3 = 0.f;
#pragma unroll 2
                for (int s = 16 * part; s < 16 * part + 16; ++s) {
                    const u32x2 kv = *(const LAS u32x2*)(lds + M_KI + s * RS_QK + dk4 * 8); const float d = dec[s];
                    a0 += d * lo16(kv.x); a1 += d * hi16(kv.x); a2 += d * lo16(kv.y); a3 += d * hi16(kv.y);
                }
                *(LAS f32x4*)(npart + part * 128 + 4 * dk4) = (f32x4){a0, a1, a2, a3};
            }
            __syncthreads();
            if (tid < 128) nN[hd * 128 + tid] += ((npart[tid] + npart[128 + tid]) + (npart[256 + tid] + npart[384 + tid])) + ((npart[512 + tid] + npart[640 + tid]) + (npart[768 + tid] + npart[896 + tid]));
            if (gD == hd) {
#pragma unroll
                for (int i = 0; i < 8; ++i) {
                    u32x2 wv; wv.x = cvt_pk_bf16(CTacc[i][0], CTacc[i][1]); wv.y = cvt_pk_bf16(CTacc[i][2], CTacc[i][3]);
                    *(LAS u32x2*)(lds + M_CTI + (16 * cD + fr) * RS_CT + (hd * 128 + 16 * i + 4 * fq) * 2) = wv;
                }
            }
            if (hd == 0) {
                ML_STORE_QK();
                if (c < 15) { ML_LOAD_QK(row0 + 128, 0); }
            }
        }
        if (c < 15) { ML_LOAD_VG(row0 + 128); }
        const int t = 16 * w + fr;
        float den1 = 0.f;
#pragma unroll
        for (int g = 0; g < 4; ++g) if (2 * g <= w) {
            const f32x4 dv0 = *(const LAS f32x4*)(dec + 32 * g + 4 * fq), dv1 = *(const LAS f32x4*)(dec + 32 * g + 16 + 4 * fq);
            f32x4 s0 = Sacc[2 * g], s1 = Sacc[2 * g + 1];
#pragma unroll
            for (int j = 0; j < 4; ++j) {
                const int sa = 32 * g + 4 * fq + j, sb = sa + 16;
                if (sa > t) s0[j] = 0.f;
                if (sb > t || 2 * g + 1 > w) s1[j] = 0.f;
                den1 += s0[j] * dv0[j] + s1[j] * dv1[j];
            }
            u32x2 w0, w1; w0.x = cvt_pk_bf16(s0[0], s0[1]); w0.y = cvt_pk_bf16(s0[2], s0[3]); w1.x = cvt_pk_bf16(s1[0], s1[1]); w1.y = cvt_pk_bf16(s1[2], s1[3]);
            *(LAS u32x2*)(lds + M_QI + t * RS_QK + (32 * g + 4 * fq) * 2) = w0;
            *(LAS u32x2*)(lds + M_QI + t * RS_QK + (32 * g + 16 + 4 * fq) * 2) = w1;
        }
        den1 += __shfl_xor(den1, 16); den1 += __shfl_xor(den1, 32);
        qnp += __shfl_xor(qnp, 16); qnp += __shfl_xor(qnp, 32);
#pragma unroll
        for (int i = 0; i < 4; ++i) N2[i] *= cs;
        if (0 <= (w >> 1)) mlstm_B<0>(N2, lds, bvB, t, fq);
        if (1 <= (w >> 1)) mlstm_B<1>(N2, lds, bvB, t, fq);
        if (2 <= (w >> 1)) mlstm_B<2>(N2, lds, bvB, t, fq);
        if (3 <= (w >> 1)) mlstm_B<3>(N2, lds, bvB, t, fq);
        {
            const float den = den1 + cs * qnp;
            const float inv = 1.0f / fmaxf(fabsf(den), expnm[t]);
            const size_t grow = grow_base + row0 + t;
#pragma unroll
            for (int c4 = 0; c4 < 4; ++c4) {
                const float y0 = N2[c4][0] * inv, y1 = N2[c4][1] * inv, y2 = N2[c4][2] * inv, y3 = N2[c4][3] * inv;
                u32x2 wv; wv.x = cvt_pk_bf16(y0, y1); wv.y = cvt_pk_bf16(y2, y3);
                *(u32x2*)(MG + grow * DMG + 1024 + h * 256 + js * 64 + 16 * c4 + 4 * fq) = wv;
            }
        }
        if (c < 15) ML_PREPASS((c + 1) & 1);
    }
    __syncthreads();
    {
        const int tid = tid0, w = tid >> 6, lane = tid & 63, fr = lane & 15, fq = lane >> 4, cD = w & 3, gD = w >> 2;
        float* pC = p.out + O_PC + ((size_t)((l * 8 + b) * 4 + h)) * 65536;
#pragma unroll
        for (int i = 0; i < 8; ++i)
#pragma unroll
            for (int j = 0; j < 4; ++j) pC[(size_t)(gD * 128 + 16 * i + 4 * fq + j) * 256 + js * 64 + 16 * cD + fr] = CTacc[i][j];
        if (js == 0) {
            if (tid < 256) p.out[O_PN + ((size_t)((l * 8 + b) * 4 + h)) * 256 + tid] = nbuf[tid];
            if (tid == 0) p.out[O_PM + (l * 8 + b) * 4 + h] = sm[1024 + 8 + 1];
        }
    }
    __syncthreads();
#undef ML_LOAD_QK
#undef ML_STORE_QK
#undef ML_LOAD_VG
#undef ML_PREPASS
}

constexpr int R_XAI = 0, R_XCF = 16768, R_XCB = 49536, R_AA = 67968, R_UU = 100736, R_PT = 133504, R_HC = 137600, R_CW = 138112, R_CH = 139392, R_WG = 140160;
__device__ void rglru_item(const Params& p, int l, int b, int cb, bool decm, LAS unsigned char* lds) {
    const int tid = otid(), w = __builtin_amdgcn_readfirstlane(tid >> 6), lane = tid & 63, fr = lane & 15, fq = lane >> 4;
    const bf16_t* U = (const bf16_t*)(p.ws + WS_U); bf16_t* MG = (bf16_t*)(p.ws + WS_MG);
    const bf16_t* WGT = (const bf16_t*)(p.ws + WS_WGT);
    LAS float* XCF = (LAS float*)(lds + R_XCF); LAS float* AA = (LAS float*)(lds + R_AA); LAS float* UU = (LAS float*)(lds + R_UU);
    LAS float* PT = (LAS float*)(lds + R_PT); LAS float* HC = (LAS float*)(lds + R_HC); LAS float* CW = (LAS float*)(lds + R_CW); LAS float* CH = (LAS float*)(lds + R_CH);
    const int ch0 = cb * 64;
    const size_t grow_base = decm ? (size_t)MP : (size_t)b * 2048;
    const int nchunk = decm ? 1 : 16;
    __syncthreads();
    if (tid < 64) {
        const int ch = ch0 + tid;
#pragma unroll
        for (int j = 0; j < 4; ++j) CW[j * 64 + tid] = p.conv_w[(size_t)(l * 4 + j) * 1024 + ch];
        CW[256 + tid] = p.conv_b[l * 1024 + ch];
        CH[tid] = p.b_r[l * 1024 + ch]; CH[64 + tid] = p.b_i[l * 1024 + ch]; CH[128 + tid] = 8.0f * softplusf_(-p.lam[l * 1024 + ch]);
        HC[tid] = 0.f; HC[64 + tid] = 0.f;
    }
    if (tid < 24) *(LAS u32x4*)(lds + R_XAI + tid * 16) = (u32x4){0u, 0u, 0u, 0u};
#pragma unroll
    for (int i = 0; i < 2; ++i) {
        const int id = tid + NT * i, g = id >> 9, r = (id >> 3) & 63, cq = id & 7;
        *(LAS u32x4*)(lds + R_WG + (g * 64 + r) * 144 + cq * 16) = *(const u32x4*)(WGT + (size_t)((l * 2 + g) * 16 + cb) * 4096 + r * 64 + cq * 8);
    }
    u32x4 xreg[2], zreg[2];
#pragma unroll
    for (int i = 0; i < 2; ++i) { const int id = tid + NT * i, r = id >> 3, cq = id & 7; const bf16_t* rp = U + (grow_base + r) * NU + ch0 + cq * 8; xreg[i] = *(const u32x4*)rp; zreg[i] = *(const u32x4*)(rp + 1024); }
    for (int c = 0; c < nchunk; ++c) {
        const int row0 = c * 128;
        __syncthreads();
        if (c > 0) {
#pragma unroll
            for (int i = 0; i < 2; ++i) { const int id = tid + NT * i, r = id >> 3, cq = id & 7; *(u32x4*)(MG + (grow_base + row0 - 128 + r) * DMG + ch0 + cq * 8) = *(const LAS u32x4*)(lds + R_XCF + r * 128 + cq * 16); }
        }
        u32x4 zcur[2];
#pragma unroll
        for (int i = 0; i < 2; ++i) { const int id = tid + NT * i, r = id >> 3, cq = id & 7; *(LAS u32x4*)(lds + R_XAI + (3 + r) * 128 + cq * 16) = xreg[i]; zcur[i] = zreg[i]; }
        if (c + 1 < nchunk) {
#pragma unroll
            for (int i = 0; i < 2; ++i) { const int id = tid + NT * i, r = id >> 3, cq = id & 7; const bf16_t* rp = U + (grow_base + row0 + 128 + r) * NU + ch0 + cq * 8; xreg[i] = *(const u32x4*)rp; zreg[i] = *(const u32x4*)(rp + 1024); }
        }
        __syncthreads();
        {
            const int t = tid >> 2, c0 = (tid & 3) * 16;
            float xc[16];
#pragma unroll
            for (int k = 0; k < 16; ++k) xc[k] = CW[256 + c0 + k];
            if (!decm) {
#pragma unroll
                for (int j = 0; j < 4; ++j) {
                    const u32x4 a = *(const LAS u32x4*)(lds + R_XAI + (t + j) * 128 + c0 * 2), bq = *(const LAS u32x4*)(lds + R_XAI + (t + j) * 128 + c0 * 2 + 16);
                    const unsigned wv[8] = {a.x, a.y, a.z, a.w, bq.x, bq.y, bq.z, bq.w};
#pragma unroll
                    for (int k = 0; k < 8; ++k) { xc[2 * k] += CW[j * 64 + c0 + 2 * k] * lo16(wv[k]); xc[2 * k + 1] += CW[j * 64 + c0 + 2 * k + 1] * hi16(wv[k]); }
                }
            } else {
                const float* stp = p.st_conv + ((size_t)(l * 128 + t) * 3) * 1024 + ch0 + c0;
                float* so = p.out + O_SCONV + ((size_t)(l * 128 + t) * 3) * 1024 + ch0 + c0;
#pragma unroll
                for (int j = 0; j < 3; ++j)
#pragma unroll
                    for (int k4 = 0; k4 < 4; ++k4) {
                        const f32x4 sv = *(const f32x4*)(stp + (size_t)j * 1024 + k4 * 4);
#pragma unroll
                        for (int e = 0; e < 4; ++e) xc[k4 * 4 + e] += CW[j * 64 + c0 + k4 * 4 + e] * sv[e];
                        if (j >= 1) *(f32x4*)(so + (size_t)(j - 1) * 1024 + k4 * 4) = sv;
                    }
                const u32x4 a = *(const LAS u32x4*)(lds + R_XAI + (t + 3) * 128 + c0 * 2), bq = *(const LAS u32x4*)(lds + R_XAI + (t + 3) * 128 + c0 * 2 + 16);
                const unsigned wv[8] = {a.x, a.y, a.z, a.w, bq.x, bq.y, bq.z, bq.w};
#pragma unroll
                for (int k = 0; k < 8; ++k) {
                    const float x0 = lo16(wv[k]), x1 = hi16(wv[k]);
                    xc[2 * k] += CW[3 * 64 + c0 + 2 * k] * x0; xc[2 * k + 1] += CW[3 * 64 + c0 + 2 * k + 1] * x1;
                    so[2 * 1024 + 2 * k] = x0; so[2 * 1024 + 2 * k + 1] = x1;
                }
            }
#pragma unroll
            for (int k4 = 0; k4 < 4; ++k4) *(LAS f32x4*)(XCF + t * 64 + c0 + k4 * 4) = (f32x4){xc[k4 * 4], xc[k4 * 4 + 1], xc[k4 * 4 + 2], xc[k4 * 4 + 3]};
            u32x4 o0, o1;
            o0.x = cvt_pk_bf16(xc[0], xc[1]); o0.y = cvt_pk_bf16(xc[2], xc[3]); o0.z = cvt_pk_bf16(xc[4], xc[5]); o0.w = cvt_pk_bf16(xc[6], xc[7]);
            o1.x = cvt_pk_bf16(xc[8], xc[9]); o1.y = cvt_pk_bf16(xc[10], xc[11]); o1.z = cvt_pk_bf16(xc[12], xc[13]); o1.w = cvt_pk_bf16(xc[14], xc[15]);
            *(LAS u32x4*)(lds + R_XCB + t * 144 + c0 * 2) = o0; *(LAS u32x4*)(lds + R_XCB + t * 144 + c0 * 2 + 16) = o1;
        }
        __syncthreads();
        if (!decm && tid < 24) { const u32x4 v = *(const LAS u32x4*)(lds + R_XAI + 128 * 128 + tid * 16); *(LAS u32x4*)(lds + R_XAI + tid * 16) = v; }
        {
            bf16x8 xf[2];
#pragma unroll
            for (int ks = 0; ks < 2; ++ks) xf[ks] = *(const LAS bf16x8*)(lds + R_XCB + (16 * w + fr) * 144 + ks * 64 + fq * 16);
            const int t = 16 * w + fr;
#pragma unroll
            for (int c4 = 0; c4 < 4; ++c4) {
                f32x4 ar = zero4(), ai = ar;
#pragma unroll
                for (int ks = 0; ks < 2; ++ks) {
                    const bf16x8 wfr = *(const LAS bf16x8*)(lds + R_WG + (16 * c4 + fr) * 144 + ks * 64 + fq * 16);
                    const bf16x8 wfi = *(const LAS bf16x8*)(lds + R_WG + (64 + 16 * c4 + fr) * 144 + ks * 64 + fq * 16);
                    ar = __builtin_amdgcn_mfma_f32_16x16x32_bf16(wfr, xf[ks], ar, 0, 0, 0); ai = __builtin_amdgcn_mfma_f32_16x16x32_bf16(wfi, xf[ks], ai, 0, 0, 0); }
                const int d = 16 * c4 + 4 * fq;
                const f32x4 xcv = *(const LAS f32x4*)(XCF + t * 64 + d);
                f32x4 av, uv;
#pragma unroll
                for (int j = 0; j < 4; ++j) {
                    const float r = sigmoidf_(ar[j] + CH[d + j]), ig = sigmoidf_(ai[j] + CH[64 + d + j]);
                    const float la = -r * CH[128 + d + j];
                    const float x2 = 2.0f * la;
                    const float ser = -x2 * (1.0f + x2 * (0.5f + x2 * (0.16666667f + x2 * (0.041666668f + x2 * (0.0083333338f + x2 * 0.0013888889f)))));
                    const float om = x2 > -0.3f ? ser : 1.0f - __expf(x2);
                    av[j] = __expf(la); uv[j] = __builtin_amdgcn_sqrtf(om) * (ig * xcv[j]);
                }
                if (!decm) { *(LAS f32x4*)(AA + t * 64 + d) = av; *(LAS f32x4*)(UU + t * 64 + d) = uv; }
                else {
                    const f32x4 h0 = *(const f32x4*)(p.st_h + (size_t)(l * 128 + t) * 1024 + ch0 + d);
                    const f32x4 hn = av * h0 + uv;
                    *(f32x4*)(p.out + O_SH + (size_t)(l * 128 + t) * 1024 + ch0 + d) = hn;
                    const u32x2 zv = *(const u32x2*)(U + (grow_base + t) * NU + 1024 + ch0 + d);
                    u32x2 wv; wv.x = cvt_pk_bf16(hn[0] * lo16(zv.x), hn[1] * hi16(zv.x)); wv.y = cvt_pk_bf16(hn[2] * lo16(zv.y), hn[3] * hi16(zv.y));
                    *(u32x2*)(MG + (grow_base + t) * DMG + ch0 + d) = wv;
                }
            }
        }
        if (decm) break;
        __syncthreads();
#pragma unroll
        for (int i = 0; i < 2; ++i) { const int id = tid + NT * i, r = id >> 3, cq = id & 7; *(LAS u32x4*)(lds + R_XCB + r * 144 + cq * 16) = zcur[i]; }
        const int ch = tid & 63, part = tid >> 6;
        float av[16], uv[16];
#pragma unroll
        for (int k = 0; k < 16; ++k) { av[k] = AA[(part * 16 + k) * 64 + ch]; uv[k] = UU[(part * 16 + k) * 64 + ch]; }
        {
            float hh = 0.f, Ac = 1.f;
#pragma unroll
            for (int k = 0; k < 16; ++k) { hh = av[k] * hh + uv[k]; Ac *= av[k]; uv[k] = hh; av[k] = Ac; }
            PT[(part * 64 + ch) * 2] = Ac; PT[(part * 64 + ch) * 2 + 1] = hh;
        }
        __syncthreads();
        {
            float zv[16];
#pragma unroll
            for (int k = 0; k < 16; ++k) zv[k] = bf2f(*(const LAS unsigned short*)(lds + R_XCB + (part * 16 + k) * 144 + ch * 2));
            float hin = HC[(c & 1) * 64 + ch];
            for (int q = 0; q < part; ++q) hin = PT[(q * 64 + ch) * 2] * hin + PT[(q * 64 + ch) * 2 + 1];
            float hf = hin;
#pragma unroll
            for (int k = 0; k < 16; ++k) {
                hf = av[k] * hin + uv[k];
                const float y = hf * zv[k];
                *(LAS unsigned short*)(lds + R_XCF + (part * 16 + k) * 128 + ch * 2) = (unsigned short)(cvt_pk_bf16(y, y) & 0xffffu);
            }
            if (part == 7) {
                HC[((c + 1) & 1) * 64 + ch] = hf;
                if (c == 15) p.out[O_PH + (size_t)(l * 8 + b) * 1024 + ch0 + ch] = hf;
            }
        }
        if (c == 15 && tid < 192) {
            const int j = tid >> 6, cc = tid & 63;
            p.out[O_PCONV + ((size_t)(l * 8 + b) * 3 + j) * 1024 + ch0 + cc] = bf2f(*(const LAS unsigned short*)(lds + R_XAI + j * 128 + cc * 2));
        }
    }
    __syncthreads();
    if (!decm) {
#pragma unroll
        for (int i = 0; i < 2; ++i) { const int id = tid + NT * i, r = id >> 3, cq = id & 7; *(u32x4*)(MG + (grow_base + 15 * 128 + r) * DMG + ch0 + cq * 8) = *(const LAS u32x4*)(lds + R_XCF + r * 128 + cq * 16); }
    }
    __syncthreads();
}

__device__ void mlstm_decode(const Params& p, int l, int b, int h, LAS unsigned char* lds) {
    const int tid = otid(), lane = tid & 63;
    const bf16_t* U = (const bf16_t*)(p.ws + WS_U); const float* G = (const float*)(p.ws + WS_G);
    bf16_t* MG = (bf16_t*)(p.ws + WS_MG);
    LAS float* qs = (LAS float*)lds; LAS float* ks = qs + 256; LAS float* vs = qs + 512; LAS float* ns = qs + 768; LAS float* red = qs + 1024; LAS float* red2 = qs + 1024 + 2048;
    const size_t row = (size_t)MP + b;
    const size_t sidx = (size_t)((l * 128 + b) * 4 + h);
    __syncthreads();
    if (tid < 256) {
        qs[tid] = bf2f(U[row * NU + 2048 + h * 256 + tid]); ks[tid] = bf2f(U[row * NU + 3072 + h * 256 + tid]); vs[tid] = bf2f(U[row * NU + 4096 + h * 256 + tid]);
        ns[tid] = p.st_n[sidx * 256 + tid];
    }
    const float ig = G[row * 8 + h], lf = G[row * 8 + 4 + h], m0 = p.st_m[sidx];
    __syncthreads();
    float qk = 0.f, qn = 0.f;
#pragma unroll
    for (int j = 0; j < 4; ++j) { const float qv = qs[lane * 4 + j]; qk += qv * ks[lane * 4 + j]; qn += qv * ns[lane * 4 + j]; }
#pragma unroll
    for (int o = 32; o >= 1; o >>= 1) { qk += __shfl_xor(qk, o); qn += __shfl_xor(qn, o); }
    const float mt = fmaxf(lf + m0, ig), wg = __expf(ig - mt), gi = __expf(lf + m0 - mt);
    const int dvq = tid & 63, dkg = tid >> 6;
    float o_pre = 0.f, zg_pre = 0.f;
    if (tid < 256) { o_pre = bf2f(U[row * NU + 5120 + h * 256 + tid]); zg_pre = p.g_mhead[l * 1024 + h * 256 + tid] * bf2f(U[row * NU + 6144 + h * 256 + tid]); }
    const float* C0 = p.st_C + sidx * 65536; float* C1 = p.out + O_SC + sidx * 65536;
    const f32x4 v4 = *(const LAS f32x4*)(vs + dvq * 4);
    f32x4 qc = zero4();
#pragma unroll 1
    for (int i0 = 0; i0 < 32; i0 += 16) {
        f32x4 cv[16];
#pragma unroll
        for (int j = 0; j < 16; ++j) cv[j] = __builtin_nontemporal_load((const f32x4*)(C0 + (size_t)(dkg * 32 + i0 + j) * 256 + dvq * 4));
#pragma unroll
        for (int j = 0; j < 16; ++j) {
            const int dk = dkg * 32 + i0 + j;
            const float qv = qs[dk], kv = wg * ks[dk];
            qc += qv * cv[j];
            const f32x4 cn = gi * cv[j] + kv * v4;
            __builtin_nontemporal_store(cn, (f32x4*)(C1 + (size_t)dk * 256 + dvq * 4));
        }
    }
    *(LAS f32x4*)(red + dkg * 256 + dvq * 4) = qc;
    __syncthreads();
    float yv = 0.f;
    if (tid < 256) {
        float qcv = 0.f;
#pragma unroll
        for (int g = 0; g < 8; ++g) qcv += red[g * 256 + tid];
        const float num = wg * qk * vs[tid] + gi * qcv, den = wg * qk + gi * qn;
        const float hh = num / fmaxf(fabsf(den), __expf(-mt));
        yv = hh * o_pre;
        float ss = yv * yv;
#pragma unroll
        for (int o = 32; o >= 1; o >>= 1) ss += __shfl_xor(ss, o);
        if (lane == 0) red2[tid >> 6] = ss;
        p.out[O_SN + sidx * 256 + tid] = gi * ns[tid] + wg * ks[tid];
    }
    __syncthreads();
    if (tid < 256) {
        const float rstd = rsqrtf(((red2[0] + red2[1]) + (red2[2] + red2[3])) * (1.0f / 256.0f) + EPSF);
        const float ov = yv * rstd * zg_pre;
        MG[row * DMG + 1024 + h * 256 + tid] = (bf16_t)(cvt_pk_bf16(ov, ov) & 0xffffu);
    }
    if (tid == 0) p.out[O_SM + sidx] = mt;
}

__device__ void decode_items(const Params& p, int l, LAS unsigned char* lds, int max_items) {
    unsigned* ctr = (unsigned*)(p.ws + WS_BAR) + 3584 + 64 * l;
    volatile LAS unsigned* slot = (volatile LAS unsigned*)(lds + LDS_BYTES - 32);
    for (int n = 0; n < max_items; ++n) {
        __syncthreads();
        if (threadIdx.x == 0) *slot = __hip_atomic_fetch_add(ctr, 1u, __ATOMIC_RELAXED, __HIP_MEMORY_SCOPE_AGENT);
        __syncthreads();
        const int item = (int)*slot;
        if (item >= 512) break;
        mlstm_decode(p, l, item >> 2, item & 3, lds);
    }
}

__device__ void phase_mixers(const Params& p, int l, LAS unsigned char* lds) {
    const int G = gridDim.x, bid = obid();
    const bool split = G >= 256;
    const int r = split ? bid - 128 : bid, R = split ? G - 128 : G;
    if (!split || bid < 128) { for (int item = bid; item < 128; item += (split ? 128 : G)) mlstm_prompt(p, l, item, lds); }
    if (r >= 0) {
        for (int item = r; item < 128; item += R) rglru_item(p, l, item >> 4, item & 15, false, lds);
        for (int item = r; item < 16; item += R) rglru_item(p, l, 0, item, true, lds);
    }
    decode_items(p, l, lds, 1 << 30);
}

__device__ void phase_headnorm(const Params& p, int l) {
    const bf16_t* U = (const bf16_t*)(p.ws + WS_U); bf16_t* MG = (bf16_t*)(p.ws + WS_MG);
    const float* gm = p.g_mhead + l * 1024;
    const int G = gridDim.x, bid = obid();
    const int b0 = G > 8 ? bid - 4 : bid, GG = G > 8 ? G - 4 : G;
    if (b0 < 0) return;
    for (size_t idx = (size_t)b0 * NT + otid(); idx < (size_t)MP * 128; idx += (size_t)GG * NT) {
        const size_t row = idx >> 7; const int col = (int)(idx & 127) * 8;
        const u32x4 hv = *(const u32x4*)(MG + row * DMG + 1024 + col);
        const u32x4 ov = *(const u32x4*)(U + row * NU + 5120 + col);
        const u32x4 zv = *(const u32x4*)(U + row * NU + 6144 + col);
        float y[8];
        y[0] = lo16(hv.x) * lo16(ov.x); y[1] = hi16(hv.x) * hi16(ov.x); y[2] = lo16(hv.y) * lo16(ov.y); y[3] = hi16(hv.y) * hi16(ov.y);
        y[4] = lo16(hv.z) * lo16(ov.z); y[5] = hi16(hv.z) * hi16(ov.z); y[6] = lo16(hv.w) * lo16(ov.w); y[7] = hi16(hv.w) * hi16(ov.w);
        float ss = ((y[0] * y[0] + y[1] * y[1]) + (y[2] * y[2] + y[3] * y[3])) + ((y[4] * y[4] + y[5] * y[5]) + (y[6] * y[6] + y[7] * y[7]));
#pragma unroll
        for (int o = 1; o < 32; o <<= 1) ss += __shfl_xor(ss, o);
        const float rstd = rsqrtf(ss * (1.0f / 256.0f) + EPSF);
        const f32x4 g0 = *(const f32x4*)(gm + col), g1 = *(const f32x4*)(gm + col + 4);
        u32x4 o;
        o.x = cvt_pk_bf16(y[0] * rstd * g0[0] * lo16(zv.x), y[1] * rstd * g0[1] * hi16(zv.x));
        o.y = cvt_pk_bf16(y[2] * rstd * g0[2] * lo16(zv.y), y[3] * rstd * g0[3] * hi16(zv.y));
        o.z = cvt_pk_bf16(y[4] * rstd * g1[0] * lo16(zv.z), y[5] * rstd * g1[1] * hi16(zv.z));
        o.w = cvt_pk_bf16(y[6] * rstd * g1[2] * lo16(zv.w), y[7] * rstd * g1[3] * hi16(zv.w));
        *(u32x4*)(MG + row * DMG + 1024 + col) = o;
    }
}

__device__ void phase_final(const Params& p) {
    const bf16_t* XB = (const bf16_t*)(p.ws + WS_XB); const float* SS = (const float*)(p.ws + WS_SS);
    const int tidf = otid(); const int wid = tidf >> 6, lane = tidf & 63;
    for (int row = blockIdx.x * 8 + wid; row < MV; row += gridDim.x * 8) {
        const f32x4* sp = (const f32x4*)(SS + (size_t)row * 16);
        const f32x4 s0 = sp[0], s1 = sp[1], s2 = sp[2], s3 = sp[3];
        const float ss = ((s0[0] + s0[1]) + (s0[2] + s0[3])) + ((s1[0] + s1[1]) + (s1[2] + s1[3])) + ((s2[0] + s2[1]) + (s2[2] + s2[3])) + ((s3[0] + s3[1]) + (s3[2] + s3[3]));
        const float rstd = rsqrtf(ss * (1.0f / 1024.0f) + EPSF);
        float* op = row < MP ? p.out + O_YP + (size_t)row * DM : p.out + O_YS + (size_t)(row - MP) * DM;
#pragma unroll
        for (int i = 0; i < 2; ++i) {
            const int c = i * 512 + lane * 8;
            const u32x4 xv = *(const u32x4*)(XB + (size_t)row * DM + c);
            const f32x4 g0 = *(const f32x4*)(p.g_final + c), g1 = *(const f32x4*)(p.g_final + c + 4);
            *(f32x4*)(op + c) = (f32x4){lo16(xv.x) * rstd * g0[0], hi16(xv.x) * rstd * g0[1], lo16(xv.y) * rstd * g0[2], hi16(xv.y) * rstd * g0[3]};
            *(f32x4*)(op + c + 4) = (f32x4){lo16(xv.z) * rstd * g1[0], hi16(xv.z) * rstd * g1[1], lo16(xv.w) * rstd * g1[2], hi16(xv.w) * rstd * g1[3]};
        }
    }
}

#define XB_XCNT(j) (64 * (j))
#define XB_XSUB(j) (1024 + 64 * (j))
#define XB_XGEN(j) (2048 + 64 * (j))
#define XB_TOP 3072
#define XB_TOPGEN 3136
__device__ __forceinline__ unsigned xb_ld(unsigned* p) { return __hip_atomic_load(p, __ATOMIC_RELAXED, __HIP_MEMORY_SCOPE_AGENT); }
__device__ __forceinline__ unsigned xb_add(unsigned* p, unsigned v) { return __hip_atomic_fetch_add(p, v, __ATOMIC_RELAXED, __HIP_MEMORY_SCOPE_AGENT); }
__device__ __forceinline__ unsigned xb_xcc_id() { return (unsigned)__builtin_amdgcn_s_getreg((3 << 11) | 20) & 0xFu; }
#define XB_SPIN(cond) do { unsigned sp_ = 0; while (cond) { __builtin_amdgcn_s_sleep(1); if (++sp_ > (1u << 24)) break; } } while (0)
__device__ __forceinline__ void gbar(unsigned* bar, volatile LAS unsigned* st) {
    asm volatile("s_waitcnt vmcnt(0) lgkmcnt(0)" ::: "memory");
    __syncthreads();
    if (threadIdx.x == 0) {
        const unsigned x = xb_xcc_id(), nloc = st[0], nx = st[1];
        const unsigned old = xb_add(&bar[XB_XSUB(x)], 1u);
        const unsigned gen = old / nloc;
        if (old + 1u == (gen + 1u) * nloc) {
            __builtin_amdgcn_fence(__ATOMIC_RELEASE, "agent");
            asm volatile("s_waitcnt vmcnt(0)" ::: "memory");
            const unsigned og = xb_add(&bar[XB_TOP], 1u);
            const unsigned tg = og / nx;
            if (og + 1u == (tg + 1u) * nx) xb_add(&bar[XB_TOPGEN], 1u);
            else XB_SPIN(xb_ld(&bar[XB_TOPGEN]) == tg);
            __builtin_amdgcn_fence(__ATOMIC_ACQUIRE, "agent");
            xb_add(&bar[XB_XGEN(x)], 1u);
            asm volatile("s_waitcnt vmcnt(0)" ::: "memory");
        } else {
            XB_SPIN(xb_ld(&bar[XB_XGEN(x)]) == gen);
            __builtin_amdgcn_fence(__ATOMIC_ACQUIRE, "agent");
            asm volatile("s_waitcnt vmcnt(0)" ::: "memory");
        }
    }
    __syncthreads();
}

__global__ void __launch_bounds__(NT, 2) hymba_fwd(Params p) {
    extern __shared__ __attribute__((aligned(16))) unsigned char lds_raw[];
    LAS unsigned char* lds = (LAS unsigned char*)lds_raw;
    cg::grid_group grid = cg::this_grid();
    bf16_t* XB = (bf16_t*)(p.ws + WS_XB); bf16_t* U = (bf16_t*)(p.ws + WS_U); float* G = (float*)(p.ws + WS_G); bf16_t* MG = (bf16_t*)(p.ws + WS_MG);
    float* SS = (float*)(p.ws + WS_SS);
    unsigned* bar = (unsigned*)(p.ws + WS_BAR);
    volatile LAS unsigned* st = (volatile LAS unsigned*)(lds + LDS_BYTES - 16);
    if (threadIdx.x == 0) (void)xb_add(&bar[XB_XCNT(xb_xcc_id())], 1u);
    if (p.out == nullptr) grid.sync();
    phase_prep(p, lds);
    if (threadIdx.x == 0) {
        const unsigned x = xb_xcc_id(), Gn = gridDim.x; unsigned mine = 1u, cnt = 1u, sp = 0u;
        for (;;) {
            unsigned sum = 0u; cnt = 0u;
            for (unsigned j = 0; j < 16; ++j) { const unsigned c = xb_ld(&bar[XB_XCNT(j)]); sum += c; cnt += c > 0u ? 1u : 0u; if (j == x) mine = c; }
            if (sum == Gn || ++sp > (1u << 22)) break;
            __builtin_amdgcn_s_sleep(1);
        }
        st[0] = mine > 0u ? mine : 1u; st[1] = cnt > 0u ? cnt : 1u;
    }
    __syncthreads();
    gbar(bar, st);
    for (int l = 0; l < 2; ++l) {
        {
            pg8::Gemm g; g.A = XB; g.Bt = (const bf16_t*)(p.ws + WS_WT1) + (size_t)l * NW1 * DM; g.M = MR; g.N = NW1; g.K = DM;
            unsigned* dctr = bar + 3712 + 64 * l;
            pg8::InOrder so; so.G = gridDim.x; so.c = obid(); so.done_ctr = dctr;
            EpiIn e; e.U = U; e.G = G; e.SS = SS; e.bmi = p.b_mi + l * 4; e.bmf = p.b_mf + l * 4;
            pg8::gemm_phase<EpiIn, pg8::InOrder, DM>(lds, g, so, e);
            const int Gn = gridDim.x, maxu = (pg8::IN_UNITS + Gn - 1) / Gn, mine = (pg8::IN_UNITS - so.c + Gn - 1) / Gn;
            if (mine < maxu) {
                if (threadIdx.x == 0) {
                    unsigned sp = 0u;
                    while (__hip_atomic_load(dctr, __ATOMIC_RELAXED, __HIP_MEMORY_SCOPE_AGENT) < 8u * pg8::IN_DEC_UNITS) { __builtin_amdgcn_s_sleep(2); if (++sp > (1u << 24)) break; }
                    __builtin_amdgcn_fence(__ATOMIC_ACQUIRE, "agent");
                    asm volatile("s_waitcnt vmcnt(0)" ::: "memory");
                }
                __syncthreads();
                decode_items(p, l, lds, 2);
            }
        }
        gbar(bar, st);
        phase_mixers(p, l, lds);
        gbar(bar, st);
        for (int pass = 0; pass < 2; ++pass) {
            if (pass == 0) phase_headnorm(p, l);
            pg8::Gemm g; g.A = MG; g.Bt = (const bf16_t*)(p.ws + WS_WT2) + (size_t)l * DM * DMG; g.M = MR; g.N = DM; g.K = DMG;
            pg8::OutOrder so; so.G = gridDim.x; so.c = obid(); so.mode = pass;
            EpiOut e; e.XBo = XB; e.SSo = SS;
            pg8::gemm_phase<EpiOut, pg8::OutOrder, DMG>(lds, g, so, e);
            gbar(bar, st);
        }
    }
    phase_final(p);
}

extern "C" void kernel_launch(void* const* d_in, const int* in_sizes, int n_in, void* d_out, int out_size, void* d_ws, size_t ws_size, hipStream_t stream) {
    static int grid_blocks = 0;
    if (!grid_blocks) {
        int dev = 0, cus = 0, per_cu = 0;
        hipGetDevice(&dev);
        hipDeviceGetAttribute(&cus, hipDeviceAttributeMultiprocessorCount, dev);
        hipFuncSetAttribute((const void*)hymba_fwd, hipFuncAttributeMaxDynamicSharedMemorySize, LDS_BYTES);
        hipOccupancyMaxActiveBlocksPerMultiprocessor(&per_cu, (const void*)hymba_fwd, NT, LDS_BYTES);
        if (per_cu < 1) per_cu = 1;
        grid_blocks = cus * per_cu;
        (void)hipGetLastError();
    }
    if (ws_size < WS_END) { fprintf(stderr, "workspace too small: %zu < %zu\n", ws_size, (size_t)WS_END); return; }
    Params p{};
    p.xp = (const float*)d_in[0]; p.xs = (const float*)d_in[1]; p.st_h = (const float*)d_in[2]; p.st_conv = (const float*)d_in[3];
    p.st_C = (const float*)d_in[4]; p.st_n = (const float*)d_in[5]; p.st_m = (const float*)d_in[6]; p.g_norm = (const float*)d_in[7];
    p.w_in = (const float*)d_in[8]; p.conv_w = (const float*)d_in[9]; p.conv_b = (const float*)d_in[10]; p.w_r = (const float*)d_in[11];
    p.b_r = (const float*)d_in[12]; p.w_i = (const float*)d_in[13]; p.b_i = (const float*)d_in[14]; p.lam = (const float*)d_in[15];
    p.b_mi = (const float*)d_in[16]; p.b_mf = (const float*)d_in[17]; p.g_mhead = (const float*)d_in[18]; p.w_out = (const float*)d_in[19];
    p.g_final = (const float*)d_in[20];
    p.out = (float*)d_out; p.ws = (unsigned char*)d_ws;
    (void)hipMemsetAsync((unsigned char*)d_ws + WS_BAR, 0, 16384, stream);
    void* args[] = {&p};
    hipError_t e = hipLaunchCooperativeKernel((const void*)hymba_fwd, dim3(grid_blocks), dim3(NT), args, LDS_BYTES, stream);
    if (e != hipSuccess) fprintf(stderr, "cooperative launch failed: %s (grid %d)\n", hipGetErrorString(e), grid_blocks);
}
```
